# Optimizing an MI355X kernel written in HIP

```python
import functools
import jax, jax.numpy as jnp
from jax import lax
import numpy as np

D_MODEL = 1024
BATCH = 16
SEQ = 2048
DEPTH = 1
DEC_BATCH = 32
DEC_SEQ = 8
PAST_LEN = 16384
PAGE_SIZE = 128

D_MIX = D_MODEL
HD_A = 64
H_A = (D_MIX // 2) // HD_A
PATTERNS = ((128, 1), (512, 4), (2048, 16))
MAX_WINDOW = max(w for w, _ in PATTERNS)
WIN_BUF = min(MAX_WINDOW, PAST_LEN)
H_B = 4
DV_B = (D_MIX - H_A * HD_A) // H_B
DK_B = DV_B // 2
GATE_RANK = 16
GLA_TAU = 16.0
CHUNK = 16
D_FF = 11 * D_MODEL // 4
CONV_W = 3
EPS = 1e-6
NEG = -1e30
SPLITS = (H_A * HD_A, H_A * HD_A, H_A * HD_A, H_B * DK_B, H_B * DK_B, H_B * DV_B, H_B * DV_B, GATE_RANK)
D_IN = sum(SPLITS)

kernel_name = "hymba_dilated_gla_convffn_step"


def rmsnorm(x, g):
    xf = x.astype(jnp.float32)
    y = xf * lax.rsqrt(jnp.mean(xf * xf, axis=-1, keepdims=True) + EPS)
    return (y * g.astype(jnp.float32)).astype(x.dtype)


def dilated_prompt(q, k, v, window, dil):
    B, S, H, E = q.shape
    n = window // dil
    span = n * dil
    Sp = -(-S // span) * span
    nb = Sp // span

    def to_blocks(t):
        t = jnp.pad(t.astype(jnp.float32), ((0, 0), (0, Sp - S), (0, 0), (0, 0)))
        t = t.reshape(B, nb, n, dil, H, E)
        return t.transpose(0, 3, 4, 1, 2, 5)

    def with_prev(t):
        prev = jnp.pad(t, ((0, 0), (0, 0), (0, 0), (1, 0), (0, 0), (0, 0)))[:, :, :, :-1]
        return jnp.concatenate([prev, t], axis=4)

    qb, kb, vb = to_blocks(q), to_blocks(k), to_blocks(v)
    kk, vv = with_prev(kb), with_prev(vb)
    s = jnp.einsum('brhcie,brhcje->brhcij', qb, kk) * (E ** -0.5)
    i = jnp.arange(n)[:, None]
    j = jnp.arange(2 * n)[None, :]
    delta = n + i - j
    band = (delta >= 0) & (delta <= n)
    first = (jnp.arange(nb) == 0)[:, None, None] & (j < n)[None]
    mask = band[None] & ~first
    s = jnp.where(mask, s, NEG)
    lse = jax.nn.logsumexp(s, axis=-1)
    p = jnp.exp(s - lse[..., None])
    o = jnp.einsum('brhcij,brhcje->brhcie', p, vv)
    o = o.transpose(0, 3, 4, 1, 2, 5).reshape(B, Sp, H, E)[:, :S]
    lse = lse.transpose(0, 3, 4, 1, 2).reshape(B, Sp, H)[:, :S]
    return o, lse


def dilated_sample(q, kc, vc, window, dil, lb):
    B, T, H, E = q.shape
    n = window // dil
    idx = lb + jnp.arange(T)[:, None] - dil * jnp.arange(n + 1)[None, :]
    valid = idx >= 0
    idxc = jnp.maximum(idx, 0).reshape(-1)
    kg = jnp.take(kc, idxc, axis=1).reshape(B, T, n + 1, H, E).astype(jnp.float32)
    vg = jnp.take(vc, idxc, axis=1).reshape(B, T, n + 1, H, E).astype(jnp.float32)
    s = jnp.einsum('bthe,btjhe->bhtj', q.astype(jnp.float32), kg) * (E ** -0.5)
    s = jnp.where(valid[None, None], s, NEG)
    lse = jax.nn.logsumexp(s, axis=-1)
    p = jnp.exp(s - lse[..., None])
    o = jnp.einsum('bhtj,btjhe->bthe', p, vg)
    return o, lse.transpose(0, 2, 1)


def combine_patterns(results):
    outs = jnp.stack([o for o, _ in results], axis=0)
    lses = jnp.stack([l for _, l in results], axis=0)
    w = jax.nn.softmax(lses, axis=0)
    return jnp.sum(w[..., None] * outs, axis=0)


def prompt_attn(q, k, v):
    return combine_patterns([dilated_prompt(q, k, v, w, d) for w, d in PATTERNS])


def sample_attn(q, k, v, ck, cv):
    kc = jnp.concatenate([ck.astype(k.dtype), k], axis=1)
    vc = jnp.concatenate([cv.astype(v.dtype), v], axis=1)
    lb = ck.shape[1]
    return combine_patterns([dilated_sample(q, kc, vc, w, d, lb) for w, d in PATTERNS])


def gla_recurrent(q, k, v, logf, s0):
    B, T, H, DK = q.shape
    Tp = -(-T // CHUNK) * CHUNK
    nC = Tp // CHUNK

    def chunks(t):
        t = jnp.pad(t.astype(jnp.float32), ((0, 0), (0, Tp - T), (0, 0), (0, 0)))
        return t.reshape(B, nC, CHUNK, H, t.shape[-1]).transpose(1, 0, 3, 2, 4)

    qc = chunks(q * (DK ** -0.5))
    kc, vc, gc = chunks(k), chunks(v), chunks(logf)
    causal = jnp.tril(jnp.ones((CHUNK, CHUNK), dtype=bool))

    def step(S, inp):
        qi, ki, vi, gi = inp
        b = jnp.cumsum(gi, axis=2)
        qe = qi * jnp.exp(b)
        ke = ki * jnp.exp(-b)
        att = jnp.where(causal, jnp.einsum('bhik,bhjk->bhij', qe, ke), 0.0)
        o = jnp.einsum('bhij,bhjv->bhiv', att, vi) + jnp.einsum('bhik,bhkv->bhiv', qe, S)
        bl = b[:, :, -1:, :]
        S = jnp.exp(bl[:, :, 0, :])[..., None] * S + jnp.einsum('bhjk,bhjv->bhkv', ki * jnp.exp(bl - b), vi)
        return S, o

    S, o = lax.scan(step, s0.astype(jnp.float32), (qc, kc, vc, gc))
    o = o.transpose(1, 0, 3, 2, 4).reshape(B, Tp, H, -1)[:, :T]
    return o, S


def conv_ffn(xn, conv_buf, w_up, conv_w, conv_b, w_down):
    T = xn.shape[1]
    up = xn @ w_up
    g, u = jnp.split(up, 2, axis=-1)
    gp = jnp.concatenate([conv_buf.astype(g.dtype), g], axis=1)
    c = conv_b + sum(conv_w[j] * gp[:, j:j + T] for j in range(CONV_W))
    h = jax.nn.gelu(c, approximate=False) * u
    return h @ w_down, gp[:, T:]


def layer(x, attn_fn, s_gla, conv_buf, w_in, w_a2, b_a, g_gla_norm, w_o,
          g_pre_mix, g_post_mix, g_pre_ffn, g_post_ffn, w_up, conv_w, conv_b, w_down):
    B, T, _ = x.shape
    xn = rmsnorm(x, g_pre_mix)
    proj = xn @ w_in
    split_idx = [int(i) for i in np.cumsum(SPLITS)[:-1]]
    q_a, k_a, v_a, q_b, k_b, v_b, r_b, a_lr = jnp.split(proj, split_idx, axis=-1)
    heads = lambda t, h: t.reshape(B, T, h, -1)
    q_a, k_a, v_a = heads(q_a, H_A), heads(k_a, H_A), heads(v_a, H_A)
    o_a = attn_fn(q_a, k_a, v_a)
    logf = jax.nn.log_sigmoid((a_lr @ w_a2 + b_a).astype(jnp.float32)) / GLA_TAU
    o_b, s_new = gla_recurrent(heads(q_b, H_B), heads(k_b, H_B), heads(v_b, H_B), heads(logf, H_B), s_gla)
    o_b = rmsnorm(o_b, g_gla_norm) * jax.nn.silu(heads(r_b, H_B).astype(jnp.float32))
    mixed = jnp.concatenate([o_a.reshape(B, T, -1), o_b.reshape(B, T, -1)], axis=-1).astype(x.dtype) @ w_o
    x = x + rmsnorm(mixed, g_post_mix)
    f, conv_new = conv_ffn(rmsnorm(x, g_pre_ffn), conv_buf, w_up, conv_w, conv_b, w_down)
    x = x + rmsnorm(f, g_post_ffn)
    return x, k_a, v_a, s_new, conv_new


def setup_inputs(seed: int = 0) -> dict:
    key = jax.random.key(seed)
    ks = jax.random.split(key, 20)
    nrm = lambda k, shape, scale: jax.random.normal(k, shape, jnp.float32) * scale
    return {
        "x_prompt": nrm(ks[0], (BATCH, SEQ, D_MODEL), 1.0),
        "x_sample": nrm(ks[1], (DEC_BATCH, DEC_SEQ, D_MODEL), 1.0),
        "cache_k_win": nrm(ks[2], (DEPTH, DEC_BATCH, WIN_BUF, H_A, HD_A), 1.0),
        "cache_v_win": nrm(ks[3], (DEPTH, DEC_BATCH, WIN_BUF, H_A, HD_A), 1.0),
        "state_gla": nrm(ks[4], (DEPTH, DEC_BATCH, H_B, DK_B, DV_B), 1.0),
        "state_ffn_conv": nrm(ks[5], (DEPTH, DEC_BATCH, CONV_W - 1, D_FF), 1.0),
        "w_in": nrm(ks[6], (DEPTH, D_MODEL, D_IN), D_MODEL ** -0.5),
        "w_a2": nrm(ks[7], (DEPTH, GATE_RANK, H_B * DK_B), GATE_RANK ** -0.5),
        "b_a": 2.0 + nrm(ks[8], (DEPTH, H_B * DK_B), 0.5),
        "g_gla_norm": 1.0 + nrm(ks[9], (DEPTH, H_B, DV_B), 0.05),
        "w_o": nrm(ks[10], (DEPTH, D_MIX, D_MODEL), D_MIX ** -0.5),
        "g_pre_mix": 1.0 + nrm(ks[11], (DEPTH, D_MODEL), 0.05),
        "g_post_mix": 1.0 + nrm(ks[12], (DEPTH, D_MODEL), 0.05),
        "g_pre_ffn": 1.0 + nrm(ks[13], (DEPTH, D_MODEL), 0.05),
        "g_post_ffn": 1.0 + nrm(ks[14], (DEPTH, D_MODEL), 0.05),
        "w_up": nrm(ks[15], (DEPTH, D_MODEL, 2 * D_FF), D_MODEL ** -0.5),
        "conv_w": nrm(ks[16], (DEPTH, CONV_W, D_FF), CONV_W ** -0.5),
        "conv_b": nrm(ks[17], (DEPTH, D_FF), 0.02),
        "w_down": nrm(ks[18], (DEPTH, D_FF, D_MODEL), D_FF ** -0.5),
    }


def reference(x_prompt, x_sample, cache_k_win, cache_v_win, state_gla, state_ffn_conv,
              w_in, w_a2, b_a, g_gla_norm, w_o, g_pre_mix, g_post_mix, g_pre_ffn, g_post_ffn,
              w_up, conv_w, conv_b, w_down):
    xp, xs = x_prompt, x_sample
    Bp, Sp_len, _ = x_prompt.shape
    prompt_buf = min(MAX_WINDOW, Sp_len)
    kp_l, vp_l, sp_l, cp_l = [], [], [], []
    ks_l, vs_l, ss_l, cs_l = [], [], [], []
    for l in range(DEPTH):
        params = (w_in[l], w_a2[l], b_a[l], g_gla_norm[l], w_o[l], g_pre_mix[l], g_post_mix[l],
                  g_pre_ffn[l], g_post_ffn[l], w_up[l], conv_w[l], conv_b[l], w_down[l])
        s0 = jnp.zeros((Bp, H_B, DK_B, DV_B), jnp.float32)
        c0 = jnp.zeros((Bp, CONV_W - 1, D_FF), xp.dtype)
        xp, k_a, v_a, s_new, c_new = layer(xp, prompt_attn, s0, c0, *params)
        kp_l.append(k_a[:, Sp_len - prompt_buf:])
        vp_l.append(v_a[:, Sp_len - prompt_buf:])
        sp_l.append(s_new)
        cp_l.append(c_new)
        attn_s = functools.partial(sample_attn, ck=cache_k_win[l], cv=cache_v_win[l])
        xs, k_a, v_a, s_new, c_new = layer(xs, attn_s, state_gla[l], state_ffn_conv[l], *params)
        ks_l.append(k_a)
        vs_l.append(v_a)
        ss_l.append(s_new)
        cs_l.append(c_new)
    return (xp, xs,
            jnp.stack(kp_l), jnp.stack(vp_l), jnp.stack(sp_l), jnp.stack(cp_l),
            jnp.stack(ks_l), jnp.stack(vs_l), jnp.stack(ss_l), jnp.stack(cs_l))
```

```cpp
#include <hip/hip_runtime.h>
#include <hip/hip_cooperative_groups.h>
#include <cstdio>
#include <cstdint>
namespace cg = cooperative_groups;

#define LAS __attribute__((address_space(3)))
#define GAS __attribute__((address_space(1)))
typedef unsigned short bf16_t;
typedef short bf16x8 __attribute__((ext_vector_type(8)));
typedef short s16x4 __attribute__((ext_vector_type(4)));
typedef float f32x4 __attribute__((ext_vector_type(4)));
typedef float f32x2 __attribute__((ext_vector_type(2)));
typedef float f32x16 __attribute__((ext_vector_type(16)));
typedef unsigned u32x4 __attribute__((ext_vector_type(4)));
typedef unsigned u32x2 __attribute__((ext_vector_type(2)));

constexpr int DM = 1024, NPB = 16, SEQ = 2048, NSB = 32, NST = 8;
constexpr int MP = NPB * SEQ;
constexpr int MS = NSB * NST;
constexpr int MT = MP + MS;
constexpr int NIN = 3328;
constexpr int DIN = 3088;
constexpr int DFF = 2816;
constexpr int WINB = 2048;
constexpr float EPS = 1e-6f;
constexpr float QSCALE = 0.125f * 1.4426950408889634f;

constexpr size_t MiB = 1u << 20;
constexpr size_t WS_CTL = 0, CTL_BYTES = 65536;
constexpr int XBST_OFF = 131072 + 8192;
constexpr size_t WS_WIN = 1 * MiB, WS_WO = 8 * MiB, WS_WUP = 10 * MiB, WS_WD = 22 * MiB;
constexpr size_t WS_SSQ1 = 28 * MiB, WS_SSQ2 = 31 * MiB;
constexpr size_t WS_XN = 34 * MiB;
constexpr size_t WS_MO = 104 * MiB;
constexpr size_t WS_QA = 172 * MiB, WS_KA = 206 * MiB, WS_VA = 240 * MiB, WS_QB = 274 * MiB, WS_KB = 291 * MiB, WS_VB = 308 * MiB, WS_RB = 342 * MiB, WS_LF = 376 * MiB, WS_MIX = 410 * MiB;
constexpr size_t WS_H = 172 * MiB;
constexpr size_t WS_ACC1 = 478 * MiB, WS_ACC2 = 482 * MiB;
constexpr size_t WS_END = 494 * MiB;
static_assert(WS_H + (size_t)MT * DFF * 2 <= WS_MIX, "h overlay");
static_assert(WS_XN + 4096 + (size_t)(131 * 254 + 260) * DM * 2 <= WS_MO, "xn2");

constexpr size_t O_YP = 0, O_YS = O_YP + (size_t)MP * DM, O_KP = O_YS + (size_t)MS * DM, O_VP = O_KP + (size_t)MP * 512, O_GP = O_VP + (size_t)MP * 512,
                 O_CP = O_GP + (size_t)NPB * 4 * 64 * 128, O_KS = O_CP + (size_t)NPB * 2 * DFF, O_VS = O_KS + (size_t)MS * 512, O_GS = O_VS + (size_t)MS * 512,
                 O_CS = O_GS + (size_t)NSB * 4 * 64 * 128, O_END = O_CS + (size_t)NSB * 2 * DFF;

__device__ __forceinline__ unsigned cvt_pk_bf16(float lo, float hi) { unsigned r; asm volatile("v_cvt_pk_bf16_f32 %0, %1, %2" : "=v"(r) : "v"(lo), "v"(hi)); return r; }
__device__ __forceinline__ float bf2f(unsigned short b) { return __uint_as_float((unsigned)b << 16); }
__device__ __forceinline__ float wave_sum(float v) {
#pragma unroll
    for (int o = 1; o < 64; o <<= 1) v += __shfl_xor(v, o);
    return v;
}

__device__ __forceinline__ int lane_id_v() { int l; asm volatile("v_mbcnt_lo_u32_b32 %0, -1, 0\n\tv_mbcnt_hi_u32_b32 %0, -1, %0" : "=v"(l)); return l; }

struct Args {
    const float* in[19];
    float* out;
    unsigned char* ws;
};

namespace pg8 {
constexpr int BM = 256, BK = 64, HALF = 128, HTB = HALF * BK * 2, STAGE_BYTES = 8 * HTB, NXCD = 8, WGM = 8;
__host__ __device__ __forceinline__ int lds_byte(int r, int c) { const int st = (r >> 4) * 2 + (c >> 5), rr = r & 15, cc = c & 31, ob = rr * 64 + cc * 2; return st * 1024 + (ob ^ (((ob >> 9) & 1) << 5)); }
__host__ __device__ __forceinline__ void stage_rc(int b, int& R, int& C) { const int st = b / 1024, sb = b % 1024, swz = sb ^ (((sb >> 9) & 1) << 5); R = (st >> 1) * 16 + swz / 64; C = (st & 1) * 32 + (swz % 64) / 2; }
__host__ __device__ __forceinline__ int perm32(int rho) { const int n = rho >> 4, i = rho & 15; return 8 * (i >> 2) + 4 * n + (i & 3); }

struct Unit { int pm, pn, kofs; };
struct Gemm { const bf16_t* A; const bf16_t* Bt; int K; int a_rows; int ldk; };

struct StaticOrder {
    int nM, nN, nwg, G, c;
    __device__ void init(int nM_, int nN_, int G_, int c_) { nM = nM_; nN = nN_; nwg = nM * nN; G = G_; c = c_; }
    __device__ bool next(int i, Unit& u) const {
        const long L = (long)i * G + c; if (L >= nwg) return false;
        int wgid = (int)L; { const int q = nwg / NXCD, r = nwg % NXCD, xcd = wgid % NXCD, off = wgid / NXCD; wgid = (xcd < r ? xcd * (q + 1) : r * (q + 1) + (xcd - r) * q) + off; }
        const int nig = WGM * nN, gid = wgid / nig, fm = gid * WGM, gsz = (nM - fm) < WGM ? (nM - fm) : WGM;
        u.pm = fm + ((wgid % nig) % gsz); u.pn = (wgid % nig) / gsz; u.kofs = 0; return true;
    }
};
struct SplitOrder {
    int nsub, G, c, pm, ksub;
    __device__ bool next(int i, Unit& u) const { const int L = i * G + c; if (L >= nsub) return false; u.pm = pm; u.pn = L & 3; u.kofs = (L >> 2) * ksub; return true; }
};

__device__ __forceinline__ f32x2 gelu_pk(f32x2 v) {
    const f32x2 av = __builtin_elementwise_abs(v), d = av * 0.2316418882f + 1.0f;
    f32x2 t; t.x = __builtin_amdgcn_rcpf(d.x); t.y = __builtin_amdgcn_rcpf(d.y);
    f32x2 q = t * 0.5307027145f + (-0.7265760135f); q = q * t + 0.7107068705f; q = q * t + (-0.142248368f); q = q * t + 0.127414796f; q = q * t;
    const f32x2 s = (v * v) * (-0.72134752044f);
    f32x2 e; e.x = __builtin_amdgcn_exp2f(s.x); e.y = __builtin_amdgcn_exp2f(s.y);
    const f32x2 m = v * (q * e), r = v - m;
    f32x2 o; o.x = v.x < 0.f ? m.x : r.x; o.y = v.y < 0.f ? m.y : r.y; return o;
}

template <class Epi, class Sched>
__device__ __forceinline__ void gemm_phase(LAS unsigned char* lds, const Gemm g, const Sched& S, const Epi& E, int wid) {
    const int lane = lane_id_v(); const int tid = wid * 64 + lane;
    const int wr = wid >> 2, wc = wid & 3, fr = lane & 15, fq = lane >> 4;
    const int K = g.ldk, nt = g.K / BK;
    unsigned voffA[2], voffB[2];
#pragma unroll
    for (int i = 0; i < 2; ++i) { int R, C; stage_rc(tid * 16 + i * 8192, R, C); const int Rb = Epi::PERM ? ((R & ~31) + perm32(R & 31)) : R;
        voffA[i] = (unsigned)(R * K + C) * 2u; voffB[i] = (unsigned)(Rb * K + C) * 2u; }
    const size_t kstep = (size_t)(BK * 2);
    const size_t hstep = (size_t)HALF * K * 2;
    const size_t tstepB = 2 * hstep;
    const size_t tstepA = (size_t)g.a_rows * K * 2;
    const unsigned ldsw = (unsigned)wid * 1024u;
    const int aoff = lds_byte(wr * 64 + fr, fq * 8), boff = lds_byte(wc * 32 + fr, fq * 8);
#define PG8_SA(b, h) (((b) * 2 + (h)) * HTB)
#define PG8_SB(b, h) ((4 + (b) * 2 + (h)) * HTB)
#define PG8_STAGE(bufoff, gbase, voff) do { _Pragma("unroll") for (int _i = 0; _i < 2; ++_i) \
        __builtin_amdgcn_global_load_lds((const unsigned*)((const char*)(gbase) + (voff)[_i]), (LAS unsigned*)(lds + (bufoff) + ldsw + _i * 8192), 16, 0, 0); } while (0)
#define PG8_LDA(dst, b, h) do { _Pragma("unroll") for (int m = 0; m < 4; ++m) _Pragma("unroll") for (int k = 0; k < 2; ++k) dst[m][k] = *(const LAS bf16x8*)(lds + PG8_SA(b, h) + aoff + m * 2048 + k * 1024); } while (0)
#define PG8_LDB(dst, b, h) do { _Pragma("unroll") for (int n = 0; n < 2; ++n) _Pragma("unroll") for (int k = 0; k < 2; ++k) dst[n][k] = *(const LAS bf16x8*)(lds + PG8_SB(b, h) + boff + n * 2048 + k * 1024); } while (0)
#define PG8_MMA(ai, bj, At, Bt) do { __builtin_amdgcn_s_setprio(1); _Pragma("unroll") for (int m = 0; m < 4; ++m) _Pragma("unroll") for (int n = 0; n < 2; ++n) _Pragma("unroll") for (int k = 0; k < 2; ++k) \
        acc[ai][bj][m][n] = __builtin_amdgcn_mfma_f32_16x16x32_bf16(Bt[n][k], At[m][k], acc[ai][bj][m][n], 0, 0, 0); __builtin_amdgcn_s_setprio(0); } while (0)
#define PG8_WAIT_V(n) asm volatile("s_waitcnt vmcnt(" #n ")" ::: "memory")
#define PG8_WAIT_L(n) asm volatile("s_waitcnt lgkmcnt(" #n ")" ::: "memory")
#define PG8_BAR __builtin_amdgcn_s_barrier()
#define PG8_SCHED __builtin_amdgcn_sched_barrier(0)
    Unit cur, nxt; int ui = 0;
    if (!S.next(0, cur)) return;
    f32x4 acc[2][2][4][2];
#pragma unroll
    for (int a = 0; a < 2; ++a)
#pragma unroll
        for (int b = 0; b < 2; ++b)
#pragma unroll
            for (int m = 0; m < 4; ++m)
#pragma unroll
                for (int n = 0; n < 2; ++n) acc[a][b][m][n] = (f32x4){0.f, 0.f, 0.f, 0.f};
    bf16x8 At[4][2], B0[2][2], B1[2][2];
    const char* cA = (const char*)g.A + (size_t)cur.pm * tstepA + (size_t)cur.kofs * 2; const char* cB = (const char*)g.Bt + (size_t)cur.pn * tstepB + (size_t)cur.kofs * 2;
    PG8_STAGE(PG8_SB(0, 0), cB, voffB); PG8_STAGE(PG8_SB(0, 1), cB + hstep, voffB); PG8_STAGE(PG8_SA(0, 0), cA, voffA); PG8_STAGE(PG8_SA(0, 1), cA + hstep, voffA);
    if (wr == 1) PG8_BAR;
    PG8_WAIT_V(2); PG8_BAR;
    PG8_STAGE(PG8_SB(1, 0), cB + kstep, voffB); PG8_STAGE(PG8_SA(1, 0), cA + kstep, voffA); PG8_STAGE(PG8_SB(1, 1), cB + hstep + kstep, voffB);
    PG8_WAIT_V(6); PG8_BAR;
    for (;;) {
        const bool has_next = S.next(ui + 1, nxt);
        const char* nA = has_next ? (const char*)g.A + (size_t)nxt.pm * tstepA + (size_t)nxt.kofs * 2 : cA; const char* nB = has_next ? (const char*)g.Bt + (size_t)nxt.pn * tstepB + (size_t)nxt.kofs * 2 : cB;
        for (int t = 0; t < nt; t += 2) {
            const bool last = (t == nt - 2);
            const char* a1 = cA + (size_t)(t + 1) * kstep;
            const char* a2 = last ? nA : cA + (size_t)(t + 2) * kstep; const char* b2 = last ? nB : cB + (size_t)(t + 2) * kstep;
            const char* a3 = a2 + kstep; const char* b3 = b2 + kstep;
            PG8_LDB(B0, 0, 0); PG8_LDB(B1, 0, 1); PG8_SCHED; PG8_LDA(At, 0, 0); PG8_STAGE(PG8_SA(1, 1), a1 + hstep, voffA);
            PG8_WAIT_V(8); PG8_WAIT_L(0); PG8_BAR; PG8_MMA(0, 0, At, B0); PG8_MMA(0, 1, At, B1); PG8_BAR; PG8_SCHED;
            PG8_LDA(At, 0, 1); PG8_STAGE(PG8_SB(0, 0), b2, voffB); PG8_STAGE(PG8_SB(0, 1), b2 + hstep, voffB); PG8_STAGE(PG8_SA(0, 0), a2, voffA);
            PG8_WAIT_V(8); PG8_WAIT_L(0); PG8_BAR; PG8_MMA(1, 0, At, B0); PG8_MMA(1, 1, At, B1); PG8_BAR; PG8_SCHED;
            PG8_LDB(B0, 1, 0); PG8_LDB(B1, 1, 1); PG8_SCHED; PG8_LDA(At, 1, 0); PG8_STAGE(PG8_SA(0, 1), a2 + hstep, voffA);
            PG8_WAIT_V(8); PG8_WAIT_L(0); PG8_BAR; PG8_MMA(0, 0, At, B0); PG8_MMA(0, 1, At, B1); PG8_BAR; PG8_SCHED;
            PG8_LDA(At, 1, 1); PG8_STAGE(PG8_SB(1, 0), b3, voffB); PG8_STAGE(PG8_SB(1, 1), b3 + hstep, voffB); PG8_STAGE(PG8_SA(1, 0), a3, voffA);
            PG8_WAIT_V(8); PG8_WAIT_L(0); PG8_BAR; PG8_MMA(1, 0, At, B0); PG8_MMA(1, 1, At, B1); PG8_BAR; PG8_SCHED;
        }
        if (wr == 0) PG8_BAR;
        E(acc, cur, wr, wc, fr, fq);
        if (!has_next) break;
#pragma unroll
        for (int a = 0; a < 2; ++a)
#pragma unroll
            for (int b = 0; b < 2; ++b)
#pragma unroll
                for (int m = 0; m < 4; ++m)
#pragma unroll
                    for (int n = 0; n < 2; ++n) acc[a][b][m][n] = (f32x4){0.f, 0.f, 0.f, 0.f};
        cur = nxt; cA = nA; cB = nB; ++ui;
        if (wr == 1) PG8_BAR;
    }
    PG8_WAIT_V(0);
    PG8_BAR;
#undef PG8_SA
#undef PG8_SB
#undef PG8_STAGE
#undef PG8_LDA
#undef PG8_LDB
#undef PG8_MMA
#undef PG8_WAIT_V
#undef PG8_WAIT_L
#undef PG8_BAR
#undef PG8_SCHED
}
}

struct EpiInProj {
    static constexpr bool PERM = true;
    bf16_t *QA, *KA, *VA, *QB, *KB, *VB, *RB; float* LF; float* out; const float* b_a;
    __device__ __forceinline__ void operator()(const f32x4 (&acc)[2][2][4][2], const pg8::Unit& u, int wr, int wc, int fr, int fq) const {
        const int pn = u.pn;
        const int row0 = u.pm * 256 + wr * 64 + fr;
        const int cl = wc * 32 + 8 * fq;
        if (pn == 12) {
#pragma unroll
            for (int bj = 0; bj < 2; ++bj) {
                const f32x4 b0 = *(const f32x4*)(b_a + cl + bj * 128), b1 = *(const f32x4*)(b_a + cl + bj * 128 + 4);
#pragma unroll
                for (int ai = 0; ai < 2; ++ai)
#pragma unroll
                    for (int m = 0; m < 4; ++m) {
                        f32x4 v0 = acc[ai][bj][m][0] + b0, v1 = acc[ai][bj][m][1] + b1;
#pragma unroll
                        for (int e = 0; e < 4; ++e) { float z = v0[e]; v0[e] = (fminf(z, 0.f) - log1pf(__expf(-fabsf(z)))) * 0.0625f; z = v1[e]; v1[e] = (fminf(z, 0.f) - log1pf(__expf(-fabsf(z)))) * 0.0625f; }
                        float* p = LF + (size_t)(row0 + ai * 128 + m * 16) * 256 + cl + bj * 128;
                        *(f32x4*)p = v0; *(f32x4*)(p + 4) = v1;
                    }
            }
            return;
        }
        bf16_t* base; int ld, cb; float sc = 1.f; float* fo = nullptr;
        if (pn < 2) { base = QA; ld = 512; cb = pn * 256; sc = QSCALE; }
        else if (pn < 4) { base = KA; ld = 512; cb = (pn - 2) * 256; fo = out + (u.pm < 128 ? O_KP : O_KS - (size_t)MP * 512); }
        else if (pn < 6) { base = VA; ld = 512; cb = (pn - 4) * 256; fo = out + (u.pm < 128 ? O_VP : O_VS - (size_t)MP * 512); }
        else if (pn == 6) { base = QB; ld = 256; cb = 0; }
        else if (pn == 7) { base = KB; ld = 256; cb = 0; }
        else if (pn < 10) { base = VB; ld = 512; cb = (pn - 8) * 256; }
        else { base = RB; ld = 512; cb = (pn - 10) * 256; }
#pragma unroll
        for (int ai = 0; ai < 2; ++ai)
#pragma unroll
            for (int m = 0; m < 4; ++m) {
                const size_t r = (size_t)(row0 + ai * 128 + m * 16);
#pragma unroll
                for (int bj = 0; bj < 2; ++bj) {
                    const f32x4 a0 = acc[ai][bj][m][0], a1 = acc[ai][bj][m][1];
                    const f32x4 v0 = a0 * sc, v1 = a1 * sc;
                    u32x4 w; w.x = cvt_pk_bf16(v0[0], v0[1]); w.y = cvt_pk_bf16(v0[2], v0[3]); w.z = cvt_pk_bf16(v1[0], v1[1]); w.w = cvt_pk_bf16(v1[2], v1[3]);
                    *(u32x4*)(base + r * ld + cb + cl + bj * 128) = w;
                    if (fo) { float* p = fo + r * 512 + cb + cl + bj * 128; *(f32x4*)p = a0; *(f32x4*)(p + 4) = a1; }
                }
            }
    }
};


struct EpiRowOut {
    static constexpr bool PERM = true;
    bf16_t* O; float* SSQ;
    __device__ __forceinline__ void operator()(const f32x4 (&acc)[2][2][4][2], const pg8::Unit& u, int wr, int wc, int fr, int fq) const {
        const int row0 = u.pm * 256 + wr * 64 + fr; const int cl = u.pn * 256 + wc * 32 + 8 * fq;
#pragma unroll
        for (int ai = 0; ai < 2; ++ai)
#pragma unroll
            for (int m = 0; m < 4; ++m) {
                const size_t r = (size_t)(row0 + ai * 128 + m * 16); float s = 0.f;
#pragma unroll
                for (int bj = 0; bj < 2; ++bj) {
                    const f32x4 v0 = acc[ai][bj][m][0], v1 = acc[ai][bj][m][1];
                    s += (v0[0] * v0[0] + v0[1] * v0[1]) + (v0[2] * v0[2] + v0[3] * v0[3]) + (v1[0] * v1[0] + v1[1] * v1[1]) + (v1[2] * v1[2] + v1[3] * v1[3]);
                    u32x4 w; w.x = cvt_pk_bf16(v0[0], v0[1]); w.y = cvt_pk_bf16(v0[2], v0[3]); w.z = cvt_pk_bf16(v1[0], v1[1]); w.w = cvt_pk_bf16(v1[2], v1[3]);
                    *(u32x4*)(O + r * 1024 + cl + bj * 128) = w;
                }
                s += __shfl_xor(s, 16); s += __shfl_xor(s, 32);
                if (fq == 0) SSQ[r * 16 + u.pn * 4 + wc] = s;
            }
    }
};

struct EpiSlice {
    static constexpr bool PERM = false;
    float* SL; int ksub;
    __device__ __forceinline__ void operator()(const f32x4 (&acc)[2][2][4][2], const pg8::Unit& u, int wr, int wc, int fr, int fq) const {
        float* base = SL + (size_t)(u.kofs / ksub) * (256 * 1024) + (unsigned)((wr * 64 + fr) * 1024 + u.pn * 256 + wc * 32 + 4 * fq);
#pragma unroll
        for (int ai = 0; ai < 2; ++ai)
#pragma unroll
            for (int m = 0; m < 4; ++m) { float* rowp = base + (ai * 128 + m * 16) * 1024;
#pragma unroll
                for (int bj = 0; bj < 2; ++bj)
#pragma unroll
                    for (int n = 0; n < 2; ++n) *(f32x4*)(rowp + bj * 128 + n * 16) = acc[ai][bj][m][n]; }
    }
};

__device__ __forceinline__ float dpp_ror1(float v) { return __int_as_float(__builtin_amdgcn_update_dpp(0, __float_as_int(v), 0x121, 0xf, 0xf, false)); }
__device__ __forceinline__ float dpp_ror2(float v) { return __int_as_float(__builtin_amdgcn_update_dpp(0, __float_as_int(v), 0x122, 0xf, 0xf, false)); }

constexpr int CONVX_OFF = 131072;
struct EpiUp {
    static constexpr bool PERM = true;
    bf16_t* H; float* out; const float* conv_w; const float* conv_b; const float* cbuf; LAS unsigned char* lds;
    __device__ __forceinline__ void operator()(const f32x4 (&acc)[2][2][4][2], const pg8::Unit& u, int wr, int wc, int fr, int fq) const {
        LAS float* X = (LAS float*)(lds + CONVX_OFF);
        const int cg_ = wc * 32 + 8 * fq;
        const int col = u.pn * 128 + cg_;
        if (fr >= 14) {
#pragma unroll
            for (int ai = 0; ai < 2; ++ai) { LAS float* p = X + ((ai * 2 + wr) * 2 + (fr - 14)) * 128 + cg_; *(LAS f32x4*)p = acc[ai][0][3][0]; *(LAS f32x4*)(p + 4) = acc[ai][0][3][1]; }
        }
        f32x4 w0[2], w1[2], w2[2], cb[2];
#pragma unroll
        for (int n = 0; n < 2; ++n) { w0[n] = *(const f32x4*)(conv_w + col + 4 * n); w1[n] = *(const f32x4*)(conv_w + DFF + col + 4 * n); w2[n] = *(const f32x4*)(conv_w + 2 * DFF + col + 4 * n); cb[n] = *(const f32x4*)(conv_b + col + 4 * n); }
        asm volatile("s_waitcnt lgkmcnt(0)" ::: "memory"); __builtin_amdgcn_s_barrier(); asm volatile("" ::: "memory");
#pragma unroll
        for (int ai = 0; ai < 2; ++ai) {
            const int pai = (wr == 1) ? ai : ai - 1, pwr = wr ^ 1;
#pragma unroll
            for (int m = 0; m < 4; ++m) {
                const int lr = ai * 128 + wr * 64 + m * 16 + fr; const int gr = u.pm * 254 - 2 + lr;
                const bool store = (lr >= 2) && (gr < MT);
                int pos, bidx; bool samp = gr >= MP;
                if (!samp) { pos = gr & (SEQ - 1); bidx = gr >> 11; } else { pos = (gr - MP) & 7; bidx = (gr - MP) >> 3; }
                u32x4 hw;
#pragma unroll
                for (int n = 0; n < 2; ++n) {
                    f32x4 g0 = acc[ai][0][m][n], uu = acc[ai][1][m][n], gm1, gm2;
#pragma unroll
                    for (int e = 0; e < 4; ++e) {
                        const float r1 = dpp_ror1(g0[e]), r2 = dpp_ror2(g0[e]);
                        float p1, p2;
                        if (m > 0) { p1 = dpp_ror1(acc[ai][0][m > 0 ? m - 1 : 0][n][e]); p2 = dpp_ror2(acc[ai][0][m > 0 ? m - 1 : 0][n][e]); }
                        else if (pai >= 0) { p1 = X[((pai * 2 + pwr) * 2 + 1) * 128 + cg_ + 4 * n + e]; p2 = X[((pai * 2 + pwr) * 2 + (fr & 1)) * 128 + cg_ + 4 * n + e]; }
                        else { p1 = 0.f; p2 = 0.f; }
                        gm1[e] = fr >= 1 ? r1 : p1; gm2[e] = fr >= 2 ? r2 : p2;
                    }
                    if (!samp) { if (pos == 0) { gm1 = (f32x4){0.f, 0.f, 0.f, 0.f}; gm2 = gm1; } else if (pos == 1) gm2 = (f32x4){0.f, 0.f, 0.f, 0.f}; }
                    else if (store) { if (pos == 0) { gm1 = *(const f32x4*)(cbuf + (size_t)(bidx * 2 + 1) * DFF + col + 4 * n); gm2 = *(const f32x4*)(cbuf + (size_t)(bidx * 2) * DFF + col + 4 * n); }
                                      else if (pos == 1) gm2 = *(const f32x4*)(cbuf + (size_t)(bidx * 2 + 1) * DFF + col + 4 * n); }
                    const f32x4 c = cb[n] + w0[n] * gm2 + w1[n] * gm1 + w2[n] * g0;
                    const f32x2 ga = pg8::gelu_pk((f32x2){c[0], c[1]}), gb = pg8::gelu_pk((f32x2){c[2], c[3]});
                    const float h0 = ga.x * uu[0], h1 = ga.y * uu[1], h2 = gb.x * uu[2], h3 = gb.y * uu[3];
                    if (n == 0) { hw.x = cvt_pk_bf16(h0, h1); hw.y = cvt_pk_bf16(h2, h3); } else { hw.z = cvt_pk_bf16(h0, h1); hw.w = cvt_pk_bf16(h2, h3); }
                    if (store) {
                        if (!samp) { if (pos >= SEQ - 2) *(f32x4*)(out + O_CP + (size_t)(bidx * 2 + (pos - (SEQ - 2))) * DFF + col + 4 * n) = g0; }
                        else { if (pos >= 6) *(f32x4*)(out + O_CS + (size_t)(bidx * 2 + (pos - 6)) * DFF + col + 4 * n) = g0; }
                    }
                }
                if (store) *(u32x4*)(H + (size_t)gr * DFF + col) = hw;
            }
        }
    }
};

__device__ __forceinline__ unsigned pk2(float lo, float hi) { return cvt_pk_bf16(lo, hi); }
__device__ __forceinline__ void p0_transpose_item(const float* W, int ldw, int scol0, int k0, bf16_t* WT, int dK, int drow0, LAS float* scr, int lane) {
#pragma unroll 8
    for (int i = 0; i < 32; ++i) { const int kk = 2 * i + (lane >> 5); scr[kk * 33 + (lane & 31)] = W[(size_t)(k0 + kk) * ldw + scol0 + (lane & 31)]; }
    asm volatile("s_waitcnt lgkmcnt(0)" ::: "memory");
    const int c = lane & 7;
#pragma unroll
    for (int j = 0; j < 4; ++j) { const int n = (lane >> 3) + 8 * j; const LAS float* s = scr + (8 * c) * 33 + n;
        u32x4 o; o.x = pk2(s[0 * 33], s[1 * 33]); o.y = pk2(s[2 * 33], s[3 * 33]); o.z = pk2(s[4 * 33], s[5 * 33]); o.w = pk2(s[6 * 33], s[7 * 33]);
        *(u32x4*)(WT + (size_t)(drow0 + n) * dK + k0 + 8 * c) = o; }
    asm volatile("s_waitcnt lgkmcnt(0)" ::: "memory");
}
__device__ __forceinline__ void p0_gate_item(const float* w_in, const float* w_a2, int k0, int n0, bf16_t* WT, LAS float* scr, int lane) {
    float w2[16];
#pragma unroll
    for (int r = 0; r < 16; ++r) w2[r] = w_a2[r * 256 + n0 + (lane & 31)];
    for (int i = 0; i < 32; ++i) { const int kk = 2 * i + (lane >> 5); const float* a = w_in + (size_t)(k0 + kk) * DIN + 3072; float s = 0.f;
#pragma unroll
        for (int r = 0; r < 16; ++r) s += a[r] * w2[r];
        scr[kk * 33 + (lane & 31)] = s; }
    asm volatile("s_waitcnt lgkmcnt(0)" ::: "memory");
    const int c = lane & 7;
#pragma unroll
    for (int j = 0; j < 4; ++j) { const int n = (lane >> 3) + 8 * j; const LAS float* s = scr + (8 * c) * 33 + n;
        u32x4 o; o.x = pk2(s[0 * 33], s[1 * 33]); o.y = pk2(s[2 * 33], s[3 * 33]); o.z = pk2(s[4 * 33], s[5 * 33]); o.w = pk2(s[6 * 33], s[7 * 33]);
        *(u32x4*)(WT + (size_t)(3072 + n0 + n) * 1024 + k0 + 8 * c) = o; }
    asm volatile("s_waitcnt lgkmcnt(0)" ::: "memory");
}
__device__ __forceinline__ void rms_row_to_bf16(const float* xrow, const float* g, bf16_t* orow, int lane) {
    const f32x4* xr = (const f32x4*)xrow + lane; const f32x4* gr = (const f32x4*)g + lane;
    f32x4 v[4]; float s = 0.f;
#pragma unroll
    for (int j = 0; j < 4; ++j) { v[j] = xr[64 * j]; s += (v[j].x * v[j].x + v[j].y * v[j].y) + (v[j].z * v[j].z + v[j].w * v[j].w); }
    const float rs = rsqrtf(wave_sum(s) * (1.f / DM) + EPS);
    u32x2* o8 = (u32x2*)orow + lane;
#pragma unroll
    for (int j = 0; j < 4; ++j) { const f32x4 gg = gr[64 * j]; const f32x4 y = v[j] * rs * gg; u32x2 w; w.x = pk2(y.x, y.y); w.y = pk2(y.z, y.w); o8[64 * j] = w; }
}


__device__ __forceinline__ int crow(int r, int hi) { return (r & 3) + 8 * (r >> 2) + 4 * hi; }
typedef short v4i16_t __attribute__((ext_vector_type(4)));
__device__ __forceinline__ s16x4 vtr(const LAS unsigned char* p) { return __builtin_bit_cast(s16x4, __builtin_amdgcn_ds_read_tr16_b64_v4i16((LAS v4i16_t*)p)); }
__device__ __forceinline__ float swapmax(float v) { auto rr = __builtin_amdgcn_permlane32_swap(__float_as_uint(v), __float_as_uint(v), false, false); return fmaxf(__uint_as_float(rr[0]), __uint_as_float(rr[1])); }
__device__ __forceinline__ float swapsum(float v) { auto rr = __builtin_amdgcn_permlane32_swap(__float_as_uint(v), __float_as_uint(v), false, false); return __uint_as_float(rr[0]) + __uint_as_float(rr[1]); }
__device__ __forceinline__ u32x4 pack8(f32x4 a, f32x4 b) { u32x4 w; w.x = cvt_pk_bf16(a.x, a.y); w.y = cvt_pk_bf16(a.z, a.w); w.z = cvt_pk_bf16(b.x, b.y); w.w = cvt_pk_bf16(b.z, b.w); return w; }

constexpr float NEGF = -1e30f;
constexpr int VPITCH = 192;
constexpr int ATT_WLDS = 32 * VPITCH + 256;

struct AttnCtx { const bf16_t *QA, *KA, *VA; bf16_t* MIX; const float *ck, *cv; };

struct TileRegs { u32x4 k[8]; u32x4 v[8]; };

template <bool SAMPLE> __device__ __forceinline__ int tile_key(int ti, int j, int g, int r4, int ncls) {
    if (SAMPLE) { if (ti < 17) return 1536 + 32 * (16 - ti) + j; const int kk = ti - 17; return 16 * (4 * kk + (j >> 3)) + (j & 7); }
    if (ti < ncls) return 4 * (32 * (g - ti) + j) + r4;
    const int jj = ti - ncls + (g == 0 ? 4 : 0); return 128 * g - 128 + 32 * jj + j;
}
template <bool SAMPLE> __device__ __forceinline__ void tile_load(const AttnCtx& C, TileRegs& T, int ti, int b, int h, int g, int r4, int ncls, int lane) {
    const int r32 = lane & 31, hi = lane >> 5;
    if (SAMPLE && ti > 0) {
        { const int idx = tile_key<SAMPLE>(ti, r32, g, r4, ncls); const float* p = C.ck + (((unsigned)(b * WINB + idx) * 8u + h) * 64u + 8 * hi);
#pragma unroll
          for (int d0 = 0; d0 < 4; ++d0) { T.k[2 * d0] = *(const GAS u32x4*)(p + 16 * d0); T.k[2 * d0 + 1] = *(const GAS u32x4*)(p + 16 * d0 + 4); } }
#pragma unroll
        for (int i = 0; i < 4; ++i) { const int key = (lane >> 3) + 8 * i; const int idx = tile_key<SAMPLE>(ti, key, g, r4, ncls);
            const float* p = C.cv + (((unsigned)(b * WINB + idx) * 8u + h) * 64u + 8 * (lane & 7)); T.v[2 * i] = *(const GAS u32x4*)p; T.v[2 * i + 1] = *(const GAS u32x4*)(p + 4); }
    } else {
        unsigned rowb;
        { int key = tile_key<SAMPLE>(ti, r32, g, r4, ncls); if (SAMPLE) { key -= WINB; key = key > 7 ? 7 : key; rowb = (unsigned)(MP + b * 8 + key); } else rowb = (unsigned)(b * SEQ + key);
          const bf16_t* p = C.KA + (rowb * 512u + h * 64 + 8 * hi);
#pragma unroll
          for (int d0 = 0; d0 < 4; ++d0) T.k[d0] = *(const GAS u32x4*)(p + 16 * d0); }
#pragma unroll
        for (int i = 0; i < 4; ++i) { int key = tile_key<SAMPLE>(ti, (lane >> 3) + 8 * i, g, r4, ncls); if (SAMPLE) { key -= WINB; key = key > 7 ? 7 : key; rowb = (unsigned)(MP + b * 8 + key); } else rowb = (unsigned)(b * SEQ + key);
            T.v[i] = *(const GAS u32x4*)(C.VA + (rowb * 512u + h * 64 + 8 * (lane & 7))); }
    }
}

template <bool SAMPLE>
__device__ __forceinline__ void attn_item(const AttnCtx& C, int b, int h, int g, int r4, LAS unsigned char* wl, int lane_in) {
    int lane = lane_in; asm volatile("" : "+v"(lane));
    const int r32 = lane & 31, hi = lane >> 5;
    LAS float* wsf = (LAS float*)(wl + 32 * VPITCH);
    const int ncls = g + 1;
    const int nt = SAMPLE ? 41 : (ncls + (g == 0 ? 4 : 8));
    bf16x8 qf[4];
    {
        unsigned qrow; if (SAMPLE) qrow = (unsigned)(MP + b * 8 + (r32 & 7)); else qrow = (unsigned)(b * SEQ + 4 * (32 * g + r32) + r4);
        const bf16_t* p = C.QA + (qrow * 512u + h * 64 + 8 * hi);
#pragma unroll
        for (int d0 = 0; d0 < 4; ++d0) qf[d0] = *(const bf16x8*)(p + 16 * d0);
    }
    float mrun = NEGF, lrun = 0.f;
    f32x16 o0 = {}, o1 = {};
    TileRegs T;
    tile_load<SAMPLE>(C, T, 0, b, h, g, r4, ncls, lane);
    const int vrd = (4 * hi + ((lane & 15) >> 2)) * VPITCH + (((lane >> 4) & 1) * 16 + (lane & 3) * 4) * 2;
    for (int ti = 0; ti < nt; ++ti) {
        bf16x8 kf[4];
        const bool f32path = SAMPLE && ti > 0;
        if (f32path) {
#pragma unroll
            for (int d0 = 0; d0 < 4; ++d0) kf[d0] = __builtin_bit_cast(bf16x8, pack8(__builtin_bit_cast(f32x4, T.k[2 * d0]), __builtin_bit_cast(f32x4, T.k[2 * d0 + 1])));
#pragma unroll
            for (int i = 0; i < 4; ++i) *(LAS u32x4*)(wl + ((lane >> 3) + 8 * i) * VPITCH + (lane & 7) * 16) = pack8(__builtin_bit_cast(f32x4, T.v[2 * i]), __builtin_bit_cast(f32x4, T.v[2 * i + 1]));
        } else {
#pragma unroll
            for (int d0 = 0; d0 < 4; ++d0) kf[d0] = __builtin_bit_cast(bf16x8, T.k[d0]);
#pragma unroll
            for (int i = 0; i < 4; ++i) *(LAS u32x4*)(wl + ((lane >> 3) + 8 * i) * VPITCH + (lane & 7) * 16) = T.v[i];
        }
        if (ti + 1 < nt) tile_load<SAMPLE>(C, T, ti + 1, b, h, g, r4, ncls, lane);
        f32x16 p = {};
#pragma unroll
        for (int d0 = 0; d0 < 4; ++d0) p = __builtin_amdgcn_mfma_f32_32x32x16_bf16(kf[d0], qf[d0], p, 0, 0, 0);
        if (SAMPLE) {
            if (ti < 17) { const int dbase = (WINB + r32) - (1536 + 32 * (16 - ti));
#pragma unroll
                for (int r = 0; r < 16; ++r) { const int d = dbase - crow(r, hi); const int mult = (d >= 0 && d <= 128) + (d >= 0 && d <= 512 && !(d & 3)) + (d >= 0 && !(d & 15));
                    p[r] = (mult == 0 || r32 >= 8) ? NEGF : p[r] + (mult == 1 ? 0.f : (mult == 2 ? 1.f : 1.5849625f)); } }
            else {
#pragma unroll
                for (int r = 0; r < 16; ++r) p[r] = ((crow(r, hi) & 7) == r32) ? p[r] : NEGF; }
        } else {
            if (ti < ncls) { const int dbase = (32 * g + r32) - 32 * (g - ti);
#pragma unroll
                for (int r = 0; r < 16; ++r) { const int d = dbase - crow(r, hi); const int mult = (d >= 0 && d <= 128) + (d >= 0 && !(d & 3));
                    p[r] = mult == 0 ? NEGF : p[r] + (mult == 2 ? 1.f : 0.f); } }
            else { const int jj = ti - ncls + (g == 0 ? 4 : 0); const int dbase = (128 * g + 4 * r32 + r4) - (128 * g - 128 + 32 * jj);
#pragma unroll
                for (int r = 0; r < 16; ++r) { const int d = dbase - crow(r, hi); p[r] = (d >= 0 && d <= 128) ? p[r] : NEGF; } }
        }
        float rm = p[0];
#pragma unroll
        for (int r = 1; r < 16; ++r) rm = fmaxf(rm, p[r]);
        rm = swapmax(rm);
        const float mnew = fmaxf(mrun, rm);
        const float f = __builtin_amdgcn_exp2f(mrun - mnew);
        mrun = mnew;
        float ls = 0.f;
#pragma unroll
        for (int r = 0; r < 16; ++r) { p[r] = __builtin_amdgcn_exp2f(p[r] - mnew); ls += p[r]; }
        lrun = lrun * f + ls;
        if (hi == 0) wsf[r32] = f;
        u32x4 pa0, pa1;
        pa0.x = cvt_pk_bf16(p[0], p[1]); pa0.y = cvt_pk_bf16(p[2], p[3]); pa0.z = cvt_pk_bf16(p[4], p[5]); pa0.w = cvt_pk_bf16(p[6], p[7]);
        pa1.x = cvt_pk_bf16(p[8], p[9]); pa1.y = cvt_pk_bf16(p[10], p[11]); pa1.z = cvt_pk_bf16(p[12], p[13]); pa1.w = cvt_pk_bf16(p[14], p[15]);
#pragma unroll
        for (int r = 0; r < 16; ++r) { const float fr_ = wsf[crow(r, hi)]; o0[r] *= fr_; o1[r] *= fr_; }
#pragma unroll
        for (int sl = 0; sl < 2; ++sl) {
            const bf16x8 pa = __builtin_bit_cast(bf16x8, sl == 0 ? pa0 : pa1);
#pragma unroll
            for (int c = 0; c < 2; ++c) {
                const s16x4 lo = vtr(wl + vrd + (16 * sl) * VPITCH + 64 * c), hi4 = vtr(wl + vrd + (16 * sl + 8) * VPITCH + 64 * c);
                const bf16x8 vf = (bf16x8){lo[0], lo[1], lo[2], lo[3], hi4[0], hi4[1], hi4[2], hi4[3]};
                if (c == 0) o0 = __builtin_amdgcn_mfma_f32_32x32x16_bf16(pa, vf, o0, 0, 0, 0); else o1 = __builtin_amdgcn_mfma_f32_32x32x16_bf16(pa, vf, o1, 0, 0, 0);
            }
        }
    }
    const float lt = swapsum(lrun);
    if (hi == 0) wsf[32 + r32] = 1.f / lt;
#pragma unroll
    for (int r = 0; r < 16; ++r) {
        const int q = crow(r, hi); const float rl = wsf[32 + q];
        unsigned orow; bool ok = true;
        if (SAMPLE) { ok = q < 8; orow = (unsigned)(MP + b * 8 + (q & 7)); } else orow = (unsigned)(b * SEQ + 4 * (32 * g + q) + r4);
        if (ok) { bf16_t* op = C.MIX + (orow * 1024u + h * 64 + r32);
            op[0] = (bf16_t)(cvt_pk_bf16(o0[r] * rl, 0.f) & 0xffffu); op[32] = (bf16_t)(cvt_pk_bf16(o1[r] * rl, 0.f) & 0xffffu); }
    }
}

struct GlaCtx { const bf16_t *QB, *KB, *VB, *RB; const float* LF; bf16_t* MIX; const float* gnorm; };
constexpr int GQ_P = 72, GT_P = 40;
constexpr int G_QE = 0, G_KE = 32 * GQ_P * 2, G_KT = G_KE + 32 * GQ_P * 2, G_EB = G_KT + 64 * GT_P * 2, G_BUF = G_EB + 256;
constexpr int GL_V = 2 * G_BUF;
constexpr int GL_O = GL_V + 2 * 4 * 2048;
constexpr int GL_END = GL_O + 2 * 4 * 4608;
static_assert(GL_END <= 131072, "gla lds");
#define LDS_BARRIER() do { asm volatile("s_waitcnt lgkmcnt(0)" ::: "memory"); __builtin_amdgcn_s_barrier(); asm volatile("" ::: "memory"); } while (0)
typedef float f32x8 __attribute__((ext_vector_type(8)));
typedef unsigned u32x8 __attribute__((ext_vector_type(8)));
typedef unsigned u32x16 __attribute__((ext_vector_type(16)));
struct GlaPre { f32x8 lf; u32x8 q, k; u32x4 v0, v1; };

template <int nvalid> __device__ __forceinline__ void gla_h_loads(const GlaCtx& C, GlaPre& P, unsigned t0, int h, int dk, int tg, int dvs, int lane) {
    const bool ok = 8 * tg < nvalid;
    const unsigned off = (t0 + (ok ? 8 * tg : 0)) * 256u + h * 64 + dk;
    const GAS float* lp = (const GAS float*)(C.LF + off); const GAS bf16_t* qp = (const GAS bf16_t*)(C.QB + off); const GAS bf16_t* kp = (const GAS bf16_t*)(C.KB + off);
#pragma unroll
    for (int e = 0; e < 8; ++e) { P.lf[e] = lp[e * 256]; P.q[e] = (unsigned)qp[e * 256]; P.k[e] = (unsigned)kp[e * 256]; }
    const int i = lane >> 1; const bool okv = i < nvalid; const GAS bf16_t* p = (const GAS bf16_t*)(C.VB + ((t0 + (okv ? i : 0)) * 512u + h * 128 + 32 * dvs + 16 * (lane & 1)));
    P.v0 = *(const GAS u32x4*)p; P.v1 = *(const GAS u32x4*)(p + 8);
}
template <int nvalid> __device__ __forceinline__ void gla_h_wave(const GlaCtx& C, LAS unsigned char* lds, int hw  , int lane, unsigned row0, int h, int nchunk) {
    const int tg = lane >> 4, dkl = lane & 15, dk = 16 * hw + dkl;
    const int ft = lane >> 3, dvg = lane & 7;
    const bool fin_ok = 8 * hw < nvalid;
    f32x4 gn[4];
#pragma unroll
    for (int k4 = 0; k4 < 4; ++k4) gn[k4] = *(const f32x4*)(C.gnorm + h * 128 + 16 * dvg + 4 * k4);
    GlaPre P; u32x4 g0 = {}, g1 = {};
    gla_h_loads<nvalid>(C, P, row0, h, dk, tg, hw, lane);
    for (int j = 0; j <= nchunk + 1; ++j) {
        if (j >= 2 && fin_ok) {
            const int c = j - 2; const int ob = c & 1;
            const LAS float* op = (const LAS float*)(lds + GL_O + (ob * 4 + (dvg >> 1)) * 4608) + (8 * hw + ft) * 36 + 16 * (dvg & 1);
            f32x4 o[4]; float s = 0.f;
#pragma unroll
            for (int k4 = 0; k4 < 4; ++k4) { o[k4] = *(const LAS f32x4*)(op + 4 * k4); s += (o[k4].x * o[k4].x + o[k4].y * o[k4].y) + (o[k4].z * o[k4].z + o[k4].w * o[k4].w); }
            s += __shfl_xor(s, 1); s += __shfl_xor(s, 2); s += __shfl_xor(s, 4);
            const float rs = rsqrtf(s * (1.f / 128.f) + EPS);
            float gt[16];
            gt[0] = __uint_as_float(g0.x << 16); gt[1] = __uint_as_float(g0.x & 0xffff0000u); gt[2] = __uint_as_float(g0.y << 16); gt[3] = __uint_as_float(g0.y & 0xffff0000u);
            gt[4] = __uint_as_float(g0.z << 16); gt[5] = __uint_as_float(g0.z & 0xffff0000u); gt[6] = __uint_as_float(g0.w << 16); gt[7] = __uint_as_float(g0.w & 0xffff0000u);
            gt[8] = __uint_as_float(g1.x << 16); gt[9] = __uint_as_float(g1.x & 0xffff0000u); gt[10] = __uint_as_float(g1.y << 16); gt[11] = __uint_as_float(g1.y & 0xffff0000u);
            gt[12] = __uint_as_float(g1.z << 16); gt[13] = __uint_as_float(g1.z & 0xffff0000u); gt[14] = __uint_as_float(g1.w << 16); gt[15] = __uint_as_float(g1.w & 0xffff0000u);
            float val[16];
#pragma unroll
            for (int k = 0; k < 16; ++k) { const float rg = gt[k]; val[k] = o[k >> 2][k & 3] * rs * gn[k >> 2][k & 3] * rg * __builtin_amdgcn_rcpf(1.f + __expf(-rg)); }
            u32x4 w0, w1;
            w0.x = cvt_pk_bf16(val[0], val[1]); w0.y = cvt_pk_bf16(val[2], val[3]); w0.z = cvt_pk_bf16(val[4], val[5]); w0.w = cvt_pk_bf16(val[6], val[7]);
            w1.x = cvt_pk_bf16(val[8], val[9]); w1.y = cvt_pk_bf16(val[10], val[11]); w1.z = cvt_pk_bf16(val[12], val[13]); w1.w = cvt_pk_bf16(val[14], val[15]);
            bf16_t* mp = C.MIX + ((row0 + 32u * c + 8 * hw + ft) * 1024u + 512 + h * 128 + 16 * dvg);
            *(GAS u32x4*)mp = w0; *(GAS u32x4*)(mp + 8) = w1;
        }
        if (j < nchunk) {
            const int buf = j & 1;
            LAS unsigned char* sh = lds + buf * G_BUF;
            LAS bf16_t* qe_l = (LAS bf16_t*)(sh + G_QE); LAS bf16_t* ke_l = (LAS bf16_t*)(sh + G_KE); LAS bf16_t* kt_l = (LAS bf16_t*)(sh + G_KT); LAS float* eb_l = (LAS float*)(sh + G_EB);
            LAS unsigned char* vl = lds + GL_V + (buf * 4 + hw) * 2048;
            const bool okp = 8 * tg < nvalid, okv = (lane >> 1) < nvalid;
            if (!okp) { P.lf = (f32x8){0.f, 0.f, 0.f, 0.f, 0.f, 0.f, 0.f, 0.f}; P.q = (u32x8){0u, 0u, 0u, 0u, 0u, 0u, 0u, 0u}; P.k = P.q; }
            if (!okv) { P.v0 = (u32x4){0u, 0u, 0u, 0u}; P.v1 = P.v0; }
            f32x8 cs; float run = 0.f;
#pragma unroll
            for (int e = 0; e < 8; ++e) { run += P.lf[e]; cs[e] = run; }
            float offs = 0.f, tot = 0.f;
#pragma unroll
            for (int t = 0; t < 4; ++t) { const float Tt = __shfl(run, dkl + 16 * t); tot += Tt; offs += (t < tg) ? Tt : 0.f; }
            u32x8 kb;
#pragma unroll
            for (int e = 0; e < 8; ++e) { const float bb = offs + cs[e]; const float eb = __expf(bb), ei = __expf(-bb); const int i = 8 * tg + e;
                qe_l[i * GQ_P + dk] = (bf16_t)(cvt_pk_bf16(__uint_as_float(P.q[e] << 16) * 0.125f * eb, 0.f) & 0xffffu);
                kb[e] = cvt_pk_bf16(__uint_as_float(P.k[e] << 16) * ei, 0.f) & 0xffffu;
                ke_l[i * GQ_P + dk] = (bf16_t)kb[e]; }
            u32x4 w; w.x = kb[0] | (kb[1] << 16); w.y = kb[2] | (kb[3] << 16); w.z = kb[4] | (kb[5] << 16); w.w = kb[6] | (kb[7] << 16);
            *(LAS u32x4*)(kt_l + dk * GT_P + 8 * tg) = w;
            if (tg == 0) eb_l[dk] = __expf(tot);
            *(LAS u32x4*)(vl + (lane >> 1) * 64 + (lane & 1) * 32) = P.v0; *(LAS u32x4*)(vl + (lane >> 1) * 64 + (lane & 1) * 32 + 16) = P.v1;
        }
        if (j + 1 < nchunk) gla_h_loads<nvalid>(C, P, row0 + 32u * (j + 1), h, dk, tg, hw, lane);
        if (j >= 1 && j <= nchunk && fin_ok) { const bf16_t* rp = C.RB + ((row0 + 32u * (j - 1) + 8 * hw + ft) * 512u + h * 128 + 16 * dvg); g0 = *(const GAS u32x4*)rp; g1 = *(const GAS u32x4*)(rp + 8); }
        if (j <= nchunk) LDS_BARRIER();
    }
}
template <int nvalid> __device__ __forceinline__ void gla_m_wave(LAS unsigned char* lds, int dvs, int lane, int nchunk, const float* s_in, float* s_out) {
    const int r32 = lane & 31, hi = lane >> 5;
    f32x16 S0 = {}, S1 = {};
    unsigned soff = (unsigned)(4 * hi * 128 + 32 * dvs + r32); asm volatile("" : "+v"(soff));
    if (s_in) {
#pragma unroll
        for (int r = 0; r < 16; ++r) { const unsigned o_ = soff + (unsigned)(((r & 3) + 8 * (r >> 2)) * 128); S0[r] = s_in[o_]; S1[r] = s_in[o_ + 4096u]; }
    }
    const int vrd = (4 * hi + ((lane & 15) >> 2)) * 64 + (((lane >> 4) & 1) * 16 + (lane & 3) * 4) * 2;
    LDS_BARRIER();
    for (int c = 0; c < nchunk; ++c) {
        const int buf = c & 1;
        LAS unsigned char* sh = lds + buf * G_BUF;
        LAS bf16_t* qe_l = (LAS bf16_t*)(sh + G_QE); LAS bf16_t* ke_l = (LAS bf16_t*)(sh + G_KE); LAS bf16_t* kt_l = (LAS bf16_t*)(sh + G_KT); LAS float* eb_l = (LAS float*)(sh + G_EB);
        const LAS unsigned char* vl = lds + GL_V + (buf * 4 + dvs) * 2048;
        f32x16 at = {};
#pragma unroll
        for (int s = 0; s < 4; ++s) { const bf16x8 a = *(const LAS bf16x8*)(ke_l + r32 * GQ_P + 16 * s + 8 * hi), bq = *(const LAS bf16x8*)(qe_l + r32 * GQ_P + 16 * s + 8 * hi);
            at = __builtin_amdgcn_mfma_f32_32x32x16_bf16(a, bq, at, 0, 0, 0); }
#pragma unroll
        for (int r = 0; r < 16; ++r) at[r] = (crow(r, hi) <= r32) ? at[r] : 0.f;
        u32x4 pa0, pa1;
        pa0.x = cvt_pk_bf16(at[0], at[1]); pa0.y = cvt_pk_bf16(at[2], at[3]); pa0.z = cvt_pk_bf16(at[4], at[5]); pa0.w = cvt_pk_bf16(at[6], at[7]);
        pa1.x = cvt_pk_bf16(at[8], at[9]); pa1.y = cvt_pk_bf16(at[10], at[11]); pa1.z = cvt_pk_bf16(at[12], at[13]); pa1.w = cvt_pk_bf16(at[14], at[15]);
        bf16x8 vf0, vf1;
        { const s16x4 lo = vtr(vl + vrd), h4 = vtr(vl + vrd + 8 * 64); vf0 = (bf16x8){lo[0], lo[1], lo[2], lo[3], h4[0], h4[1], h4[2], h4[3]}; }
        { const s16x4 lo = vtr(vl + vrd + 16 * 64), h4 = vtr(vl + vrd + 24 * 64); vf1 = (bf16x8){lo[0], lo[1], lo[2], lo[3], h4[0], h4[1], h4[2], h4[3]}; }
        f32x16 o = {};
        o = __builtin_amdgcn_mfma_f32_32x32x16_bf16(__builtin_bit_cast(bf16x8, pa0), vf0, o, 0, 0, 0);
        o = __builtin_amdgcn_mfma_f32_32x32x16_bf16(__builtin_bit_cast(bf16x8, pa1), vf1, o, 0, 0, 0);
#pragma unroll
        for (int s = 0; s < 4; ++s) {
            const u32x2 q0 = *(const LAS u32x2*)(qe_l + r32 * GQ_P + 16 * s + 4 * hi), q1 = *(const LAS u32x2*)(qe_l + r32 * GQ_P + 16 * s + 8 + 4 * hi);
            const u32x4 qa = (u32x4){q0.x, q0.y, q1.x, q1.y};
            u32x4 sb;
            if (s == 0) { sb.x = cvt_pk_bf16(S0[0], S0[1]); sb.y = cvt_pk_bf16(S0[2], S0[3]); sb.z = cvt_pk_bf16(S0[4], S0[5]); sb.w = cvt_pk_bf16(S0[6], S0[7]); }
            else if (s == 1) { sb.x = cvt_pk_bf16(S0[8], S0[9]); sb.y = cvt_pk_bf16(S0[10], S0[11]); sb.z = cvt_pk_bf16(S0[12], S0[13]); sb.w = cvt_pk_bf16(S0[14], S0[15]); }
            else if (s == 2) { sb.x = cvt_pk_bf16(S1[0], S1[1]); sb.y = cvt_pk_bf16(S1[2], S1[3]); sb.z = cvt_pk_bf16(S1[4], S1[5]); sb.w = cvt_pk_bf16(S1[6], S1[7]); }
            else { sb.x = cvt_pk_bf16(S1[8], S1[9]); sb.y = cvt_pk_bf16(S1[10], S1[11]); sb.z = cvt_pk_bf16(S1[12], S1[13]); sb.w = cvt_pk_bf16(S1[14], S1[15]); }
            o = __builtin_amdgcn_mfma_f32_32x32x16_bf16(__builtin_bit_cast(bf16x8, qa), __builtin_bit_cast(bf16x8, sb), o, 0, 0, 0);
        }
        { LAS float* ol = (LAS float*)(lds + GL_O + (buf * 4 + dvs) * 4608);
#pragma unroll
          for (int r = 0; r < 16; ++r) ol[crow(r, hi) * 36 + r32] = o[r]; }
        {
            const u32x2 a0 = *(const LAS u32x2*)(kt_l + r32 * GT_P + 4 * hi), a1 = *(const LAS u32x2*)(kt_l + r32 * GT_P + 8 + 4 * hi);
            const u32x2 c0 = *(const LAS u32x2*)(kt_l + (32 + r32) * GT_P + 4 * hi), c1 = *(const LAS u32x2*)(kt_l + (32 + r32) * GT_P + 8 + 4 * hi);
            S0 = __builtin_amdgcn_mfma_f32_32x32x16_bf16(__builtin_bit_cast(bf16x8, (u32x4){a0.x, a0.y, a1.x, a1.y}), vf0, S0, 0, 0, 0);
            S1 = __builtin_amdgcn_mfma_f32_32x32x16_bf16(__builtin_bit_cast(bf16x8, (u32x4){c0.x, c0.y, c1.x, c1.y}), vf0, S1, 0, 0, 0);
        }
        {
            const u32x2 a0 = *(const LAS u32x2*)(kt_l + r32 * GT_P + 16 + 4 * hi), a1 = *(const LAS u32x2*)(kt_l + r32 * GT_P + 24 + 4 * hi);
            const u32x2 c0 = *(const LAS u32x2*)(kt_l + (32 + r32) * GT_P + 16 + 4 * hi), c1 = *(const LAS u32x2*)(kt_l + (32 + r32) * GT_P + 24 + 4 * hi);
            S0 = __builtin_amdgcn_mfma_f32_32x32x16_bf16(__builtin_bit_cast(bf16x8, (u32x4){a0.x, a0.y, a1.x, a1.y}), vf1, S0, 0, 0, 0);
            S1 = __builtin_amdgcn_mfma_f32_32x32x16_bf16(__builtin_bit_cast(bf16x8, (u32x4){c0.x, c0.y, c1.x, c1.y}), vf1, S1, 0, 0, 0);
        }
#pragma unroll
        for (int r = 0; r < 16; ++r) { S0[r] *= eb_l[crow(r, hi)]; S1[r] *= eb_l[32 + crow(r, hi)]; }
        LDS_BARRIER();
    }
    if (s_out) {
        unsigned soff2 = (unsigned)(4 * hi * 128 + 32 * dvs + r32); asm volatile("" : "+v"(soff2));
#pragma unroll
        for (int r = 0; r < 16; ++r) { const unsigned o_ = soff2 + (unsigned)(((r & 3) + 8 * (r >> 2)) * 128); s_out[o_] = S0[r]; s_out[o_ + 4096u] = S1[r]; }
    }
}

#define XB_TMO      128
#define XB_XCNT(j)  (256  + 64 * (j))
#define XB_XSUB(j)  (1280 + 64 * (j))
#define XB_XGEN(j)  (2304 + 64 * (j))
#define XB_TOP      3328
#define XB_TOPGEN   3392
#define XCD_BAR_WORDS 3456
#define XB_SPIN_CAP (1u << 18)
__device__ __forceinline__ unsigned xb_ld(unsigned* p)              { return __hip_atomic_load(p, __ATOMIC_RELAXED, __HIP_MEMORY_SCOPE_AGENT); }
__device__ __forceinline__ unsigned xb_add(unsigned* p, unsigned v) { return __hip_atomic_fetch_add(p, v, __ATOMIC_RELAXED, __HIP_MEMORY_SCOPE_AGENT); }
__device__ __forceinline__ unsigned xb_xcc_id() { return (unsigned)__builtin_amdgcn_s_getreg((3 << 11) | 20) & 0xFu; }
#define XB_SPIN(cond, bar) do { unsigned _sp = 0; while (cond) { __builtin_amdgcn_s_sleep(1); \
    if ((++_sp & 255u) == 0u) { if (xb_ld(&(bar)[XB_TMO])) break; if (_sp > XB_SPIN_CAP) { atomicAdd(&(bar)[XB_TMO], 1u); break; } } } } while (0)
struct XcdBarrier { unsigned* bar; unsigned x; volatile LAS unsigned* st; };
__device__ __forceinline__ XcdBarrier xcd_barrier_post(unsigned* bar, volatile LAS unsigned* st) {
    XcdBarrier b; b.bar = bar; b.x = xb_xcc_id(); b.st = st;
    if (threadIdx.x == 0) (void)xb_add(&bar[XB_XCNT(b.x)], 1u);
    return b;
}
__device__ __forceinline__ void xcd_barrier_complete(unsigned* bar, unsigned x, unsigned& nloc, unsigned& nx) {
    const unsigned G = gridDim.x * gridDim.y * gridDim.z;
    unsigned sum, cnt, mine, sp = 0u;
    for (;;) {
        sum = 0u; cnt = 0u; mine = 0u;
#pragma unroll
        for (unsigned j = 0; j < 16; ++j) { const unsigned c = xb_ld(&bar[XB_XCNT(j)]); sum += c; cnt += (c > 0u) ? 1u : 0u; mine = (j == x) ? c : mine; }
        if (sum == G) break;
        __builtin_amdgcn_s_sleep(1);
        if ((++sp & 255u) == 0u) { if (xb_ld(&bar[XB_TMO])) break; if (sp > XB_SPIN_CAP) { atomicAdd(&bar[XB_TMO], 1u); break; } }
    }
    nloc = mine > 0u ? mine : 1u; nx = cnt > 0u ? cnt : 1u;
}
__device__ __forceinline__ void xcd_barrier(const XcdBarrier& b, int wave0) {
    asm volatile("s_waitcnt vmcnt(0)" ::: "memory");
    __syncthreads();
    if (wave0 == 0 && lane_id_v() == 0) {
        unsigned* bar = b.bar;
        __builtin_amdgcn_s_waitcnt(0);
        unsigned nloc = b.st[0], nx = b.st[1];
        if (nloc == 0u) { xcd_barrier_complete(bar, b.x, nloc, nx); b.st[0] = nloc; b.st[1] = nx; }
        const unsigned old = xb_add(&bar[XB_XSUB(b.x)], 1u);
        const unsigned gen = old / nloc;
        if (old + 1u == (gen + 1u) * nloc) {
            __builtin_amdgcn_fence(__ATOMIC_RELEASE, "agent");
            asm volatile("s_waitcnt vmcnt(0)" ::: "memory");
            const unsigned og = xb_add(&bar[XB_TOP], 1u);
            const unsigned tg = og / nx;
            if (og + 1u == (tg + 1u) * nx) xb_add(&bar[XB_TOPGEN], 1u);
            else XB_SPIN(xb_ld(&bar[XB_TOPGEN]) == tg, bar);
            __builtin_amdgcn_fence(__ATOMIC_ACQUIRE, "agent");
            xb_add(&bar[XB_XGEN(b.x)], 1u);
            asm volatile("s_waitcnt vmcnt(0)" ::: "memory");
        } else {
            XB_SPIN(xb_ld(&bar[XB_XGEN(b.x)]) == gen, bar);
            __builtin_amdgcn_fence(__ATOMIC_ACQUIRE, "agent");
            asm volatile("s_waitcnt vmcnt(0)" ::: "memory");
        }
    }
    __syncthreads();
}

constexpr int LDS_BYTES = 147456;

__global__ void __launch_bounds__(512, 2) hymba_fwd(Args args) {
    extern __shared__ __attribute__((aligned(16))) unsigned char lds_raw[];
    cg::grid_group grid = cg::this_grid();
    LAS unsigned char* lds = (LAS unsigned char*)lds_raw;
#define PHASE_IDS() const int lane = lane_id_v(); const int wave = wave0; (void)lane; (void)wave
    const int G = gridDim.x, bx = blockIdx.x;
    const int wave0 = __builtin_amdgcn_readfirstlane((int)(threadIdx.x >> 6));
    if (threadIdx.x < 4) ((LAS unsigned*)(lds + XBST_OFF))[threadIdx.x] = 0u;
    __syncthreads();
    const XcdBarrier xbar = xcd_barrier_post((unsigned*)(args.ws + WS_CTL) + 4096, (volatile LAS unsigned*)(lds + XBST_OFF));
    const int vcu = (G % 8 == 0) ? (bx % 8) * (G / 8) + bx / 8 : bx;
    const float* x_prompt = args.in[0]; const float* x_sample = args.in[1];
    const float* w_in = args.in[6]; const float* w_a2 = args.in[7]; const float* b_a = args.in[8];
    const float* w_o = args.in[10]; const float* g_pre_mix = args.in[11];
    const float* w_up = args.in[15]; const float* w_down = args.in[18];
#define PHASE_WS() unsigned char* ws = args.ws; asm volatile("" : "+s"(ws))

    {
        PHASE_IDS(); PHASE_WS();
        bf16_t* WinT = (bf16_t*)(ws + WS_WIN); bf16_t* WoT = (bf16_t*)(ws + WS_WO); bf16_t* WupT = (bf16_t*)(ws + WS_WUP); bf16_t* WdT = (bf16_t*)(ws + WS_WD); bf16_t* XN = (bf16_t*)(ws + WS_XN + 4096);
        LAS float* scr = (LAS float*)(lds + wave * 16384);
        const int gw = vcu * 8 + wave, NGW = G * 8;
        constexpr int I_IN = 16 * 96, I_G = 16 * 8, I_O = 16 * 32, I_UP = 16 * 176, I_D = 44 * 32;
        constexpr int NITEMS = I_IN + I_G + I_O + I_UP + I_D;
        for (int it = gw; it < NITEMS; it += NGW) {
            int r = it;
            if (r < I_IN) { const int kb = r / 96, nb = r % 96; p0_transpose_item(w_in, DIN, 32 * nb, 64 * kb, WinT, 1024, 32 * nb, scr, lane); continue; } r -= I_IN;
            if (r < I_G) { const int kb = r / 8, nb = r % 8; p0_gate_item(w_in, w_a2, 64 * kb, 32 * nb, WinT, scr, lane); continue; } r -= I_G;
            if (r < I_O) { const int kb = r / 32, nb = r % 32; p0_transpose_item(w_o, 1024, 32 * nb, 64 * kb, WoT, 1024, 32 * nb, scr, lane); continue; } r -= I_O;
            if (r < I_UP) { const int kb = r / 176, nb = r % 176; const int n0 = 32 * nb, t = n0 >> 8, w = n0 & 255;
                const int sc = (w < 128) ? (128 * t + w) : (DFF + 128 * t + (w - 128));
                p0_transpose_item(w_up, 2 * DFF, sc, 64 * kb, WupT, 1024, n0, scr, lane); continue; } r -= I_UP;
            { const int kb = r / 32, nb = r % 32; p0_transpose_item(w_down, 1024, 32 * nb, 64 * kb, WdT, DFF, 32 * nb, scr, lane); }
        }
        for (int m = gw; m < MT; m += NGW) {
            const float* xr = (m < MP) ? x_prompt + (size_t)m * DM : x_sample + (size_t)(m - MP) * DM;
            rms_row_to_bf16(xr, g_pre_mix, XN + (size_t)m * DM, lane);
        }
    }
    grid.sync();

    {
        PHASE_WS();
        pg8::Gemm g{(bf16_t*)(ws + WS_XN + 4096), (bf16_t*)(ws + WS_WIN), 1024, 256, 1024}; pg8::StaticOrder S; S.init(MT / 256, NIN / 256, G, bx);
        EpiInProj E{(bf16_t*)(ws + WS_QA), (bf16_t*)(ws + WS_KA), (bf16_t*)(ws + WS_VA), (bf16_t*)(ws + WS_QB), (bf16_t*)(ws + WS_KB), (bf16_t*)(ws + WS_VB), (bf16_t*)(ws + WS_RB),
                    (float*)(ws + WS_LF), args.out, b_a};
        pg8::gemm_phase<EpiInProj, pg8::StaticOrder>(lds, g, S, E, wave0);
    }
    xcd_barrier(xbar, wave0);

    {
        PHASE_IDS(); PHASE_WS();
        bf16_t* MIX = (bf16_t*)(ws + WS_MIX);
        GlaCtx GC{(const bf16_t*)(ws + WS_QB), (const bf16_t*)(ws + WS_KB), (const bf16_t*)(ws + WS_VB), (const bf16_t*)(ws + WS_RB), (const float*)(ws + WS_LF), MIX, args.in[9]};
        const float* state_gla = args.in[4];
#ifndef NO_GLA
        for (int it = bx; it < 64 + 128; it += G) {
            const bool pr = it < 64; const int seq = pr ? it : it - 64; const int b = seq >> 2, h = seq & 3;
            const size_t row0 = pr ? (size_t)b * SEQ : (size_t)MP + (size_t)b * 8;
            const float* s_in = pr ? nullptr : state_gla + (size_t)seq * 8192;
            float* s_out = args.out + (pr ? O_GP : O_GS) + (size_t)seq * 8192;
            const int nchunk = pr ? SEQ / 32 : 1;
            if (wave < 4) { if (pr) gla_m_wave<32>(lds, wave, lane, nchunk, s_in, s_out); else gla_m_wave<8>(lds, wave, lane, nchunk, s_in, s_out); }
            else { if (pr) gla_h_wave<32>(GC, lds, wave - 4, lane, (unsigned)row0, h, nchunk); else gla_h_wave<8>(GC, lds, wave - 4, lane, (unsigned)row0, h, nchunk); }
            __syncthreads();
        }
#endif
        AttnCtx AC{(const bf16_t*)(ws + WS_QA), (const bf16_t*)(ws + WS_KA), (const bf16_t*)(ws + WS_VA), MIX, args.in[2], args.in[3]};
        unsigned* counter = (unsigned*)(ws + WS_CTL);
        LAS unsigned char* wl = lds + wave * 8192;
        const int lane2 = lane_id_v();
        for (int sb = (bx + 64) % G; sb < NSB; sb += G) attn_item<true>(AC, sb, wave, 0, 0, wl, lane2);
        const unsigned xq0 = xb_xcc_id() & 7u;
        for (unsigned kq = 0; kq < 8u; ++kq) {
            const unsigned xq = (xq0 + kq) & 7u;
            unsigned* head = counter + 64 * xq;
            for (;;) {
                unsigned loc = 0; if (lane2 == 0) loc = atomicAdd(head, 1u);
                loc = (unsigned)__builtin_amdgcn_readfirstlane((int)loc);
                if (loc >= 1024u) break;
                { const unsigned p = loc; const unsigned grp = p >> 8, q = p & 255u; const int g = 15 - (int)(q >> 4); const unsigned bhl = (q >> 2) & 3u; const int r4 = (int)(q & 3u);
                    const int bh = (int)(xq + 8u * (4u * grp + bhl));
                    attn_item<false>(AC, bh >> 3, bh & 7, g, r4, wl, lane2); }
            }
        }
    }
    xcd_barrier(xbar, wave0);

    {
        PHASE_WS();
        bf16_t* MO = (bf16_t*)(ws + WS_MO); float* SSQ1 = (float*)(ws + WS_SSQ1);
        pg8::Gemm g{(bf16_t*)(ws + WS_MIX), (bf16_t*)(ws + WS_WO), 1024, 256, 1024}; pg8::StaticOrder S; S.init(MP / 256, 4, G, bx);
        EpiRowOut E{MO, SSQ1};
        pg8::gemm_phase<EpiRowOut, pg8::StaticOrder>(lds, g, S, E, wave0);
        pg8::Gemm g2{(bf16_t*)(ws + WS_MIX), (bf16_t*)(ws + WS_WO), 256, 256, 1024}; pg8::SplitOrder S2{16, G, bx, 128, 256};
        EpiSlice E2{(float*)(ws + WS_ACC1), 256};
        pg8::gemm_phase<EpiSlice, pg8::SplitOrder>(lds, g2, S2, E2, wave0);
    }
    xcd_barrier(xbar, wave0);
    {
        PHASE_IDS(); PHASE_WS();
        bf16_t* MO = (bf16_t*)(ws + WS_MO); float* SSQ1 = (float*)(ws + WS_SSQ1); bf16_t* XN = (bf16_t*)(ws + WS_XN + 4096);
        const float* g_post = args.in[12]; const float* g_pre = args.in[13];
        const int gw = vcu * 8 + wave, NGW = G * 8;
        {
            f32x4 gp4[4], gq4[4];
#pragma unroll
            for (int j = 0; j < 4; ++j) { gp4[j] = ((const GAS f32x4*)g_post)[64 * j + lane]; gq4[j] = ((const GAS f32x4*)g_pre)[64 * j + lane]; }
            for (int m0 = gw; m0 < MP; m0 += 2 * NGW) {
                const int m1 = (m0 + NGW < MP) ? m0 + NGW : m0;
                f32x4 sp[2], xv[2][4]; u32x2 mw[2][4];
#pragma unroll
                for (int r = 0; r < 2; ++r) { const int m = r ? m1 : m0; sp[r] = *((const GAS f32x4*)(SSQ1 + (size_t)m * 16) + (lane & 3));
#pragma unroll
                    for (int j = 0; j < 4; ++j) { xv[r][j] = ((const GAS f32x4*)(x_prompt + (size_t)m * DM))[64 * j + lane]; mw[r][j] = ((const GAS u32x2*)(MO + (size_t)m * DM))[64 * j + lane]; } }
#pragma unroll
                for (int r = 0; r < 2; ++r) if (r == 0 || m1 != m0) { const int m = r ? m1 : m0;
                    float ss = (sp[r].x + sp[r].y) + (sp[r].z + sp[r].w); ss += __shfl_xor(ss, 1); ss += __shfl_xor(ss, 2);
                    const float rs = rsqrtf(ss * (1.f / DM) + EPS);
                    f32x4 x1[4]; float s2 = 0.f;
#pragma unroll
                    for (int j = 0; j < 4; ++j) { f32x4 mv; mv.x = __uint_as_float(mw[r][j].x << 16); mv.y = __uint_as_float(mw[r][j].x & 0xffff0000u); mv.z = __uint_as_float(mw[r][j].y << 16); mv.w = __uint_as_float(mw[r][j].y & 0xffff0000u);
                        x1[j] = xv[r][j] + mv * rs * gp4[j]; s2 += (x1[j].x * x1[j].x + x1[j].y * x1[j].y) + (x1[j].z * x1[j].z + x1[j].w * x1[j].w);
                        ((GAS f32x4*)(args.out + (size_t)m * DM))[64 * j + lane] = x1[j]; }
                    const float rs2 = rsqrtf(wave_sum(s2) * (1.f / DM) + EPS);
#pragma unroll
                    for (int j = 0; j < 4; ++j) { const f32x4 y = x1[j] * rs2 * gq4[j]; u32x2 w; w.x = pk2(y.x, y.y); w.y = pk2(y.z, y.w); ((GAS u32x2*)(XN + (size_t)m * DM))[64 * j + lane] = w; }
                }
            }
        }
        for (int m = MP + gw; m < MT; m += NGW) {
            const float* xr = (m < MP) ? x_prompt + (size_t)m * DM : x_sample + (size_t)(m - MP) * DM;
            float* orow = args.out + (size_t)m * DM;
            f32x4 mvv[4]; float ss;
            if (m < MP) {
                const f32x4 sp = *((const f32x4*)(SSQ1 + (size_t)m * 16) + (lane & 3));
                ss = (sp.x + sp.y) + (sp.z + sp.w); ss += __shfl_xor(ss, 1); ss += __shfl_xor(ss, 2);
#pragma unroll
                for (int j = 0; j < 4; ++j) { const u32x2 mw = ((const u32x2*)(MO + (size_t)m * DM))[64 * j + lane];
                    mvv[j].x = __uint_as_float(mw.x << 16); mvv[j].y = __uint_as_float(mw.x & 0xffff0000u); mvv[j].z = __uint_as_float(mw.y << 16); mvv[j].w = __uint_as_float(mw.y & 0xffff0000u); }
            } else {
                const f32x4* ar = (const f32x4*)(ws + WS_ACC1) + (size_t)(m - MP) * 256; float s = 0.f;
#pragma unroll
                for (int j = 0; j < 4; ++j) { f32x4 a = ar[64 * j + lane];
                    for (int sl = 1; sl < 4; ++sl) a += ar[(size_t)sl * 65536 + 64 * j + lane];
                    mvv[j] = a; s += (a.x * a.x + a.y * a.y) + (a.z * a.z + a.w * a.w); }
                ss = wave_sum(s);
            }
            const float rs = rsqrtf(ss * (1.f / DM) + EPS);
            f32x4 x1[4]; float s2 = 0.f;
#pragma unroll
            for (int j = 0; j < 4; ++j) { const int c4 = 64 * j + lane; const f32x4 xv = ((const f32x4*)xr)[c4]; const f32x4 gp = ((const f32x4*)g_post)[c4];
                const f32x4 mv = mvv[j];
                x1[j] = xv + mv * rs * gp; s2 += (x1[j].x * x1[j].x + x1[j].y * x1[j].y) + (x1[j].z * x1[j].z + x1[j].w * x1[j].w);
                ((f32x4*)orow)[c4] = x1[j]; }
            const float rs2 = rsqrtf(wave_sum(s2) * (1.f / DM) + EPS);
#pragma unroll
            for (int j = 0; j < 4; ++j) { const int c4 = 64 * j + lane; const f32x4 gq = ((const f32x4*)g_pre)[c4]; const f32x4 y = x1[j] * rs2 * gq; u32x2 w; w.x = pk2(y.x, y.y); w.y = pk2(y.z, y.w); ((u32x2*)(XN + (size_t)m * DM))[c4] = w; }
        }
    }
    xcd_barrier(xbar, wave0);
    {
        PHASE_WS();
        bf16_t* Hb = (bf16_t*)(ws + WS_H);
        pg8::Gemm g{(bf16_t*)(ws + WS_XN + 4096) - 2 * DM, (bf16_t*)(ws + WS_WUP), 1024, 254, 1024}; pg8::StaticOrder S; S.init(131, 22, G, bx);
        EpiUp E{Hb, args.out, args.in[16], args.in[17], args.in[5], lds};
        pg8::gemm_phase<EpiUp, pg8::StaticOrder>(lds, g, S, E, wave0);
    }
    xcd_barrier(xbar, wave0);
    {
        PHASE_WS();
        bf16_t* MO = (bf16_t*)(ws + WS_MO); float* SSQ2 = (float*)(ws + WS_SSQ2);
        pg8::Gemm g{(bf16_t*)(ws + WS_H), (bf16_t*)(ws + WS_WD), DFF, 256, DFF}; pg8::StaticOrder S; S.init(MP / 256, 4, G, bx);
        EpiRowOut E{MO, SSQ2};
        pg8::gemm_phase<EpiRowOut, pg8::StaticOrder>(lds, g, S, E, wave0);
        pg8::Gemm g2{(bf16_t*)(ws + WS_H), (bf16_t*)(ws + WS_WD), 256, 256, DFF}; pg8::SplitOrder S2{44, G, bx, 128, 256};
        EpiSlice E2{(float*)(ws + WS_ACC2), 256};
        pg8::gemm_phase<EpiSlice, pg8::SplitOrder>(lds, g2, S2, E2, wave0);
    }
    xcd_barrier(xbar, wave0);
    {
        PHASE_IDS(); PHASE_WS();
        bf16_t* MO = (bf16_t*)(ws + WS_MO); float* SSQ2 = (float*)(ws + WS_SSQ2);
        const float* g_post = args.in[14];
        const int gw = vcu * 8 + wave, NGW = G * 8;
        {
            const f32x4 gp4[4] = {((const GAS f32x4*)g_post)[lane], ((const GAS f32x4*)g_post)[64 + lane], ((const GAS f32x4*)g_post)[128 + lane], ((const GAS f32x4*)g_post)[192 + lane]};
            for (int m0 = gw; m0 < MP; m0 += 2 * NGW) {
                const int m1 = (m0 + NGW < MP) ? m0 + NGW : m0;
                GAS float* ro[2] = {(GAS float*)(args.out + (size_t)m0 * DM), (GAS float*)(args.out + (size_t)m1 * DM)};
                f32x4 sp[2], xv[2][4]; u32x2 mw[2][4];
#pragma unroll
                for (int r = 0; r < 2; ++r) { const int m = r ? m1 : m0; sp[r] = *((const GAS f32x4*)(SSQ2 + (size_t)m * 16) + (lane & 3));
#pragma unroll
                    for (int j = 0; j < 4; ++j) { xv[r][j] = ((const GAS f32x4*)ro[r])[64 * j + lane]; mw[r][j] = ((const GAS u32x2*)(MO + (size_t)m * DM))[64 * j + lane]; } }
                f32x4 yv[2][4];
#pragma unroll
                for (int r = 0; r < 2; ++r) { float ss = (sp[r].x + sp[r].y) + (sp[r].z + sp[r].w); ss += __shfl_xor(ss, 1); ss += __shfl_xor(ss, 2);
                    const float rs = rsqrtf(ss * (1.f / DM) + EPS);
#pragma unroll
                    for (int j = 0; j < 4; ++j) { f32x4 mv; mv.x = __uint_as_float(mw[r][j].x << 16); mv.y = __uint_as_float(mw[r][j].x & 0xffff0000u); mv.z = __uint_as_float(mw[r][j].y << 16); mv.w = __uint_as_float(mw[r][j].y & 0xffff0000u);
                        yv[r][j] = xv[r][j] + mv * rs * gp4[j]; } }
#pragma unroll
                for (int r = 0; r < 2; ++r) if (r == 0 || m1 != m0) {
#pragma unroll
                    for (int j = 0; j < 4; ++j) ((GAS f32x4*)ro[r])[64 * j + lane] = yv[r][j]; }
            }
        }
        for (int m = MP + gw; m < MT; m += NGW) {
            float* orow = args.out + (size_t)m * DM;
            f32x4 mvv[4]; float ss;
            if (m < MP) {
                const f32x4 sp = *((const f32x4*)(SSQ2 + (size_t)m * 16) + (lane & 3));
                ss = (sp.x + sp.y) + (sp.z + sp.w); ss += __shfl_xor(ss, 1); ss += __shfl_xor(ss, 2);
#pragma unroll
                for (int j = 0; j < 4; ++j) { const u32x2 mw = ((const u32x2*)(MO + (size_t)m * DM))[64 * j + lane];
                    mvv[j].x = __uint_as_float(mw.x << 16); mvv[j].y = __uint_as_float(mw.x & 0xffff0000u); mvv[j].z = __uint_as_float(mw.y << 16); mvv[j].w = __uint_as_float(mw.y & 0xffff0000u); }
            } else {
                const f32x4* ar = (const f32x4*)(ws + WS_ACC2) + (size_t)(m - MP) * 256; float s = 0.f;
#pragma unroll
                for (int j = 0; j < 4; ++j) { f32x4 a = ar[64 * j + lane];
                    for (int sl = 1; sl < 11; ++sl) a += ar[(size_t)sl * 65536 + 64 * j + lane];
                    mvv[j] = a; s += (a.x * a.x + a.y * a.y) + (a.z * a.z + a.w * a.w); }
                ss = wave_sum(s);
            }
            const float rs = rsqrtf(ss * (1.f / DM) + EPS);
#pragma unroll
            for (int j = 0; j < 4; ++j) { const int c4 = 64 * j + lane; const f32x4 xv = ((const f32x4*)orow)[c4]; const f32x4 gp = ((const f32x4*)g_post)[c4];
                ((f32x4*)orow)[c4] = xv + mvv[j] * rs * gp; }
        }
    }
}

extern "C" void kernel_launch(void* const* d_in, const int* in_sizes, int n_in, void* d_out, int out_size, void* d_ws, size_t ws_size, hipStream_t stream) {
    static int grid = 0;
    if (grid == 0) {
        if (n_in != 19 || ws_size < WS_END || (size_t)out_size != O_END) { fprintf(stderr, "kernel_launch: unexpected shapes n_in %d out %d ws %zu\n", n_in, out_size, ws_size); grid = -1; return; }
        int dev = 0, cus = 0, per_cu = 0;
        hipGetDevice(&dev); hipDeviceGetAttribute(&cus, hipDeviceAttributeMultiprocessorCount, dev);
        hipFuncSetAttribute((const void*)hymba_fwd, hipFuncAttributeMaxDynamicSharedMemorySize, LDS_BYTES);
        hipOccupancyMaxActiveBlocksPerMultiprocessor(&per_cu, (const void*)hymba_fwd, 512, LDS_BYTES);
        if (per_cu < 1) { fprintf(stderr, "kernel_launch: occupancy query says %d blocks per CU\n", per_cu); grid = -1; return; }
        grid = cus;
    }
    if (grid < 0) return;
    hipMemsetAsync((char*)d_ws + WS_CTL, 0, CTL_BYTES, stream);
    Args a{};
    for (int i = 0; i < 19; ++i) a.in[i] = (const float*)d_in[i];
    a.out = (float*)d_out; a.ws = (unsigned char*)d_ws;
    void* kargs[] = {&a};
    hipError_t e = hipLaunchCooperativeKernel((const void*)hymba_fwd, dim3(grid), dim3(512), kargs, LDS_BYTES, stream);
    if (e != hipSuccess) fprintf(stderr, "cooperative launch failed: %s (grid %d)\n", hipGetErrorString(e), grid);
}
```

```cpp
#include <hip/hip_runtime.h>
#include <hip/hip_cooperative_groups.h>
#include <cstdio>
#include <cstdint>
namespace cg = cooperative_groups;

#define LAS __attribute__((address_space(3)))
#define GAS __attribute__((address_space(1)))
typedef unsigned short bf16_t;
typedef short bf16x8 __attribute__((ext_vector_type(8)));
typedef short s16x4 __attribute__((ext_vector_type(4)));
typedef float f32x4 __attribute__((ext_vector_type(4)));
typedef float f32x2 __attribute__((ext_vector_type(2)));
typedef float f32x16 __attribute__((ext_vector_type(16)));
typedef unsigned u32x4 __attribute__((ext_vector_type(4)));
typedef unsigned u32x2 __attribute__((ext_vector_type(2)));

constexpr int DM = 1024, NPB = 16, SEQ = 2048, NSB = 32, NST = 8;
constexpr int MP = NPB * SEQ;
constexpr int MS = NSB * NST;
constexpr int MT = MP + MS;
constexpr int NIN = 3328;
constexpr int DIN = 3088;
constexpr int DFF = 2816;
constexpr int WINB = 2048;
constexpr float EPS = 1e-6f;
constexpr float QSCALE = 0.125f * 1.4426950408889634f;

constexpr size_t MiB = 1u << 20;
constexpr size_t WS_CTL = 0, CTL_BYTES = 65536;
constexpr int XBST_OFF = 131072 + 8192;
constexpr size_t WS_WIN = 1 * MiB, WS_WO = 8 * MiB, WS_WUP = 10 * MiB, WS_WD = 22 * MiB;
constexpr size_t WS_SSQ1 = 28 * MiB, WS_SSQ2 = 31 * MiB;
constexpr size_t WS_XN = 34 * MiB;
constexpr size_t WS_MO = 104 * MiB;
constexpr size_t WS_QA = 172 * MiB, WS_KA = 206 * MiB, WS_VA = 240 * MiB, WS_QB = 274 * MiB, WS_KB = 291 * MiB, WS_VB = 308 * MiB, WS_RB = 342 * MiB, WS_LF = 376 * MiB, WS_MIX = 410 * MiB;
constexpr size_t WS_H = 172 * MiB;
constexpr size_t WS_ACC1 = 478 * MiB, WS_ACC2 = 482 * MiB;
constexpr size_t WS_END = 494 * MiB;
static_assert(WS_H + (size_t)MT * DFF * 2 <= WS_MIX, "h overlay");
static_assert(WS_XN + 4096 + (size_t)(131 * 254 + 260) * DM * 2 <= WS_MO, "xn2");

constexpr size_t O_YP = 0, O_YS = O_YP + (size_t)MP * DM, O_KP = O_YS + (size_t)MS * DM, O_VP = O_KP + (size_t)MP * 512, O_GP = O_VP + (size_t)MP * 512,
                 O_CP = O_GP + (size_t)NPB * 4 * 64 * 128, O_KS = O_CP + (size_t)NPB * 2 * DFF, O_VS = O_KS + (size_t)MS * 512, O_GS = O_VS + (size_t)MS * 512,
                 O_CS = O_GS + (size_t)NSB * 4 * 64 * 128, O_END = O_CS + (size_t)NSB * 2 * DFF;

__device__ __forceinline__ unsigned cvt_pk_bf16(float lo, float hi) { unsigned r; asm volatile("v_cvt_pk_bf16_f32 %0, %1, %2" : "=v"(r) : "v"(lo), "v"(hi)); return r; }
__device__ __forceinline__ float bf2f(unsigned short b) { return __uint_as_float((unsigned)b << 16); }
__device__ __forceinline__ float wave_sum(float v) {
#pragma unroll
    for (int o = 1; o < 64; o <<= 1) v += __shfl_xor(v, o);
    return v;
}

__device__ __forceinline__ int lane_id_v() { int l; asm volatile("v_mbcnt_lo_u32_b32 %0, -1, 0\n\tv_mbcnt_hi_u32_b32 %0, -1, %0" : "=v"(l)); return l; }

struct Args {
    const float* in[19];
    float* out;
    unsigned char* ws;
};

namespace pg8 {
constexpr int BM = 256, BK = 64, HALF = 128, HTB = HALF * BK * 2, STAGE_BYTES = 8 * HTB, NXCD = 8, WGM = 8;
__host__ __device__ __forceinline__ int lds_byte(int r, int c) { const int st = (r >> 4) * 2 + (c >> 5), rr = r & 15, cc = c & 31, ob = rr * 64 + cc * 2; return st * 1024 + (ob ^ (((ob >> 9) & 1) << 5)); }
__host__ __device__ __forceinline__ void stage_rc(int b, int& R, int& C) { const int st = b / 1024, sb = b % 1024, swz = sb ^ (((sb >> 9) & 1) << 5); R = (st >> 1) * 16 + swz / 64; C = (st & 1) * 32 + (swz % 64) / 2; }
__host__ __device__ __forceinline__ int perm32(int rho) { const int n = rho >> 4, i = rho & 15; return 8 * (i >> 2) + 4 * n + (i & 3); }

struct Unit { int pm, pn, kofs; };
struct Gemm { const bf16_t* A; const bf16_t* Bt; int K; int a_rows; int ldk; };

struct StaticOrder {
    int nM, nN, nwg, G, c;
    __device__ void init(int nM_, int nN_, int G_, int c_) { nM = nM_; nN = nN_; nwg = nM * nN; G = G_; c = c_; }
    __device__ bool next(int i, Unit& u) const {
        const long L = (long)i * G + c; if (L >= nwg) return false;
        int wgid = (int)L; { const int q = nwg / NXCD, r = nwg % NXCD, xcd = wgid % NXCD, off = wgid / NXCD; wgid = (xcd < r ? xcd * (q + 1) : r * (q + 1) + (xcd - r) * q) + off; }
        const int nig = WGM * nN, gid = wgid / nig, fm = gid * WGM, gsz = (nM - fm) < WGM ? (nM - fm) : WGM;
        u.pm = fm + ((wgid % nig) % gsz); u.pn = (wgid % nig) / gsz; u.kofs = 0; return true;
    }
};
struct SplitOrder {
    int nsub, G, c, pm, ksub;
    __device__ bool next(int i, Unit& u) const { const int L = i * G + c; if (L >= nsub) return false; u.pm = pm; u.pn = L & 3; u.kofs = (L >> 2) * ksub; return true; }
};

__device__ __forceinline__ f32x2 gelu_pk(f32x2 v) {
    const f32x2 av = __builtin_elementwise_abs(v), d = av * 0.2316418882f + 1.0f;
    f32x2 t; t.x = __builtin_amdgcn_rcpf(d.x); t.y = __builtin_amdgcn_rcpf(d.y);
    f32x2 q = t * 0.5307027145f + (-0.7265760135f); q = q * t + 0.7107068705f; q = q * t + (-0.142248368f); q = q * t + 0.127414796f; q = q * t;
    const f32x2 s = (v * v) * (-0.72134752044f);
    f32x2 e; e.x = __builtin_amdgcn_exp2f(s.x); e.y = __builtin_amdgcn_exp2f(s.y);
    const f32x2 m = v * (q * e), r = v - m;
    f32x2 o; o.x = v.x < 0.f ? m.x : r.x; o.y = v.y < 0.f ? m.y : r.y; return o;
}

template <class Epi, class Sched>
__device__ __forceinline__ void gemm_phase(LAS unsigned char* lds, const Gemm g, const Sched& S, const Epi& E, int wid) {
    const int lane = lane_id_v(); const int tid = wid * 64 + lane;
    const int wr = wid >> 2, wc = wid & 3, fr = lane & 15, fq = lane >> 4;
    const int K = g.ldk, nt = g.K / BK;
    unsigned voffA[2], voffB[2];
#pragma unroll
    for (int i = 0; i < 2; ++i) { int R, C; stage_rc(tid * 16 + i * 8192, R, C); const int Rb = Epi::PERM ? ((R & ~31) + perm32(R & 31)) : R;
        voffA[i] = (unsigned)(R * K + C) * 2u; voffB[i] = (unsigned)(Rb * K + C) * 2u; }
    const size_t kstep = (size_t)(BK * 2);
    const size_t hstep = (size_t)HALF * K * 2;
    const size_t tstepB = 2 * hstep;
    const size_t tstepA = (size_t)g.a_rows * K * 2;
    const unsigned ldsw = (unsigned)wid * 1024u;
    const int aoff = lds_byte(wr * 64 + fr, fq * 8), boff = lds_byte(wc * 32 + fr, fq * 8);
#define PG8_SA(b, h) (((b) * 2 + (h)) * HTB)
#define PG8_SB(b, h) ((4 + (b) * 2 + (h)) * HTB)
#define PG8_STAGE(bufoff, gbase, voff) do { _Pragma("unroll") for (int _i = 0; _i < 2; ++_i) \
        __builtin_amdgcn_global_load_lds((const unsigned*)((const char*)(gbase) + (voff)[_i]), (LAS unsigned*)(lds + (bufoff) + ldsw + _i * 8192), 16, 0, 0); } while (0)
#define PG8_LDA(dst, b, h) do { _Pragma("unroll") for (int m = 0; m < 4; ++m) _Pragma("unroll") for (int k = 0; k < 2; ++k) dst[m][k] = *(const LAS bf16x8*)(lds + PG8_SA(b, h) + aoff + m * 2048 + k * 1024); } while (0)
#define PG8_LDB(dst, b, h) do { _Pragma("unroll") for (int n = 0; n < 2; ++n) _Pragma("unroll") for (int k = 0; k < 2; ++k) dst[n][k] = *(const LAS bf16x8*)(lds + PG8_SB(b, h) + boff + n * 2048 + k * 1024); } while (0)
#define PG8_MMA(ai, bj, At, Bt) do { __builtin_amdgcn_s_setprio(1); _Pragma("unroll") for (int m = 0; m < 4; ++m) _Pragma("unroll") for (int n = 0; n < 2; ++n) _Pragma("unroll") for (int k = 0; k < 2; ++k) \
        acc[ai][bj][m][n] = __builtin_amdgcn_mfma_f32_16x16x32_bf16(Bt[n][k], At[m][k], acc[ai][bj][m][n], 0, 0, 0); __builtin_amdgcn_s_setprio(0); } while (0)
#define PG8_WAIT_V(n) asm volatile("s_waitcnt vmcnt(" #n ")" ::: "memory")
#define PG8_WAIT_L(n) asm volatile("s_waitcnt lgkmcnt(" #n ")" ::: "memory")
#define PG8_BAR __builtin_amdgcn_s_barrier()
#define PG8_SCHED __builtin_amdgcn_sched_barrier(0)
    Unit cur, nxt; int ui = 0;
    if (!S.next(0, cur)) return;
    f32x4 acc[2][2][4][2];
#pragma unroll
    for (int a = 0; a < 2; ++a)
#pragma unroll
        for (int b = 0; b < 2; ++b)
#pragma unroll
            for (int m = 0; m < 4; ++m)
#pragma unroll
                for (int n = 0; n < 2; ++n) acc[a][b][m][n] = (f32x4){0.f, 0.f, 0.f, 0.f};
    bf16x8 At[4][2], B0[2][2], B1[2][2];
    const char* cA = (const char*)g.A + (size_t)cur.pm * tstepA + (size_t)cur.kofs * 2; const char* cB = (const char*)g.Bt + (size_t)cur.pn * tstepB + (size_t)cur.kofs * 2;
    PG8_STAGE(PG8_SB(0, 0), cB, voffB); PG8_STAGE(PG8_SB(0, 1), cB + hstep, voffB); PG8_STAGE(PG8_SA(0, 0), cA, voffA); PG8_STAGE(PG8_SA(0, 1), cA + hstep, voffA);
    if (wr == 1) PG8_BAR;
    PG8_WAIT_V(2); PG8_BAR;
    PG8_STAGE(PG8_SB(1, 0), cB + kstep, voffB); PG8_STAGE(PG8_SA(1, 0), cA + kstep, voffA); PG8_STAGE(PG8_SB(1, 1), cB + hstep + kstep, voffB);
    PG8_WAIT_V(6); PG8_BAR;
    for (;;) {
        const bool has_next = S.next(ui + 1, nxt);
        const char* nA = has_next ? (const char*)g.A + (size_t)nxt.pm * tstepA + (size_t)nxt.kofs * 2 : cA; const char* nB = has_next ? (const char*)g.Bt + (size_t)nxt.pn * tstepB + (size_t)nxt.kofs * 2 : cB;
        for (int t = 0; t < nt; t += 2) {
            const bool last = (t == nt - 2);
            const char* a1 = cA + (size_t)(t + 1) * kstep;
            const char* a2 = last ? nA : cA + (size_t)(t + 2) * kstep; const char* b2 = last ? nB : cB + (size_t)(t + 2) * kstep;
            const char* a3 = a2 + kstep; const char* b3 = b2 + kstep;
            PG8_LDB(B0, 0, 0); PG8_LDB(B1, 0, 1); PG8_SCHED; PG8_LDA(At, 0, 0); PG8_STAGE(PG8_SA(1, 1), a1 + hstep, voffA);
            PG8_WAIT_V(8); PG8_WAIT_L(0); PG8_BAR; PG8_MMA(0, 0, At, B0); PG8_MMA(0, 1, At, B1); PG8_BAR; PG8_SCHED;
            PG8_LDA(At, 0, 1); PG8_STAGE(PG8_SB(0, 0), b2, voffB); PG8_STAGE(PG8_SB(0, 1), b2 + hstep, voffB); PG8_STAGE(PG8_SA(0, 0), a2, voffA);
            PG8_WAIT_V(8); PG8_WAIT_L(0); PG8_BAR; PG8_MMA(1, 0, At, B0); PG8_MMA(1, 1, At, B1); PG8_BAR; PG8_SCHED;
            PG8_LDB(B0, 1, 0); PG8_LDB(B1, 1, 1); PG8_SCHED; PG8_LDA(At, 1, 0); PG8_STAGE(PG8_SA(0, 1), a2 + hstep, voffA);
            PG8_WAIT_V(8); PG8_WAIT_L(0); PG8_BAR; PG8_MMA(0, 0, At, B0); PG8_MMA(0, 1, At, B1); PG8_BAR; PG8_SCHED;
            PG8_LDA(At, 1, 1); PG8_STAGE(PG8_SB(1, 0), b3, voffB); PG8_STAGE(PG8_SB(1, 1), b3 + hstep, voffB); PG8_STAGE(PG8_SA(1, 0), a3, voffA);
            PG8_WAIT_V(8); PG8_WAIT_L(0); PG8_BAR; PG8_MMA(1, 0, At, B0); PG8_MMA(1, 1, At, B1); PG8_BAR; PG8_SCHED;
        }
        if (wr == 0) PG8_BAR;
        E(acc, cur, wr, wc, fr, fq);
        if (!has_next) break;
#pragma unroll
        for (int a = 0; a < 2; ++a)
#pragma unroll
            for (int b = 0; b < 2; ++b)
#pragma unroll
                for (int m = 0; m < 4; ++m)
#pragma unroll
                    for (int n = 0; n < 2; ++n) acc[a][b][m][n] = (f32x4){0.f, 0.f, 0.f, 0.f};
        cur = nxt; cA = nA; cB = nB; ++ui;
        if (wr == 1) PG8_BAR;
    }
    PG8_WAIT_V(0);
    PG8_BAR;
#undef PG8_SA
#undef PG8_SB
#undef PG8_STAGE
#undef PG8_LDA
#undef PG8_LDB
#undef PG8_MMA
#undef PG8_WAIT_V
#undef PG8_WAIT_L
#undef PG8_BAR
#undef PG8_SCHED
}
}

struct EpiInProj {
    static constexpr bool PERM = true;
    bf16_t *QA, *KA, *VA, *QB, *KB, *VB, *RB; float* LF; float* out; const float* b_a;
    __device__ __forceinline__ void operator()(const f32x4 (&acc)[2][2][4][2], const pg8::Unit& u, int wr, int wc, int fr, int fq) const {
        const int pn = u.pn;
        const int row0 = u.pm * 256 + wr * 64 + fr;
        const int cl = wc * 32 + 8 * fq;
        if (pn == 12) {
#pragma unroll
            for (int bj = 0; bj < 2; ++bj) {
                const f32x4 b0 = *(const f32x4*)(b_a + cl + bj * 128), b1 = *(const f32x4*)(b_a + cl + bj * 128 + 4);
#pragma unroll
                for (int ai = 0; ai < 2; ++ai)
#pragma unroll
                    for (int m = 0; m < 4; ++m) {
                        f32x4 v0 = acc[ai][bj][m][0] + b0, v1 = acc[ai][bj][m][1] + b1;
#pragma unroll
                        for (int e = 0; e < 4; ++e) { float z = v0[e]; v0[e] = (fminf(z, 0.f) - log1pf(__expf(-fabsf(z)))) * 0.0625f; z = v1[e]; v1[e] = (fminf(z, 0.f) - log1pf(__expf(-fabsf(z)))) * 0.0625f; }
                        float* p = LF + (size_t)(row0 + ai * 128 + m * 16) * 256 + cl + bj * 128;
                        *(f32x4*)p = v0; *(f32x4*)(p + 4) = v1;
                    }
            }
            return;
        }
        bf16_t* base; int ld, cb; float sc = 1.f; float* fo = nullptr;
        if (pn < 2) { base = QA; ld = 512; cb = pn * 256; sc = QSCALE; }
        else if (pn < 4) { base = KA; ld = 512; cb = (pn - 2) * 256; fo = out + (u.pm < 128 ? O_KP : O_KS - (size_t)MP * 512); }
        else if (pn < 6) { base = VA; ld = 512; cb = (pn - 4) * 256; fo = out + (u.pm < 128 ? O_VP : O_VS - (size_t)MP * 512); }
        else if (pn == 6) { base = QB; ld = 256; cb = 0; }
        else if (pn == 7) { base = KB; ld = 256; cb = 0; }
        else if (pn < 10) { base = VB; ld = 512; cb = (pn - 8) * 256; }
        else { base = RB; ld = 512; cb = (pn - 10) * 256; }
#pragma unroll
        for (int ai = 0; ai < 2; ++ai)
#pragma unroll
            for (int m = 0; m < 4; ++m) {
                const size_t r = (size_t)(row0 + ai * 128 + m * 16);
#pragma unroll
                for (int bj = 0; bj < 2; ++bj) {
                    const f32x4 a0 = acc[ai][bj][m][0], a1 = acc[ai][bj][m][1];
                    const f32x4 v0 = a0 * sc, v1 = a1 * sc;
                    u32x4 w; w.x = cvt_pk_bf16(v0[0], v0[1]); w.y = cvt_pk_bf16(v0[2], v0[3]); w.z = cvt_pk_bf16(v1[0], v1[1]); w.w = cvt_pk_bf16(v1[2], v1[3]);
                    *(u32x4*)(base + r * ld + cb + cl + bj * 128) = w;
                    if (fo) { float* p = fo + r * 512 + cb + cl + bj * 128; *(f32x4*)p = a0; *(f32x4*)(p + 4) = a1; }
                }
            }
    }
};


struct EpiRowOut {
    static constexpr bool PERM = true;
    bf16_t* O; float* SSQ;
    __device__ __forceinline__ void operator()(const f32x4 (&acc)[2][2][4][2], const pg8::Unit& u, int wr, int wc, int fr, int fq) const {
        const int row0 = u.pm * 256 + wr * 64 + fr; const int cl = u.pn * 256 + wc * 32 + 8 * fq;
#pragma unroll
        for (int ai = 0; ai < 2; ++ai)
#pragma unroll
            for (int m = 0; m < 4; ++m) {
                const size_t r = (size_t)(row0 + ai * 128 + m * 16); float s = 0.f;
#pragma unroll
                for (int bj = 0; bj < 2; ++bj) {
                    const f32x4 v0 = acc[ai][bj][m][0], v1 = acc[ai][bj][m][1];
                    s += (v0[0] * v0[0] + v0[1] * v0[1]) + (v0[2] * v0[2] + v0[3] * v0[3]) + (v1[0] * v1[0] + v1[1] * v1[1]) + (v1[2] * v1[2] + v1[3] * v1[3]);
                    u32x4 w; w.x = cvt_pk_bf16(v0[0], v0[1]); w.y = cvt_pk_bf16(v0[2], v0[3]); w.z = cvt_pk_bf16(v1[0], v1[1]); w.w = cvt_pk_bf16(v1[2], v1[3]);
                    *(u32x4*)(O + r * 1024 + cl + bj * 128) = w;
                }
                s += __shfl_xor(s, 16); s += __shfl_xor(s, 32);
                if (fq == 0) SSQ[r * 16 + u.pn * 4 + wc] = s;
            }
    }
};

struct EpiSlice {
    static constexpr bool PERM = false;
    float* SL; int ksub;
    __device__ __forceinline__ void operator()(const f32x4 (&acc)[2][2][4][2], const pg8::Unit& u, int wr, int wc, int fr, int fq) const {
        float* base = SL + (size_t)(u.kofs / ksub) * (256 * 1024) + (unsigned)((wr * 64 + fr) * 1024 + u.pn * 256 + wc * 32 + 4 * fq);
#pragma unroll
        for (int ai = 0; ai < 2; ++ai)
#pragma unroll
            for (int m = 0; m < 4; ++m) { float* rowp = base + (ai * 128 + m * 16) * 1024;
#pragma unroll
                for (int bj = 0; bj < 2; ++bj)
#pragma unroll
                    for (int n = 0; n < 2; ++n) *(f32x4*)(rowp + bj * 128 + n * 16) = acc[ai][bj][m][n]; }
    }
};

__device__ __forceinline__ float dpp_ror1(float v) { return __int_as_float(__builtin_amdgcn_update_dpp(0, __float_as_int(v), 0x121, 0xf, 0xf, false)); }
__device__ __forceinline__ float dpp_ror2(float v) { return __int_as_float(__builtin_amdgcn_update_dpp(0, __float_as_int(v), 0x122, 0xf, 0xf, false)); }

constexpr int CONVX_OFF = 131072;
struct EpiUp {
    static constexpr bool PERM = true;
    bf16_t* H; float* out; const float* conv_w; const float* conv_b; const float* cbuf; LAS unsigned char* lds;
    __device__ __forceinline__ void operator()(const f32x4 (&acc)[2][2][4][2], const pg8::Unit& u, int wr, int wc, int fr, int fq) const {
        LAS float* X = (LAS float*)(lds + CONVX_OFF);
        const int cg_ = wc * 32 + 8 * fq;
        const int col = u.pn * 128 + cg_;
        if (fr >= 14) {
#pragma unroll
            for (int ai = 0; ai < 2; ++ai) { LAS float* p = X + ((ai * 2 + wr) * 2 + (fr - 14)) * 128 + cg_; *(LAS f32x4*)p = acc[ai][0][3][0]; *(LAS f32x4*)(p + 4) = acc[ai][0][3][1]; }
        }
        f32x4 w0[2], w1[2], w2[2], cb[2];
#pragma unroll
        for (int n = 0; n < 2; ++n) { w0[n] = *(const f32x4*)(conv_w + col + 4 * n); w1[n] = *(const f32x4*)(conv_w + DFF + col + 4 * n); w2[n] = *(const f32x4*)(conv_w + 2 * DFF + col + 4 * n); cb[n] = *(const f32x4*)(conv_b + col + 4 * n); }
        asm volatile("s_waitcnt lgkmcnt(0)" ::: "memory"); __builtin_amdgcn_s_barrier(); asm volatile("" ::: "memory");
#pragma unroll
        for (int ai = 0; ai < 2; ++ai) {
            const int pai = (wr == 1) ? ai : ai - 1, pwr = wr ^ 1;
#pragma unroll
            for (int m = 0; m < 4; ++m) {
                const int lr = ai * 128 + wr * 64 + m * 16 + fr; const int gr = u.pm * 254 - 2 + lr;
                const bool store = (lr >= 2) && (gr < MT);
                int pos, bidx; bool samp = gr >= MP;
                if (!samp) { pos = gr & (SEQ - 1); bidx = gr >> 11; } else { pos = (gr - MP) & 7; bidx = (gr - MP) >> 3; }
                u32x4 hw;
#pragma unroll
                for (int n = 0; n < 2; ++n) {
                    f32x4 g0 = acc[ai][0][m][n], uu = acc[ai][1][m][n], gm1, gm2;
#pragma unroll
                    for (int e = 0; e < 4; ++e) {
                        const float r1 = dpp_ror1(g0[e]), r2 = dpp_ror2(g0[e]);
                        float p1, p2;
                        if (m > 0) { p1 = dpp_ror1(acc[ai][0][m > 0 ? m - 1 : 0][n][e]); p2 = dpp_ror2(acc[ai][0][m > 0 ? m - 1 : 0][n][e]); }
                        else if (pai >= 0) { p1 = X[((pai * 2 + pwr) * 2 + 1) * 128 + cg_ + 4 * n + e]; p2 = X[((pai * 2 + pwr) * 2 + (fr & 1)) * 128 + cg_ + 4 * n + e]; }
                        else { p1 = 0.f; p2 = 0.f; }
                        gm1[e] = fr >= 1 ? r1 : p1; gm2[e] = fr >= 2 ? r2 : p2;
                    }
                    if (!samp) { if (pos == 0) { gm1 = (f32x4){0.f, 0.f, 0.f, 0.f}; gm2 = gm1; } else if (pos == 1) gm2 = (f32x4){0.f, 0.f, 0.f, 0.f}; }
                    else if (store) { if (pos == 0) { gm1 = *(const f32x4*)(cbuf + (size_t)(bidx * 2 + 1) * DFF + col + 4 * n); gm2 = *(const f32x4*)(cbuf + (size_t)(bidx * 2) * DFF + col + 4 * n); }
                                      else if (pos == 1) gm2 = *(const f32x4*)(cbuf + (size_t)(bidx * 2 + 1) * DFF + col + 4 * n); }
                    const f32x4 c = cb[n] + w0[n] * gm2 + w1[n] * gm1 + w2[n] * g0;
                    const f32x2 ga = pg8::gelu_pk((f32x2){c[0], c[1]}), gb = pg8::gelu_pk((f32x2){c[2], c[3]});
                    const float h0 = ga.x * uu[0], h1 = ga.y * uu[1], h2 = gb.x * uu[2], h3 = gb.y * uu[3];
                    if (n == 0) { hw.x = cvt_pk_bf16(h0, h1); hw.y = cvt_pk_bf16(h2, h3); } else { hw.z = cvt_pk_bf16(h0, h1); hw.w = cvt_pk_bf16(h2, h3); }
                    if (store) {
                        if (!samp) { if (pos >= SEQ - 2) *(f32x4*)(out + O_CP + (size_t)(bidx * 2 + (pos - (SEQ - 2))) * DFF + col + 4 * n) = g0; }
                        else { if (pos >= 6) *(f32x4*)(out + O_CS + (size_t)(bidx * 2 + (pos - 6)) * DFF + col + 4 * n) = g0; }
                    }
                }
                if (store) *(u32x4*)(H + (size_t)gr * DFF + col) = hw;
            }
        }
    }
};

__device__ __forceinline__ unsigned pk2(float lo, float hi) { return cvt_pk_bf16(lo, hi); }
__device__ __forceinline__ void p0_transpose_item(const float* W, int ldw, int scol0, int k0, bf16_t* WT, int dK, int drow0, LAS float* scr, int lane) {
#pragma unroll 8
    for (int i = 0; i < 32; ++i) { const int kk = 2 * i + (lane >> 5); scr[kk * 33 + (lane & 31)] = W[(size_t)(k0 + kk) * ldw + scol0 + (lane & 31)]; }
    asm volatile("s_waitcnt lgkmcnt(0)" ::: "memory");
    const int c = lane & 7;
#pragma unroll
    for (int j = 0; j < 4; ++j) { const int n = (lane >> 3) + 8 * j; const LAS float* s = scr + (8 * c) * 33 + n;
        u32x4 o; o.x = pk2(s[0 * 33], s[1 * 33]); o.y = pk2(s[2 * 33], s[3 * 33]); o.z = pk2(s[4 * 33], s[5 * 33]); o.w = pk2(s[6 * 33], s[7 * 33]);
        *(u32x4*)(WT + (size_t)(drow0 + n) * dK + k0 + 8 * c) = o; }
    asm volatile("s_waitcnt lgkmcnt(0)" ::: "memory");
}
__device__ __forceinline__ void p0_gate_item(const float* w_in, const float* w_a2, int k0, int n0, bf16_t* WT, LAS float* scr, int lane) {
    float w2[16];
#pragma unroll
    for (int r = 0; r < 16; ++r) w2[r] = w_a2[r * 256 + n0 + (lane & 31)];
    for (int i = 0; i < 32; ++i) { const int kk = 2 * i + (lane >> 5); const float* a = w_in + (size_t)(k0 + kk) * DIN + 3072; float s = 0.f;
#pragma unroll
        for (int r = 0; r < 16; ++r) s += a[r] * w2[r];
        scr[kk * 33 + (lane & 31)] = s; }
    asm volatile("s_waitcnt lgkmcnt(0)" ::: "memory");
    const int c = lane & 7;
#pragma unroll
    for (int j = 0; j < 4; ++j) { const int n = (lane >> 3) + 8 * j; const LAS float* s = scr + (8 * c) * 33 + n;
        u32x4 o; o.x = pk2(s[0 * 33], s[1 * 33]); o.y = pk2(s[2 * 33], s[3 * 33]); o.z = pk2(s[4 * 33], s[5 * 33]); o.w = pk2(s[6 * 33], s[7 * 33]);
        *(u32x4*)(WT + (size_t)(3072 + n0 + n) * 1024 + k0 + 8 * c) = o; }
    asm volatile("s_waitcnt lgkmcnt(0)" ::: "memory");
}
__device__ __forceinline__ void rms_row_to_bf16(const float* xrow, const float* g, bf16_t* orow, int lane) {
    const f32x4* xr = (const f32x4*)xrow + lane; const f32x4* gr = (const f32x4*)g + lane;
    f32x4 v[4]; float s = 0.f;
#pragma unroll
    for (int j = 0; j < 4; ++j) { v[j] = xr[64 * j]; s += (v[j].x * v[j].x + v[j].y * v[j].y) + (v[j].z * v[j].z + v[j].w * v[j].w); }
    const float rs = rsqrtf(wave_sum(s) * (1.f / DM) + EPS);
    u32x2* o8 = (u32x2*)orow + lane;
#pragma unroll
    for (int j = 0; j < 4; ++j) { const f32x4 gg = gr[64 * j]; const f32x4 y = v[j] * rs * gg; u32x2 w; w.x = pk2(y.x, y.y); w.y = pk2(y.z, y.w); o8[64 * j] = w; }
}


__device__ __forceinline__ int crow(int r, int hi) { return (r & 3) + 8 * (r >> 2) + 4 * hi; }
typedef short v4i16_t __attribute__((ext_vector_type(4)));
__device__ __forceinline__ s16x4 vtr(const LAS unsigned char* p) { return __builtin_bit_cast(s16x4, __builtin_amdgcn_ds_read_tr16_b64_v4i16((LAS v4i16_t*)p)); }
__device__ __forceinline__ float swapmax(float v) { auto rr = __builtin_amdgcn_permlane32_swap(__float_as_uint(v), __float_as_uint(v), false, false); return fmaxf(__uint_as_float(rr[0]), __uint_as_float(rr[1])); }
__device__ __forceinline__ float swapsum(float v) { auto rr = __builtin_amdgcn_permlane32_swap(__float_as_uint(v), __float_as_uint(v), false, false); return __uint_as_float(rr[0]) + __uint_as_float(rr[1]); }
__device__ __forceinline__ u32x4 pack8(f32x4 a, f32x4 b) { u32x4 w; w.x = cvt_pk_bf16(a.x, a.y); w.y = cvt_pk_bf16(a.z, a.w); w.z = cvt_pk_bf16(b.x, b.y); w.w = cvt_pk_bf16(b.z, b.w); return w; }

constexpr float NEGF = -1e30f;
constexpr int VPITCH = 192;
constexpr int ATT_WLDS = 32 * VPITCH + 256;

struct AttnCtx { const bf16_t *QA, *KA, *VA; bf16_t* MIX; const float *ck, *cv; };

struct TileRegs { u32x4 k[8]; u32x4 v[8]; };

template <bool SAMPLE> __device__ __forceinline__ int tile_key(int ti, int j, int g, int r4, int ncls) {
    if (SAMPLE) { if (ti < 17) return 1536 + 32 * (16 - ti) + j; const int kk = ti - 17; return 16 * (4 * kk + (j >> 3)) + (j & 7); }
    if (ti < ncls) return 4 * (32 * (g - ti) + j) + r4;
    const int jj = ti - ncls + (g == 0 ? 4 : 0); return 128 * g - 128 + 32 * jj + j;
}
template <bool SAMPLE> __device__ __forceinline__ void tile_load(const AttnCtx& C, TileRegs& T, int ti, int b, int h, int g, int r4, int ncls, int lane) {
    const int r32 = lane & 31, hi = lane >> 5;
    if (SAMPLE && ti > 0) {
        { const int idx = tile_key<SAMPLE>(ti, r32, g, r4, ncls); const float* p = C.ck + (((unsigned)(b * WINB + idx) * 8u + h) * 64u + 8 * hi);
#pragma unroll
          for (int d0 = 0; d0 < 4; ++d0) { T.k[2 * d0] = *(const GAS u32x4*)(p + 16 * d0); T.k[2 * d0 + 1] = *(const GAS u32x4*)(p + 16 * d0 + 4); } }
#pragma unroll
        for (int i = 0; i < 4; ++i) { const int key = (lane >> 3) + 8 * i; const int idx = tile_key<SAMPLE>(ti, key, g, r4, ncls);
            const float* p = C.cv + (((unsigned)(b * WINB + idx) * 8u + h) * 64u + 8 * (lane & 7)); T.v[2 * i] = *(const GAS u32x4*)p; T.v[2 * i + 1] = *(const GAS u32x4*)(p + 4); }
    } else {
        unsigned rowb;
        { int key = tile_key<SAMPLE>(ti, r32, g, r4, ncls); if (SAMPLE) { key -= WINB; key = key > 7 ? 7 : key; rowb = (unsigned)(MP + b * 8 + key); } else rowb = (unsigned)(b * SEQ + key);
          const bf16_t* p = C.KA + (rowb * 512u + h * 64 + 8 * hi);
#pragma unroll
          for (int d0 = 0; d0 < 4; ++d0) T.k[d0] = *(const GAS u32x4*)(p + 16 * d0); }
#pragma unroll
        for (int i = 0; i < 4; ++i) { int key = tile_key<SAMPLE>(ti, (lane >> 3) + 8 * i, g, r4, ncls); if (SAMPLE) { key -= WINB; key = key > 7 ? 7 : key; rowb = (unsigned)(MP + b * 8 + key); } else rowb = (unsigned)(b * SEQ + key);
            T.v[i] = *(const GAS u32x4*)(C.VA + (rowb * 512u + h * 64 + 8 * (lane & 7))); }
    }
}

template <bool SAMPLE>
__device__ __forceinline__ void attn_item(const AttnCtx& C, int b, int h, int g, int r4, LAS unsigned char* wl, int lane_in) {
    int lane = lane_in; asm volatile("" : "+v"(lane));
    const int r32 = lane & 31, hi = lane >> 5;
    LAS float* wsf = (LAS float*)(wl + 32 * VPITCH);
    const int ncls = g + 1;
    const int nt = SAMPLE ? 41 : (ncls + (g == 0 ? 4 : 8));
    bf16x8 qf[4];
    {
        unsigned qrow; if (SAMPLE) qrow = (unsigned)(MP + b * 8 + (r32 & 7)); else qrow = (unsigned)(b * SEQ + 4 * (32 * g + r32) + r4);
        const bf16_t* p = C.QA + (qrow * 512u + h * 64 + 8 * hi);
#pragma unroll
        for (int d0 = 0; d0 < 4; ++d0) qf[d0] = *(const bf16x8*)(p + 16 * d0);
    }
    float mrun = NEGF, lrun = 0.f;
    f32x16 o0 = {}, o1 = {};
    TileRegs T;
    tile_load<SAMPLE>(C, T, 0, b, h, g, r4, ncls, lane);
    const int vrd = (4 * hi + ((lane & 15) >> 2)) * VPITCH + (((lane >> 4) & 1) * 16 + (lane & 3) * 4) * 2;
    for (int ti = 0; ti < nt; ++ti) {
        bf16x8 kf[4];
        const bool f32path = SAMPLE && ti > 0;
        if (f32path) {
#pragma unroll
            for (int d0 = 0; d0 < 4; ++d0) kf[d0] = __builtin_bit_cast(bf16x8, pack8(__builtin_bit_cast(f32x4, T.k[2 * d0]), __builtin_bit_cast(f32x4, T.k[2 * d0 + 1])));
#pragma unroll
            for (int i = 0; i < 4; ++i) *(LAS u32x4*)(wl + ((lane >> 3) + 8 * i) * VPITCH + (lane & 7) * 16) = pack8(__builtin_bit_cast(f32x4, T.v[2 * i]), __builtin_bit_cast(f32x4, T.v[2 * i + 1]));
        } else {
#pragma unroll
            for (int d0 = 0; d0 < 4; ++d0) kf[d0] = __builtin_bit_cast(bf16x8, T.k[d0]);
#pragma unroll
            for (int i = 0; i < 4; ++i) *(LAS u32x4*)(wl + ((lane >> 3) + 8 * i) * VPITCH + (lane & 7) * 16) = T.v[i];
        }
        if (ti + 1 < nt) tile_load<SAMPLE>(C, T, ti + 1, b, h, g, r4, ncls, lane);
        f32x16 p = {};
#pragma unroll
        for (int d0 = 0; d0 < 4; ++d0) p = __builtin_amdgcn_mfma_f32_32x32x16_bf16(kf[d0], qf[d0], p, 0, 0, 0);
        if (SAMPLE) {
            if (ti < 17) { const int dbase = (WINB + r32) - (1536 + 32 * (16 - ti));
#pragma unroll
                for (int r = 0; r < 16; ++r) { const int d = dbase - crow(r, hi); const int mult = (d >= 0 && d <= 128) + (d >= 0 && d <= 512 && !(d & 3)) + (d >= 0 && !(d & 15));
                    p[r] = (mult == 0 || r32 >= 8) ? NEGF : p[r] + (mult == 1 ? 0.f : (mult == 2 ? 1.f : 1.5849625f)); } }
            else {
#pragma unroll
                for (int r = 0; r < 16; ++r) p[r] = ((crow(r, hi) & 7) == r32) ? p[r] : NEGF; }
        } else {
            if (ti < ncls) { const int dbase = (32 * g + r32) - 32 * (g - ti);
#pragma unroll
                for (int r = 0; r < 16; ++r) { const int d = dbase - crow(r, hi); const int mult = (d >= 0 && d <= 128) + (d >= 0 && !(d & 3));
                    p[r] = mult == 0 ? NEGF : p[r] + (mult == 2 ? 1.f : 0.f); } }
            else { const int jj = ti - ncls + (g == 0 ? 4 : 0); const int dbase = (128 * g + 4 * r32 + r4) - (128 * g - 128 + 32 * jj);
#pragma unroll
                for (int r = 0; r < 16; ++r) { const int d = dbase - crow(r, hi); p[r] = (d >= 0 && d <= 128) ? p[r] : NEGF; } }
        }
        float rm = p[0];
#pragma unroll
        for (int r = 1; r < 16; ++r) rm = fmaxf(rm, p[r]);
        rm = swapmax(rm);
        const float mnew = fmaxf(mrun, rm);
        const float f = __builtin_amdgcn_exp2f(mrun - mnew);
        mrun = mnew;
        float ls = 0.f;
#pragma unroll
        for (int r = 0; r < 16; ++r) { p[r] = __builtin_amdgcn_exp2f(p[r] - mnew); ls += p[r]; }
        lrun = lrun * f + ls;
        if (hi == 0) wsf[r32] = f;
        u32x4 pa0, pa1;
        pa0.x = cvt_pk_bf16(p[0], p[1]); pa0.y = cvt_pk_bf16(p[2], p[3]); pa0.z = cvt_pk_bf16(p[4], p[5]); pa0.w = cvt_pk_bf16(p[6], p[7]);
        pa1.x = cvt_pk_bf16(p[8], p[9]); pa1.y = cvt_pk_bf16(p[10], p[11]); pa1.z = cvt_pk_bf16(p[12], p[13]); pa1.w = cvt_pk_bf16(p[14], p[15]);
#pragma unroll
        for (int r = 0; r < 16; ++r) { const float fr_ = wsf[crow(r, hi)]; o0[r] *= fr_; o1[r] *= fr_; }
#pragma unroll
        for (int sl = 0; sl < 2; ++sl) {
            const bf16x8 pa = __builtin_bit_cast(bf16x8, sl == 0 ? pa0 : pa1);
#pragma unroll
            for (int c = 0; c < 2; ++c) {
                const s16x4 lo = vtr(wl + vrd + (16 * sl) * VPITCH + 64 * c), hi4 = vtr(wl + vrd + (16 * sl + 8) * VPITCH + 64 * c);
                const bf16x8 vf = (bf16x8){lo[0], lo[1], lo[2], lo[3], hi4[0], hi4[1], hi4[2], hi4[3]};
                if (c == 0) o0 = __builtin_amdgcn_mfma_f32_32x32x16_bf16(pa, vf, o0, 0, 0, 0); else o1 = __builtin_amdgcn_mfma_f32_32x32x16_bf16(pa, vf, o1, 0, 0, 0);
            }
        }
    }
    const float lt = swapsum(lrun);
    if (hi == 0) wsf[32 + r32] = 1.f / lt;
#pragma unroll
    for (int r = 0; r < 16; ++r) {
        const int q = crow(r, hi); const float rl = wsf[32 + q];
        unsigned orow; bool ok = true;
        if (SAMPLE) { ok = q < 8; orow = (unsigned)(MP + b * 8 + (q & 7)); } else orow = (unsigned)(b * SEQ + 4 * (32 * g + q) + r4);
        if (ok) { bf16_t* op = C.MIX + (orow * 1024u + h * 64 + r32);
            op[0] = (bf16_t)(cvt_pk_bf16(o0[r] * rl, 0.f) & 0xffffu); op[32] = (bf16_t)(cvt_pk_bf16(o1[r] * rl, 0.f) & 0xffffu); }
    }
}

struct GlaCtx { const bf16_t *QB, *KB, *VB, *RB; const float* LF; bf16_t* MIX; const float* gnorm; };
constexpr int GQ_P = 72, GT_P = 40;
constexpr int G_QE = 0, G_KE = 32 * GQ_P * 2, G_KT = G_KE + 32 * GQ_P * 2, G_EB = G_KT + 64 * GT_P * 2, G_BUF = G_EB + 256;
constexpr int GL_V = 2 * G_BUF;
constexpr int GL_O = GL_V + 2 * 4 * 2048;
constexpr int GL_END = GL_O + 2 * 4 * 4608;
static_assert(GL_END <= 131072, "gla lds");
#define LDS_BARRIER() do { asm volatile("s_waitcnt lgkmcnt(0)" ::: "memory"); __builtin_amdgcn_s_barrier(); asm volatile("" ::: "memory"); } while (0)
typedef float f32x8 __attribute__((ext_vector_type(8)));
typedef unsigned u32x8 __attribute__((ext_vector_type(8)));
typedef unsigned u32x16 __attribute__((ext_vector_type(16)));
struct GlaPre { f32x8 lf; u32x8 q, k; u32x4 v0, v1; };

template <int nvalid> __device__ __forceinline__ void gla_h_loads(const GlaCtx& C, GlaPre& P, unsigned t0, int h, int dk, int tg, int dvs, int lane) {
    const bool ok = 8 * tg < nvalid;
    const unsigned off = (t0 + (ok ? 8 * tg : 0)) * 256u + h * 64 + dk;
    const GAS float* lp = (const GAS float*)(C.LF + off); const GAS bf16_t* qp = (const GAS bf16_t*)(C.QB + off); const GAS bf16_t* kp = (const GAS bf16_t*)(C.KB + off);
#pragma unroll
    for (int e = 0; e < 8; ++e) { P.lf[e] = lp[e * 256]; P.q[e] = (unsigned)qp[e * 256]; P.k[e] = (unsigned)kp[e * 256]; }
    const int i = lane >> 1; const bool okv = i < nvalid; const GAS bf16_t* p = (const GAS bf16_t*)(C.VB + ((t0 + (okv ? i : 0)) * 512u + h * 128 + 32 * dvs + 16 * (lane & 1)));
    P.v0 = *(const GAS u32x4*)p; P.v1 = *(const GAS u32x4*)(p + 8);
}
template <int nvalid> __device__ __forceinline__ void gla_h_wave(const GlaCtx& C, LAS unsigned char* lds, int hw  , int lane, unsigned row0, int h, int nchunk) {
    const int tg = lane >> 4, dkl = lane & 15, dk = 16 * hw + dkl;
    const int ft = lane >> 3, dvg = lane & 7;
    const bool fin_ok = 8 * hw < nvalid;
    f32x4 gn[4];
#pragma unroll
    for (int k4 = 0; k4 < 4; ++k4) gn[k4] = *(const f32x4*)(C.gnorm + h * 128 + 16 * dvg + 4 * k4);
    GlaPre P; u32x4 g0 = {}, g1 = {};
    gla_h_loads<nvalid>(C, P, row0, h, dk, tg, hw, lane);
    for (int j = 0; j <= nchunk + 1; ++j) {
        if (j >= 2 && fin_ok) {
            const int c = j - 2; const int ob = c & 1;
            const LAS float* op = (const LAS float*)(lds + GL_O + (ob * 4 + (dvg >> 1)) * 4608) + (8 * hw + ft) * 36 + 16 * (dvg & 1);
            f32x4 o[4]; float s = 0.f;
#pragma unroll
            for (int k4 = 0; k4 < 4; ++k4) { o[k4] = *(const LAS f32x4*)(op + 4 * k4); s += (o[k4].x * o[k4].x + o[k4].y * o[k4].y) + (o[k4].z * o[k4].z + o[k4].w * o[k4].w); }
            s += __shfl_xor(s, 1); s += __shfl_xor(s, 2); s += __shfl_xor(s, 4);
            const float rs = rsqrtf(s * (1.f / 128.f) + EPS);
            float gt[16];
            gt[0] = __uint_as_float(g0.x << 16); gt[1] = __uint_as_float(g0.x & 0xffff0000u); gt[2] = __uint_as_float(g0.y << 16); gt[3] = __uint_as_float(g0.y & 0xffff0000u);
            gt[4] = __uint_as_float(g0.z << 16); gt[5] = __uint_as_float(g0.z & 0xffff0000u); gt[6] = __uint_as_float(g0.w << 16); gt[7] = __uint_as_float(g0.w & 0xffff0000u);
            gt[8] = __uint_as_float(g1.x << 16); gt[9] = __uint_as_float(g1.x & 0xffff0000u); gt[10] = __uint_as_float(g1.y << 16); gt[11] = __uint_as_float(g1.y & 0xffff0000u);
            gt[12] = __uint_as_float(g1.z << 16); gt[13] = __uint_as_float(g1.z & 0xffff0000u); gt[14] = __uint_as_float(g1.w << 16); gt[15] = __uint_as_float(g1.w & 0xffff0000u);
            float val[16];
#pragma unroll
            for (int k = 0; k < 16; ++k) { const float rg = gt[k]; val[k] = o[k >> 2][k & 3] * rs * gn[k >> 2][k & 3] * rg * __builtin_amdgcn_rcpf(1.f + __expf(-rg)); }
            u32x4 w0, w1;
            w0.x = cvt_pk_bf16(val[0], val[1]); w0.y = cvt_pk_bf16(val[2], val[3]); w0.z = cvt_pk_bf16(val[4], val[5]); w0.w = cvt_pk_bf16(val[6], val[7]);
            w1.x = cvt_pk_bf16(val[8], val[9]); w1.y = cvt_pk_bf16(val[10], val[11]); w1.z = cvt_pk_bf16(val[12], val[13]); w1.w = cvt_pk_bf16(val[14], val[15]);
            bf16_t* mp = C.MIX + ((row0 + 32u * c + 8 * hw + ft) * 1024u + 512 + h * 128 + 16 * dvg);
            *(GAS u32x4*)mp = w0; *(GAS u32x4*)(mp + 8) = w1;
        }
        if (j < nchunk) {
            const int buf = j & 1;
            LAS unsigned char* sh = lds + buf * G_BUF;
            LAS bf16_t* qe_l = (LAS bf16_t*)(sh + G_QE); LAS bf16_t* ke_l = (LAS bf16_t*)(sh + G_KE); LAS bf16_t* kt_l = (LAS bf16_t*)(sh + G_KT); LAS float* eb_l = (LAS float*)(sh + G_EB);
            LAS unsigned char* vl = lds + GL_V + (buf * 4 + hw) * 2048;
            const bool okp = 8 * tg < nvalid, okv = (lane >> 1) < nvalid;
            if (!okp) { P.lf = (f32x8){0.f, 0.f, 0.f, 0.f, 0.f, 0.f, 0.f, 0.f}; P.q = (u32x8){0u, 0u, 0u, 0u, 0u, 0u, 0u, 0u}; P.k = P.q; }
            if (!okv) { P.v0 = (u32x4){0u, 0u, 0u, 0u}; P.v1 = P.v0; }
            f32x8 cs; float run = 0.f;
#pragma unroll
            for (int e = 0; e < 8; ++e) { run += P.lf[e]; cs[e] = run; }
            float offs = 0.f, tot = 0.f;
#pragma unroll
            for (int t = 0; t < 4; ++t) { const float Tt = __shfl(run, dkl + 16 * t); tot += Tt; offs += (t < tg) ? Tt : 0.f; }
            u32x8 kb;
#pragma unroll
            for (int e = 0; e < 8; ++e) { const float bb = offs + cs[e]; const float eb = __expf(bb), ei = __expf(-bb); const int i = 8 * tg + e;
                qe_l[i * GQ_P + dk] = (bf16_t)(cvt_pk_bf16(__uint_as_float(P.q[e] << 16) * 0.125f * eb, 0.f) & 0xffffu);
                kb[e] = cvt_pk_bf16(__uint_as_float(P.k[e] << 16) * ei, 0.f) & 0xffffu;
                ke_l[i * GQ_P + dk] = (bf16_t)kb[e]; }
            u32x4 w; w.x = kb[0] | (kb[1] << 16); w.y = kb[2] | (kb[3] << 16); w.z = kb[4] | (kb[5] << 16); w.w = kb[6] | (kb[7] << 16);
            *(LAS u32x4*)(kt_l + dk * GT_P + 8 * tg) = w;
            if (tg == 0) eb_l[dk] = __expf(tot);
            *(LAS u32x4*)(vl + (lane >> 1) * 64 + (lane & 1) * 32) = P.v0; *(LAS u32x4*)(vl + (lane >> 1) * 64 + (lane & 1) * 32 + 16) = P.v1;
        }
        if (j + 1 < nchunk) gla_h_loads<nvalid>(C, P, row0 + 32u * (j + 1), h, dk, tg, hw, lane);
        if (j >= 1 && j <= nchunk && fin_ok) { const bf16_t* rp = C.RB + ((row0 + 32u * (j - 1) + 8 * hw + ft) * 512u + h * 128 + 16 * dvg); g0 = *(const GAS u32x4*)rp; g1 = *(const GAS u32x4*)(rp + 8); }
        if (j <= nchunk) LDS_BARRIER();
    }
}
template <int nvalid> __device__ __forceinline__ void gla_m_wave(LAS unsigned char* lds, int dvs, int lane, int nchunk, const float* s_in, float* s_out) {
    const int r32 = lane & 31, hi = lane >> 5;
    f32x16 S0 = {}, S1 = {};
    unsigned soff = (unsigned)(4 * hi * 128 + 32 * dvs + r32); asm volatile("" : "+v"(soff));
    if (s_in) {
#pragma unroll
        for (int r = 0; r < 16; ++r) { const unsigned o_ = soff + (unsigned)(((r & 3) + 8 * (r >> 2)) * 128); S0[r] = s_in[o_]; S1[r] = s_in[o_ + 4096u]; }
    }
    const int vrd = (4 * hi + ((lane & 15) >> 2)) * 64 + (((lane >> 4) & 1) * 16 + (lane & 3) * 4) * 2;
    LDS_BARRIER();
    for (int c = 0; c < nchunk; ++c) {
        const int buf = c & 1;
        LAS unsigned char* sh = lds + buf * G_BUF;
        LAS bf16_t* qe_l = (LAS bf16_t*)(sh + G_QE); LAS bf16_t* ke_l = (LAS bf16_t*)(sh + G_KE); LAS bf16_t* kt_l = (LAS bf16_t*)(sh + G_KT); LAS float* eb_l = (LAS float*)(sh + G_EB);
        const LAS unsigned char* vl = lds + GL_V + (buf * 4 + dvs) * 2048;
        f32x16 at = {};
#pragma unroll
        for (int s = 0; s < 4; ++s) { const bf16x8 a = *(const LAS bf16x8*)(ke_l + r32 * GQ_P + 16 * s + 8 * hi), bq = *(const LAS bf16x8*)(qe_l + r32 * GQ_P + 16 * s + 8 * hi);
            at = __builtin_amdgcn_mfma_f32_32x32x16_bf16(a, bq, at, 0, 0, 0); }
#pragma unroll
        for (int r = 0; r < 16; ++r) at[r] = (crow(r, hi) <= r32) ? at[r] : 0.f;
        u32x4 pa0, pa1;
        pa0.x = cvt_pk_bf16(at[0], at[1]); pa0.y = cvt_pk_bf16(at[2], at[3]); pa0.z = cvt_pk_bf16(at[4], at[5]); pa0.w = cvt_pk_bf16(at[6], at[7]);
        pa1.x = cvt_pk_bf16(at[8], at[9]); pa1.y = cvt_pk_bf16(at[10], at[11]); pa1.z = cvt_pk_bf16(at[12], at[13]); pa1.w = cvt_pk_bf16(at[14], at[15]);
        bf16x8 vf0, vf1;
        { const s16x4 lo = vtr(vl + vrd), h4 = vtr(vl + vrd + 8 * 64); vf0 = (bf16x8){lo[0], lo[1], lo[2], lo[3], h4[0], h4[1], h4[2], h4[3]}; }
        { const s16x4 lo = vtr(vl + vrd + 16 * 64), h4 = vtr(vl + vrd + 24 * 64); vf1 = (bf16x8){lo[0], lo[1], lo[2], lo[3], h4[0], h4[1], h4[2], h4[3]}; }
        f32x16 o = {};
        o = __builtin_amdgcn_mfma_f32_32x32x16_bf16(__builtin_bit_cast(bf16x8, pa0), vf0, o, 0, 0, 0);
        o = __builtin_amdgcn_mfma_f32_32x32x16_bf16(__builtin_bit_cast(bf16x8, pa1), vf1, o, 0, 0, 0);
#pragma unroll
        for (int s = 0; s < 4; ++s) {
            const u32x2 q0 = *(const LAS u32x2*)(qe_l + r32 * GQ_P + 16 * s + 4 * hi), q1 = *(const LAS u32x2*)(qe_l + r32 * GQ_P + 16 * s + 8 + 4 * hi);
            const u32x4 qa = (u32x4){q0.x, q0.y, q1.x, q1.y};
            u32x4 sb;
            if (s == 0) { sb.x = cvt_pk_bf16(S0[0], S0[1]); sb.y = cvt_pk_bf16(S0[2], S0[3]); sb.z = cvt_pk_bf16(S0[4], S0[5]); sb.w = cvt_pk_bf16(S0[6], S0[7]); }
            else if (s == 1) { sb.x = cvt_pk_bf16(S0[8], S0[9]); sb.y = cvt_pk_bf16(S0[10], S0[11]); sb.z = cvt_pk_bf16(S0[12], S0[13]); sb.w = cvt_pk_bf16(S0[14], S0[15]); }
            else if (s == 2) { sb.x = cvt_pk_bf16(S1[0], S1[1]); sb.y = cvt_pk_bf16(S1[2], S1[3]); sb.z = cvt_pk_bf16(S1[4], S1[5]); sb.w = cvt_pk_bf16(S1[6], S1[7]); }
            else { sb.x = cvt_pk_bf16(S1[8], S1[9]); sb.y = cvt_pk_bf16(S1[10], S1[11]); sb.z = cvt_pk_bf16(S1[12], S1[13]); sb.w = cvt_pk_bf16(S1[14], S1[15]); }
            o = __builtin_amdgcn_mfma_f32_32x32x16_bf16(__builtin_bit_cast(bf16x8, qa), __builtin_bit_cast(bf16x8, sb), o, 0, 0, 0);
        }
        { LAS float* ol = (LAS float*)(lds + GL_O + (buf * 4 + dvs) * 4608);
#pragma unroll
          for (int r = 0; r < 16; ++r) ol[crow(r, hi) * 36 + r32] = o[r]; }
        {
            const u32x2 a0 = *(const LAS u32x2*)(kt_l + r32 * GT_P + 4 * hi), a1 = *(const LAS u32x2*)(kt_l + r32 * GT_P + 8 + 4 * hi);
            const u32x2 c0 = *(const LAS u32x2*)(kt_l + (32 + r32) * GT_P + 4 * hi), c1 = *(const LAS u32x2*)(kt_l + (32 + r32) * GT_P + 8 + 4 * hi);
            S0 = __builtin_amdgcn_mfma_f32_32x32x16_bf16(__builtin_bit_cast(bf16x8, (u32x4){a0.x, a0.y, a1.x, a1.y}), vf0, S0, 0, 0, 0);
            S1 = __builtin_amdgcn_mfma_f32_32x32x16_bf16(__builtin_bit_cast(bf16x8, (u32x4){c0.x, c0.y, c1.x, c1.y}), vf0, S1, 0, 0, 0);
        }
        {
            const u32x2 a0 = *(const LAS u32x2*)(kt_l + r32 * GT_P + 16 + 4 * hi), a1 = *(const LAS u32x2*)(kt_l + r32 * GT_P + 24 + 4 * hi);
            const u32x2 c0 = *(const LAS u32x2*)(kt_l + (32 + r32) * GT_P + 16 + 4 * hi), c1 = *(const LAS u32x2*)(kt_l + (32 + r32) * GT_P + 24 + 4 * hi);
            S0 = __builtin_amdgcn_mfma_f32_32x32x16_bf16(__builtin_bit_cast(bf16x8, (u32x4){a0.x, a0.y, a1.x, a1.y}), vf1, S0, 0, 0, 0);
            S1 = __builtin_amdgcn_mfma_f32_32x32x16_bf16(__builtin_bit_cast(bf16x8, (u32x4){c0.x, c0.y, c1.x, c1.y}), vf1, S1, 0, 0, 0);
        }
#pragma unroll
        for (int r = 0; r < 16; ++r) { S0[r] *= eb_l[crow(r, hi)]; S1[r] *= eb_l[32 + crow(r, hi)]; }
        LDS_BARRIER();
    }
    if (s_out) {
        unsigned soff2 = (unsigned)(4 * hi * 128 + 32 * dvs + r32); asm volatile("" : "+v"(soff2));
#pragma unroll
        for (int r = 0; r < 16; ++r) { const unsigned o_ = soff2 + (unsigned)(((r & 3) + 8 * (r >> 2)) * 128); s_out[o_] = S0[r]; s_out[o_ + 4096u] = S1[r]; }
    }
}

#define XB_TMO      128
#define XB_XCNT(j)  (256  + 64 * (j))
#define XB_XSUB(j)  (1280 + 64 * (j))
#define XB_XGEN(j)  (2304 + 64 * (j))
#define XB_TOP      3328
#define XB_TOPGEN   3392
#define XCD_BAR_WORDS 3456
#define XB_SPIN_CAP (1u << 18)
__device__ __forceinline__ unsigned xb_ld(unsigned* p)              { return __hip_atomic_load(p, __ATOMIC_RELAXED, __HIP_MEMORY_SCOPE_AGENT); }
__device__ __forceinline__ unsigned xb_add(unsigned* p, unsigned v) { return __hip_atomic_fetch_add(p, v, __ATOMIC_RELAXED, __HIP_MEMORY_SCOPE_AGENT); }
__device__ __forceinline__ unsigned xb_xcc_id() { return (unsigned)__builtin_amdgcn_s_getreg((3 << 11) | 20) & 0xFu; }
#define XB_SPIN(cond, bar) do { unsigned _sp = 0; while (cond) { __builtin_amdgcn_s_sleep(1); \
    if ((++_sp & 255u) == 0u) { if (xb_ld(&(bar)[XB_TMO])) break; if (_sp > XB_SPIN_CAP) { atomicAdd(&(bar)[XB_TMO], 1u); break; } } } } while (0)
struct XcdBarrier { unsigned* bar; unsigned x; volatile LAS unsigned* st; };
__device__ __forceinline__ XcdBarrier xcd_barrier_post(unsigned* bar, volatile LAS unsigned* st) {
    XcdBarrier b; b.bar = bar; b.x = xb_xcc_id(); b.st = st;
    if (threadIdx.x == 0) (void)xb_add(&bar[XB_XCNT(b.x)], 1u);
    return b;
}
__device__ __forceinline__ void xcd_barrier_complete(unsigned* bar, unsigned x, unsigned& nloc, unsigned& nx) {
    const unsigned G = gridDim.x * gridDim.y * gridDim.z;
    unsigned sum, cnt, mine, sp = 0u;
    for (;;) {
        sum = 0u; cnt = 0u; mine = 0u;
#pragma unroll
        for (unsigned j = 0; j < 16; ++j) { const unsigned c = xb_ld(&bar[XB_XCNT(j)]); sum += c; cnt += (c > 0u) ? 1u : 0u; mine = (j == x) ? c : mine; }
        if (sum == G) break;
        __builtin_amdgcn_s_sleep(1);
        if ((++sp & 255u) == 0u) { if (xb_ld(&bar[XB_TMO])) break; if (sp > XB_SPIN_CAP) { atomicAdd(&bar[XB_TMO], 1u); break; } }
    }
    nloc = mine > 0u ? mine : 1u; nx = cnt > 0u ? cnt : 1u;
}
__device__ __forceinline__ void xcd_barrier(const XcdBarrier& b, int wave0) {
    asm volatile("s_waitcnt vmcnt(0)" ::: "memory");
    __syncthreads();
    if (wave0 == 0 && lane_id_v() == 0) {
        unsigned* bar = b.bar;
        __builtin_amdgcn_s_waitcnt(0);
        unsigned nloc = b.st[0], nx = b.st[1];
        if (nloc == 0u) { xcd_barrier_complete(bar, b.x, nloc, nx); b.st[0] = nloc; b.st[1] = nx; }
        const unsigned old = xb_add(&bar[XB_XSUB(b.x)], 1u);
        const unsigned gen = old / nloc;
        if (old + 1u == (gen + 1u) * nloc) {
            __builtin_amdgcn_fence(__ATOMIC_RELEASE, "agent");
            asm volatile("s_waitcnt vmcnt(0)" ::: "memory");
            const unsigned og = xb_add(&bar[XB_TOP], 1u);
            const unsigned tg = og / nx;
            if (og + 1u == (tg + 1u) * nx) xb_add(&bar[XB_TOPGEN], 1u);
            else XB_SPIN(xb_ld(&bar[XB_TOPGEN]) == tg, bar);
            __builtin_amdgcn_fence(__ATOMIC_ACQUIRE, "agent");
            xb_add(&bar[XB_XGEN(b.x)], 1u);
            asm volatile("s_waitcnt vmcnt(0)" ::: "memory");
        } else {
            XB_SPIN(xb_ld(&bar[XB_XGEN(b.x)]) == gen, bar);
            __builtin_amdgcn_fence(__ATOMIC_ACQUIRE, "agent");
            asm volatile("s_waitcnt vmcnt(0)" ::: "memory");
        }
    }
    __syncthreads();
}

constexpr int LDS_BYTES = 147456;

__global__ void __launch_bounds__(512, 2) hymba_fwd(Args args) {
    extern __shared__ __attribute__((aligned(16))) unsigned char lds_raw[];
    LAS unsigned char* lds = (LAS unsigned char*)lds_raw;
#define PHASE_IDS() const int lane = lane_id_v(); const int wave = wave0; (void)lane; (void)wave
    const int G = gridDim.x, bx = blockIdx.x;
    const int wave0 = __builtin_amdgcn_readfirstlane((int)(threadIdx.x >> 6));
    if (threadIdx.x < 4) ((LAS unsigned*)(lds + XBST_OFF))[threadIdx.x] = 0u;
    __syncthreads();
    const XcdBarrier xbar = xcd_barrier_post((unsigned*)(args.ws + WS_CTL) + 4096, (volatile LAS unsigned*)(lds + XBST_OFF));
    const int vcu = (G % 8 == 0) ? (bx % 8) * (G / 8) + bx / 8 : bx;
    const float* x_prompt = args.in[0]; const float* x_sample = args.in[1];
    const float* w_in = args.in[6]; const float* w_a2 = args.in[7]; const float* b_a = args.in[8];
    const float* w_o = args.in[10]; const float* g_pre_mix = args.in[11];
    const float* w_up = args.in[15]; const float* w_down = args.in[18];
#define PHASE_WS() unsigned char* ws = args.ws; asm volatile("" : "+s"(ws))

    {
        PHASE_IDS(); PHASE_WS();
        bf16_t* WinT = (bf16_t*)(ws + WS_WIN); bf16_t* WoT = (bf16_t*)(ws + WS_WO); bf16_t* WupT = (bf16_t*)(ws + WS_WUP); bf16_t* WdT = (bf16_t*)(ws + WS_WD); bf16_t* XN = (bf16_t*)(ws + WS_XN + 4096);
        LAS float* scr = (LAS float*)(lds + wave * 16384);
        const int gw = vcu * 8 + wave, NGW = G * 8;
        constexpr int I_IN = 16 * 96, I_G = 16 * 8, I_O = 16 * 32, I_UP = 16 * 176, I_D = 44 * 32;
        constexpr int NITEMS = I_IN + I_G + I_O + I_UP + I_D;
        for (int it = gw; it < NITEMS; it += NGW) {
            int r = it;
            if (r < I_IN) { const int kb = r / 96, nb = r % 96; p0_transpose_item(w_in, DIN, 32 * nb, 64 * kb, WinT, 1024, 32 * nb, scr, lane); continue; } r -= I_IN;
            if (r < I_G) { const int kb = r / 8, nb = r % 8; p0_gate_item(w_in, w_a2, 64 * kb, 32 * nb, WinT, scr, lane); continue; } r -= I_G;
            if (r < I_O) { const int kb = r / 32, nb = r % 32; p0_transpose_item(w_o, 1024, 32 * nb, 64 * kb, WoT, 1024, 32 * nb, scr, lane); continue; } r -= I_O;
            if (r < I_UP) { const int kb = r / 176, nb = r % 176; const int n0 = 32 * nb, t = n0 >> 8, w = n0 & 255;
                const int sc = (w < 128) ? (128 * t + w) : (DFF + 128 * t + (w - 128));
                p0_transpose_item(w_up, 2 * DFF, sc, 64 * kb, WupT, 1024, n0, scr, lane); continue; } r -= I_UP;
            { const int kb = r / 32, nb = r % 32; p0_transpose_item(w_down, 1024, 32 * nb, 64 * kb, WdT, DFF, 32 * nb, scr, lane); }
        }
        for (int m = gw; m < MT; m += NGW) {
            const float* xr = (m < MP) ? x_prompt + (size_t)m * DM : x_sample + (size_t)(m - MP) * DM;
            rms_row_to_bf16(xr, g_pre_mix, XN + (size_t)m * DM, lane);
        }
    }
    xcd_barrier(xbar, wave0);

    {
        PHASE_WS();
        pg8::Gemm g{(bf16_t*)(ws + WS_XN + 4096), (bf16_t*)(ws + WS_WIN), 1024, 256, 1024}; pg8::StaticOrder S; S.init(MT / 256, NIN / 256, G, bx);
        EpiInProj E{(bf16_t*)(ws + WS_QA), (bf16_t*)(ws + WS_KA), (bf16_t*)(ws + WS_VA), (bf16_t*)(ws + WS_QB), (bf16_t*)(ws + WS_KB), (bf16_t*)(ws + WS_VB), (bf16_t*)(ws + WS_RB),
                    (float*)(ws + WS_LF), args.out, b_a};
        pg8::gemm_phase<EpiInProj, pg8::StaticOrder>(lds, g, S, E, wave0);
    }
    xcd_barrier(xbar, wave0);

    {
        PHASE_IDS(); PHASE_WS();
        bf16_t* MIX = (bf16_t*)(ws + WS_MIX);
        GlaCtx GC{(const bf16_t*)(ws + WS_QB), (const bf16_t*)(ws + WS_KB), (const bf16_t*)(ws + WS_VB), (const bf16_t*)(ws + WS_RB), (const float*)(ws + WS_LF), MIX, args.in[9]};
        const float* state_gla = args.in[4];
#ifndef NO_GLA
        for (int it = bx; it < 64 + 128; it += G) {
            const bool pr = it < 64; const int seq = pr ? it : it - 64; const int b = seq >> 2, h = seq & 3;
            const size_t row0 = pr ? (size_t)b * SEQ : (size_t)MP + (size_t)b * 8;
            const float* s_in = pr ? nullptr : state_gla + (size_t)seq * 8192;
            float* s_out = args.out + (pr ? O_GP : O_GS) + (size_t)seq * 8192;
            const int nchunk = pr ? SEQ / 32 : 1;
            if (wave < 4) { if (pr) gla_m_wave<32>(lds, wave, lane, nchunk, s_in, s_out); else gla_m_wave<8>(lds, wave, lane, nchunk, s_in, s_out); }
            else { if (pr) gla_h_wave<32>(GC, lds, wave - 4, lane, (unsigned)row0, h, nchunk); else gla_h_wave<8>(GC, lds, wave - 4, lane, (unsigned)row0, h, nchunk); }
            __syncthreads();
        }
#endif
        AttnCtx AC{(const bf16_t*)(ws + WS_QA), (const bf16_t*)(ws + WS_KA), (const bf16_t*)(ws + WS_VA), MIX, args.in[2], args.in[3]};
        unsigned* counter = (unsigned*)(ws + WS_CTL);
        LAS unsigned char* wl = lds + wave * 8192;
        const int lane2 = lane_id_v();
        for (int sb = (bx + 64) % G; sb < NSB; sb += G) attn_item<true>(AC, sb, wave, 0, 0, wl, lane2);
        const unsigned xq0 = xb_xcc_id() & 7u;
        for (unsigned kq = 0; kq < 8u; ++kq) {
            const unsigned xq = (xq0 + kq) & 7u;
            unsigned* head = counter + 64 * xq;
            for (;;) {
                unsigned loc = 0; if (lane2 == 0) loc = atomicAdd(head, 1u);
                loc = (unsigned)__builtin_amdgcn_readfirstlane((int)loc);
                if (loc >= 1024u) break;
                { const unsigned p = loc; const unsigned grp = p >> 8, q = p & 255u; const int g = 15 - (int)(q >> 4); const unsigned bhl = (q >> 2) & 3u; const int r4 = (int)(q & 3u);
                    const int bh = (int)(xq + 8u * (4u * grp + bhl));
                    attn_item<false>(AC, bh >> 3, bh & 7, g, r4, wl, lane2); }
            }
        }
    }
    xcd_barrier(xbar, wave0);

    {
        PHASE_WS();
        bf16_t* MO = (bf16_t*)(ws + WS_MO); float* SSQ1 = (float*)(ws + WS_SSQ1);
        pg8::Gemm g{(bf16_t*)(ws + WS_MIX), (bf16_t*)(ws + WS_WO), 1024, 256, 1024}; pg8::StaticOrder S; S.init(MP / 256, 4, G, bx);
        EpiRowOut E{MO, SSQ1};
        pg8::gemm_phase<EpiRowOut, pg8::StaticOrder>(lds, g, S, E, wave0);
        pg8::Gemm g2{(bf16_t*)(ws + WS_MIX), (bf16_t*)(ws + WS_WO), 256, 256, 1024}; pg8::SplitOrder S2{16, G, bx, 128, 256};
        EpiSlice E2{(float*)(ws + WS_ACC1), 256};
        pg8::gemm_phase<EpiSlice, pg8::SplitOrder>(lds, g2, S2, E2, wave0);
    }
    xcd_barrier(xbar, wave0);
    {
        PHASE_IDS(); PHASE_WS();
        bf16_t* MO = (bf16_t*)(ws + WS_MO); float* SSQ1 = (float*)(ws + WS_SSQ1); bf16_t* XN = (bf16_t*)(ws + WS_XN + 4096);
        const float* g_post = args.in[12]; const float* g_pre = args.in[13];
        const int gw = vcu * 8 + wave, NGW = G * 8;
        {
            f32x4 gp4[4], gq4[4];
#pragma unroll
            for (int j = 0; j < 4; ++j) { gp4[j] = ((const GAS f32x4*)g_post)[64 * j + lane]; gq4[j] = ((const GAS f32x4*)g_pre)[64 * j + lane]; }
            for (int m0 = gw; m0 < MP; m0 += 2 * NGW) {
                const int m1 = (m0 + NGW < MP) ? m0 + NGW : m0;
                f32x4 sp[2], xv[2][4]; u32x2 mw[2][4];
#pragma unroll
                for (int r = 0; r < 2; ++r) { const int m = r ? m1 : m0; sp[r] = *((const GAS f32x4*)(SSQ1 + (size_t)m * 16) + (lane & 3));
#pragma unroll
                    for (int j = 0; j < 4; ++j) { xv[r][j] = ((const GAS f32x4*)(x_prompt + (size_t)m * DM))[64 * j + lane]; mw[r][j] = ((const GAS u32x2*)(MO + (size_t)m * DM))[64 * j + lane]; } }
#pragma unroll
                for (int r = 0; r < 2; ++r) if (r == 0 || m1 != m0) { const int m = r ? m1 : m0;
                    float ss = (sp[r].x + sp[r].y) + (sp[r].z + sp[r].w); ss += __shfl_xor(ss, 1); ss += __shfl_xor(ss, 2);
                    const float rs = rsqrtf(ss * (1.f / DM) + EPS);
                    f32x4 x1[4]; float s2 = 0.f;
#pragma unroll
                    for (int j = 0; j < 4; ++j) { f32x4 mv; mv.x = __uint_as_float(mw[r][j].x << 16); mv.y = __uint_as_float(mw[r][j].x & 0xffff0000u); mv.z = __uint_as_float(mw[r][j].y << 16); mv.w = __uint_as_float(mw[r][j].y & 0xffff0000u);
                        x1[j] = xv[r][j] + mv * rs * gp4[j]; s2 += (x1[j].x * x1[j].x + x1[j].y * x1[j].y) + (x1[j].z * x1[j].z + x1[j].w * x1[j].w);
                        ((GAS f32x4*)(args.out + (size_t)m * DM))[64 * j + lane] = x1[j]; }
                    const float rs2 = rsqrtf(wave_sum(s2) * (1.f / DM) + EPS);
#pragma unroll
                    for (int j = 0; j < 4; ++j) { const f32x4 y = x1[j] * rs2 * gq4[j]; u32x2 w; w.x = pk2(y.x, y.y); w.y = pk2(y.z, y.w); ((GAS u32x2*)(XN + (size_t)m * DM))[64 * j + lane] = w; }
                }
            }
        }
        for (int m = MP + gw; m < MT; m += NGW) {
            const float* xr = (m < MP) ? x_prompt + (size_t)m * DM : x_sample + (size_t)(m - MP) * DM;
            float* orow = args.out + (size_t)m * DM;
            f32x4 mvv[4]; float ss;
            if (m < MP) {
                const f32x4 sp = *((const f32x4*)(SSQ1 + (size_t)m * 16) + (lane & 3));
                ss = (sp.x + sp.y) + (sp.z + sp.w); ss += __shfl_xor(ss, 1); ss += __shfl_xor(ss, 2);
#pragma unroll
                for (int j = 0; j < 4; ++j) { const u32x2 mw = ((const u32x2*)(MO + (size_t)m * DM))[64 * j + lane];
                    mvv[j].x = __uint_as_float(mw.x << 16); mvv[j].y = __uint_as_float(mw.x & 0xffff0000u); mvv[j].z = __uint_as_float(mw.y << 16); mvv[j].w = __uint_as_float(mw.y & 0xffff0000u); }
            } else {
                const f32x4* ar = (const f32x4*)(ws + WS_ACC1) + (size_t)(m - MP) * 256; float s = 0.f;
#pragma unroll
                for (int j = 0; j < 4; ++j) { f32x4 a = ar[64 * j + lane];
                    for (int sl = 1; sl < 4; ++sl) a += ar[(size_t)sl * 65536 + 64 * j + lane];
                    mvv[j] = a; s += (a.x * a.x + a.y * a.y) + (a.z * a.z + a.w * a.w); }
                ss = wave_sum(s);
            }
            const float rs = rsqrtf(ss * (1.f / DM) + EPS);
            f32x4 x1[4]; float s2 = 0.f;
#pragma unroll
            for (int j = 0; j < 4; ++j) { const int c4 = 64 * j + lane; const f32x4 xv = ((const f32x4*)xr)[c4]; const f32x4 gp = ((const f32x4*)g_post)[c4];
                const f32x4 mv = mvv[j];
                x1[j] = xv + mv * rs * gp; s2 += (x1[j].x * x1[j].x + x1[j].y * x1[j].y) + (x1[j].z * x1[j].z + x1[j].w * x1[j].w);
                ((f32x4*)orow)[c4] = x1[j]; }
            const float rs2 = rsqrtf(wave_sum(s2) * (1.f / DM) + EPS);
#pragma unroll
            for (int j = 0; j < 4; ++j) { const int c4 = 64 * j + lane; const f32x4 gq = ((const f32x4*)g_pre)[c4]; const f32x4 y = x1[j] * rs2 * gq; u32x2 w; w.x = pk2(y.x, y.y); w.y = pk2(y.z, y.w); ((u32x2*)(XN + (size_t)m * DM))[c4] = w; }
        }
    }
    xcd_barrier(xbar, wave0);
    {
        PHASE_WS();
        bf16_t* Hb = (bf16_t*)(ws + WS_H);
        pg8::Gemm g{(bf16_t*)(ws + WS_XN + 4096) - 2 * DM, (bf16_t*)(ws + WS_WUP), 1024, 254, 1024}; pg8::StaticOrder S; S.init(131, 22, G, bx);
        EpiUp E{Hb, args.out, args.in[16], args.in[17], args.in[5], lds};
        pg8::gemm_phase<EpiUp, pg8::StaticOrder>(lds, g, S, E, wave0);
    }
    xcd_barrier(xbar, wave0);
    {
        PHASE_WS();
        bf16_t* MO = (bf16_t*)(ws + WS_MO); float* SSQ2 = (float*)(ws + WS_SSQ2);
        pg8::Gemm g{(bf16_t*)(ws + WS_H), (bf16_t*)(ws + WS_WD), DFF, 256, DFF}; pg8::StaticOrder S; S.init(MP / 256, 4, G, bx);
        EpiRowOut E{MO, SSQ2};
        pg8::gemm_phase<EpiRowOut, pg8::StaticOrder>(lds, g, S, E, wave0);
        pg8::Gemm g2{(bf16_t*)(ws + WS_H), (bf16_t*)(ws + WS_WD), 256, 256, DFF}; pg8::SplitOrder S2{44, G, bx, 128, 256};
        EpiSlice E2{(float*)(ws + WS_ACC2), 256};
        pg8::gemm_phase<EpiSlice, pg8::SplitOrder>(lds, g2, S2, E2, wave0);
    }
    xcd_barrier(xbar, wave0);
    {
        PHASE_IDS(); PHASE_WS();
        bf16_t* MO = (bf16_t*)(ws + WS_MO); float* SSQ2 = (float*)(ws + WS_SSQ2);
        const float* g_post = args.in[14];
        const int gw = vcu * 8 + wave, NGW = G * 8;
        {
            const f32x4 gp4[4] = {((const GAS f32x4*)g_post)[lane], ((const GAS f32x4*)g_post)[64 + lane], ((const GAS f32x4*)g_post)[128 + lane], ((const GAS f32x4*)g_post)[192 + lane]};
            for (int m0 = gw; m0 < MP; m0 += 2 * NGW) {
                const int m1 = (m0 + NGW < MP) ? m0 + NGW : m0;
                GAS float* ro[2] = {(GAS float*)(args.out + (size_t)m0 * DM), (GAS float*)(args.out + (size_t)m1 * DM)};
                f32x4 sp[2], xv[2][4]; u32x2 mw[2][4];
#pragma unroll
                for (int r = 0; r < 2; ++r) { const int m = r ? m1 : m0; sp[r] = *((const GAS f32x4*)(SSQ2 + (size_t)m * 16) + (lane & 3));
#pragma unroll
                    for (int j = 0; j < 4; ++j) { xv[r][j] = ((const GAS f32x4*)ro[r])[64 * j + lane]; mw[r][j] = ((const GAS u32x2*)(MO + (size_t)m * DM))[64 * j + lane]; } }
                f32x4 yv[2][4];
#pragma unroll
                for (int r = 0; r < 2; ++r) { float ss = (sp[r].x + sp[r].y) + (sp[r].z + sp[r].w); ss += __shfl_xor(ss, 1); ss += __shfl_xor(ss, 2);
                    const float rs = rsqrtf(ss * (1.f / DM) + EPS);
#pragma unroll
                    for (int j = 0; j < 4; ++j) { f32x4 mv; mv.x = __uint_as_float(mw[r][j].x << 16); mv.y = __uint_as_float(mw[r][j].x & 0xffff0000u); mv.z = __uint_as_float(mw[r][j].y << 16); mv.w = __uint_as_float(mw[r][j].y & 0xffff0000u);
                        yv[r][j] = xv[r][j] + mv * rs * gp4[j]; } }
#pragma unroll
                for (int r = 0; r < 2; ++r) if (r == 0 || m1 != m0) {
#pragma unroll
                    for (int j = 0; j < 4; ++j) ((GAS f32x4*)ro[r])[64 * j + lane] = yv[r][j]; }
            }
        }
        for (int m = MP + gw; m < MT; m += NGW) {
            float* orow = args.out + (size_t)m * DM;
            f32x4 mvv[4]; float ss;
            if (m < MP) {
                const f32x4 sp = *((const f32x4*)(SSQ2 + (size_t)m * 16) + (lane & 3));
                ss = (sp.x + sp.y) + (sp.z + sp.w); ss += __shfl_xor(ss, 1); ss += __shfl_xor(ss, 2);
#pragma unroll
                for (int j = 0; j < 4; ++j) { const u32x2 mw = ((const u32x2*)(MO + (size_t)m * DM))[64 * j + lane];
                    mvv[j].x = __uint_as_float(mw.x << 16); mvv[j].y = __uint_as_float(mw.x & 0xffff0000u); mvv[j].z = __uint_as_float(mw.y << 16); mvv[j].w = __uint_as_float(mw.y & 0xffff0000u); }
            } else {
                const f32x4* ar = (const f32x4*)(ws + WS_ACC2) + (size_t)(m - MP) * 256; float s = 0.f;
#pragma unroll
                for (int j = 0; j < 4; ++j) { f32x4 a = ar[64 * j + lane];
                    for (int sl = 1; sl < 11; ++sl) a += ar[(size_t)sl * 65536 + 64 * j + lane];
                    mvv[j] = a; s += (a.x * a.x + a.y * a.y) + (a.z * a.z + a.w * a.w); }
                ss = wave_sum(s);
            }
            const float rs = rsqrtf(ss * (1.f / DM) + EPS);
#pragma unroll
            for (int j = 0; j < 4; ++j) { const int c4 = 64 * j + lane; const f32x4 xv = ((const f32x4*)orow)[c4]; const f32x4 gp = ((const f32x4*)g_post)[c4];
                ((f32x4*)orow)[c4] = xv + mvv[j] * rs * gp; }
        }
    }
}

extern "C" void kernel_launch(void* const* d_in, const int* in_sizes, int n_in, void* d_out, int out_size, void* d_ws, size_t ws_size, hipStream_t stream) {
    static int grid = 0;
    if (grid == 0) {
        if (n_in != 19 || ws_size < WS_END || (size_t)out_size != O_END) { fprintf(stderr, "kernel_launch: unexpected shapes n_in %d out %d ws %zu\n", n_in, out_size, ws_size); grid = -1; return; }
        int dev = 0, cus = 0, per_cu = 0;
        hipGetDevice(&dev); hipDeviceGetAttribute(&cus, hipDeviceAttributeMultiprocessorCount, dev);
        hipFuncSetAttribute((const void*)hymba_fwd, hipFuncAttributeMaxDynamicSharedMemorySize, LDS_BYTES);
        hipOccupancyMaxActiveBlocksPerMultiprocessor(&per_cu, (const void*)hymba_fwd, 512, LDS_BYTES);
        if (per_cu < 1) { fprintf(stderr, "kernel_launch: occupancy query says %d blocks per CU\n", per_cu); grid = -1; return; }
        grid = cus;
    }
    if (grid < 0) return;
    hipMemsetAsync((char*)d_ws + WS_CTL, 0, CTL_BYTES, stream);
    Args a{};
    for (int i = 0; i < 19; ++i) a.in[i] = (const float*)d_in[i];
    a.out = (float*)d_out; a.ws = (unsigned char*)d_ws;
    void* kargs[] = {&a};
    hipError_t e = hipLaunchCooperativeKernel((const void*)hymba_fwd, dim3(grid), dim3(512), kargs, LDS_BYTES, stream);
    if (e != hipSuccess) fprintf(stderr, "cooperative launch failed: %s (grid %d)\n", hipGetErrorString(e), grid);
}
```

```cpp
#include <hip/hip_runtime.h>
#include <hip/hip_cooperative_groups.h>
#include <cstdio>
#include <cstdint>
namespace cg = cooperative_groups;

#define LAS __attribute__((address_space(3)))
#define GAS __attribute__((address_space(1)))
typedef unsigned short bf16_t;
typedef short bf16x8 __attribute__((ext_vector_type(8)));
typedef short s16x4 __attribute__((ext_vector_type(4)));
typedef float f32x4 __attribute__((ext_vector_type(4)));
typedef float f32x2 __attribute__((ext_vector_type(2)));
typedef float f32x16 __attribute__((ext_vector_type(16)));
typedef unsigned u32x4 __attribute__((ext_vector_type(4)));
typedef unsigned u32x2 __attribute__((ext_vector_type(2)));

constexpr int DM = 1024, NPB = 16, SEQ = 2048, NSB = 32, NST = 8;
constexpr int MP = NPB * SEQ;
constexpr int MS = NSB * NST;
constexpr int MT = MP + MS;
constexpr int NIN = 3328;
constexpr int DIN = 3088;
constexpr int DFF = 2816;
constexpr int WINB = 2048;
constexpr float EPS = 1e-6f;
constexpr float QSCALE = 0.125f * 1.4426950408889634f;

constexpr size_t MiB = 1u << 20;
constexpr size_t WS_CTL = 0, CTL_BYTES = 65536;
constexpr int XBST_OFF = 131072 + 8192;
constexpr size_t WS_WIN = 1 * MiB, WS_WO = 8 * MiB, WS_WUP = 10 * MiB, WS_WD = 22 * MiB;
constexpr size_t WS_SSQ1 = 28 * MiB, WS_SSQ2 = 31 * MiB;
constexpr size_t WS_XN = 34 * MiB;
constexpr size_t WS_MO = 104 * MiB;
constexpr size_t WS_QA = 172 * MiB, WS_KA = 206 * MiB, WS_VA = 240 * MiB, WS_QB = 274 * MiB, WS_KB = 291 * MiB, WS_VB = 308 * MiB, WS_RB = 342 * MiB, WS_LF = 376 * MiB, WS_MIX = 410 * MiB;
constexpr size_t WS_H = 172 * MiB;
constexpr size_t WS_ACC1 = 478 * MiB, WS_ACC2 = 482 * MiB;
constexpr size_t WS_END = 494 * MiB;
static_assert(WS_H + (size_t)MT * DFF * 2 <= WS_MIX, "h overlay");
static_assert(WS_XN + 4096 + (size_t)(131 * 254 + 260) * DM * 2 <= WS_MO, "xn2");

constexpr size_t O_YP = 0, O_YS = O_YP + (size_t)MP * DM, O_KP = O_YS + (size_t)MS * DM, O_VP = O_KP + (size_t)MP * 512, O_GP = O_VP + (size_t)MP * 512,
                 O_CP = O_GP + (size_t)NPB * 4 * 64 * 128, O_KS = O_CP + (size_t)NPB * 2 * DFF, O_VS = O_KS + (size_t)MS * 512, O_GS = O_VS + (size_t)MS * 512,
                 O_CS = O_GS + (size_t)NSB * 4 * 64 * 128, O_END = O_CS + (size_t)NSB * 2 * DFF;

__device__ __forceinline__ unsigned cvt_pk_bf16(float lo, float hi) { unsigned r; asm volatile("v_cvt_pk_bf16_f32 %0, %1, %2" : "=v"(r) : "v"(lo), "v"(hi)); return r; }
__device__ __forceinline__ float bf2f(unsigned short b) { return __uint_as_float((unsigned)b << 16); }
__device__ __forceinline__ float wave_sum(float v) {
#pragma unroll
    for (int o = 1; o < 64; o <<= 1) v += __shfl_xor(v, o);
    return v;
}

__device__ __forceinline__ int lane_id_v() { int l; asm volatile("v_mbcnt_lo_u32_b32 %0, -1, 0\n\tv_mbcnt_hi_u32_b32 %0, -1, %0" : "=v"(l)); return l; }

struct Args {
    const float* in[19];
    float* out;
    unsigned char* ws;
};

namespace pg8 {
constexpr int BM = 256, BK = 64, HALF = 128, HTB = HALF * BK * 2, STAGE_BYTES = 8 * HTB, NXCD = 8, WGM = 8;
__host__ __device__ __forceinline__ int lds_byte(int r, int c) { const int st = (r >> 4) * 2 + (c >> 5), rr = r & 15, cc = c & 31, ob = rr * 64 + cc * 2; return st * 1024 + (ob ^ (((ob >> 9) & 1) << 5)); }
__host__ __device__ __forceinline__ void stage_rc(int b, int& R, int& C) { const int st = b / 1024, sb = b % 1024, swz = sb ^ (((sb >> 9) & 1) << 5); R = (st >> 1) * 16 + swz / 64; C = (st & 1) * 32 + (swz % 64) / 2; }
__host__ __device__ __forceinline__ int perm32(int rho) { const int n = rho >> 4, i = rho & 15; return 8 * (i >> 2) + 4 * n + (i & 3); }

struct Unit { int pm, pn, kofs; };
struct Gemm { const bf16_t* A; const bf16_t* Bt; int K; int a_rows; int ldk; };

struct StaticOrder {
    int nM, nN, nwg, G, c;
    __device__ void init(int nM_, int nN_, int G_, int c_) { nM = nM_; nN = nN_; nwg = nM * nN; G = G_; c = c_; }
    __device__ bool next(int i, Unit& u) const {
        const long L = (long)i * G + c; if (L >= nwg) return false;
        int wgid = (int)L; { const int q = nwg / NXCD, r = nwg % NXCD, xcd = wgid % NXCD, off = wgid / NXCD; wgid = (xcd < r ? xcd * (q + 1) : r * (q + 1) + (xcd - r) * q) + off; }
        const int nig = WGM * nN, gid = wgid / nig, fm = gid * WGM, gsz = (nM - fm) < WGM ? (nM - fm) : WGM;
        u.pm = fm + ((wgid % nig) % gsz); u.pn = (wgid % nig) / gsz; u.kofs = 0; return true;
    }
};
struct SplitOrder {
    int nsub, G, c, pm, ksub;
    __device__ bool next(int i, Unit& u) const { const int L = i * G + c; if (L >= nsub) return false; u.pm = pm; u.pn = L & 3; u.kofs = (L >> 2) * ksub; return true; }
};

__device__ __forceinline__ f32x2 gelu_pk(f32x2 v) {
    const f32x2 av = __builtin_elementwise_abs(v), d = av * 0.2316418882f + 1.0f;
    f32x2 t; t.x = __builtin_amdgcn_rcpf(d.x); t.y = __builtin_amdgcn_rcpf(d.y);
    f32x2 q = t * 0.5307027145f + (-0.7265760135f); q = q * t + 0.7107068705f; q = q * t + (-0.142248368f); q = q * t + 0.127414796f; q = q * t;
    const f32x2 s = (v * v) * (-0.72134752044f);
    f32x2 e; e.x = __builtin_amdgcn_exp2f(s.x); e.y = __builtin_amdgcn_exp2f(s.y);
    const f32x2 m = v * (q * e), r = v - m;
    f32x2 o; o.x = v.x < 0.f ? m.x : r.x; o.y = v.y < 0.f ? m.y : r.y; return o;
}

template <class Epi, class Sched>
__device__ __forceinline__ void gemm_phase(LAS unsigned char* lds, const Gemm g, const Sched& S, const Epi& E, int wid) {
    const int lane = lane_id_v(); const int tid = wid * 64 + lane;
    const int wr = wid >> 2, wc = wid & 3, fr = lane & 15, fq = lane >> 4;
    const int K = g.ldk, nt = g.K / BK;
    unsigned voffA[2], voffB[2];
#pragma unroll
    for (int i = 0; i < 2; ++i) { int R, C; stage_rc(tid * 16 + i * 8192, R, C); const int Rb = Epi::PERM ? ((R & ~31) + perm32(R & 31)) : R;
        voffA[i] = (unsigned)(R * K + C) * 2u; voffB[i] = (unsigned)(Rb * K + C) * 2u; }
    const size_t kstep = (size_t)(BK * 2);
    const size_t hstep = (size_t)HALF * K * 2;
    const size_t tstepB = 2 * hstep;
    const size_t tstepA = (size_t)g.a_rows * K * 2;
    const unsigned ldsw = (unsigned)wid * 1024u;
    const int aoff = lds_byte(wr * 64 + fr, fq * 8), boff = lds_byte(wc * 32 + fr, fq * 8);
#define PG8_SA(b, h) (((b) * 2 + (h)) * HTB)
#define PG8_SB(b, h) ((4 + (b) * 2 + (h)) * HTB)
#define PG8_STAGE(bufoff, gbase, voff) do { _Pragma("unroll") for (int _i = 0; _i < 2; ++_i) \
        __builtin_amdgcn_global_load_lds((const unsigned*)((const char*)(gbase) + (voff)[_i]), (LAS unsigned*)(lds + (bufoff) + ldsw + _i * 8192), 16, 0, 0); } while (0)
#define PG8_LDA(dst, b, h) do { _Pragma("unroll") for (int m = 0; m < 4; ++m) _Pragma("unroll") for (int k = 0; k < 2; ++k) dst[m][k] = *(const LAS bf16x8*)(lds + PG8_SA(b, h) + aoff + m * 2048 + k * 1024); } while (0)
#define PG8_LDB(dst, b, h) do { _Pragma("unroll") for (int n = 0; n < 2; ++n) _Pragma("unroll") for (int k = 0; k < 2; ++k) dst[n][k] = *(const LAS bf16x8*)(lds + PG8_SB(b, h) + boff + n * 2048 + k * 1024); } while (0)
#define PG8_MMA(ai, bj, At, Bt) do { __builtin_amdgcn_s_setprio(1); _Pragma("unroll") for (int m = 0; m < 4; ++m) _Pragma("unroll") for (int n = 0; n < 2; ++n) _Pragma("unroll") for (int k = 0; k < 2; ++k) \
        acc[ai][bj][m][n] = __builtin_amdgcn_mfma_f32_16x16x32_bf16(Bt[n][k], At[m][k], acc[ai][bj][m][n], 0, 0, 0); __builtin_amdgcn_s_setprio(0); } while (0)
#define PG8_WAIT_V(n) asm volatile("s_waitcnt vmcnt(" #n ")" ::: "memory")
#define PG8_WAIT_L(n) asm volatile("s_waitcnt lgkmcnt(" #n ")" ::: "memory")
#define PG8_BAR __builtin_amdgcn_s_barrier()
#define PG8_SCHED __builtin_amdgcn_sched_barrier(0)
    Unit cur, nxt; int ui = 0;
    if (!S.next(0, cur)) return;
    f32x4 acc[2][2][4][2];
#pragma unroll
    for (int a = 0; a < 2; ++a)
#pragma unroll
        for (int b = 0; b < 2; ++b)
#pragma unroll
            for (int m = 0; m < 4; ++m)
#pragma unroll
                for (int n = 0; n < 2; ++n) acc[a][b][m][n] = (f32x4){0.f, 0.f, 0.f, 0.f};
    bf16x8 At[4][2], B0[2][2], B1[2][2];
    const char* cA = (const char*)g.A + (size_t)cur.pm * tstepA + (size_t)cur.kofs * 2; const char* cB = (const char*)g.Bt + (size_t)cur.pn * tstepB + (size_t)cur.kofs * 2;
    PG8_STAGE(PG8_SB(0, 0), cB, voffB); PG8_STAGE(PG8_SB(0, 1), cB + hstep, voffB); PG8_STAGE(PG8_SA(0, 0), cA, voffA); PG8_STAGE(PG8_SA(0, 1), cA + hstep, voffA);
    if (wr == 1) PG8_BAR;
    PG8_WAIT_V(2); PG8_BAR;
    PG8_STAGE(PG8_SB(1, 0), cB + kstep, voffB); PG8_STAGE(PG8_SA(1, 0), cA + kstep, voffA); PG8_STAGE(PG8_SB(1, 1), cB + hstep + kstep, voffB);
    PG8_WAIT_V(6); PG8_BAR;
    for (;;) {
        const bool has_next = S.next(ui + 1, nxt);
        const char* nA = has_next ? (const char*)g.A + (size_t)nxt.pm * tstepA + (size_t)nxt.kofs * 2 : cA; const char* nB = has_next ? (const char*)g.Bt + (size_t)nxt.pn * tstepB + (size_t)nxt.kofs * 2 : cB;
        for (int t = 0; t < nt; t += 2) {
            const bool last = (t == nt - 2);
            const char* a1 = cA + (size_t)(t + 1) * kstep;
            const char* a2 = last ? nA : cA + (size_t)(t + 2) * kstep; const char* b2 = last ? nB : cB + (size_t)(t + 2) * kstep;
            const char* a3 = a2 + kstep; const char* b3 = b2 + kstep;
            PG8_LDB(B0, 0, 0); PG8_LDB(B1, 0, 1); PG8_SCHED; PG8_LDA(At, 0, 0); PG8_STAGE(PG8_SA(1, 1), a1 + hstep, voffA);
            PG8_WAIT_V(8); PG8_WAIT_L(0); PG8_BAR; PG8_MMA(0, 0, At, B0); PG8_MMA(0, 1, At, B1); PG8_BAR; PG8_SCHED;
            PG8_LDA(At, 0, 1); PG8_STAGE(PG8_SB(0, 0), b2, voffB); PG8_STAGE(PG8_SB(0, 1), b2 + hstep, voffB); PG8_STAGE(PG8_SA(0, 0), a2, voffA);
            PG8_WAIT_V(8); PG8_WAIT_L(0); PG8_BAR; PG8_MMA(1, 0, At, B0); PG8_MMA(1, 1, At, B1); PG8_BAR; PG8_SCHED;
            PG8_LDB(B0, 1, 0); PG8_LDB(B1, 1, 1); PG8_SCHED; PG8_LDA(At, 1, 0); PG8_STAGE(PG8_SA(0, 1), a2 + hstep, voffA);
            PG8_WAIT_V(8); PG8_WAIT_L(0); PG8_BAR; PG8_MMA(0, 0, At, B0); PG8_MMA(0, 1, At, B1); PG8_BAR; PG8_SCHED;
            PG8_LDA(At, 1, 1); PG8_STAGE(PG8_SB(1, 0), b3, voffB); PG8_STAGE(PG8_SB(1, 1), b3 + hstep, voffB); PG8_STAGE(PG8_SA(1, 0), a3, voffA);
            PG8_WAIT_V(8); PG8_WAIT_L(0); PG8_BAR; PG8_MMA(1, 0, At, B0); PG8_MMA(1, 1, At, B1); PG8_BAR; PG8_SCHED;
        }
        if (wr == 0) PG8_BAR;
        E(acc, cur, wr, wc, fr, fq);
        if (!has_next) break;
#pragma unroll
        for (int a = 0; a < 2; ++a)
#pragma unroll
            for (int b = 0; b < 2; ++b)
#pragma unroll
                for (int m = 0; m < 4; ++m)
#pragma unroll
                    for (int n = 0; n < 2; ++n) acc[a][b][m][n] = (f32x4){0.f, 0.f, 0.f, 0.f};
        cur = nxt; cA = nA; cB = nB; ++ui;
        if (wr == 1) PG8_BAR;
    }
    PG8_WAIT_V(0);
    PG8_BAR;
#undef PG8_SA
#undef PG8_SB
#undef PG8_STAGE
#undef PG8_LDA
#undef PG8_LDB
#undef PG8_MMA
#undef PG8_WAIT_V
#undef PG8_WAIT_L
#undef PG8_BAR
#undef PG8_SCHED
}
}

struct EpiInProj {
    static constexpr bool PERM = true;
    bf16_t *QA, *KA, *VA, *QB, *KB, *VB, *RB; float* LF; float* out; const float* b_a;
    __device__ __forceinline__ void operator()(const f32x4 (&acc)[2][2][4][2], const pg8::Unit& u, int wr, int wc, int fr, int fq) const {
        const int pn = u.pn;
        const int row0 = u.pm * 256 + wr * 64 + fr;
        const int cl = wc * 32 + 8 * fq;
        if (pn == 12) {
#pragma unroll
            for (int bj = 0; bj < 2; ++bj) {
                const f32x4 b0 = *(const f32x4*)(b_a + cl + bj * 128), b1 = *(const f32x4*)(b_a + cl + bj * 128 + 4);
#pragma unroll
                for (int ai = 0; ai < 2; ++ai)
#pragma unroll
                    for (int m = 0; m < 4; ++m) {
                        f32x4 v0 = acc[ai][bj][m][0] + b0, v1 = acc[ai][bj][m][1] + b1;
#pragma unroll
                        for (int e = 0; e < 4; ++e) { float z = v0[e]; v0[e] = (fminf(z, 0.f) - log1pf(__expf(-fabsf(z)))) * 0.0625f; z = v1[e]; v1[e] = (fminf(z, 0.f) - log1pf(__expf(-fabsf(z)))) * 0.0625f; }
                        float* p = LF + (size_t)(row0 + ai * 128 + m * 16) * 256 + cl + bj * 128;
                        *(f32x4*)p = v0; *(f32x4*)(p + 4) = v1;
                    }
            }
            return;
        }
        bf16_t* base; int ld, cb; float sc = 1.f; float* fo = nullptr;
        if (pn < 2) { base = QA; ld = 512; cb = pn * 256; sc = QSCALE; }
        else if (pn < 4) { base = KA; ld = 512; cb = (pn - 2) * 256; fo = out + (u.pm < 128 ? O_KP : O_KS - (size_t)MP * 512); }
        else if (pn < 6) { base = VA; ld = 512; cb = (pn - 4) * 256; fo = out + (u.pm < 128 ? O_VP : O_VS - (size_t)MP * 512); }
        else if (pn == 6) { base = QB; ld = 256; cb = 0; }
        else if (pn == 7) { base = KB; ld = 256; cb = 0; }
        else if (pn < 10) { base = VB; ld = 512; cb = (pn - 8) * 256; }
        else { base = RB; ld = 512; cb = (pn - 10) * 256; }
#pragma unroll
        for (int ai = 0; ai < 2; ++ai)
#pragma unroll
            for (int m = 0; m < 4; ++m) {
                const size_t r = (size_t)(row0 + ai * 128 + m * 16);
#pragma unroll
                for (int bj = 0; bj < 2; ++bj) {
                    const f32x4 a0 = acc[ai][bj][m][0], a1 = acc[ai][bj][m][1];
                    const f32x4 v0 = a0 * sc, v1 = a1 * sc;
                    u32x4 w; w.x = cvt_pk_bf16(v0[0], v0[1]); w.y = cvt_pk_bf16(v0[2], v0[3]); w.z = cvt_pk_bf16(v1[0], v1[1]); w.w = cvt_pk_bf16(v1[2], v1[3]);
                    *(u32x4*)(base + r * ld + cb + cl + bj * 128) = w;
                    if (fo) { float* p = fo + r * 512 + cb + cl + bj * 128; *(f32x4*)p = a0; *(f32x4*)(p + 4) = a1; }
                }
            }
    }
};


struct EpiRowOut {
    static constexpr bool PERM = true;
    bf16_t* O; float* SSQ;
    __device__ __forceinline__ void operator()(const f32x4 (&acc)[2][2][4][2], const pg8::Unit& u, int wr, int wc, int fr, int fq) const {
        const int row0 = u.pm * 256 + wr * 64 + fr; const int cl = u.pn * 256 + wc * 32 + 8 * fq;
#pragma unroll
        for (int ai = 0; ai < 2; ++ai)
#pragma unroll
            for (int m = 0; m < 4; ++m) {
                const size_t r = (size_t)(row0 + ai * 128 + m * 16); float s = 0.f;
#pragma unroll
                for (int bj = 0; bj < 2; ++bj) {
                    const f32x4 v0 = acc[ai][bj][m][0], v1 = acc[ai][bj][m][1];
                    s += (v0[0] * v0[0] + v0[1] * v0[1]) + (v0[2] * v0[2] + v0[3] * v0[3]) + (v1[0] * v1[0] + v1[1] * v1[1]) + (v1[2] * v1[2] + v1[3] * v1[3]);
                    u32x4 w; w.x = cvt_pk_bf16(v0[0], v0[1]); w.y = cvt_pk_bf16(v0[2], v0[3]); w.z = cvt_pk_bf16(v1[0], v1[1]); w.w = cvt_pk_bf16(v1[2], v1[3]);
                    *(u32x4*)(O + r * 1024 + cl + bj * 128) = w;
                }
                s += __shfl_xor(s, 16); s += __shfl_xor(s, 32);
                if (fq == 0) SSQ[r * 16 + u.pn * 4 + wc] = s;
            }
    }
};

struct EpiSlice {
    static constexpr bool PERM = false;
    float* SL; int ksub;
    __device__ __forceinline__ void operator()(const f32x4 (&acc)[2][2][4][2], const pg8::Unit& u, int wr, int wc, int fr, int fq) const {
        float* base = SL + (size_t)(u.kofs / ksub) * (256 * 1024) + (unsigned)((wr * 64 + fr) * 1024 + u.pn * 256 + wc * 32 + 4 * fq);
#pragma unroll
        for (int ai = 0; ai < 2; ++ai)
#pragma unroll
            for (int m = 0; m < 4; ++m) { float* rowp = base + (ai * 128 + m * 16) * 1024;
#pragma unroll
                for (int bj = 0; bj < 2; ++bj)
#pragma unroll
                    for (int n = 0; n < 2; ++n) *(f32x4*)(rowp + bj * 128 + n * 16) = acc[ai][bj][m][n]; }
    }
};

__device__ __forceinline__ float dpp_ror1(float v) { return __int_as_float(__builtin_amdgcn_update_dpp(0, __float_as_int(v), 0x121, 0xf, 0xf, false)); }
__device__ __forceinline__ float dpp_ror2(float v) { return __int_as_float(__builtin_amdgcn_update_dpp(0, __float_as_int(v), 0x122, 0xf, 0xf, false)); }

constexpr int CONVX_OFF = 131072;
struct EpiUp {
    static constexpr bool PERM = true;
    bf16_t* H; float* out; const float* conv_w; const float* conv_b; const float* cbuf; LAS unsigned char* lds;
    __device__ __forceinline__ void operator()(const f32x4 (&acc)[2][2][4][2], const pg8::Unit& u, int wr, int wc, int fr, int fq) const {
        LAS float* X = (LAS float*)(lds + CONVX_OFF);
        const int cg_ = wc * 32 + 8 * fq;
        const int col = u.pn * 128 + cg_;
        if (fr >= 14) {
#pragma unroll
            for (int ai = 0; ai < 2; ++ai) { LAS float* p = X + ((ai * 2 + wr) * 2 + (fr - 14)) * 128 + cg_; *(LAS f32x4*)p = acc[ai][0][3][0]; *(LAS f32x4*)(p + 4) = acc[ai][0][3][1]; }
        }
        f32x4 w0[2], w1[2], w2[2], cb[2];
#pragma unroll
        for (int n = 0; n < 2; ++n) { w0[n] = *(const f32x4*)(conv_w + col + 4 * n); w1[n] = *(const f32x4*)(conv_w + DFF + col + 4 * n); w2[n] = *(const f32x4*)(conv_w + 2 * DFF + col + 4 * n); cb[n] = *(const f32x4*)(conv_b + col + 4 * n); }
        asm volatile("s_waitcnt lgkmcnt(0)" ::: "memory"); __builtin_amdgcn_s_barrier(); asm volatile("" ::: "memory");
#pragma unroll
        for (int ai = 0; ai < 2; ++ai) {
            const int pai = (wr == 1) ? ai : ai - 1, pwr = wr ^ 1;
            f32x4 pr1[2], pr2[2];
#pragma unroll
            for (int n = 0; n < 2; ++n) {
                if (pai >= 0) { pr1[n] = *(const LAS f32x4*)(X + ((pai * 2 + pwr) * 2 + 1) * 128 + cg_ + 4 * n); pr2[n] = *(const LAS f32x4*)(X + ((pai * 2 + pwr) * 2 + (fr & 1)) * 128 + cg_ + 4 * n); }
                else { pr1[n] = (f32x4){0.f, 0.f, 0.f, 0.f}; pr2[n] = pr1[n]; }
            }
#pragma unroll
            for (int m = 0; m < 4; ++m) {
                const int lr = ai * 128 + wr * 64 + m * 16 + fr; const int gr = u.pm * 254 - 2 + lr;
                const bool store = (lr >= 2) && (gr < MT);
                int pos, bidx; const bool samp = gr >= MP;
                if (!samp) { pos = gr & (SEQ - 1); bidx = gr >> 11; } else { pos = (gr - MP) & 7; bidx = (gr - MP) >> 3; }
                const bool head_rows = __builtin_amdgcn_ballot_w64(pos < 2) != 0ull;
                const bool tail_rows = __builtin_amdgcn_ballot_w64(store && (samp ? pos >= 6 : pos >= SEQ - 2)) != 0ull;
                u32x4 hw;
#pragma unroll
                for (int n = 0; n < 2; ++n) {
                    const f32x4 g0 = acc[ai][0][m][n], uu = acc[ai][1][m][n]; f32x4 gm1, gm2, nr1, nr2;
#pragma unroll
                    for (int e = 0; e < 4; ++e) {
                        gm1[e] = __int_as_float(__builtin_amdgcn_update_dpp(__float_as_int(pr1[n][e]), __float_as_int(g0[e]), 0x111, 0xf, 0xf, false));
                        gm2[e] = __int_as_float(__builtin_amdgcn_update_dpp(__float_as_int(pr2[n][e]), __float_as_int(g0[e]), 0x112, 0xf, 0xf, false));
                        nr1[e] = dpp_ror1(g0[e]); nr2[e] = dpp_ror2(g0[e]);
                    }
                    pr1[n] = nr1; pr2[n] = nr2;
                    if (head_rows) {
                        if (!samp) { if (pos == 0) { gm1 = (f32x4){0.f, 0.f, 0.f, 0.f}; gm2 = gm1; } else if (pos == 1) gm2 = (f32x4){0.f, 0.f, 0.f, 0.f}; }
                        else if (store) { if (pos == 0) { gm1 = *(const f32x4*)(cbuf + (size_t)(bidx * 2 + 1) * DFF + col + 4 * n); gm2 = *(const f32x4*)(cbuf + (size_t)(bidx * 2) * DFF + col + 4 * n); }
                                          else if (pos == 1) gm2 = *(const f32x4*)(cbuf + (size_t)(bidx * 2 + 1) * DFF + col + 4 * n); }
                    }
                    const f32x4 c = cb[n] + w0[n] * gm2 + w1[n] * gm1 + w2[n] * g0;
                    const f32x2 ga = pg8::gelu_pk((f32x2){c[0], c[1]}), gb = pg8::gelu_pk((f32x2){c[2], c[3]});
                    const float h0 = ga.x * uu[0], h1 = ga.y * uu[1], h2 = gb.x * uu[2], h3 = gb.y * uu[3];
                    if (n == 0) { hw.x = cvt_pk_bf16(h0, h1); hw.y = cvt_pk_bf16(h2, h3); } else { hw.z = cvt_pk_bf16(h0, h1); hw.w = cvt_pk_bf16(h2, h3); }
                    if (tail_rows && store) {
                        if (!samp) { if (pos >= SEQ - 2) *(f32x4*)(out + O_CP + (size_t)(bidx * 2 + (pos - (SEQ - 2))) * DFF + col + 4 * n) = g0; }
                        else { if (pos >= 6) *(f32x4*)(out + O_CS + (size_t)(bidx * 2 + (pos - 6)) * DFF + col + 4 * n) = g0; }
                    }
                }
                if (store) *(u32x4*)(H + (size_t)gr * DFF + col) = hw;
            }
        }
    }
};

__device__ __forceinline__ unsigned pk2(float lo, float hi) { return cvt_pk_bf16(lo, hi); }
__device__ __forceinline__ void p0_transpose_item(const float* W, int ldw, int scol0, int k0, bf16_t* WT, int dK, int drow0, LAS float* scr, int lane) {
#pragma unroll 8
    for (int i = 0; i < 32; ++i) { const int kk = 2 * i + (lane >> 5); scr[kk * 33 + (lane & 31)] = W[(size_t)(k0 + kk) * ldw + scol0 + (lane & 31)]; }
    asm volatile("s_waitcnt lgkmcnt(0)" ::: "memory");
    const int c = lane & 7;
#pragma unroll
    for (int j = 0; j < 4; ++j) { const int n = (lane >> 3) + 8 * j; const LAS float* s = scr + (8 * c) * 33 + n;
        u32x4 o; o.x = pk2(s[0 * 33], s[1 * 33]); o.y = pk2(s[2 * 33], s[3 * 33]); o.z = pk2(s[4 * 33], s[5 * 33]); o.w = pk2(s[6 * 33], s[7 * 33]);
        *(u32x4*)(WT + (size_t)(drow0 + n) * dK + k0 + 8 * c) = o; }
    asm volatile("s_waitcnt lgkmcnt(0)" ::: "memory");
}
__device__ __forceinline__ void p0_gate_item(const float* w_in, const float* w_a2, int k0, int n0, bf16_t* WT, LAS float* scr, int lane) {
    float w2[16];
#pragma unroll
    for (int r = 0; r < 16; ++r) w2[r] = w_a2[r * 256 + n0 + (lane & 31)];
    for (int i = 0; i < 32; ++i) { const int kk = 2 * i + (lane >> 5); const float* a = w_in + (size_t)(k0 + kk) * DIN + 3072; float s = 0.f;
#pragma unroll
        for (int r = 0; r < 16; ++r) s += a[r] * w2[r];
        scr[kk * 33 + (lane & 31)] = s; }
    asm volatile("s_waitcnt lgkmcnt(0)" ::: "memory");
    const int c = lane & 7;
#pragma unroll
    for (int j = 0; j < 4; ++j) { const int n = (lane >> 3) + 8 * j; const LAS float* s = scr + (8 * c) * 33 + n;
        u32x4 o; o.x = pk2(s[0 * 33], s[1 * 33]); o.y = pk2(s[2 * 33], s[3 * 33]); o.z = pk2(s[4 * 33], s[5 * 33]); o.w = pk2(s[6 * 33], s[7 * 33]);
        *(u32x4*)(WT + (size_t)(3072 + n0 + n) * 1024 + k0 + 8 * c) = o; }
    asm volatile("s_waitcnt lgkmcnt(0)" ::: "memory");
}
__device__ __forceinline__ void rms_row_to_bf16(const float* xrow, const float* g, bf16_t* orow, int lane) {
    const f32x4* xr = (const f32x4*)xrow + lane; const f32x4* gr = (const f32x4*)g + lane;
    f32x4 v[4]; float s = 0.f;
#pragma unroll
    for (int j = 0; j < 4; ++j) { v[j] = xr[64 * j]; s += (v[j].x * v[j].x + v[j].y * v[j].y) + (v[j].z * v[j].z + v[j].w * v[j].w); }
    const float rs = rsqrtf(wave_sum(s) * (1.f / DM) + EPS);
    u32x2* o8 = (u32x2*)orow + lane;
#pragma unroll
    for (int j = 0; j < 4; ++j) { const f32x4 gg = gr[64 * j]; const f32x4 y = v[j] * rs * gg; u32x2 w; w.x = pk2(y.x, y.y); w.y = pk2(y.z, y.w); o8[64 * j] = w; }
}


__device__ __forceinline__ int crow(int r, int hi) { return (r & 3) + 8 * (r >> 2) + 4 * hi; }
typedef short v4i16_t __attribute__((ext_vector_type(4)));
__device__ __forceinline__ s16x4 vtr(const LAS unsigned char* p) { return __builtin_bit_cast(s16x4, __builtin_amdgcn_ds_read_tr16_b64_v4i16((LAS v4i16_t*)p)); }
__device__ __forceinline__ float swapmax(float v) { auto rr = __builtin_amdgcn_permlane32_swap(__float_as_uint(v), __float_as_uint(v), false, false); return fmaxf(__uint_as_float(rr[0]), __uint_as_float(rr[1])); }
__device__ __forceinline__ float swapsum(float v) { auto rr = __builtin_amdgcn_permlane32_swap(__float_as_uint(v), __float_as_uint(v), false, false); return __uint_as_float(rr[0]) + __uint_as_float(rr[1]); }
__device__ __forceinline__ u32x4 pack8(f32x4 a, f32x4 b) { u32x4 w; w.x = cvt_pk_bf16(a.x, a.y); w.y = cvt_pk_bf16(a.z, a.w); w.z = cvt_pk_bf16(b.x, b.y); w.w = cvt_pk_bf16(b.z, b.w); return w; }

constexpr float NEGF = -1e30f;
constexpr int VPITCH = 192;
constexpr int ATT_WLDS = 32 * VPITCH + 256;

struct AttnCtx { const bf16_t *QA, *KA, *VA; bf16_t* MIX; const float *ck, *cv; };

struct TileRegs { u32x4 k[8]; u32x4 v[8]; };

template <bool SAMPLE> __device__ __forceinline__ int tile_key(int ti, int j, int g, int r4, int ncls) {
    if (SAMPLE) { if (ti < 17) return 1536 + 32 * (16 - ti) + j; const int kk = ti - 17; return 16 * (4 * kk + (j >> 3)) + (j & 7); }
    if (ti < ncls) return 4 * (32 * (g - ti) + j) + r4;
    const int jj = ti - ncls + (g == 0 ? 4 : 0); return 128 * g - 128 + 32 * jj + j;
}
template <bool SAMPLE> __device__ __forceinline__ void tile_load(const AttnCtx& C, TileRegs& T, int ti, int b, int h, int g, int r4, int ncls, int lane) {
    const int r32 = lane & 31, hi = lane >> 5;
    if (SAMPLE && ti > 0) {
        { const int idx = tile_key<SAMPLE>(ti, r32, g, r4, ncls); const float* p = C.ck + (((unsigned)(b * WINB + idx) * 8u + h) * 64u + 8 * hi);
#pragma unroll
          for (int d0 = 0; d0 < 4; ++d0) { T.k[2 * d0] = *(const GAS u32x4*)(p + 16 * d0); T.k[2 * d0 + 1] = *(const GAS u32x4*)(p + 16 * d0 + 4); } }
#pragma unroll
        for (int i = 0; i < 4; ++i) { const int key = (lane >> 3) + 8 * i; const int idx = tile_key<SAMPLE>(ti, key, g, r4, ncls);
            const float* p = C.cv + (((unsigned)(b * WINB + idx) * 8u + h) * 64u + 8 * (lane & 7)); T.v[2 * i] = *(const GAS u32x4*)p; T.v[2 * i + 1] = *(const GAS u32x4*)(p + 4); }
    } else {
        unsigned rowb;
        { int key = tile_key<SAMPLE>(ti, r32, g, r4, ncls); if (SAMPLE) { key -= WINB; key = key > 7 ? 7 : key; rowb = (unsigned)(MP + b * 8 + key); } else rowb = (unsigned)(b * SEQ + key);
          const bf16_t* p = C.KA + (rowb * 512u + h * 64 + 8 * hi);
#pragma unroll
          for (int d0 = 0; d0 < 4; ++d0) T.k[d0] = *(const GAS u32x4*)(p + 16 * d0); }
#pragma unroll
        for (int i = 0; i < 4; ++i) { int key = tile_key<SAMPLE>(ti, (lane >> 3) + 8 * i, g, r4, ncls); if (SAMPLE) { key -= WINB; key = key > 7 ? 7 : key; rowb = (unsigned)(MP + b * 8 + key); } else rowb = (unsigned)(b * SEQ + key);
            T.v[i] = *(const GAS u32x4*)(C.VA + (rowb * 512u + h * 64 + 8 * (lane & 7))); }
    }
}

template <bool SAMPLE>
__device__ __forceinline__ void attn_item(const AttnCtx& C, int b, int h, int g, int r4, LAS unsigned char* wl, int lane_in) {
    int lane = lane_in; asm volatile("" : "+v"(lane));
    const int r32 = lane & 31, hi = lane >> 5;
    LAS float* wsf = (LAS float*)(wl + 32 * VPITCH);
    const int ncls = g + 1;
    const int nt = SAMPLE ? 41 : (ncls + (g == 0 ? 4 : 8));
    bf16x8 qf[4];
    {
        unsigned qrow; if (SAMPLE) qrow = (unsigned)(MP + b * 8 + (r32 & 7)); else qrow = (unsigned)(b * SEQ + 4 * (32 * g + r32) + r4);
        const bf16_t* p = C.QA + (qrow * 512u + h * 64 + 8 * hi);
#pragma unroll
        for (int d0 = 0; d0 < 4; ++d0) qf[d0] = *(const bf16x8*)(p + 16 * d0);
    }
    float mrun = NEGF, lrun = 0.f;
    f32x16 o0 = {}, o1 = {};
    TileRegs T;
    tile_load<SAMPLE>(C, T, 0, b, h, g, r4, ncls, lane);
    const int vrd = (4 * hi + ((lane & 15) >> 2)) * VPITCH + (((lane >> 4) & 1) * 16 + (lane & 3) * 4) * 2;
    for (int ti = 0; ti < nt; ++ti) {
        bf16x8 kf[4];
        const bool f32path = SAMPLE && ti > 0;
        if (f32path) {
#pragma unroll
            for (int d0 = 0; d0 < 4; ++d0) kf[d0] = __builtin_bit_cast(bf16x8, pack8(__builtin_bit_cast(f32x4, T.k[2 * d0]), __builtin_bit_cast(f32x4, T.k[2 * d0 + 1])));
#pragma unroll
            for (int i = 0; i < 4; ++i) *(LAS u32x4*)(wl + ((lane >> 3) + 8 * i) * VPITCH + (lane & 7) * 16) = pack8(__builtin_bit_cast(f32x4, T.v[2 * i]), __builtin_bit_cast(f32x4, T.v[2 * i + 1]));
        } else {
#pragma unroll
            for (int d0 = 0; d0 < 4; ++d0) kf[d0] = __builtin_bit_cast(bf16x8, T.k[d0]);
#pragma unroll
            for (int i = 0; i < 4; ++i) *(LAS u32x4*)(wl + ((lane >> 3) + 8 * i) * VPITCH + (lane & 7) * 16) = T.v[i];
        }
        if (ti + 1 < nt) tile_load<SAMPLE>(C, T, ti + 1, b, h, g, r4, ncls, lane);
        f32x16 p = {};
#pragma unroll
        for (int d0 = 0; d0 < 4; ++d0) p = __builtin_amdgcn_mfma_f32_32x32x16_bf16(kf[d0], qf[d0], p, 0, 0, 0);
        if (SAMPLE) {
            if (ti < 17) { const int dbase = (WINB + r32) - (1536 + 32 * (16 - ti));
#pragma unroll
                for (int r = 0; r < 16; ++r) { const int d = dbase - crow(r, hi); const int mult = (d >= 0 && d <= 128) + (d >= 0 && d <= 512 && !(d & 3)) + (d >= 0 && !(d & 15));
                    p[r] = (mult == 0 || r32 >= 8) ? NEGF : p[r] + (mult == 1 ? 0.f : (mult == 2 ? 1.f : 1.5849625f)); } }
            else {
#pragma unroll
                for (int r = 0; r < 16; ++r) p[r] = ((crow(r, hi) & 7) == r32) ? p[r] : NEGF; }
        } else {
            if (ti < ncls) { const int dbase = (32 * g + r32) - 32 * (g - ti);
#pragma unroll
                for (int r = 0; r < 16; ++r) { const int d = dbase - crow(r, hi); const int mult = (d >= 0 && d <= 128) + (d >= 0 && !(d & 3));
                    p[r] = mult == 0 ? NEGF : p[r] + (mult == 2 ? 1.f : 0.f); } }
            else { const int jj = ti - ncls + (g == 0 ? 4 : 0); const int dbase = (128 * g + 4 * r32 + r4) - (128 * g - 128 + 32 * jj);
#pragma unroll
                for (int r = 0; r < 16; ++r) { const int d = dbase - crow(r, hi); p[r] = (d >= 0 && d <= 128) ? p[r] : NEGF; } }
        }
        float rm = p[0];
#pragma unroll
        for (int r = 1; r < 16; ++r) rm = fmaxf(rm, p[r]);
        rm = swapmax(rm);
        const float mnew = fmaxf(mrun, rm);
        const float f = __builtin_amdgcn_exp2f(mrun - mnew);
        mrun = mnew;
        float ls = 0.f;
#pragma unroll
        for (int r = 0; r < 16; ++r) { p[r] = __builtin_amdgcn_exp2f(p[r] - mnew); ls += p[r]; }
        lrun = lrun * f + ls;
        if (hi == 0) wsf[r32] = f;
        u32x4 pa0, pa1;
        pa0.x = cvt_pk_bf16(p[0], p[1]); pa0.y = cvt_pk_bf16(p[2], p[3]); pa0.z = cvt_pk_bf16(p[4], p[5]); pa0.w = cvt_pk_bf16(p[6], p[7]);
        pa1.x = cvt_pk_bf16(p[8], p[9]); pa1.y = cvt_pk_bf16(p[10], p[11]); pa1.z = cvt_pk_bf16(p[12], p[13]); pa1.w = cvt_pk_bf16(p[14], p[15]);
#pragma unroll
        for (int r = 0; r < 16; ++r) { const float fr_ = wsf[crow(r, hi)]; o0[r] *= fr_; o1[r] *= fr_; }
#pragma unroll
        for (int sl = 0; sl < 2; ++sl) {
            const bf16x8 pa = __builtin_bit_cast(bf16x8, sl == 0 ? pa0 : pa1);
#pragma unroll
            for (int c = 0; c < 2; ++c) {
                const s16x4 lo = vtr(wl + vrd + (16 * sl) * VPITCH + 64 * c), hi4 = vtr(wl + vrd + (16 * sl + 8) * VPITCH + 64 * c);
                const bf16x8 vf = (bf16x8){lo[0], lo[1], lo[2], lo[3], hi4[0], hi4[1], hi4[2], hi4[3]};
                if (c == 0) o0 = __builtin_amdgcn_mfma_f32_32x32x16_bf16(pa, vf, o0, 0, 0, 0); else o1 = __builtin_amdgcn_mfma_f32_32x32x16_bf16(pa, vf, o1, 0, 0, 0);
            }
        }
    }
    const float lt = swapsum(lrun);
    if (hi == 0) wsf[32 + r32] = 1.f / lt;
#pragma unroll
    for (int r = 0; r < 16; ++r) {
        const int q = crow(r, hi); const float rl = wsf[32 + q];
        unsigned orow; bool ok = true;
        if (SAMPLE) { ok = q < 8; orow = (unsigned)(MP + b * 8 + (q & 7)); } else orow = (unsigned)(b * SEQ + 4 * (32 * g + q) + r4);
        if (ok) { bf16_t* op = C.MIX + (orow * 1024u + h * 64 + r32);
            op[0] = (bf16_t)(cvt_pk_bf16(o0[r] * rl, 0.f) & 0xffffu); op[32] = (bf16_t)(cvt_pk_bf16(o1[r] * rl, 0.f) & 0xffffu); }
    }
}

struct GlaCtx { const bf16_t *QB, *KB, *VB, *RB; const float* LF; bf16_t* MIX; const float* gnorm; };
constexpr int GQ_P = 72, GT_P = 40;
constexpr int G_QE = 0, G_KE = 32 * GQ_P * 2, G_KT = G_KE + 32 * GQ_P * 2, G_EB = G_KT + 64 * GT_P * 2, G_BUF = G_EB + 256;
constexpr int GL_V = 2 * G_BUF;
constexpr int GL_O = GL_V + 2 * 4 * 2048;
constexpr int GL_END = GL_O + 2 * 4 * 4608;
static_assert(GL_END <= 131072, "gla lds");
#define LDS_BARRIER() do { asm volatile("s_waitcnt lgkmcnt(0)" ::: "memory"); __builtin_amdgcn_s_barrier(); asm volatile("" ::: "memory"); } while (0)
typedef float f32x8 __attribute__((ext_vector_type(8)));
typedef unsigned u32x8 __attribute__((ext_vector_type(8)));
typedef unsigned u32x16 __attribute__((ext_vector_type(16)));
struct GlaPre { f32x8 lf; u32x8 q, k; u32x4 v0, v1; };

template <int nvalid> __device__ __forceinline__ void gla_h_loads(const GlaCtx& C, GlaPre& P, unsigned t0, int h, int dk, int tg, int dvs, int lane) {
    const bool ok = 8 * tg < nvalid;
    const unsigned off = (t0 + (ok ? 8 * tg : 0)) * 256u + h * 64 + dk;
    const GAS float* lp = (const GAS float*)(C.LF + off); const GAS bf16_t* qp = (const GAS bf16_t*)(C.QB + off); const GAS bf16_t* kp = (const GAS bf16_t*)(C.KB + off);
#pragma unroll
    for (int e = 0; e < 8; ++e) { P.lf[e] = lp[e * 256]; P.q[e] = (unsigned)qp[e * 256]; P.k[e] = (unsigned)kp[e * 256]; }
    const int i = lane >> 1; const bool okv = i < nvalid; const GAS bf16_t* p = (const GAS bf16_t*)(C.VB + ((t0 + (okv ? i : 0)) * 512u + h * 128 + 32 * dvs + 16 * (lane & 1)));
    P.v0 = *(const GAS u32x4*)p; P.v1 = *(const GAS u32x4*)(p + 8);
}
template <int nvalid> __device__ __forceinline__ void gla_h_wave(const GlaCtx& C, LAS unsigned char* lds, int hw  , int lane, unsigned row0, int h, int nchunk) {
    const int tg = lane >> 4, dkl = lane & 15, dk = 16 * hw + dkl;
    const int ft = lane >> 3, dvg = lane & 7;
    const bool fin_ok = 8 * hw < nvalid;
    f32x4 gn[4];
#pragma unroll
    for (int k4 = 0; k4 < 4; ++k4) gn[k4] = *(const f32x4*)(C.gnorm + h * 128 + 16 * dvg + 4 * k4);
    GlaPre P; u32x4 g0 = {}, g1 = {};
    gla_h_loads<nvalid>(C, P, row0, h, dk, tg, hw, lane);
    for (int j = 0; j <= nchunk + 1; ++j) {
        if (j >= 2 && fin_ok) {
            const int c = j - 2; const int ob = c & 1;
            const LAS float* op = (const LAS float*)(lds + GL_O + (ob * 4 + (dvg >> 1)) * 4608) + (8 * hw + ft) * 36 + 16 * (dvg & 1);
            f32x4 o[4]; float s = 0.f;
#pragma unroll
            for (int k4 = 0; k4 < 4; ++k4) { o[k4] = *(const LAS f32x4*)(op + 4 * k4); s += (o[k4].x * o[k4].x + o[k4].y * o[k4].y) + (o[k4].z * o[k4].z + o[k4].w * o[k4].w); }
            s += __shfl_xor(s, 1); s += __shfl_xor(s, 2); s += __shfl_xor(s, 4);
            const float rs = rsqrtf(s * (1.f / 128.f) + EPS);
            float gt[16];
            gt[0] = __uint_as_float(g0.x << 16); gt[1] = __uint_as_float(g0.x & 0xffff0000u); gt[2] = __uint_as_float(g0.y << 16); gt[3] = __uint_as_float(g0.y & 0xffff0000u);
            gt[4] = __uint_as_float(g0.z << 16); gt[5] = __uint_as_float(g0.z & 0xffff0000u); gt[6] = __uint_as_float(g0.w << 16); gt[7] = __uint_as_float(g0.w & 0xffff0000u);
            gt[8] = __uint_as_float(g1.x << 16); gt[9] = __uint_as_float(g1.x & 0xffff0000u); gt[10] = __uint_as_float(g1.y << 16); gt[11] = __uint_as_float(g1.y & 0xffff0000u);
            gt[12] = __uint_as_float(g1.z << 16); gt[13] = __uint_as_float(g1.z & 0xffff0000u); gt[14] = __uint_as_float(g1.w << 16); gt[15] = __uint_as_float(g1.w & 0xffff0000u);
            float val[16];
#pragma unroll
            for (int k = 0; k < 16; ++k) { const float rg = gt[k]; val[k] = o[k >> 2][k & 3] * rs * gn[k >> 2][k & 3] * rg * __builtin_amdgcn_rcpf(1.f + __expf(-rg)); }
            u32x4 w0, w1;
            w0.x = cvt_pk_bf16(val[0], val[1]); w0.y = cvt_pk_bf16(val[2], val[3]); w0.z = cvt_pk_bf16(val[4], val[5]); w0.w = cvt_pk_bf16(val[6], val[7]);
            w1.x = cvt_pk_bf16(val[8], val[9]); w1.y = cvt_pk_bf16(val[10], val[11]); w1.z = cvt_pk_bf16(val[12], val[13]); w1.w = cvt_pk_bf16(val[14], val[15]);
            bf16_t* mp = C.MIX + ((row0 + 32u * c + 8 * hw + ft) * 1024u + 512 + h * 128 + 16 * dvg);
            *(GAS u32x4*)mp = w0; *(GAS u32x4*)(mp + 8) = w1;
        }
        if (j < nchunk) {
            const int buf = j & 1;
            LAS unsigned char* sh = lds + buf * G_BUF;
            LAS bf16_t* qe_l = (LAS bf16_t*)(sh + G_QE); LAS bf16_t* ke_l = (LAS bf16_t*)(sh + G_KE); LAS bf16_t* kt_l = (LAS bf16_t*)(sh + G_KT); LAS float* eb_l = (LAS float*)(sh + G_EB);
            LAS unsigned char* vl = lds + GL_V + (buf * 4 + hw) * 2048;
            const bool okp = 8 * tg < nvalid, okv = (lane >> 1) < nvalid;
            if (!okp) { P.lf = (f32x8){0.f, 0.f, 0.f, 0.f, 0.f, 0.f, 0.f, 0.f}; P.q = (u32x8){0u, 0u, 0u, 0u, 0u, 0u, 0u, 0u}; P.k = P.q; }
            if (!okv) { P.v0 = (u32x4){0u, 0u, 0u, 0u}; P.v1 = P.v0; }
            f32x8 cs; float run = 0.f;
#pragma unroll
            for (int e = 0; e < 8; ++e) { run += P.lf[e]; cs[e] = run; }
            float offs = 0.f, tot = 0.f;
#pragma unroll
            for (int t = 0; t < 4; ++t) { const float Tt = __shfl(run, dkl + 16 * t); tot += Tt; offs += (t < tg) ? Tt : 0.f; }
            u32x8 kb;
#pragma unroll
            for (int e = 0; e < 8; ++e) { const float bb = offs + cs[e]; const float eb = __expf(bb), ei = __expf(-bb); const int i = 8 * tg + e;
                qe_l[i * GQ_P + dk] = (bf16_t)(cvt_pk_bf16(__uint_as_float(P.q[e] << 16) * 0.125f * eb, 0.f) & 0xffffu);
                kb[e] = cvt_pk_bf16(__uint_as_float(P.k[e] << 16) * ei, 0.f) & 0xffffu;
                ke_l[i * GQ_P + dk] = (bf16_t)kb[e]; }
            u32x4 w; w.x = kb[0] | (kb[1] << 16); w.y = kb[2] | (kb[3] << 16); w.z = kb[4] | (kb[5] << 16); w.w = kb[6] | (kb[7] << 16);
            *(LAS u32x4*)(kt_l + dk * GT_P + 8 * tg) = w;
            if (tg == 0) eb_l[dk] = __expf(tot);
            *(LAS u32x4*)(vl + (lane >> 1) * 64 + (lane & 1) * 32) = P.v0; *(LAS u32x4*)(vl + (lane >> 1) * 64 + (lane & 1) * 32 + 16) = P.v1;
        }
        if (j + 1 < nchunk) gla_h_loads<nvalid>(C, P, row0 + 32u * (j + 1), h, dk, tg, hw, lane);
        if (j >= 1 && j <= nchunk && fin_ok) { const bf16_t* rp = C.RB + ((row0 + 32u * (j - 1) + 8 * hw + ft) * 512u + h * 128 + 16 * dvg); g0 = *(const GAS u32x4*)rp; g1 = *(const GAS u32x4*)(rp + 8); }
        if (j <= nchunk) LDS_BARRIER();
    }
}
template <int nvalid> __device__ __forceinline__ void gla_m_wave(LAS unsigned char* lds, int dvs, int lane, int nchunk, const float* s_in, float* s_out) {
    const int r32 = lane & 31, hi = lane >> 5;
    f32x16 S0 = {}, S1 = {};
    unsigned soff = (unsigned)(4 * hi * 128 + 32 * dvs + r32); asm volatile("" : "+v"(soff));
    if (s_in) {
#pragma unroll
        for (int r = 0; r < 16; ++r) { const unsigned o_ = soff + (unsigned)(((r & 3) + 8 * (r >> 2)) * 128); S0[r] = s_in[o_]; S1[r] = s_in[o_ + 4096u]; }
    }
    const int vrd = (4 * hi + ((lane & 15) >> 2)) * 64 + (((lane >> 4) & 1) * 16 + (lane & 3) * 4) * 2;
    LDS_BARRIER();
    for (int c = 0; c < nchunk; ++c) {
        const int buf = c & 1;
        LAS unsigned char* sh = lds + buf * G_BUF;
        LAS bf16_t* qe_l = (LAS bf16_t*)(sh + G_QE); LAS bf16_t* ke_l = (LAS bf16_t*)(sh + G_KE); LAS bf16_t* kt_l = (LAS bf16_t*)(sh + G_KT); LAS float* eb_l = (LAS float*)(sh + G_EB);
        const LAS unsigned char* vl = lds + GL_V + (buf * 4 + dvs) * 2048;
        f32x16 at = {};
#pragma unroll
        for (int s = 0; s < 4; ++s) { const bf16x8 a = *(const LAS bf16x8*)(ke_l + r32 * GQ_P + 16 * s + 8 * hi), bq = *(const LAS bf16x8*)(qe_l + r32 * GQ_P + 16 * s + 8 * hi);
            at = __builtin_amdgcn_mfma_f32_32x32x16_bf16(a, bq, at, 0, 0, 0); }
#pragma unroll
        for (int r = 0; r < 16; ++r) at[r] = (crow(r, hi) <= r32) ? at[r] : 0.f;
        u32x4 pa0, pa1;
        pa0.x = cvt_pk_bf16(at[0], at[1]); pa0.y = cvt_pk_bf16(at[2], at[3]); pa0.z = cvt_pk_bf16(at[4], at[5]); pa0.w = cvt_pk_bf16(at[6], at[7]);
        pa1.x = cvt_pk_bf16(at[8], at[9]); pa1.y = cvt_pk_bf16(at[10], at[11]); pa1.z = cvt_pk_bf16(at[12], at[13]); pa1.w = cvt_pk_bf16(at[14], at[15]);
        bf16x8 vf0, vf1;
        { const s16x4 lo = vtr(vl + vrd), h4 = vtr(vl + vrd + 8 * 64); vf0 = (bf16x8){lo[0], lo[1], lo[2], lo[3], h4[0], h4[1], h4[2], h4[3]}; }
        { const s16x4 lo = vtr(vl + vrd + 16 * 64), h4 = vtr(vl + vrd + 24 * 64); vf1 = (bf16x8){lo[0], lo[1], lo[2], lo[3], h4[0], h4[1], h4[2], h4[3]}; }
        f32x16 o = {};
        o = __builtin_amdgcn_mfma_f32_32x32x16_bf16(__builtin_bit_cast(bf16x8, pa0), vf0, o, 0, 0, 0);
        o = __builtin_amdgcn_mfma_f32_32x32x16_bf16(__builtin_bit_cast(bf16x8, pa1), vf1, o, 0, 0, 0);
#pragma unroll
        for (int s = 0; s < 4; ++s) {
            const u32x2 q0 = *(const LAS u32x2*)(qe_l + r32 * GQ_P + 16 * s + 4 * hi), q1 = *(const LAS u32x2*)(qe_l + r32 * GQ_P + 16 * s + 8 + 4 * hi);
            const u32x4 qa = (u32x4){q0.x, q0.y, q1.x, q1.y};
            u32x4 sb;
            if (s == 0) { sb.x = cvt_pk_bf16(S0[0], S0[1]); sb.y = cvt_pk_bf16(S0[2], S0[3]); sb.z = cvt_pk_bf16(S0[4], S0[5]); sb.w = cvt_pk_bf16(S0[6], S0[7]); }
            else if (s == 1) { sb.x = cvt_pk_bf16(S0[8], S0[9]); sb.y = cvt_pk_bf16(S0[10], S0[11]); sb.z = cvt_pk_bf16(S0[12], S0[13]); sb.w = cvt_pk_bf16(S0[14], S0[15]); }
            else if (s == 2) { sb.x = cvt_pk_bf16(S1[0], S1[1]); sb.y = cvt_pk_bf16(S1[2], S1[3]); sb.z = cvt_pk_bf16(S1[4], S1[5]); sb.w = cvt_pk_bf16(S1[6], S1[7]); }
            else { sb.x = cvt_pk_bf16(S1[8], S1[9]); sb.y = cvt_pk_bf16(S1[10], S1[11]); sb.z = cvt_pk_bf16(S1[12], S1[13]); sb.w = cvt_pk_bf16(S1[14], S1[15]); }
            o = __builtin_amdgcn_mfma_f32_32x32x16_bf16(__builtin_bit_cast(bf16x8, qa), __builtin_bit_cast(bf16x8, sb), o, 0, 0, 0);
        }
        { LAS float* ol = (LAS float*)(lds + GL_O + (buf * 4 + dvs) * 4608);
#pragma unroll
          for (int r = 0; r < 16; ++r) ol[crow(r, hi) * 36 + r32] = o[r]; }
        {
            const u32x2 a0 = *(const LAS u32x2*)(kt_l + r32 * GT_P + 4 * hi), a1 = *(const LAS u32x2*)(kt_l + r32 * GT_P + 8 + 4 * hi);
            const u32x2 c0 = *(const LAS u32x2*)(kt_l + (32 + r32) * GT_P + 4 * hi), c1 = *(const LAS u32x2*)(kt_l + (32 + r32) * GT_P + 8 + 4 * hi);
            S0 = __builtin_amdgcn_mfma_f32_32x32x16_bf16(__builtin_bit_cast(bf16x8, (u32x4){a0.x, a0.y, a1.x, a1.y}), vf0, S0, 0, 0, 0);
            S1 = __builtin_amdgcn_mfma_f32_32x32x16_bf16(__builtin_bit_cast(bf16x8, (u32x4){c0.x, c0.y, c1.x, c1.y}), vf0, S1, 0, 0, 0);
        }
        {
            const u32x2 a0 = *(const LAS u32x2*)(kt_l + r32 * GT_P + 16 + 4 * hi), a1 = *(const LAS u32x2*)(kt_l + r32 * GT_P + 24 + 4 * hi);
            const u32x2 c0 = *(const LAS u32x2*)(kt_l + (32 + r32) * GT_P + 16 + 4 * hi), c1 = *(const LAS u32x2*)(kt_l + (32 + r32) * GT_P + 24 + 4 * hi);
            S0 = __builtin_amdgcn_mfma_f32_32x32x16_bf16(__builtin_bit_cast(bf16x8, (u32x4){a0.x, a0.y, a1.x, a1.y}), vf1, S0, 0, 0, 0);
            S1 = __builtin_amdgcn_mfma_f32_32x32x16_bf16(__builtin_bit_cast(bf16x8, (u32x4){c0.x, c0.y, c1.x, c1.y}), vf1, S1, 0, 0, 0);
        }
#pragma unroll
        for (int r = 0; r < 16; ++r) { S0[r] *= eb_l[crow(r, hi)]; S1[r] *= eb_l[32 + crow(r, hi)]; }
        LDS_BARRIER();
    }
    if (s_out) {
        unsigned soff2 = (unsigned)(4 * hi * 128 + 32 * dvs + r32); asm volatile("" : "+v"(soff2));
#pragma unroll
        for (int r = 0; r < 16; ++r) { const unsigned o_ = soff2 + (unsigned)(((r & 3) + 8 * (r >> 2)) * 128); s_out[o_] = S0[r]; s_out[o_ + 4096u] = S1[r]; }
    }
}

#define XB_TMO      128
#define XB_XCNT(j)  (256  + 64 * (j))
#define XB_XSUB(j)  (1280 + 64 * (j))
#define XB_XGEN(j)  (2304 + 64 * (j))
#define XB_TOP      3328
#define XB_TOPGEN   3392
#define XCD_BAR_WORDS 3456
#define XB_SPIN_CAP (1u << 18)
__device__ __forceinline__ unsigned xb_ld(unsigned* p)              { return __hip_atomic_load(p, __ATOMIC_RELAXED, __HIP_MEMORY_SCOPE_AGENT); }
__device__ __forceinline__ unsigned xb_add(unsigned* p, unsigned v) { return __hip_atomic_fetch_add(p, v, __ATOMIC_RELAXED, __HIP_MEMORY_SCOPE_AGENT); }
__device__ __forceinline__ unsigned xb_xcc_id() { return (unsigned)__builtin_amdgcn_s_getreg((3 << 11) | 20) & 0xFu; }
#define XB_SPIN(cond, bar) do { unsigned _sp = 0; while (cond) { __builtin_amdgcn_s_sleep(1); \
    if ((++_sp & 255u) == 0u) { if (xb_ld(&(bar)[XB_TMO])) break; if (_sp > XB_SPIN_CAP) { atomicAdd(&(bar)[XB_TMO], 1u); break; } } } } while (0)
struct XcdBarrier { unsigned* bar; unsigned x; volatile LAS unsigned* st; };
__device__ __forceinline__ XcdBarrier xcd_barrier_post(unsigned* bar, volatile LAS unsigned* st) {
    XcdBarrier b; b.bar = bar; b.x = xb_xcc_id(); b.st = st;
    if (threadIdx.x == 0) (void)xb_add(&bar[XB_XCNT(b.x)], 1u);
    return b;
}
__device__ __forceinline__ void xcd_barrier_complete(unsigned* bar, unsigned x, unsigned& nloc, unsigned& nx) {
    const unsigned G = gridDim.x * gridDim.y * gridDim.z;
    unsigned sum, cnt, mine, sp = 0u;
    for (;;) {
        sum = 0u; cnt = 0u; mine = 0u;
#pragma unroll
        for (unsigned j = 0; j < 16; ++j) { const unsigned c = xb_ld(&bar[XB_XCNT(j)]); sum += c; cnt += (c > 0u) ? 1u : 0u; mine = (j == x) ? c : mine; }
        if (sum == G) break;
        __builtin_amdgcn_s_sleep(1);
        if ((++sp & 255u) == 0u) { if (xb_ld(&bar[XB_TMO])) break; if (sp > XB_SPIN_CAP) { atomicAdd(&bar[XB_TMO], 1u); break; } }
    }
    nloc = mine > 0u ? mine : 1u; nx = cnt > 0u ? cnt : 1u;
}
__device__ __forceinline__ void xcd_barrier(const XcdBarrier& b, int wave0) {
    asm volatile("s_waitcnt vmcnt(0)" ::: "memory");
    __syncthreads();
    if (wave0 == 0 && lane_id_v() == 0) {
        unsigned* bar = b.bar;
        __builtin_amdgcn_s_waitcnt(0);
        unsigned nloc = b.st[0], nx = b.st[1];
        if (nloc == 0u) { xcd_barrier_complete(bar, b.x, nloc, nx); b.st[0] = nloc; b.st[1] = nx; }
        const unsigned old = xb_add(&bar[XB_XSUB(b.x)], 1u);
        const unsigned gen = old / nloc;
        if (old + 1u == (gen + 1u) * nloc) {
            __builtin_amdgcn_fence(__ATOMIC_RELEASE, "agent");
            asm volatile("s_waitcnt vmcnt(0)" ::: "memory");
            const unsigned og = xb_add(&bar[XB_TOP], 1u);
            const unsigned tg = og / nx;
            if (og + 1u == (tg + 1u) * nx) xb_add(&bar[XB_TOPGEN], 1u);
            else XB_SPIN(xb_ld(&bar[XB_TOPGEN]) == tg, bar);
            __builtin_amdgcn_fence(__ATOMIC_ACQUIRE, "agent");
            xb_add(&bar[XB_XGEN(b.x)], 1u);
            asm volatile("s_waitcnt vmcnt(0)" ::: "memory");
        } else {
            XB_SPIN(xb_ld(&bar[XB_XGEN(b.x)]) == gen, bar);
            __builtin_amdgcn_fence(__ATOMIC_ACQUIRE, "agent");
            asm volatile("s_waitcnt vmcnt(0)" ::: "memory");
        }
    }
    __syncthreads();
}

constexpr int LDS_BYTES = 147456;

__global__ void __launch_bounds__(512, 2) hymba_fwd(Args args) {
    extern __shared__ __attribute__((aligned(16))) unsigned char lds_raw[];
    LAS unsigned char* lds = (LAS unsigned char*)lds_raw;
#define PHASE_IDS() const int lane = lane_id_v(); const int wave = wave0; (void)lane; (void)wave
    const int G = gridDim.x, bx = blockIdx.x;
    const int wave0 = __builtin_amdgcn_readfirstlane((int)(threadIdx.x >> 6));
    if (threadIdx.x < 4) ((LAS unsigned*)(lds + XBST_OFF))[threadIdx.x] = 0u;
    __syncthreads();
    const XcdBarrier xbar = xcd_barrier_post((unsigned*)(args.ws + WS_CTL) + 4096, (volatile LAS unsigned*)(lds + XBST_OFF));
    const int vcu = (G % 8 == 0) ? (bx % 8) * (G / 8) + bx / 8 : bx;
    const float* x_prompt = args.in[0]; const float* x_sample = args.in[1];
    const float* w_in = args.in[6]; const float* w_a2 = args.in[7]; const float* b_a = args.in[8];
    const float* w_o = args.in[10]; const float* g_pre_mix = args.in[11];
    const float* w_up = args.in[15]; const float* w_down = args.in[18];
#define PHASE_WS() unsigned char* ws = args.ws; asm volatile("" : "+s"(ws))

    {
        PHASE_IDS(); PHASE_WS();
        bf16_t* WinT = (bf16_t*)(ws + WS_WIN); bf16_t* WoT = (bf16_t*)(ws + WS_WO); bf16_t* WupT = (bf16_t*)(ws + WS_WUP); bf16_t* WdT = (bf16_t*)(ws + WS_WD); bf16_t* XN = (bf16_t*)(ws + WS_XN + 4096);
        LAS float* scr = (LAS float*)(lds + wave * 16384);
        const int gw = vcu * 8 + wave, NGW = G * 8;
        constexpr int I_IN = 16 * 96, I_G = 16 * 8, I_O = 16 * 32, I_UP = 16 * 176, I_D = 44 * 32;
        constexpr int NITEMS = I_IN + I_G + I_O + I_UP + I_D;
        for (int it = gw; it < NITEMS; it += NGW) {
            int r = it;
            if (r < I_IN) { const int kb = r / 96, nb = r % 96; p0_transpose_item(w_in, DIN, 32 * nb, 64 * kb, WinT, 1024, 32 * nb, scr, lane); continue; } r -= I_IN;
            if (r < I_G) { const int kb = r / 8, nb = r % 8; p0_gate_item(w_in, w_a2, 64 * kb, 32 * nb, WinT, scr, lane); continue; } r -= I_G;
            if (r < I_O) { const int kb = r / 32, nb = r % 32; p0_transpose_item(w_o, 1024, 32 * nb, 64 * kb, WoT, 1024, 32 * nb, scr, lane); continue; } r -= I_O;
            if (r < I_UP) { const int kb = r / 176, nb = r % 176; const int n0 = 32 * nb, t = n0 >> 8, w = n0 & 255;
                const int sc = (w < 128) ? (128 * t + w) : (DFF + 128 * t + (w - 128));
                p0_transpose_item(w_up, 2 * DFF, sc, 64 * kb, WupT, 1024, n0, scr, lane); continue; } r -= I_UP;
            { const int kb = r / 32, nb = r % 32; p0_transpose_item(w_down, 1024, 32 * nb, 64 * kb, WdT, DFF, 32 * nb, scr, lane); }
        }
        for (int m = gw; m < MT; m += NGW) {
            const float* xr = (m < MP) ? x_prompt + (size_t)m * DM : x_sample + (size_t)(m - MP) * DM;
            rms_row_to_bf16(xr, g_pre_mix, XN + (size_t)m * DM, lane);
        }
    }
    xcd_barrier(xbar, wave0);

    {
        PHASE_WS();
        pg8::Gemm g{(bf16_t*)(ws + WS_XN + 4096), (bf16_t*)(ws + WS_WIN), 1024, 256, 1024}; pg8::StaticOrder S; S.init(MT / 256, NIN / 256, G, bx);
        EpiInProj E{(bf16_t*)(ws + WS_QA), (bf16_t*)(ws + WS_KA), (bf16_t*)(ws + WS_VA), (bf16_t*)(ws + WS_QB), (bf16_t*)(ws + WS_KB), (bf16_t*)(ws + WS_VB), (bf16_t*)(ws + WS_RB),
                    (float*)(ws + WS_LF), args.out, b_a};
        pg8::gemm_phase<EpiInProj, pg8::StaticOrder>(lds, g, S, E, wave0);
    }
    xcd_barrier(xbar, wave0);

    {
        PHASE_IDS(); PHASE_WS();
        bf16_t* MIX = (bf16_t*)(ws + WS_MIX);
        GlaCtx GC{(const bf16_t*)(ws + WS_QB), (const bf16_t*)(ws + WS_KB), (const bf16_t*)(ws + WS_VB), (const bf16_t*)(ws + WS_RB), (const float*)(ws + WS_LF), MIX, args.in[9]};
        const float* state_gla = args.in[4];
#ifndef NO_GLA
        for (int it = bx; it < 64 + 128; it += G) {
            const bool pr = it < 64; const int seq = pr ? it : it - 64; const int b = seq >> 2, h = seq & 3;
            const size_t row0 = pr ? (size_t)b * SEQ : (size_t)MP + (size_t)b * 8;
            const float* s_in = pr ? nullptr : state_gla + (size_t)seq * 8192;
            float* s_out = args.out + (pr ? O_GP : O_GS) + (size_t)seq * 8192;
            const int nchunk = pr ? SEQ / 32 : 1;
            if (wave < 4) { if (pr) gla_m_wave<32>(lds, wave, lane, nchunk, s_in, s_out); else gla_m_wave<8>(lds, wave, lane, nchunk, s_in, s_out); }
            else { if (pr) gla_h_wave<32>(GC, lds, wave - 4, lane, (unsigned)row0, h, nchunk); else gla_h_wave<8>(GC, lds, wave - 4, lane, (unsigned)row0, h, nchunk); }
            __syncthreads();
        }
#endif
        AttnCtx AC{(const bf16_t*)(ws + WS_QA), (const bf16_t*)(ws + WS_KA), (const bf16_t*)(ws + WS_VA), MIX, args.in[2], args.in[3]};
        unsigned* counter = (unsigned*)(ws + WS_CTL);
        LAS unsigned char* wl = lds + wave * 8192;
        const int lane2 = lane_id_v();
        for (int sb = (bx + 64) % G; sb < NSB; sb += G) attn_item<true>(AC, sb, wave, 0, 0, wl, lane2);
        const unsigned xq0 = xb_xcc_id() & 7u;
        for (unsigned kq = 0; kq < 8u; ++kq) {
            const unsigned xq = (xq0 + kq) & 7u;
            unsigned* head = counter + 64 * xq;
            for (;;) {
                unsigned loc = 0; if (lane2 == 0) loc = atomicAdd(head, 1u);
                loc = (unsigned)__builtin_amdgcn_readfirstlane((int)loc);
                if (loc >= 1024u) break;
                { const unsigned p = loc; const unsigned grp = p >> 8, q = p & 255u; const int g = 15 - (int)(q >> 4); const unsigned bhl = (q >> 2) & 3u; const int r4 = (int)(q & 3u);
                    const int bh = (int)(xq + 8u * (4u * grp + bhl));
                    attn_item<false>(AC, bh >> 3, bh & 7, g, r4, wl, lane2); }
            }
        }
    }
    xcd_barrier(xbar, wave0);

    {
        PHASE_WS();
        bf16_t* MO = (bf16_t*)(ws + WS_MO); float* SSQ1 = (float*)(ws + WS_SSQ1);
        pg8::Gemm g{(bf16_t*)(ws + WS_MIX), (bf16_t*)(ws + WS_WO), 1024, 256, 1024}; pg8::StaticOrder S; S.init(MP / 256, 4, G, bx);
        EpiRowOut E{MO, SSQ1};
        pg8::gemm_phase<EpiRowOut, pg8::StaticOrder>(lds, g, S, E, wave0);
        pg8::Gemm g2{(bf16_t*)(ws + WS_MIX), (bf16_t*)(ws + WS_WO), 256, 256, 1024}; pg8::SplitOrder S2{16, G, bx, 128, 256};
        EpiSlice E2{(float*)(ws + WS_ACC1), 256};
        pg8::gemm_phase<EpiSlice, pg8::SplitOrder>(lds, g2, S2, E2, wave0);
    }
    xcd_barrier(xbar, wave0);
    {
        PHASE_IDS(); PHASE_WS();
        bf16_t* MO = (bf16_t*)(ws + WS_MO); float* SSQ1 = (float*)(ws + WS_SSQ1); bf16_t* XN = (bf16_t*)(ws + WS_XN + 4096);
        const float* g_post = args.in[12]; const float* g_pre = args.in[13];
        const int gw = vcu * 8 + wave, NGW = G * 8;
        {
            f32x4 gp4[4], gq4[4];
#pragma unroll
            for (int j = 0; j < 4; ++j) { gp4[j] = ((const GAS f32x4*)g_post)[64 * j + lane]; gq4[j] = ((const GAS f32x4*)g_pre)[64 * j + lane]; }
            for (int m0 = gw; m0 < MP; m0 += 2 * NGW) {
                const int m1 = (m0 + NGW < MP) ? m0 + NGW : m0;
                f32x4 sp[2], xv[2][4]; u32x2 mw[2][4];
#pragma unroll
                for (int r = 0; r < 2; ++r) { const int m = r ? m1 : m0; sp[r] = *((const GAS f32x4*)(SSQ1 + (size_t)m * 16) + (lane & 3));
#pragma unroll
                    for (int j = 0; j < 4; ++j) { xv[r][j] = ((const GAS f32x4*)(x_prompt + (size_t)m * DM))[64 * j + lane]; mw[r][j] = ((const GAS u32x2*)(MO + (size_t)m * DM))[64 * j + lane]; } }
#pragma unroll
                for (int r = 0; r < 2; ++r) if (r == 0 || m1 != m0) { const int m = r ? m1 : m0;
                    float ss = (sp[r].x + sp[r].y) + (sp[r].z + sp[r].w); ss += __shfl_xor(ss, 1); ss += __shfl_xor(ss, 2);
                    const float rs = rsqrtf(ss * (1.f / DM) + EPS);
                    f32x4 x1[4]; float s2 = 0.f;
#pragma unroll
                    for (int j = 0; j < 4; ++j) { f32x4 mv; mv.x = __uint_as_float(mw[r][j].x << 16); mv.y = __uint_as_float(mw[r][j].x & 0xffff0000u); mv.z = __uint_as_float(mw[r][j].y << 16); mv.w = __uint_as_float(mw[r][j].y & 0xffff0000u);
                        x1[j] = xv[r][j] + mv * rs * gp4[j]; s2 += (x1[j].x * x1[j].x + x1[j].y * x1[j].y) + (x1[j].z * x1[j].z + x1[j].w * x1[j].w);
                        ((GAS f32x4*)(args.out + (size_t)m * DM))[64 * j + lane] = x1[j]; }
                    const float rs2 = rsqrtf(wave_sum(s2) * (1.f / DM) + EPS);
#pragma unroll
                    for (int j = 0; j < 4; ++j) { const f32x4 y = x1[j] * rs2 * gq4[j]; u32x2 w; w.x = pk2(y.x, y.y); w.y = pk2(y.z, y.w); ((GAS u32x2*)(XN + (size_t)m * DM))[64 * j + lane] = w; }
                }
            }
        }
        for (int m = MP + gw; m < MT; m += NGW) {
            const float* xr = (m < MP) ? x_prompt + (size_t)m * DM : x_sample + (size_t)(m - MP) * DM;
            float* orow = args.out + (size_t)m * DM;
            f32x4 mvv[4]; float ss;
            if (m < MP) {
                const f32x4 sp = *((const f32x4*)(SSQ1 + (size_t)m * 16) + (lane & 3));
                ss = (sp.x + sp.y) + (sp.z + sp.w); ss += __shfl_xor(ss, 1); ss += __shfl_xor(ss, 2);
#pragma unroll
                for (int j = 0; j < 4; ++j) { const u32x2 mw = ((const u32x2*)(MO + (size_t)m * DM))[64 * j + lane];
                    mvv[j].x = __uint_as_float(mw.x << 16); mvv[j].y = __uint_as_float(mw.x & 0xffff0000u); mvv[j].z = __uint_as_float(mw.y << 16); mvv[j].w = __uint_as_float(mw.y & 0xffff0000u); }
            } else {
                const f32x4* ar = (const f32x4*)(ws + WS_ACC1) + (size_t)(m - MP) * 256; float s = 0.f;
#pragma unroll
                for (int j = 0; j < 4; ++j) { f32x4 a = ar[64 * j + lane];
                    for (int sl = 1; sl < 4; ++sl) a += ar[(size_t)sl * 65536 + 64 * j + lane];
                    mvv[j] = a; s += (a.x * a.x + a.y * a.y) + (a.z * a.z + a.w * a.w); }
                ss = wave_sum(s);
            }
            const float rs = rsqrtf(ss * (1.f / DM) + EPS);
            f32x4 x1[4]; float s2 = 0.f;
#pragma unroll
            for (int j = 0; j < 4; ++j) { const int c4 = 64 * j + lane; const f32x4 xv = ((const f32x4*)xr)[c4]; const f32x4 gp = ((const f32x4*)g_post)[c4];
                const f32x4 mv = mvv[j];
                x1[j] = xv + mv * rs * gp; s2 += (x1[j].x * x1[j].x + x1[j].y * x1[j].y) + (x1[j].z * x1[j].z + x1[j].w * x1[j].w);
                ((f32x4*)orow)[c4] = x1[j]; }
            const float rs2 = rsqrtf(wave_sum(s2) * (1.f / DM) + EPS);
#pragma unroll
            for (int j = 0; j < 4; ++j) { const int c4 = 64 * j + lane; const f32x4 gq = ((const f32x4*)g_pre)[c4]; const f32x4 y = x1[j] * rs2 * gq; u32x2 w; w.x = pk2(y.x, y.y); w.y = pk2(y.z, y.w); ((u32x2*)(XN + (size_t)m * DM))[c4] = w; }
        }
    }
    xcd_barrier(xbar, wave0);
    {
        PHASE_WS();
        bf16_t* Hb = (bf16_t*)(ws + WS_H);
        pg8::Gemm g{(bf16_t*)(ws + WS_XN + 4096) - 2 * DM, (bf16_t*)(ws + WS_WUP), 1024, 254, 1024}; pg8::StaticOrder S; S.init(131, 22, G, bx);
        EpiUp E{Hb, args.out, args.in[16], args.in[17], args.in[5], lds};
        pg8::gemm_phase<EpiUp, pg8::StaticOrder>(lds, g, S, E, wave0);
    }
    xcd_barrier(xbar, wave0);
    {
        PHASE_WS();
        bf16_t* MO = (bf16_t*)(ws + WS_MO); float* SSQ2 = (float*)(ws + WS_SSQ2);
        pg8::Gemm g{(bf16_t*)(ws + WS_H), (bf16_t*)(ws + WS_WD), DFF, 256, DFF}; pg8::StaticOrder S; S.init(MP / 256, 4, G, bx);
        EpiRowOut E{MO, SSQ2};
        pg8::gemm_phase<EpiRowOut, pg8::StaticOrder>(lds, g, S, E, wave0);
        pg8::Gemm g2{(bf16_t*)(ws + WS_H), (bf16_t*)(ws + WS_WD), 256, 256, DFF}; pg8::SplitOrder S2{44, G, bx, 128, 256};
        EpiSlice E2{(float*)(ws + WS_ACC2), 256};
        pg8::gemm_phase<EpiSlice, pg8::SplitOrder>(lds, g2, S2, E2, wave0);
    }
    xcd_barrier(xbar, wave0);
    {
        PHASE_IDS(); PHASE_WS();
        bf16_t* MO = (bf16_t*)(ws + WS_MO); float* SSQ2 = (float*)(ws + WS_SSQ2);
        const float* g_post = args.in[14];
        const int gw = vcu * 8 + wave, NGW = G * 8;
        {
            const f32x4 gp4[4] = {((const GAS f32x4*)g_post)[lane], ((const GAS f32x4*)g_post)[64 + lane], ((const GAS f32x4*)g_post)[128 + lane], ((const GAS f32x4*)g_post)[192 + lane]};
            for (int m0 = gw; m0 < MP; m0 += 2 * NGW) {
                const int m1 = (m0 + NGW < MP) ? m0 + NGW : m0;
                GAS float* ro[2] = {(GAS float*)(args.out + (size_t)m0 * DM), (GAS float*)(args.out + (size_t)m1 * DM)};
                f32x4 sp[2], xv[2][4]; u32x2 mw[2][4];
#pragma unroll
                for (int r = 0; r < 2; ++r) { const int m = r ? m1 : m0; sp[r] = *((const GAS f32x4*)(SSQ2 + (size_t)m * 16) + (lane & 3));
#pragma unroll
                    for (int j = 0; j < 4; ++j) { xv[r][j] = ((const GAS f32x4*)ro[r])[64 * j + lane]; mw[r][j] = ((const GAS u32x2*)(MO + (size_t)m * DM))[64 * j + lane]; } }
                f32x4 yv[2][4];
#pragma unroll
                for (int r = 0; r < 2; ++r) { float ss = (sp[r].x + sp[r].y) + (sp[r].z + sp[r].w); ss += __shfl_xor(ss, 1); ss += __shfl_xor(ss, 2);
                    const float rs = rsqrtf(ss * (1.f / DM) + EPS);
#pragma unroll
                    for (int j = 0; j < 4; ++j) { f32x4 mv; mv.x = __uint_as_float(mw[r][j].x << 16); mv.y = __uint_as_float(mw[r][j].x & 0xffff0000u); mv.z = __uint_as_float(mw[r][j].y << 16); mv.w = __uint_as_float(mw[r][j].y & 0xffff0000u);
                        yv[r][j] = xv[r][j] + mv * rs * gp4[j]; } }
#pragma unroll
                for (int r = 0; r < 2; ++r) if (r == 0 || m1 != m0) {
#pragma unroll
                    for (int j = 0; j < 4; ++j) ((GAS f32x4*)ro[r])[64 * j + lane] = yv[r][j]; }
            }
        }
        for (int m = MP + gw; m < MT; m += NGW) {
            float* orow = args.out + (size_t)m * DM;
            f32x4 mvv[4]; float ss;
            if (m < MP) {
                const f32x4 sp = *((const f32x4*)(SSQ2 + (size_t)m * 16) + (lane & 3));
                ss = (sp.x + sp.y) + (sp.z + sp.w); ss += __shfl_xor(ss, 1); ss += __shfl_xor(ss, 2);
#pragma unroll
                for (int j = 0; j < 4; ++j) { const u32x2 mw = ((const u32x2*)(MO + (size_t)m * DM))[64 * j + lane];
                    mvv[j].x = __uint_as_float(mw.x << 16); mvv[j].y = __uint_as_float(mw.x & 0xffff0000u); mvv[j].z = __uint_as_float(mw.y << 16); mvv[j].w = __uint_as_float(mw.y & 0xffff0000u); }
            } else {
                const f32x4* ar = (const f32x4*)(ws + WS_ACC2) + (size_t)(m - MP) * 256; float s = 0.f;
#pragma unroll
                for (int j = 0; j < 4; ++j) { f32x4 a = ar[64 * j + lane];
                    for (int sl = 1; sl < 11; ++sl) a += ar[(size_t)sl * 65536 + 64 * j + lane];
                    mvv[j] = a; s += (a.x * a.x + a.y * a.y) + (a.z * a.z + a.w * a.w); }
                ss = wave_sum(s);
            }
            const float rs = rsqrtf(ss * (1.f / DM) + EPS);
#pragma unroll
            for (int j = 0; j < 4; ++j) { const int c4 = 64 * j + lane; const f32x4 xv = ((const f32x4*)orow)[c4]; const f32x4 gp = ((const f32x4*)g_post)[c4];
                ((f32x4*)orow)[c4] = xv + mvv[j] * rs * gp; }
        }
    }
}

extern "C" void kernel_launch(void* const* d_in, const int* in_sizes, int n_in, void* d_out, int out_size, void* d_ws, size_t ws_size, hipStream_t stream) {
    static int grid = 0;
    if (grid == 0) {
        if (n_in != 19 || ws_size < WS_END || (size_t)out_size != O_END) { fprintf(stderr, "kernel_launch: unexpected shapes n_in %d out %d ws %zu\n", n_in, out_size, ws_size); grid = -1; return; }
        int dev = 0, cus = 0, per_cu = 0;
        hipGetDevice(&dev); hipDeviceGetAttribute(&cus, hipDeviceAttributeMultiprocessorCount, dev);
        hipFuncSetAttribute((const void*)hymba_fwd, hipFuncAttributeMaxDynamicSharedMemorySize, LDS_BYTES);
        hipOccupancyMaxActiveBlocksPerMultiprocessor(&per_cu, (const void*)hymba_fwd, 512, LDS_BYTES);
        if (per_cu < 1) { fprintf(stderr, "kernel_launch: occupancy query says %d blocks per CU\n", per_cu); grid = -1; return; }
        grid = cus;
    }
    if (grid < 0) return;
    hipMemsetAsync((char*)d_ws + WS_CTL, 0, CTL_BYTES, stream);
    Args a{};
    for (int i = 0; i < 19; ++i) a.in[i] = (const float*)d_in[i];
    a.out = (float*)d_out; a.ws = (unsigned char*)d_ws;
    void* kargs[] = {&a};
    hipError_t e = hipLaunchCooperativeKernel((const void*)hymba_fwd, dim3(grid), dim3(512), kargs, LDS_BYTES, stream);
    if (e != hipSuccess) fprintf(stderr, "cooperative launch failed: %s (grid %d)\n", hipGetErrorString(e), grid);
}
```

```cpp
#include <hip/hip_runtime.h>
#include <hip/hip_cooperative_groups.h>
#include <cstdio>
#include <cstdint>
namespace cg = cooperative_groups;

#define LAS __attribute__((address_space(3)))
#define GAS __attribute__((address_space(1)))
typedef unsigned short bf16_t;
typedef short bf16x8 __attribute__((ext_vector_type(8)));
typedef short s16x4 __attribute__((ext_vector_type(4)));
typedef float f32x4 __attribute__((ext_vector_type(4)));
typedef float f32x2 __attribute__((ext_vector_type(2)));
typedef float f32x16 __attribute__((ext_vector_type(16)));
typedef unsigned u32x4 __attribute__((ext_vector_type(4)));
typedef unsigned u32x2 __attribute__((ext_vector_type(2)));

constexpr int DM = 1024, NPB = 16, SEQ = 2048, NSB = 32, NST = 8;
constexpr int MP = NPB * SEQ;
constexpr int MS = NSB * NST;
constexpr int MT = MP + MS;
constexpr int NIN = 3328;
constexpr int DIN = 3088;
constexpr int DFF = 2816;
constexpr int WINB = 2048;
constexpr float EPS = 1e-6f;
constexpr float QSCALE = 0.125f * 1.4426950408889634f;

constexpr size_t MiB = 1u << 20;
constexpr size_t WS_CTL = 0, CTL_BYTES = 65536;
constexpr int XBST_OFF = 131072 + 8192;
constexpr size_t WS_WIN = 1 * MiB, WS_WO = 8 * MiB, WS_WUP = 10 * MiB, WS_WD = 22 * MiB;
constexpr size_t WS_SSQ1 = 28 * MiB, WS_SSQ2 = 31 * MiB;
constexpr size_t WS_XN = 34 * MiB;
constexpr size_t WS_MO = 104 * MiB;
constexpr size_t WS_QA = 172 * MiB, WS_KA = 206 * MiB, WS_VA = 240 * MiB, WS_QB = 274 * MiB, WS_KB = 291 * MiB, WS_VB = 308 * MiB, WS_RB = 342 * MiB, WS_LF = 376 * MiB, WS_MIX = 410 * MiB;
constexpr size_t WS_H = 172 * MiB;
constexpr size_t WS_ACC1 = 478 * MiB, WS_ACC2 = 482 * MiB;
constexpr size_t WS_END = 494 * MiB;
static_assert(WS_H + (size_t)MT * DFF * 2 <= WS_MIX, "h overlay");
static_assert(WS_XN + 4096 + (size_t)(131 * 254 + 260) * DM * 2 <= WS_MO, "xn2");

constexpr size_t O_YP = 0, O_YS = O_YP + (size_t)MP * DM, O_KP = O_YS + (size_t)MS * DM, O_VP = O_KP + (size_t)MP * 512, O_GP = O_VP + (size_t)MP * 512,
                 O_CP = O_GP + (size_t)NPB * 4 * 64 * 128, O_KS = O_CP + (size_t)NPB * 2 * DFF, O_VS = O_KS + (size_t)MS * 512, O_GS = O_VS + (size_t)MS * 512,
                 O_CS = O_GS + (size_t)NSB * 4 * 64 * 128, O_END = O_CS + (size_t)NSB * 2 * DFF;

__device__ __forceinline__ unsigned cvt_pk_bf16(float lo, float hi) { unsigned r; asm volatile("v_cvt_pk_bf16_f32 %0, %1, %2" : "=v"(r) : "v"(lo), "v"(hi)); return r; }
__device__ __forceinline__ float bf2f(unsigned short b) { return __uint_as_float((unsigned)b << 16); }
__device__ __forceinline__ float wave_sum(float v) {
#pragma unroll
    for (int o = 1; o < 64; o <<= 1) v += __shfl_xor(v, o);
    return v;
}

__device__ __forceinline__ int lane_id_v() { int l; asm volatile("v_mbcnt_lo_u32_b32 %0, -1, 0\n\tv_mbcnt_hi_u32_b32 %0, -1, %0" : "=v"(l)); return l; }

struct Args {
    const float* in[19];
    float* out;
    unsigned char* ws;
};

namespace pg8 {
constexpr int BM = 256, BK = 64, HALF = 128, HTB = HALF * BK * 2, STAGE_BYTES = 8 * HTB, NXCD = 8, WGM = 8;
__host__ __device__ __forceinline__ int lds_byte(int r, int c) { const int st = (r >> 4) * 2 + (c >> 5), rr = r & 15, cc = c & 31, ob = rr * 64 + cc * 2; return st * 1024 + (ob ^ (((ob >> 9) & 1) << 5)); }
__host__ __device__ __forceinline__ void stage_rc(int b, int& R, int& C) { const int st = b / 1024, sb = b % 1024, swz = sb ^ (((sb >> 9) & 1) << 5); R = (st >> 1) * 16 + swz / 64; C = (st & 1) * 32 + (swz % 64) / 2; }
__host__ __device__ __forceinline__ int perm32(int rho) { const int n = rho >> 4, i = rho & 15; return 8 * (i >> 2) + 4 * n + (i & 3); }

struct Unit { int pm, pn, kofs; };
struct Gemm { const bf16_t* A; const bf16_t* Bt; int K; int a_rows; int ldk; };

struct StaticOrder {
    int nM, nN, nwg, G, c;
    __device__ void init(int nM_, int nN_, int G_, int c_) { nM = nM_; nN = nN_; nwg = nM * nN; G = G_; c = c_; }
    __device__ bool next(int i, Unit& u) const {
        const long L = (long)i * G + c; if (L >= nwg) return false;
        int wgid = (int)L; { const int q = nwg / NXCD, r = nwg % NXCD, xcd = wgid % NXCD, off = wgid / NXCD; wgid = (xcd < r ? xcd * (q + 1) : r * (q + 1) + (xcd - r) * q) + off; }
        const int nig = WGM * nN, gid = wgid / nig, fm = gid * WGM, gsz = (nM - fm) < WGM ? (nM - fm) : WGM;
        u.pm = fm + ((wgid % nig) % gsz); u.pn = (wgid % nig) / gsz; u.kofs = 0; return true;
    }
};
struct SplitOrder {
    int nsub, G, c, pm, ksub;
    __device__ bool next(int i, Unit& u) const { const int L = i * G + c; if (L >= nsub) return false; u.pm = pm; u.pn = L & 3; u.kofs = (L >> 2) * ksub; return true; }
};

__device__ __forceinline__ f32x2 gelu_pk(f32x2 v) {
    const f32x2 av = __builtin_elementwise_abs(v), d = av * 0.2316418882f + 1.0f;
    f32x2 t; t.x = __builtin_amdgcn_rcpf(d.x); t.y = __builtin_amdgcn_rcpf(d.y);
    f32x2 q = t * 0.5307027145f + (-0.7265760135f); q = q * t + 0.7107068705f; q = q * t + (-0.142248368f); q = q * t + 0.127414796f; q = q * t;
    const f32x2 s = (v * v) * (-0.72134752044f);
    f32x2 e; e.x = __builtin_amdgcn_exp2f(s.x); e.y = __builtin_amdgcn_exp2f(s.y);
    const f32x2 m = v * (q * e), r = v - m;
    f32x2 o; o.x = v.x < 0.f ? m.x : r.x; o.y = v.y < 0.f ? m.y : r.y; return o;
}

template <class Epi, class Sched>
__device__ __forceinline__ void gemm_phase(LAS unsigned char* lds, const Gemm g, const Sched& S, const Epi& E, int wid) {
    const int lane = lane_id_v(); const int tid = wid * 64 + lane;
    const int wr = wid >> 2, wc = wid & 3, fr = lane & 15, fq = lane >> 4;
    const int K = g.ldk, nt = g.K / BK;
    unsigned voffA[2], voffB[2];
#pragma unroll
    for (int i = 0; i < 2; ++i) { int R, C; stage_rc(tid * 16 + i * 8192, R, C); const int Rb = Epi::PERM ? ((R & ~31) + perm32(R & 31)) : R;
        voffA[i] = (unsigned)(R * K + C) * 2u; voffB[i] = (unsigned)(Rb * K + C) * 2u; }
    const size_t kstep = (size_t)(BK * 2);
    const size_t hstep = (size_t)HALF * K * 2;
    const size_t tstepB = 2 * hstep;
    const size_t tstepA = (size_t)g.a_rows * K * 2;
    const unsigned ldsw = (unsigned)wid * 1024u;
    const int aoff = lds_byte(wr * 64 + fr, fq * 8), boff = lds_byte(wc * 32 + fr, fq * 8);
#define PG8_SA(b, h) (((b) * 2 + (h)) * HTB)
#define PG8_SB(b, h) ((4 + (b) * 2 + (h)) * HTB)
#define PG8_STAGE(bufoff, gbase, voff) do { _Pragma("unroll") for (int _i = 0; _i < 2; ++_i) \
        __builtin_amdgcn_global_load_lds((const unsigned*)((const char*)(gbase) + (voff)[_i]), (LAS unsigned*)(lds + (bufoff) + ldsw + _i * 8192), 16, 0, 0); } while (0)
#define PG8_LDA(dst, b, h) do { _Pragma("unroll") for (int m = 0; m < 4; ++m) _Pragma("unroll") for (int k = 0; k < 2; ++k) dst[m][k] = *(const LAS bf16x8*)(lds + PG8_SA(b, h) + aoff + m * 2048 + k * 1024); } while (0)
#define PG8_LDB(dst, b, h) do { _Pragma("unroll") for (int n = 0; n < 2; ++n) _Pragma("unroll") for (int k = 0; k < 2; ++k) dst[n][k] = *(const LAS bf16x8*)(lds + PG8_SB(b, h) + boff + n * 2048 + k * 1024); } while (0)
#define PG8_MMA(ai, bj, At, Bt) do { __builtin_amdgcn_s_setprio(1); _Pragma("unroll") for (int m = 0; m < 4; ++m) _Pragma("unroll") for (int n = 0; n < 2; ++n) _Pragma("unroll") for (int k = 0; k < 2; ++k) \
        acc[ai][bj][m][n] = __builtin_amdgcn_mfma_f32_16x16x32_bf16(Bt[n][k], At[m][k], acc[ai][bj][m][n], 0, 0, 0); __builtin_amdgcn_s_setprio(0); } while (0)
#define PG8_WAIT_V(n) asm volatile("s_waitcnt vmcnt(" #n ")" ::: "memory")
#define PG8_WAIT_L(n) asm volatile("s_waitcnt lgkmcnt(" #n ")" ::: "memory")
#define PG8_BAR __builtin_amdgcn_s_barrier()
#define PG8_SCHED __builtin_amdgcn_sched_barrier(0)
    Unit cur, nxt; int ui = 0;
    if (!S.next(0, cur)) return;
    f32x4 acc[2][2][4][2];
#pragma unroll
    for (int a = 0; a < 2; ++a)
#pragma unroll
        for (int b = 0; b < 2; ++b)
#pragma unroll
            for (int m = 0; m < 4; ++m)
#pragma unroll
                for (int n = 0; n < 2; ++n) acc[a][b][m][n] = (f32x4){0.f, 0.f, 0.f, 0.f};
    bf16x8 At[4][2], B0[2][2], B1[2][2];
    const char* cA = (const char*)g.A + (size_t)cur.pm * tstepA + (size_t)cur.kofs * 2; const char* cB = (const char*)g.Bt + (size_t)cur.pn * tstepB + (size_t)cur.kofs * 2;
    PG8_STAGE(PG8_SB(0, 0), cB, voffB); PG8_STAGE(PG8_SB(0, 1), cB + hstep, voffB); PG8_STAGE(PG8_SA(0, 0), cA, voffA); PG8_STAGE(PG8_SA(0, 1), cA + hstep, voffA);
    if (wr == 1) PG8_BAR;
    PG8_WAIT_V(2); PG8_BAR;
    PG8_STAGE(PG8_SB(1, 0), cB + kstep, voffB); PG8_STAGE(PG8_SA(1, 0), cA + kstep, voffA); PG8_STAGE(PG8_SB(1, 1), cB + hstep + kstep, voffB);
    PG8_WAIT_V(6); PG8_BAR;
    for (;;) {
        const bool has_next = S.next(ui + 1, nxt);
        const char* nA = has_next ? (const char*)g.A + (size_t)nxt.pm * tstepA + (size_t)nxt.kofs * 2 : cA; const char* nB = has_next ? (const char*)g.Bt + (size_t)nxt.pn * tstepB + (size_t)nxt.kofs * 2 : cB;
        for (int t = 0; t < nt; t += 2) {
            const bool last = (t == nt - 2);
            const char* a1 = cA + (size_t)(t + 1) * kstep;
            const char* a2 = last ? nA : cA + (size_t)(t + 2) * kstep; const char* b2 = last ? nB : cB + (size_t)(t + 2) * kstep;
            const char* a3 = a2 + kstep; const char* b3 = b2 + kstep;
            PG8_LDB(B0, 0, 0); PG8_LDB(B1, 0, 1); PG8_SCHED; PG8_LDA(At, 0, 0); PG8_STAGE(PG8_SA(1, 1), a1 + hstep, voffA);
            PG8_WAIT_V(8); PG8_WAIT_L(0); PG8_BAR; PG8_MMA(0, 0, At, B0); PG8_MMA(0, 1, At, B1); PG8_BAR; PG8_SCHED;
            PG8_LDA(At, 0, 1); PG8_STAGE(PG8_SB(0, 0), b2, voffB); PG8_STAGE(PG8_SB(0, 1), b2 + hstep, voffB); PG8_STAGE(PG8_SA(0, 0), a2, voffA);
            PG8_WAIT_V(8); PG8_WAIT_L(0); PG8_BAR; PG8_MMA(1, 0, At, B0); PG8_MMA(1, 1, At, B1); PG8_BAR; PG8_SCHED;
            PG8_LDB(B0, 1, 0); PG8_LDB(B1, 1, 1); PG8_SCHED; PG8_LDA(At, 1, 0); PG8_STAGE(PG8_SA(0, 1), a2 + hstep, voffA);
            PG8_WAIT_V(8); PG8_WAIT_L(0); PG8_BAR; PG8_MMA(0, 0, At, B0); PG8_MMA(0, 1, At, B1); PG8_BAR; PG8_SCHED;
            PG8_LDA(At, 1, 1); PG8_STAGE(PG8_SB(1, 0), b3, voffB); PG8_STAGE(PG8_SB(1, 1), b3 + hstep, voffB); PG8_STAGE(PG8_SA(1, 0), a3, voffA);
            PG8_WAIT_V(8); PG8_WAIT_L(0); PG8_BAR; PG8_MMA(1, 0, At, B0); PG8_MMA(1, 1, At, B1); PG8_BAR; PG8_SCHED;
        }
        if (wr == 0) PG8_BAR;
        E(acc, cur, wr, wc, fr, fq);
        if (!has_next) break;
#pragma unroll
        for (int a = 0; a < 2; ++a)
#pragma unroll
            for (int b = 0; b < 2; ++b)
#pragma unroll
                for (int m = 0; m < 4; ++m)
#pragma unroll
                    for (int n = 0; n < 2; ++n) acc[a][b][m][n] = (f32x4){0.f, 0.f, 0.f, 0.f};
        cur = nxt; cA = nA; cB = nB; ++ui;
        if (wr == 1) PG8_BAR;
    }
    PG8_WAIT_V(0);
    PG8_BAR;
#undef PG8_SA
#undef PG8_SB
#undef PG8_STAGE
#undef PG8_LDA
#undef PG8_LDB
#undef PG8_MMA
#undef PG8_WAIT_V
#undef PG8_WAIT_L
#undef PG8_BAR
#undef PG8_SCHED
}
}

struct EpiInProj {
    static constexpr bool PERM = true;
    bf16_t *QA, *KA, *VA, *QB, *KB, *VB, *RB; float* LF; float* out; const float* b_a;
    __device__ __forceinline__ void operator()(const f32x4 (&acc)[2][2][4][2], const pg8::Unit& u, int wr, int wc, int fr, int fq) const {
        const int pn = u.pn;
        const int row0 = u.pm * 256 + wr * 64 + fr;
        const int cl = wc * 32 + 8 * fq;
        if (pn == 12) {
#pragma unroll
            for (int bj = 0; bj < 2; ++bj) {
                const f32x4 b0 = *(const f32x4*)(b_a + cl + bj * 128), b1 = *(const f32x4*)(b_a + cl + bj * 128 + 4);
#pragma unroll
                for (int ai = 0; ai < 2; ++ai)
#pragma unroll
                    for (int m = 0; m < 4; ++m) {
                        f32x4 v0 = acc[ai][bj][m][0] + b0, v1 = acc[ai][bj][m][1] + b1;
#pragma unroll
                        for (int e = 0; e < 4; ++e) { float z = v0[e]; v0[e] = (fminf(z, 0.f) - log1pf(__expf(-fabsf(z)))) * 0.0625f; z = v1[e]; v1[e] = (fminf(z, 0.f) - log1pf(__expf(-fabsf(z)))) * 0.0625f; }
                        float* p = LF + (size_t)(row0 + ai * 128 + m * 16) * 256 + cl + bj * 128;
                        *(f32x4*)p = v0; *(f32x4*)(p + 4) = v1;
                    }
            }
            return;
        }
        bf16_t* base; int ld, cb; float sc = 1.f; float* fo = nullptr;
        if (pn < 2) { base = QA; ld = 512; cb = pn * 256; sc = QSCALE; }
        else if (pn < 4) { base = KA; ld = 512; cb = (pn - 2) * 256; fo = out + (u.pm < 128 ? O_KP : O_KS - (size_t)MP * 512); }
        else if (pn < 6) { base = VA; ld = 512; cb = (pn - 4) * 256; fo = out + (u.pm < 128 ? O_VP : O_VS - (size_t)MP * 512); }
        else if (pn == 6) { base = QB; ld = 256; cb = 0; }
        else if (pn == 7) { base = KB; ld = 256; cb = 0; }
        else if (pn < 10) { base = VB; ld = 512; cb = (pn - 8) * 256; }
        else { base = RB; ld = 512; cb = (pn - 10) * 256; }
#pragma unroll
        for (int ai = 0; ai < 2; ++ai)
#pragma unroll
            for (int m = 0; m < 4; ++m) {
                const size_t r = (size_t)(row0 + ai * 128 + m * 16);
#pragma unroll
                for (int bj = 0; bj < 2; ++bj) {
                    const f32x4 a0 = acc[ai][bj][m][0], a1 = acc[ai][bj][m][1];
                    const f32x4 v0 = a0 * sc, v1 = a1 * sc;
                    u32x4 w; w.x = cvt_pk_bf16(v0[0], v0[1]); w.y = cvt_pk_bf16(v0[2], v0[3]); w.z = cvt_pk_bf16(v1[0], v1[1]); w.w = cvt_pk_bf16(v1[2], v1[3]);
                    *(u32x4*)(base + r * ld + cb + cl + bj * 128) = w;
                    if (fo) { float* p = fo + r * 512 + cb + cl + bj * 128; *(f32x4*)p = a0; *(f32x4*)(p + 4) = a1; }
                }
            }
    }
};


struct EpiRowOut {
    static constexpr bool PERM = true;
    bf16_t* O; float* SSQ;
    __device__ __forceinline__ void operator()(const f32x4 (&acc)[2][2][4][2], const pg8::Unit& u, int wr, int wc, int fr, int fq) const {
        const int row0 = u.pm * 256 + wr * 64 + fr; const int cl = u.pn * 256 + wc * 32 + 8 * fq;
#pragma unroll
        for (int ai = 0; ai < 2; ++ai)
#pragma unroll
            for (int m = 0; m < 4; ++m) {
                const size_t r = (size_t)(row0 + ai * 128 + m * 16); float s = 0.f;
#pragma unroll
                for (int bj = 0; bj < 2; ++bj) {
                    const f32x4 v0 = acc[ai][bj][m][0], v1 = acc[ai][bj][m][1];
                    s += (v0[0] * v0[0] + v0[1] * v0[1]) + (v0[2] * v0[2] + v0[3] * v0[3]) + (v1[0] * v1[0] + v1[1] * v1[1]) + (v1[2] * v1[2] + v1[3] * v1[3]);
                    u32x4 w; w.x = cvt_pk_bf16(v0[0], v0[1]); w.y = cvt_pk_bf16(v0[2], v0[3]); w.z = cvt_pk_bf16(v1[0], v1[1]); w.w = cvt_pk_bf16(v1[2], v1[3]);
                    *(u32x4*)(O + r * 1024 + cl + bj * 128) = w;
                }
                s += __shfl_xor(s, 16); s += __shfl_xor(s, 32);
                if (fq == 0) SSQ[r * 16 + u.pn * 4 + wc] = s;
            }
    }
};

struct EpiSlice {
    static constexpr bool PERM = false;
    float* SL; int ksub;
    __device__ __forceinline__ void operator()(const f32x4 (&acc)[2][2][4][2], const pg8::Unit& u, int wr, int wc, int fr, int fq) const {
        float* base = SL + (size_t)(u.kofs / ksub) * (256 * 1024) + (unsigned)((wr * 64 + fr) * 1024 + u.pn * 256 + wc * 32 + 4 * fq);
#pragma unroll
        for (int ai = 0; ai < 2; ++ai)
#pragma unroll
            for (int m = 0; m < 4; ++m) { float* rowp = base + (ai * 128 + m * 16) * 1024;
#pragma unroll
                for (int bj = 0; bj < 2; ++bj)
#pragma unroll
                    for (int n = 0; n < 2; ++n) *(f32x4*)(rowp + bj * 128 + n * 16) = acc[ai][bj][m][n]; }
    }
};

__device__ __forceinline__ float dpp_ror1(float v) { return __int_as_float(__builtin_amdgcn_update_dpp(0, __float_as_int(v), 0x121, 0xf, 0xf, false)); }
__device__ __forceinline__ float dpp_ror2(float v) { return __int_as_float(__builtin_amdgcn_update_dpp(0, __float_as_int(v), 0x122, 0xf, 0xf, false)); }

constexpr int CONVX_OFF = 131072;
struct EpiUp {
    static constexpr bool PERM = true;
    bf16_t* H; float* out; const float* conv_w; const float* conv_b; const float* cbuf; LAS unsigned char* lds;
    __device__ __forceinline__ void operator()(const f32x4 (&acc)[2][2][4][2], const pg8::Unit& u, int wr, int wc, int fr, int fq) const {
        LAS float* X = (LAS float*)(lds + CONVX_OFF);
        const int cg_ = wc * 32 + 8 * fq;
        const int col = u.pn * 128 + cg_;
        if (fr >= 14) {
#pragma unroll
            for (int ai = 0; ai < 2; ++ai) { LAS float* p = X + ((ai * 2 + wr) * 2 + (fr - 14)) * 128 + cg_; *(LAS f32x4*)p = acc[ai][0][3][0]; *(LAS f32x4*)(p + 4) = acc[ai][0][3][1]; }
        }
        f32x4 w0[2], w1[2], w2[2], cb[2];
#pragma unroll
        for (int n = 0; n < 2; ++n) { w0[n] = *(const f32x4*)(conv_w + col + 4 * n); w1[n] = *(const f32x4*)(conv_w + DFF + col + 4 * n); w2[n] = *(const f32x4*)(conv_w + 2 * DFF + col + 4 * n); cb[n] = *(const f32x4*)(conv_b + col + 4 * n); }
        asm volatile("s_waitcnt lgkmcnt(0)" ::: "memory"); __builtin_amdgcn_s_barrier(); asm volatile("" ::: "memory");
#pragma unroll
        for (int ai = 0; ai < 2; ++ai) {
            const int pai = (wr == 1) ? ai : ai - 1, pwr = wr ^ 1;
            f32x4 pr1[2], pr2[2];
#pragma unroll
            for (int n = 0; n < 2; ++n) {
                if (pai >= 0) { pr1[n] = *(const LAS f32x4*)(X + ((pai * 2 + pwr) * 2 + 1) * 128 + cg_ + 4 * n); pr2[n] = *(const LAS f32x4*)(X + ((pai * 2 + pwr) * 2 + (fr & 1)) * 128 + cg_ + 4 * n); }
                else { pr1[n] = (f32x4){0.f, 0.f, 0.f, 0.f}; pr2[n] = pr1[n]; }
            }
#pragma unroll
            for (int m = 0; m < 4; ++m) {
                const int lr = ai * 128 + wr * 64 + m * 16 + fr; const int gr = u.pm * 254 - 2 + lr;
                const bool store = (lr >= 2) && (gr < MT);
                int pos, bidx; const bool samp = gr >= MP;
                if (!samp) { pos = gr & (SEQ - 1); bidx = gr >> 11; } else { pos = (gr - MP) & 7; bidx = (gr - MP) >> 3; }
                const bool head_rows = __builtin_amdgcn_ballot_w64(pos < 2) != 0ull;
                const bool tail_rows = __builtin_amdgcn_ballot_w64(store && (samp ? pos >= 6 : pos >= SEQ - 2)) != 0ull;
                u32x4 hw;
#pragma unroll
                for (int n = 0; n < 2; ++n) {
                    const f32x4 g0 = acc[ai][0][m][n], uu = acc[ai][1][m][n]; f32x4 gm1, gm2, nr1, nr2;
#pragma unroll
                    for (int e = 0; e < 4; ++e) {
                        gm1[e] = __int_as_float(__builtin_amdgcn_update_dpp(__float_as_int(pr1[n][e]), __float_as_int(g0[e]), 0x111, 0xf, 0xf, false));
                        gm2[e] = __int_as_float(__builtin_amdgcn_update_dpp(__float_as_int(pr2[n][e]), __float_as_int(g0[e]), 0x112, 0xf, 0xf, false));
                        nr1[e] = dpp_ror1(g0[e]); nr2[e] = dpp_ror2(g0[e]);
                    }
                    pr1[n] = nr1; pr2[n] = nr2;
                    if (head_rows) {
                        if (!samp) { if (pos == 0) { gm1 = (f32x4){0.f, 0.f, 0.f, 0.f}; gm2 = gm1; } else if (pos == 1) gm2 = (f32x4){0.f, 0.f, 0.f, 0.f}; }
                        else if (store) { if (pos == 0) { gm1 = *(const f32x4*)(cbuf + (size_t)(bidx * 2 + 1) * DFF + col + 4 * n); gm2 = *(const f32x4*)(cbuf + (size_t)(bidx * 2) * DFF + col + 4 * n); }
                                          else if (pos == 1) gm2 = *(const f32x4*)(cbuf + (size_t)(bidx * 2 + 1) * DFF + col + 4 * n); }
                    }
                    const f32x4 c = cb[n] + w0[n] * gm2 + w1[n] * gm1 + w2[n] * g0;
                    const f32x2 ga = pg8::gelu_pk((f32x2){c[0], c[1]}), gb = pg8::gelu_pk((f32x2){c[2], c[3]});
                    const float h0 = ga.x * uu[0], h1 = ga.y * uu[1], h2 = gb.x * uu[2], h3 = gb.y * uu[3];
                    if (n == 0) { hw.x = cvt_pk_bf16(h0, h1); hw.y = cvt_pk_bf16(h2, h3); } else { hw.z = cvt_pk_bf16(h0, h1); hw.w = cvt_pk_bf16(h2, h3); }
                    if (tail_rows && store) {
                        if (!samp) { if (pos >= SEQ - 2) *(f32x4*)(out + O_CP + (size_t)(bidx * 2 + (pos - (SEQ - 2))) * DFF + col + 4 * n) = g0; }
                        else { if (pos >= 6) *(f32x4*)(out + O_CS + (size_t)(bidx * 2 + (pos - 6)) * DFF + col + 4 * n) = g0; }
                    }
                }
                if (store) *(u32x4*)(H + (size_t)gr * DFF + col) = hw;
            }
        }
    }
};

__device__ __forceinline__ unsigned pk2(float lo, float hi) { return cvt_pk_bf16(lo, hi); }
__device__ __forceinline__ void p0_transpose_item(const float* W, int ldw, int scol0, int k0, bf16_t* WT, int dK, int drow0, LAS float* scr, int lane) {
#pragma unroll 8
    for (int i = 0; i < 32; ++i) { const int kk = 2 * i + (lane >> 5); scr[kk * 33 + (lane & 31)] = W[(size_t)(k0 + kk) * ldw + scol0 + (lane & 31)]; }
    asm volatile("s_waitcnt lgkmcnt(0)" ::: "memory");
    const int c = lane & 7;
#pragma unroll
    for (int j = 0; j < 4; ++j) { const int n = (lane >> 3) + 8 * j; const LAS float* s = scr + (8 * c) * 33 + n;
        u32x4 o; o.x = pk2(s[0 * 33], s[1 * 33]); o.y = pk2(s[2 * 33], s[3 * 33]); o.z = pk2(s[4 * 33], s[5 * 33]); o.w = pk2(s[6 * 33], s[7 * 33]);
        *(u32x4*)(WT + (size_t)(drow0 + n) * dK + k0 + 8 * c) = o; }
    asm volatile("s_waitcnt lgkmcnt(0)" ::: "memory");
}
__device__ __forceinline__ void p0_gate_item(const float* w_in, const float* w_a2, int k0, int n0, bf16_t* WT, LAS float* scr, int lane) {
    float w2[16];
#pragma unroll
    for (int r = 0; r < 16; ++r) w2[r] = w_a2[r * 256 + n0 + (lane & 31)];
    for (int i = 0; i < 32; ++i) { const int kk = 2 * i + (lane >> 5); const float* a = w_in + (size_t)(k0 + kk) * DIN + 3072; float s = 0.f;
#pragma unroll
        for (int r = 0; r < 16; ++r) s += a[r] * w2[r];
        scr[kk * 33 + (lane & 31)] = s; }
    asm volatile("s_waitcnt lgkmcnt(0)" ::: "memory");
    const int c = lane & 7;
#pragma unroll
    for (int j = 0; j < 4; ++j) { const int n = (lane >> 3) + 8 * j; const LAS float* s = scr + (8 * c) * 33 + n;
        u32x4 o; o.x = pk2(s[0 * 33], s[1 * 33]); o.y = pk2(s[2 * 33], s[3 * 33]); o.z = pk2(s[4 * 33], s[5 * 33]); o.w = pk2(s[6 * 33], s[7 * 33]);
        *(u32x4*)(WT + (size_t)(3072 + n0 + n) * 1024 + k0 + 8 * c) = o; }
    asm volatile("s_waitcnt lgkmcnt(0)" ::: "memory");
}
__device__ __forceinline__ void rms_row_to_bf16(const float* xrow, const float* g, bf16_t* orow, int lane) {
    const f32x4* xr = (const f32x4*)xrow + lane; const f32x4* gr = (const f32x4*)g + lane;
    f32x4 v[4]; float s = 0.f;
#pragma unroll
    for (int j = 0; j < 4; ++j) { v[j] = xr[64 * j]; s += (v[j].x * v[j].x + v[j].y * v[j].y) + (v[j].z * v[j].z + v[j].w * v[j].w); }
    const float rs = rsqrtf(wave_sum(s) * (1.f / DM) + EPS);
    u32x2* o8 = (u32x2*)orow + lane;
#pragma unroll
    for (int j = 0; j < 4; ++j) { const f32x4 gg = gr[64 * j]; const f32x4 y = v[j] * rs * gg; u32x2 w; w.x = pk2(y.x, y.y); w.y = pk2(y.z, y.w); o8[64 * j] = w; }
}


__device__ __forceinline__ int crow(int r, int hi) { return (r & 3) + 8 * (r >> 2) + 4 * hi; }
typedef short v4i16_t __attribute__((ext_vector_type(4)));
__device__ __forceinline__ s16x4 vtr(const LAS unsigned char* p) { return __builtin_bit_cast(s16x4, __builtin_amdgcn_ds_read_tr16_b64_v4i16((LAS v4i16_t*)p)); }
__device__ __forceinline__ float swapmax(float v) { auto rr = __builtin_amdgcn_permlane32_swap(__float_as_uint(v), __float_as_uint(v), false, false); return fmaxf(__uint_as_float(rr[0]), __uint_as_float(rr[1])); }
__device__ __forceinline__ float swapsum(float v) { auto rr = __builtin_amdgcn_permlane32_swap(__float_as_uint(v), __float_as_uint(v), false, false); return __uint_as_float(rr[0]) + __uint_as_float(rr[1]); }
__device__ __forceinline__ u32x4 pack8(f32x4 a, f32x4 b) { u32x4 w; w.x = cvt_pk_bf16(a.x, a.y); w.y = cvt_pk_bf16(a.z, a.w); w.z = cvt_pk_bf16(b.x, b.y); w.w = cvt_pk_bf16(b.z, b.w); return w; }

constexpr float NEGF = -1e30f;
constexpr int VPITCH = 192;
constexpr int ATT_WLDS = 32 * VPITCH + 256;

struct AttnCtx { const bf16_t *QA, *KA, *VA; bf16_t* MIX; const float *ck, *cv; };

struct TileRegs { u32x4 k[8]; u32x4 v[8]; };

template <bool SAMPLE> __device__ __forceinline__ int tile_key(int ti, int j, int g, int r4, int ncls) {
    if (SAMPLE) { if (ti < 17) return 1536 + 32 * (16 - ti) + j; const int kk = ti - 17; return 16 * (4 * kk + (j >> 3)) + (j & 7); }
    if (ti < ncls) return 4 * (32 * (g - ti) + j) + r4;
    const int jj = ti - ncls + (g == 0 ? 4 : 0); return 128 * g - 128 + 32 * jj + j;
}
template <bool SAMPLE> __device__ __forceinline__ void tile_load(const AttnCtx& C, TileRegs& T, int ti, int b, int h, int g, int r4, int ncls, int lane) {
    const int r32 = lane & 31, hi = lane >> 5;
    if (SAMPLE && ti > 0) {
        { const int idx = tile_key<SAMPLE>(ti, r32, g, r4, ncls); const float* p = C.ck + (((unsigned)(b * WINB + idx) * 8u + h) * 64u + 8 * hi);
#pragma unroll
          for (int d0 = 0; d0 < 4; ++d0) { T.k[2 * d0] = *(const GAS u32x4*)(p + 16 * d0); T.k[2 * d0 + 1] = *(const GAS u32x4*)(p + 16 * d0 + 4); } }
#pragma unroll
        for (int i = 0; i < 4; ++i) { const int key = (lane >> 3) + 8 * i; const int idx = tile_key<SAMPLE>(ti, key, g, r4, ncls);
            const float* p = C.cv + (((unsigned)(b * WINB + idx) * 8u + h) * 64u + 8 * (lane & 7)); T.v[2 * i] = *(const GAS u32x4*)p; T.v[2 * i + 1] = *(const GAS u32x4*)(p + 4); }
    } else {
        unsigned rowb;
        { int key = tile_key<SAMPLE>(ti, r32, g, r4, ncls); if (SAMPLE) { key -= WINB; key = key > 7 ? 7 : key; rowb = (unsigned)(MP + b * 8 + key); } else rowb = (unsigned)(b * SEQ + key);
          const bf16_t* p = C.KA + (rowb * 512u + h * 64 + 8 * hi);
#pragma unroll
          for (int d0 = 0; d0 < 4; ++d0) T.k[d0] = *(const GAS u32x4*)(p + 16 * d0); }
#pragma unroll
        for (int i = 0; i < 4; ++i) { int key = tile_key<SAMPLE>(ti, (lane >> 3) + 8 * i, g, r4, ncls); if (SAMPLE) { key -= WINB; key = key > 7 ? 7 : key; rowb = (unsigned)(MP + b * 8 + key); } else rowb = (unsigned)(b * SEQ + key);
            T.v[i] = *(const GAS u32x4*)(C.VA + (rowb * 512u + h * 64 + 8 * (lane & 7))); }
    }
}

template <bool SAMPLE>
__device__ __forceinline__ void attn_item(const AttnCtx& C, int b, int h, int g, int r4, LAS unsigned char* wl, int lane_in) {
    int lane = lane_in; asm volatile("" : "+v"(lane));
    const int r32 = lane & 31, hi = lane >> 5;
    LAS float* wsf = (LAS float*)(wl + 32 * VPITCH);
    const int ncls = g + 1;
    const int nt = SAMPLE ? 41 : (ncls + (g == 0 ? 4 : 8));
    bf16x8 qf[4];
    {
        unsigned qrow; if (SAMPLE) qrow = (unsigned)(MP + b * 8 + (r32 & 7)); else qrow = (unsigned)(b * SEQ + 4 * (32 * g + r32) + r4);
        const bf16_t* p = C.QA + (qrow * 512u + h * 64 + 8 * hi);
#pragma unroll
        for (int d0 = 0; d0 < 4; ++d0) qf[d0] = *(const bf16x8*)(p + 16 * d0);
    }
    float mrun = NEGF, lrun = 0.f;
    f32x16 o0 = {}, o1 = {};
    TileRegs T;
    tile_load<SAMPLE>(C, T, 0, b, h, g, r4, ncls, lane);
    const int vrd = (4 * hi + ((lane & 15) >> 2)) * VPITCH + (((lane >> 4) & 1) * 16 + (lane & 3) * 4) * 2;
    for (int ti = 0; ti < nt; ++ti) {
        bf16x8 kf[4];
        const bool f32path = SAMPLE && ti > 0;
        if (f32path) {
#pragma unroll
            for (int d0 = 0; d0 < 4; ++d0) kf[d0] = __builtin_bit_cast(bf16x8, pack8(__builtin_bit_cast(f32x4, T.k[2 * d0]), __builtin_bit_cast(f32x4, T.k[2 * d0 + 1])));
#pragma unroll
            for (int i = 0; i < 4; ++i) *(LAS u32x4*)(wl + ((lane >> 3) + 8 * i) * VPITCH + (lane & 7) * 16) = pack8(__builtin_bit_cast(f32x4, T.v[2 * i]), __builtin_bit_cast(f32x4, T.v[2 * i + 1]));
        } else {
#pragma unroll
            for (int d0 = 0; d0 < 4; ++d0) kf[d0] = __builtin_bit_cast(bf16x8, T.k[d0]);
#pragma unroll
            for (int i = 0; i < 4; ++i) *(LAS u32x4*)(wl + ((lane >> 3) + 8 * i) * VPITCH + (lane & 7) * 16) = T.v[i];
        }
        if (ti + 1 < nt) tile_load<SAMPLE>(C, T, ti + 1, b, h, g, r4, ncls, lane);
        f32x16 p = {};
#pragma unroll
        for (int d0 = 0; d0 < 4; ++d0) p = __builtin_amdgcn_mfma_f32_32x32x16_bf16(kf[d0], qf[d0], p, 0, 0, 0);
        if (SAMPLE) {
            if (ti < 17) { const int dbase = (WINB + r32) - (1536 + 32 * (16 - ti));
#pragma unroll
                for (int r = 0; r < 16; ++r) { const int d = dbase - crow(r, hi); const int mult = (d >= 0 && d <= 128) + (d >= 0 && d <= 512 && !(d & 3)) + (d >= 0 && !(d & 15));
                    p[r] = (mult == 0 || r32 >= 8) ? NEGF : p[r] + (mult == 1 ? 0.f : (mult == 2 ? 1.f : 1.5849625f)); } }
            else {
#pragma unroll
                for (int r = 0; r < 16; ++r) p[r] = ((crow(r, hi) & 7) == r32) ? p[r] : NEGF; }
        } else {
            if (ti < ncls) { const int dbase = (32 * g + r32) - 32 * (g - ti);
#pragma unroll
                for (int r = 0; r < 16; ++r) { const int d = dbase - crow(r, hi); const int mult = (d >= 0 && d <= 128) + (d >= 0 && !(d & 3));
                    p[r] = mult == 0 ? NEGF : p[r] + (mult == 2 ? 1.f : 0.f); } }
            else { const int jj = ti - ncls + (g == 0 ? 4 : 0); const int dbase = (128 * g + 4 * r32 + r4) - (128 * g - 128 + 32 * jj);
#pragma unroll
                for (int r = 0; r < 16; ++r) { const int d = dbase - crow(r, hi); p[r] = (d >= 0 && d <= 128) ? p[r] : NEGF; } }
        }
        float rm = p[0];
#pragma unroll
        for (int r = 1; r < 16; ++r) rm = fmaxf(rm, p[r]);
        rm = swapmax(rm);
        const float mnew = fmaxf(mrun, rm);
        const float f = __builtin_amdgcn_exp2f(mrun - mnew);
        mrun = mnew;
        float ls = 0.f;
#pragma unroll
        for (int r = 0; r < 16; ++r) { p[r] = __builtin_amdgcn_exp2f(p[r] - mnew); ls += p[r]; }
        lrun = lrun * f + ls;
        if (hi == 0) wsf[r32] = f;
        u32x4 pa0, pa1;
        pa0.x = cvt_pk_bf16(p[0], p[1]); pa0.y = cvt_pk_bf16(p[2], p[3]); pa0.z = cvt_pk_bf16(p[4], p[5]); pa0.w = cvt_pk_bf16(p[6], p[7]);
        pa1.x = cvt_pk_bf16(p[8], p[9]); pa1.y = cvt_pk_bf16(p[10], p[11]); pa1.z = cvt_pk_bf16(p[12], p[13]); pa1.w = cvt_pk_bf16(p[14], p[15]);
#pragma unroll
        for (int r = 0; r < 16; ++r) { const float fr_ = wsf[crow(r, hi)]; o0[r] *= fr_; o1[r] *= fr_; }
#pragma unroll
        for (int sl = 0; sl < 2; ++sl) {
            const bf16x8 pa = __builtin_bit_cast(bf16x8, sl == 0 ? pa0 : pa1);
#pragma unroll
            for (int c = 0; c < 2; ++c) {
                const s16x4 lo = vtr(wl + vrd + (16 * sl) * VPITCH + 64 * c), hi4 = vtr(wl + vrd + (16 * sl + 8) * VPITCH + 64 * c);
                const bf16x8 vf = (bf16x8){lo[0], lo[1], lo[2], lo[3], hi4[0], hi4[1], hi4[2], hi4[3]};
                if (c == 0) o0 = __builtin_amdgcn_mfma_f32_32x32x16_bf16(pa, vf, o0, 0, 0, 0); else o1 = __builtin_amdgcn_mfma_f32_32x32x16_bf16(pa, vf, o1, 0, 0, 0);
            }
        }
    }
    const float lt = swapsum(lrun);
    if (hi == 0) wsf[32 + r32] = 1.f / lt;
#pragma unroll
    for (int r = 0; r < 16; ++r) {
        const int q = crow(r, hi); const float rl = wsf[32 + q];
        unsigned orow; bool ok = true;
        if (SAMPLE) { ok = q < 8; orow = (unsigned)(MP + b * 8 + (q & 7)); } else orow = (unsigned)(b * SEQ + 4 * (32 * g + q) + r4);
        if (ok) { bf16_t* op = C.MIX + (orow * 1024u + h * 64 + r32);
            op[0] = (bf16_t)(cvt_pk_bf16(o0[r] * rl, 0.f) & 0xffffu); op[32] = (bf16_t)(cvt_pk_bf16(o1[r] * rl, 0.f) & 0xffffu); }
    }
}

struct GlaCtx { const bf16_t *QB, *KB, *VB, *RB; const float* LF; bf16_t* MIX; const float* gnorm; };
constexpr int GQ_P = 72, GT_P = 40;
constexpr int G_QE = 0, G_KE = 32 * GQ_P * 2, G_KT = G_KE + 32 * GQ_P * 2, G_EB = G_KT + 64 * GT_P * 2, G_BUF = G_EB + 256;
constexpr int GL_V = 2 * G_BUF;
constexpr int GL_O = GL_V + 2 * 4 * 2048;
constexpr int GL_END = GL_O + 2 * 4 * 4608;
static_assert(GL_END <= 131072, "gla lds");
#define LDS_BARRIER() do { asm volatile("s_waitcnt lgkmcnt(0)" ::: "memory"); __builtin_amdgcn_s_barrier(); asm volatile("" ::: "memory"); } while (0)
typedef float f32x8 __attribute__((ext_vector_type(8)));
typedef unsigned u32x8 __attribute__((ext_vector_type(8)));
typedef unsigned u32x16 __attribute__((ext_vector_type(16)));
struct GlaPre { f32x8 lf; u32x8 q, k; u32x4 v0, v1; };

template <int nvalid> __device__ __forceinline__ void gla_h_loads(const GlaCtx& C, GlaPre& P, unsigned t0, int h, int dk, int tg, int dvs, int lane) {
    const bool ok = 8 * tg < nvalid;
    const unsigned off = (t0 + (ok ? 8 * tg : 0)) * 256u + h * 64 + dk;
    const GAS float* lp = (const GAS float*)(C.LF + off); const GAS bf16_t* qp = (const GAS bf16_t*)(C.QB + off); const GAS bf16_t* kp = (const GAS bf16_t*)(C.KB + off);
#pragma unroll
    for (int e = 0; e < 8; ++e) { P.lf[e] = lp[e * 256]; P.q[e] = (unsigned)qp[e * 256]; P.k[e] = (unsigned)kp[e * 256]; }
    const int i = lane >> 1; const bool okv = i < nvalid; const GAS bf16_t* p = (const GAS bf16_t*)(C.VB + ((t0 + (okv ? i : 0)) * 512u + h * 128 + 32 * dvs + 16 * (lane & 1)));
    P.v0 = *(const GAS u32x4*)p; P.v1 = *(const GAS u32x4*)(p + 8);
}
struct GlaGate { u32x4 g0, g1; };
template <int nvalid> __device__ __forceinline__ void gla_h_interval(const GlaCtx& C, LAS unsigned char* lds, GlaPre& P, GlaGate& G, const f32x4 (&gn)[4], int j, int nchunk, int hw, int lane, unsigned row0, int h) {
    const int tg = lane >> 4, dkl = lane & 15, dk = 16 * hw + dkl;
    const int ft = lane >> 3, dvg = lane & 7;
    const bool fin_ok = 8 * hw < nvalid;
    if (j >= 2 && fin_ok) {
        const int c = j - 2; const int ob = c & 1;
        const LAS float* op = (const LAS float*)(lds + GL_O + (ob * 4 + (dvg >> 1)) * 4608) + (8 * hw + ft) * 36 + 16 * (dvg & 1);
        f32x4 o[4]; float s = 0.f;
#pragma unroll
        for (int k4 = 0; k4 < 4; ++k4) { o[k4] = *(const LAS f32x4*)(op + 4 * k4); s += (o[k4].x * o[k4].x + o[k4].y * o[k4].y) + (o[k4].z * o[k4].z + o[k4].w * o[k4].w); }
        s += __shfl_xor(s, 1); s += __shfl_xor(s, 2); s += __shfl_xor(s, 4);
        const float rs = rsqrtf(s * (1.f / 128.f) + EPS);
        const u32x4 g0 = G.g0, g1 = G.g1;
        float gt[16];
        gt[0] = __uint_as_float(g0.x << 16); gt[1] = __uint_as_float(g0.x & 0xffff0000u); gt[2] = __uint_as_float(g0.y << 16); gt[3] = __uint_as_float(g0.y & 0xffff0000u);
        gt[4] = __uint_as_float(g0.z << 16); gt[5] = __uint_as_float(g0.z & 0xffff0000u); gt[6] = __uint_as_float(g0.w << 16); gt[7] = __uint_as_float(g0.w & 0xffff0000u);
        gt[8] = __uint_as_float(g1.x << 16); gt[9] = __uint_as_float(g1.x & 0xffff0000u); gt[10] = __uint_as_float(g1.y << 16); gt[11] = __uint_as_float(g1.y & 0xffff0000u);
        gt[12] = __uint_as_float(g1.z << 16); gt[13] = __uint_as_float(g1.z & 0xffff0000u); gt[14] = __uint_as_float(g1.w << 16); gt[15] = __uint_as_float(g1.w & 0xffff0000u);
        float val[16];
#pragma unroll
        for (int k = 0; k < 16; ++k) { const float rg = gt[k]; val[k] = o[k >> 2][k & 3] * rs * gn[k >> 2][k & 3] * rg * __builtin_amdgcn_rcpf(1.f + __expf(-rg)); }
        u32x4 w0, w1;
        w0.x = cvt_pk_bf16(val[0], val[1]); w0.y = cvt_pk_bf16(val[2], val[3]); w0.z = cvt_pk_bf16(val[4], val[5]); w0.w = cvt_pk_bf16(val[6], val[7]);
        w1.x = cvt_pk_bf16(val[8], val[9]); w1.y = cvt_pk_bf16(val[10], val[11]); w1.z = cvt_pk_bf16(val[12], val[13]); w1.w = cvt_pk_bf16(val[14], val[15]);
        bf16_t* mp = C.MIX + ((row0 + 32u * c + 8 * hw + ft) * 1024u + 512 + h * 128 + 16 * dvg);
        *(GAS u32x4*)mp = w0; *(GAS u32x4*)(mp + 8) = w1;
    }
    if (j < nchunk) {
        const int buf = j & 1;
        LAS unsigned char* sh = lds + buf * G_BUF;
        LAS bf16_t* qe_l = (LAS bf16_t*)(sh + G_QE); LAS bf16_t* ke_l = (LAS bf16_t*)(sh + G_KE); LAS bf16_t* kt_l = (LAS bf16_t*)(sh + G_KT); LAS float* eb_l = (LAS float*)(sh + G_EB);
        LAS unsigned char* vl = lds + GL_V + (buf * 4 + hw) * 2048;
        const bool okp = 8 * tg < nvalid, okv = (lane >> 1) < nvalid;
        if (!okp) { P.lf = (f32x8){0.f, 0.f, 0.f, 0.f, 0.f, 0.f, 0.f, 0.f}; P.q = (u32x8){0u, 0u, 0u, 0u, 0u, 0u, 0u, 0u}; P.k = P.q; }
        if (!okv) { P.v0 = (u32x4){0u, 0u, 0u, 0u}; P.v1 = P.v0; }
        f32x8 cs; float run = 0.f;
#pragma unroll
        for (int e = 0; e < 8; ++e) { run += P.lf[e]; cs[e] = run; }
        float offs = 0.f, tot = 0.f;
#pragma unroll
        for (int t = 0; t < 4; ++t) { const float Tt = __shfl(run, dkl + 16 * t); tot += Tt; offs += (t < tg) ? Tt : 0.f; }
        u32x8 kb;
#pragma unroll
        for (int e = 0; e < 8; ++e) { const float bb = offs + cs[e]; const float eb = __expf(bb), ei = __expf(-bb); const int i = 8 * tg + e;
            qe_l[i * GQ_P + dk] = (bf16_t)(cvt_pk_bf16(__uint_as_float(P.q[e] << 16) * 0.125f * eb, 0.f) & 0xffffu);
            kb[e] = cvt_pk_bf16(__uint_as_float(P.k[e] << 16) * ei, 0.f) & 0xffffu;
            ke_l[i * GQ_P + dk] = (bf16_t)kb[e]; }
        u32x4 w; w.x = kb[0] | (kb[1] << 16); w.y = kb[2] | (kb[3] << 16); w.z = kb[4] | (kb[5] << 16); w.w = kb[6] | (kb[7] << 16);
        *(LAS u32x4*)(kt_l + dk * GT_P + 8 * tg) = w;
        if (tg == 0) eb_l[dk] = __expf(tot);
        *(LAS u32x4*)(vl + (lane >> 1) * 64 + (lane & 1) * 32) = P.v0; *(LAS u32x4*)(vl + (lane >> 1) * 64 + (lane & 1) * 32 + 16) = P.v1;
    }
    if (j + 3 < nchunk) gla_h_loads<nvalid>(C, P, row0 + 32u * (j + 3), h, dk, tg, hw, lane);
    if (j + 1 < nchunk && fin_ok) { const bf16_t* rp = C.RB + ((row0 + 32u * (j + 1) + 8 * hw + ft) * 512u + h * 128 + 16 * dvg); G.g0 = *(const GAS u32x4*)rp; G.g1 = *(const GAS u32x4*)(rp + 8); }
    if (j <= nchunk) LDS_BARRIER();
}
template <int nvalid> __device__ __forceinline__ void gla_h_wave(const GlaCtx& C, LAS unsigned char* lds, int hw  , int lane, unsigned row0, int h, int nchunk) {
    const int tg = lane >> 4, dkl = lane & 15, dk = 16 * hw + dkl;
    const int ft = lane >> 3, dvg = lane & 7;
    f32x4 gn[4];
#pragma unroll
    for (int k4 = 0; k4 < 4; ++k4) gn[k4] = *(const f32x4*)(C.gnorm + h * 128 + 16 * dvg + 4 * k4);
    GlaPre P0, P1, P2; GlaGate G0 = {}, G1 = {}, G2 = {};
    gla_h_loads<nvalid>(C, P0, row0, h, dk, tg, hw, lane);
    if (1 < nchunk) gla_h_loads<nvalid>(C, P1, row0 + 32u, h, dk, tg, hw, lane);
    if (2 < nchunk) gla_h_loads<nvalid>(C, P2, row0 + 64u, h, dk, tg, hw, lane);
    if (8 * hw < nvalid) { const bf16_t* rp = C.RB + ((row0 + 8 * hw + ft) * 512u + h * 128 + 16 * dvg); G0.g0 = *(const GAS u32x4*)rp; G0.g1 = *(const GAS u32x4*)(rp + 8); }
    for (int j = 0; j <= nchunk + 1; j += 3) {
        gla_h_interval<nvalid>(C, lds, P0, G1, gn, j, nchunk, hw, lane, row0, h);
        if (j + 1 <= nchunk + 1) gla_h_interval<nvalid>(C, lds, P1, G2, gn, j + 1, nchunk, hw, lane, row0, h);
        if (j + 2 <= nchunk + 1) gla_h_interval<nvalid>(C, lds, P2, G0, gn, j + 2, nchunk, hw, lane, row0, h);
    }
}
template <int nvalid> __device__ __forceinline__ void gla_m_wave(LAS unsigned char* lds, int dvs, int lane, int nchunk, const float* s_in, float* s_out) {
    const int r32 = lane & 31, hi = lane >> 5;
    f32x16 S0 = {}, S1 = {};
    unsigned soff = (unsigned)(4 * hi * 128 + 32 * dvs + r32); asm volatile("" : "+v"(soff));
    if (s_in) {
#pragma unroll
        for (int r = 0; r < 16; ++r) { const unsigned o_ = soff + (unsigned)(((r & 3) + 8 * (r >> 2)) * 128); S0[r] = s_in[o_]; S1[r] = s_in[o_ + 4096u]; }
    }
    const int vrd = (4 * hi + ((lane & 15) >> 2)) * 64 + (((lane >> 4) & 1) * 16 + (lane & 3) * 4) * 2;
    LDS_BARRIER();
    for (int c = 0; c < nchunk; ++c) {
        const int buf = c & 1;
        LAS unsigned char* sh = lds + buf * G_BUF;
        LAS bf16_t* qe_l = (LAS bf16_t*)(sh + G_QE); LAS bf16_t* ke_l = (LAS bf16_t*)(sh + G_KE); LAS bf16_t* kt_l = (LAS bf16_t*)(sh + G_KT); LAS float* eb_l = (LAS float*)(sh + G_EB);
        const LAS unsigned char* vl = lds + GL_V + (buf * 4 + dvs) * 2048;
        f32x16 at = {};
#pragma unroll
        for (int s = 0; s < 4; ++s) { const bf16x8 a = *(const LAS bf16x8*)(ke_l + r32 * GQ_P + 16 * s + 8 * hi), bq = *(const LAS bf16x8*)(qe_l + r32 * GQ_P + 16 * s + 8 * hi);
            at = __builtin_amdgcn_mfma_f32_32x32x16_bf16(a, bq, at, 0, 0, 0); }
#pragma unroll
        for (int r = 0; r < 16; ++r) at[r] = (crow(r, hi) <= r32) ? at[r] : 0.f;
        u32x4 pa0, pa1;
        pa0.x = cvt_pk_bf16(at[0], at[1]); pa0.y = cvt_pk_bf16(at[2], at[3]); pa0.z = cvt_pk_bf16(at[4], at[5]); pa0.w = cvt_pk_bf16(at[6], at[7]);
        pa1.x = cvt_pk_bf16(at[8], at[9]); pa1.y = cvt_pk_bf16(at[10], at[11]); pa1.z = cvt_pk_bf16(at[12], at[13]); pa1.w = cvt_pk_bf16(at[14], at[15]);
        bf16x8 vf0, vf1;
        { const s16x4 lo = vtr(vl + vrd), h4 = vtr(vl + vrd + 8 * 64); vf0 = (bf16x8){lo[0], lo[1], lo[2], lo[3], h4[0], h4[1], h4[2], h4[3]}; }
        { const s16x4 lo = vtr(vl + vrd + 16 * 64), h4 = vtr(vl + vrd + 24 * 64); vf1 = (bf16x8){lo[0], lo[1], lo[2], lo[3], h4[0], h4[1], h4[2], h4[3]}; }
        f32x16 o = {};
        o = __builtin_amdgcn_mfma_f32_32x32x16_bf16(__builtin_bit_cast(bf16x8, pa0), vf0, o, 0, 0, 0);
        o = __builtin_amdgcn_mfma_f32_32x32x16_bf16(__builtin_bit_cast(bf16x8, pa1), vf1, o, 0, 0, 0);
#pragma unroll
        for (int s = 0; s < 4; ++s) {
            const u32x2 q0 = *(const LAS u32x2*)(qe_l + r32 * GQ_P + 16 * s + 4 * hi), q1 = *(const LAS u32x2*)(qe_l + r32 * GQ_P + 16 * s + 8 + 4 * hi);
            const u32x4 qa = (u32x4){q0.x, q0.y, q1.x, q1.y};
            u32x4 sb;
            if (s == 0) { sb.x = cvt_pk_bf16(S0[0], S0[1]); sb.y = cvt_pk_bf16(S0[2], S0[3]); sb.z = cvt_pk_bf16(S0[4], S0[5]); sb.w = cvt_pk_bf16(S0[6], S0[7]); }
            else if (s == 1) { sb.x = cvt_pk_bf16(S0[8], S0[9]); sb.y = cvt_pk_bf16(S0[10], S0[11]); sb.z = cvt_pk_bf16(S0[12], S0[13]); sb.w = cvt_pk_bf16(S0[14], S0[15]); }
            else if (s == 2) { sb.x = cvt_pk_bf16(S1[0], S1[1]); sb.y = cvt_pk_bf16(S1[2], S1[3]); sb.z = cvt_pk_bf16(S1[4], S1[5]); sb.w = cvt_pk_bf16(S1[6], S1[7]); }
            else { sb.x = cvt_pk_bf16(S1[8], S1[9]); sb.y = cvt_pk_bf16(S1[10], S1[11]); sb.z = cvt_pk_bf16(S1[12], S1[13]); sb.w = cvt_pk_bf16(S1[14], S1[15]); }
            o = __builtin_amdgcn_mfma_f32_32x32x16_bf16(__builtin_bit_cast(bf16x8, qa), __builtin_bit_cast(bf16x8, sb), o, 0, 0, 0);
        }
        { LAS float* ol = (LAS float*)(lds + GL_O + (buf * 4 + dvs) * 4608);
#pragma unroll
          for (int r = 0; r < 16; ++r) ol[crow(r, hi) * 36 + r32] = o[r]; }
        {
            const u32x2 a0 = *(const LAS u32x2*)(kt_l + r32 * GT_P + 4 * hi), a1 = *(const LAS u32x2*)(kt_l + r32 * GT_P + 8 + 4 * hi);
            const u32x2 c0 = *(const LAS u32x2*)(kt_l + (32 + r32) * GT_P + 4 * hi), c1 = *(const LAS u32x2*)(kt_l + (32 + r32) * GT_P + 8 + 4 * hi);
            S0 = __builtin_amdgcn_mfma_f32_32x32x16_bf16(__builtin_bit_cast(bf16x8, (u32x4){a0.x, a0.y, a1.x, a1.y}), vf0, S0, 0, 0, 0);
            S1 = __builtin_amdgcn_mfma_f32_32x32x16_bf16(__builtin_bit_cast(bf16x8, (u32x4){c0.x, c0.y, c1.x, c1.y}), vf0, S1, 0, 0, 0);
        }
        {
            const u32x2 a0 = *(const LAS u32x2*)(kt_l + r32 * GT_P + 16 + 4 * hi), a1 = *(const LAS u32x2*)(kt_l + r32 * GT_P + 24 + 4 * hi);
            const u32x2 c0 = *(const LAS u32x2*)(kt_l + (32 + r32) * GT_P + 16 + 4 * hi), c1 = *(const LAS u32x2*)(kt_l + (32 + r32) * GT_P + 24 + 4 * hi);
            S0 = __builtin_amdgcn_mfma_f32_32x32x16_bf16(__builtin_bit_cast(bf16x8, (u32x4){a0.x, a0.y, a1.x, a1.y}), vf1, S0, 0, 0, 0);
            S1 = __builtin_amdgcn_mfma_f32_32x32x16_bf16(__builtin_bit_cast(bf16x8, (u32x4){c0.x, c0.y, c1.x, c1.y}), vf1, S1, 0, 0, 0);
        }
#pragma unroll
        for (int r = 0; r < 16; ++r) { S0[r] *= eb_l[crow(r, hi)]; S1[r] *= eb_l[32 + crow(r, hi)]; }
        LDS_BARRIER();
    }
    if (s_out) {
        unsigned soff2 = (unsigned)(4 * hi * 128 + 32 * dvs + r32); asm volatile("" : "+v"(soff2));
#pragma unroll
        for (int r = 0; r < 16; ++r) { const unsigned o_ = soff2 + (unsigned)(((r & 3) + 8 * (r >> 2)) * 128); s_out[o_] = S0[r]; s_out[o_ + 4096u] = S1[r]; }
    }
}

#define XB_TMO      128
#define XB_XCNT(j)  (256  + 64 * (j))
#define XB_XSUB(j)  (1280 + 64 * (j))
#define XB_XGEN(j)  (2304 + 64 * (j))
#define XB_TOP      3328
#define XB_TOPGEN   3392
#define XCD_BAR_WORDS 3456
#define XB_SPIN_CAP (1u << 18)
__device__ __forceinline__ unsigned xb_ld(unsigned* p)              { return __hip_atomic_load(p, __ATOMIC_RELAXED, __HIP_MEMORY_SCOPE_AGENT); }
__device__ __forceinline__ unsigned xb_add(unsigned* p, unsigned v) { return __hip_atomic_fetch_add(p, v, __ATOMIC_RELAXED, __HIP_MEMORY_SCOPE_AGENT); }
__device__ __forceinline__ unsigned xb_xcc_id() { return (unsigned)__builtin_amdgcn_s_getreg((3 << 11) | 20) & 0xFu; }
#define XB_SPIN(cond, bar) do { unsigned _sp = 0; while (cond) { __builtin_amdgcn_s_sleep(1); \
    if ((++_sp & 255u) == 0u) { if (xb_ld(&(bar)[XB_TMO])) break; if (_sp > XB_SPIN_CAP) { atomicAdd(&(bar)[XB_TMO], 1u); break; } } } } while (0)
struct XcdBarrier { unsigned* bar; unsigned x; volatile LAS unsigned* st; };
__device__ __forceinline__ XcdBarrier xcd_barrier_post(unsigned* bar, volatile LAS unsigned* st) {
    XcdBarrier b; b.bar = bar; b.x = xb_xcc_id(); b.st = st;
    if (threadIdx.x == 0) (void)xb_add(&bar[XB_XCNT(b.x)], 1u);
    return b;
}
__device__ __forceinline__ void xcd_barrier_complete(unsigned* bar, unsigned x, unsigned& nloc, unsigned& nx) {
    const unsigned G = gridDim.x * gridDim.y * gridDim.z;
    unsigned sum, cnt, mine, sp = 0u;
    for (;;) {
        sum = 0u; cnt = 0u; mine = 0u;
#pragma unroll
        for (unsigned j = 0; j < 16; ++j) { const unsigned c = xb_ld(&bar[XB_XCNT(j)]); sum += c; cnt += (c > 0u) ? 1u : 0u; mine = (j == x) ? c : mine; }
        if (sum == G) break;
        __builtin_amdgcn_s_sleep(1);
        if ((++sp & 255u) == 0u) { if (xb_ld(&bar[XB_TMO])) break; if (sp > XB_SPIN_CAP) { atomicAdd(&bar[XB_TMO], 1u); break; } }
    }
    nloc = mine > 0u ? mine : 1u; nx = cnt > 0u ? cnt : 1u;
}
__device__ __forceinline__ void xcd_barrier(const XcdBarrier& b, int wave0) {
    asm volatile("s_waitcnt vmcnt(0)" ::: "memory");
    __syncthreads();
    if (wave0 == 0 && lane_id_v() == 0) {
        unsigned* bar = b.bar;
        __builtin_amdgcn_s_waitcnt(0);
        unsigned nloc = b.st[0], nx = b.st[1];
        if (nloc == 0u) { xcd_barrier_complete(bar, b.x, nloc, nx); b.st[0] = nloc; b.st[1] = nx; }
        const unsigned old = xb_add(&bar[XB_XSUB(b.x)], 1u);
        const unsigned gen = old / nloc;
        if (old + 1u == (gen + 1u) * nloc) {
            __builtin_amdgcn_fence(__ATOMIC_RELEASE, "agent");
            asm volatile("s_waitcnt vmcnt(0)" ::: "memory");
            const unsigned og = xb_add(&bar[XB_TOP], 1u);
            const unsigned tg = og / nx;
            if (og + 1u == (tg + 1u) * nx) xb_add(&bar[XB_TOPGEN], 1u);
            else XB_SPIN(xb_ld(&bar[XB_TOPGEN]) == tg, bar);
            __builtin_amdgcn_fence(__ATOMIC_ACQUIRE, "agent");
            xb_add(&bar[XB_XGEN(b.x)], 1u);
            asm volatile("s_waitcnt vmcnt(0)" ::: "memory");
        } else {
            XB_SPIN(xb_ld(&bar[XB_XGEN(b.x)]) == gen, bar);
            __builtin_amdgcn_fence(__ATOMIC_ACQUIRE, "agent");
            asm volatile("s_waitcnt vmcnt(0)" ::: "memory");
        }
    }
    __syncthreads();
}

constexpr int LDS_BYTES = 147456;

__global__ void __launch_bounds__(512, 2) hymba_fwd(Args args) {
    extern __shared__ __attribute__((aligned(16))) unsigned char lds_raw[];
    LAS unsigned char* lds = (LAS unsigned char*)lds_raw;
#define PHASE_IDS() const int lane = lane_id_v(); const int wave = wave0; (void)lane; (void)wave
    const int G = gridDim.x, bx = blockIdx.x;
    const int wave0 = __builtin_amdgcn_readfirstlane((int)(threadIdx.x >> 6));
    if (threadIdx.x < 4) ((LAS unsigned*)(lds + XBST_OFF))[threadIdx.x] = 0u;
    __syncthreads();
    const XcdBarrier xbar = xcd_barrier_post((unsigned*)(args.ws + WS_CTL) + 4096, (volatile LAS unsigned*)(lds + XBST_OFF));
    const int vcu = (G % 8 == 0) ? (bx % 8) * (G / 8) + bx / 8 : bx;
    const float* x_prompt = args.in[0]; const float* x_sample = args.in[1];
    const float* w_in = args.in[6]; const float* w_a2 = args.in[7]; const float* b_a = args.in[8];
    const float* w_o = args.in[10]; const float* g_pre_mix = args.in[11];
    const float* w_up = args.in[15]; const float* w_down = args.in[18];
#define PHASE_WS() unsigned char* ws = args.ws; asm volatile("" : "+s"(ws))

    {
        PHASE_IDS(); PHASE_WS();
        bf16_t* WinT = (bf16_t*)(ws + WS_WIN); bf16_t* WoT = (bf16_t*)(ws + WS_WO); bf16_t* WupT = (bf16_t*)(ws + WS_WUP); bf16_t* WdT = (bf16_t*)(ws + WS_WD); bf16_t* XN = (bf16_t*)(ws + WS_XN + 4096);
        LAS float* scr = (LAS float*)(lds + wave * 16384);
        const int gw = vcu * 8 + wave, NGW = G * 8;
        constexpr int I_IN = 16 * 96, I_G = 16 * 8, I_O = 16 * 32, I_UP = 16 * 176, I_D = 44 * 32;
        constexpr int NITEMS = I_IN + I_G + I_O + I_UP + I_D;
        for (int it = gw; it < NITEMS; it += NGW) {
            int r = it;
            if (r < I_IN) { const int kb = r / 96, nb = r % 96; p0_transpose_item(w_in, DIN, 32 * nb, 64 * kb, WinT, 1024, 32 * nb, scr, lane); continue; } r -= I_IN;
            if (r < I_G) { const int kb = r / 8, nb = r % 8; p0_gate_item(w_in, w_a2, 64 * kb, 32 * nb, WinT, scr, lane); continue; } r -= I_G;
            if (r < I_O) { const int kb = r / 32, nb = r % 32; p0_transpose_item(w_o, 1024, 32 * nb, 64 * kb, WoT, 1024, 32 * nb, scr, lane); continue; } r -= I_O;
            if (r < I_UP) { const int kb = r / 176, nb = r % 176; const int n0 = 32 * nb, t = n0 >> 8, w = n0 & 255;
                const int sc = (w < 128) ? (128 * t + w) : (DFF + 128 * t + (w - 128));
                p0_transpose_item(w_up, 2 * DFF, sc, 64 * kb, WupT, 1024, n0, scr, lane); continue; } r -= I_UP;
            { const int kb = r / 32, nb = r % 32; p0_transpose_item(w_down, 1024, 32 * nb, 64 * kb, WdT, DFF, 32 * nb, scr, lane); }
        }
        for (int m = gw; m < MT; m += NGW) {
            const float* xr = (m < MP) ? x_prompt + (size_t)m * DM : x_sample + (size_t)(m - MP) * DM;
            rms_row_to_bf16(xr, g_pre_mix, XN + (size_t)m * DM, lane);
        }
    }
    xcd_barrier(xbar, wave0);

    {
        PHASE_WS();
        pg8::Gemm g{(bf16_t*)(ws + WS_XN + 4096), (bf16_t*)(ws + WS_WIN), 1024, 256, 1024}; pg8::StaticOrder S; S.init(MT / 256, NIN / 256, G, bx);
        EpiInProj E{(bf16_t*)(ws + WS_QA), (bf16_t*)(ws + WS_KA), (bf16_t*)(ws + WS_VA), (bf16_t*)(ws + WS_QB), (bf16_t*)(ws + WS_KB), (bf16_t*)(ws + WS_VB), (bf16_t*)(ws + WS_RB),
                    (float*)(ws + WS_LF), args.out, b_a};
        pg8::gemm_phase<EpiInProj, pg8::StaticOrder>(lds, g, S, E, wave0);
    }
    xcd_barrier(xbar, wave0);

    {
        PHASE_IDS(); PHASE_WS();
        bf16_t* MIX = (bf16_t*)(ws + WS_MIX);
        GlaCtx GC{(const bf16_t*)(ws + WS_QB), (const bf16_t*)(ws + WS_KB), (const bf16_t*)(ws + WS_VB), (const bf16_t*)(ws + WS_RB), (const float*)(ws + WS_LF), MIX, args.in[9]};
        const float* state_gla = args.in[4];
#ifndef NO_GLA
        for (int it = bx; it < 64 + 128; it += G) {
            const bool pr = it < 64; const int seq = pr ? it : it - 64; const int b = seq >> 2, h = seq & 3;
            const size_t row0 = pr ? (size_t)b * SEQ : (size_t)MP + (size_t)b * 8;
            const float* s_in = pr ? nullptr : state_gla + (size_t)seq * 8192;
            float* s_out = args.out + (pr ? O_GP : O_GS) + (size_t)seq * 8192;
            const int nchunk = pr ? SEQ / 32 : 1;
            if (wave < 4) { if (pr) gla_m_wave<32>(lds, wave, lane, nchunk, s_in, s_out); else gla_m_wave<8>(lds, wave, lane, nchunk, s_in, s_out); }
            else { if (pr) gla_h_wave<32>(GC, lds, wave - 4, lane, (unsigned)row0, h, nchunk); else gla_h_wave<8>(GC, lds, wave - 4, lane, (unsigned)row0, h, nchunk); }
            __syncthreads();
        }
#endif
        AttnCtx AC{(const bf16_t*)(ws + WS_QA), (const bf16_t*)(ws + WS_KA), (const bf16_t*)(ws + WS_VA), MIX, args.in[2], args.in[3]};
        unsigned* counter = (unsigned*)(ws + WS_CTL);
        LAS unsigned char* wl = lds + wave * 8192;
        const int lane2 = lane_id_v();
        for (int sb = (bx + 64) % G; sb < NSB; sb += G) attn_item<true>(AC, sb, wave, 0, 0, wl, lane2);
        const unsigned xq0 = xb_xcc_id() & 7u;
        for (unsigned kq = 0; kq < 8u; ++kq) {
            const unsigned xq = (xq0 + kq) & 7u;
            unsigned* head = counter + 64 * xq;
            for (;;) {
                unsigned loc = 0; if (lane2 == 0) loc = atomicAdd(head, 1u);
                loc = (unsigned)__builtin_amdgcn_readfirstlane((int)loc);
                if (loc >= 1024u) break;
                { const unsigned p = loc; const unsigned grp = p >> 8, q = p & 255u; const int g = 15 - (int)(q >> 4); const unsigned bhl = (q >> 2) & 3u; const int r4 = (int)(q & 3u);
                    const int bh = (int)(xq + 8u * (4u * grp + bhl));
                    attn_item<false>(AC, bh >> 3, bh & 7, g, r4, wl, lane2); }
            }
        }
    }
    xcd_barrier(xbar, wave0);

    {
        PHASE_WS();
        bf16_t* MO = (bf16_t*)(ws + WS_MO); float* SSQ1 = (float*)(ws + WS_SSQ1);
        pg8::Gemm g{(bf16_t*)(ws + WS_MIX), (bf16_t*)(ws + WS_WO), 1024, 256, 1024}; pg8::StaticOrder S; S.init(MP / 256, 4, G, bx);
        EpiRowOut E{MO, SSQ1};
        pg8::gemm_phase<EpiRowOut, pg8::StaticOrder>(lds, g, S, E, wave0);
        pg8::Gemm g2{(bf16_t*)(ws + WS_MIX), (bf16_t*)(ws + WS_WO), 256, 256, 1024}; pg8::SplitOrder S2{16, G, bx, 128, 256};
        EpiSlice E2{(float*)(ws + WS_ACC1), 256};
        pg8::gemm_phase<EpiSlice, pg8::SplitOrder>(lds, g2, S2, E2, wave0);
    }
    xcd_barrier(xbar, wave0);
    {
        PHASE_IDS(); PHASE_WS();
        bf16_t* MO = (bf16_t*)(ws + WS_MO); float* SSQ1 = (float*)(ws + WS_SSQ1); bf16_t* XN = (bf16_t*)(ws + WS_XN + 4096);
        const float* g_post = args.in[12]; const float* g_pre = args.in[13];
        const int gw = vcu * 8 + wave, NGW = G * 8;
        {
            f32x4 gp4[4], gq4[4];
#pragma unroll
            for (int j = 0; j < 4; ++j) { gp4[j] = ((const GAS f32x4*)g_post)[64 * j + lane]; gq4[j] = ((const GAS f32x4*)g_pre)[64 * j + lane]; }
            for (int m0 = gw; m0 < MP; m0 += 2 * NGW) {
                const int m1 = (m0 + NGW < MP) ? m0 + NGW : m0;
                f32x4 sp[2], xv[2][4]; u32x2 mw[2][4];
#pragma unroll
                for (int r = 0; r < 2; ++r) { const int m = r ? m1 : m0; sp[r] = *((const GAS f32x4*)(SSQ1 + (size_t)m * 16) + (lane & 3));
#pragma unroll
                    for (int j = 0; j < 4; ++j) { xv[r][j] = ((const GAS f32x4*)(x_prompt + (size_t)m * DM))[64 * j + lane]; mw[r][j] = ((const GAS u32x2*)(MO + (size_t)m * DM))[64 * j + lane]; } }
#pragma unroll
                for (int r = 0; r < 2; ++r) if (r == 0 || m1 != m0) { const int m = r ? m1 : m0;
                    float ss = (sp[r].x + sp[r].y) + (sp[r].z + sp[r].w); ss += __shfl_xor(ss, 1); ss += __shfl_xor(ss, 2);
                    const float rs = rsqrtf(ss * (1.f / DM) + EPS);
                    f32x4 x1[4]; float s2 = 0.f;
#pragma unroll
                    for (int j = 0; j < 4; ++j) { f32x4 mv; mv.x = __uint_as_float(mw[r][j].x << 16); mv.y = __uint_as_float(mw[r][j].x & 0xffff0000u); mv.z = __uint_as_float(mw[r][j].y << 16); mv.w = __uint_as_float(mw[r][j].y & 0xffff0000u);
                        x1[j] = xv[r][j] + mv * rs * gp4[j]; s2 += (x1[j].x * x1[j].x + x1[j].y * x1[j].y) + (x1[j].z * x1[j].z + x1[j].w * x1[j].w);
                        ((GAS f32x4*)(args.out + (size_t)m * DM))[64 * j + lane] = x1[j]; }
                    const float rs2 = rsqrtf(wave_sum(s2) * (1.f / DM) + EPS);
#pragma unroll
                    for (int j = 0; j < 4; ++j) { const f32x4 y = x1[j] * rs2 * gq4[j]; u32x2 w; w.x = pk2(y.x, y.y); w.y = pk2(y.z, y.w); ((GAS u32x2*)(XN + (size_t)m * DM))[64 * j + lane] = w; }
                }
            }
        }
        for (int m = MP + gw; m < MT; m += NGW) {
            const float* xr = (m < MP) ? x_prompt + (size_t)m * DM : x_sample + (size_t)(m - MP) * DM;
            float* orow = args.out + (size_t)m * DM;
            f32x4 mvv[4]; float ss;
            if (m < MP) {
                const f32x4 sp = *((const f32x4*)(SSQ1 + (size_t)m * 16) + (lane & 3));
                ss = (sp.x + sp.y) + (sp.z + sp.w); ss += __shfl_xor(ss, 1); ss += __shfl_xor(ss, 2);
#pragma unroll
                for (int j = 0; j < 4; ++j) { const u32x2 mw = ((const u32x2*)(MO + (size_t)m * DM))[64 * j + lane];
                    mvv[j].x = __uint_as_float(mw.x << 16); mvv[j].y = __uint_as_float(mw.x & 0xffff0000u); mvv[j].z = __uint_as_float(mw.y << 16); mvv[j].w = __uint_as_float(mw.y & 0xffff0000u); }
            } else {
                const f32x4* ar = (const f32x4*)(ws + WS_ACC1) + (size_t)(m - MP) * 256; float s = 0.f;
#pragma unroll
                for (int j = 0; j < 4; ++j) { f32x4 a = ar[64 * j + lane];
                    for (int sl = 1; sl < 4; ++sl) a += ar[(size_t)sl * 65536 + 64 * j + lane];
                    mvv[j] = a; s += (a.x * a.x + a.y * a.y) + (a.z * a.z + a.w * a.w); }
                ss = wave_sum(s);
            }
            const float rs = rsqrtf(ss * (1.f / DM) + EPS);
            f32x4 x1[4]; float s2 = 0.f;
#pragma unroll
            for (int j = 0; j < 4; ++j) { const int c4 = 64 * j + lane; const f32x4 xv = ((const f32x4*)xr)[c4]; const f32x4 gp = ((const f32x4*)g_post)[c4];
                const f32x4 mv = mvv[j];
                x1[j] = xv + mv * rs * gp; s2 += (x1[j].x * x1[j].x + x1[j].y * x1[j].y) + (x1[j].z * x1[j].z + x1[j].w * x1[j].w);
                ((f32x4*)orow)[c4] = x1[j]; }
            const float rs2 = rsqrtf(wave_sum(s2) * (1.f / DM) + EPS);
#pragma unroll
            for (int j = 0; j < 4; ++j) { const int c4 = 64 * j + lane; const f32x4 gq = ((const f32x4*)g_pre)[c4]; const f32x4 y = x1[j] * rs2 * gq; u32x2 w; w.x = pk2(y.x, y.y); w.y = pk2(y.z, y.w); ((u32x2*)(XN + (size_t)m * DM))[c4] = w; }
        }
    }
    xcd_barrier(xbar, wave0);
    {
        PHASE_WS();
        bf16_t* Hb = (bf16_t*)(ws + WS_H);
        pg8::Gemm g{(bf16_t*)(ws + WS_XN + 4096) - 2 * DM, (bf16_t*)(ws + WS_WUP), 1024, 254, 1024}; pg8::StaticOrder S; S.init(131, 22, G, bx);
        EpiUp E{Hb, args.out, args.in[16], args.in[17], args.in[5], lds};
        pg8::gemm_phase<EpiUp, pg8::StaticOrder>(lds, g, S, E, wave0);
    }
    xcd_barrier(xbar, wave0);
    {
        PHASE_WS();
        bf16_t* MO = (bf16_t*)(ws + WS_MO); float* SSQ2 = (float*)(ws + WS_SSQ2);
        pg8::Gemm g{(bf16_t*)(ws + WS_H), (bf16_t*)(ws + WS_WD), DFF, 256, DFF}; pg8::StaticOrder S; S.init(MP / 256, 4, G, bx);
        EpiRowOut E{MO, SSQ2};
        pg8::gemm_phase<EpiRowOut, pg8::StaticOrder>(lds, g, S, E, wave0);
        pg8::Gemm g2{(bf16_t*)(ws + WS_H), (bf16_t*)(ws + WS_WD), 256, 256, DFF}; pg8::SplitOrder S2{44, G, bx, 128, 256};
        EpiSlice E2{(float*)(ws + WS_ACC2), 256};
        pg8::gemm_phase<EpiSlice, pg8::SplitOrder>(lds, g2, S2, E2, wave0);
    }
    xcd_barrier(xbar, wave0);
    {
        PHASE_IDS(); PHASE_WS();
        bf16_t* MO = (bf16_t*)(ws + WS_MO); float* SSQ2 = (float*)(ws + WS_SSQ2);
        const float* g_post = args.in[14];
        const int gw = vcu * 8 + wave, NGW = G * 8;
        {
            const f32x4 gp4[4] = {((const GAS f32x4*)g_post)[lane], ((const GAS f32x4*)g_post)[64 + lane], ((const GAS f32x4*)g_post)[128 + lane], ((const GAS f32x4*)g_post)[192 + lane]};
            for (int m0 = gw; m0 < MP; m0 += 2 * NGW) {
                const int m1 = (m0 + NGW < MP) ? m0 + NGW : m0;
                GAS float* ro[2] = {(GAS float*)(args.out + (size_t)m0 * DM), (GAS float*)(args.out + (size_t)m1 * DM)};
                f32x4 sp[2], xv[2][4]; u32x2 mw[2][4];
#pragma unroll
                for (int r = 0; r < 2; ++r) { const int m = r ? m1 : m0; sp[r] = *((const GAS f32x4*)(SSQ2 + (size_t)m * 16) + (lane & 3));
#pragma unroll
                    for (int j = 0; j < 4; ++j) { xv[r][j] = ((const GAS f32x4*)ro[r])[64 * j + lane]; mw[r][j] = ((const GAS u32x2*)(MO + (size_t)m * DM))[64 * j + lane]; } }
                f32x4 yv[2][4];
#pragma unroll
                for (int r = 0; r < 2; ++r) { float ss = (sp[r].x + sp[r].y) + (sp[r].z + sp[r].w); ss += __shfl_xor(ss, 1); ss += __shfl_xor(ss, 2);
                    const float rs = rsqrtf(ss * (1.f / DM) + EPS);
#pragma unroll
                    for (int j = 0; j < 4; ++j) { f32x4 mv; mv.x = __uint_as_float(mw[r][j].x << 16); mv.y = __uint_as_float(mw[r][j].x & 0xffff0000u); mv.z = __uint_as_float(mw[r][j].y << 16); mv.w = __uint_as_float(mw[r][j].y & 0xffff0000u);
                        yv[r][j] = xv[r][j] + mv * rs * gp4[j]; } }
#pragma unroll
                for (int r = 0; r < 2; ++r) if (r == 0 || m1 != m0) {
#pragma unroll
                    for (int j = 0; j < 4; ++j) ((GAS f32x4*)ro[r])[64 * j + lane] = yv[r][j]; }
            }
        }
        for (int m = MP + gw; m < MT; m += NGW) {
            float* orow = args.out + (size_t)m * DM;
            f32x4 mvv[4]; float ss;
            if (m < MP) {
                const f32x4 sp = *((const f32x4*)(SSQ2 + (size_t)m * 16) + (lane & 3));
                ss = (sp.x + sp.y) + (sp.z + sp.w); ss += __shfl_xor(ss, 1); ss += __shfl_xor(ss, 2);
#pragma unroll
                for (int j = 0; j < 4; ++j) { const u32x2 mw = ((const u32x2*)(MO + (size_t)m * DM))[64 * j + lane];
                    mvv[j].x = __uint_as_float(mw.x << 16); mvv[j].y = __uint_as_float(mw.x & 0xffff0000u); mvv[j].z = __uint_as_float(mw.y << 16); mvv[j].w = __uint_as_float(mw.y & 0xffff0000u); }
            } else {
                const f32x4* ar = (const f32x4*)(ws + WS_ACC2) + (size_t)(m - MP) * 256; float s = 0.f;
#pragma unroll
                for (int j = 0; j < 4; ++j) { f32x4 a = ar[64 * j + lane];
                    for (int sl = 1; sl < 11; ++sl) a += ar[(size_t)sl * 65536 + 64 * j + lane];
                    mvv[j] = a; s += (a.x * a.x + a.y * a.y) + (a.z * a.z + a.w * a.w); }
                ss = wave_sum(s);
            }
            const float rs = rsqrtf(ss * (1.f / DM) + EPS);
#pragma unroll
            for (int j = 0; j < 4; ++j) { const int c4 = 64 * j + lane; const f32x4 xv = ((const f32x4*)orow)[c4]; const f32x4 gp = ((const f32x4*)g_post)[c4];
                ((f32x4*)orow)[c4] = xv + mvv[j] * rs * gp; }
        }
    }
}

extern "C" void kernel_launch(void* const* d_in, const int* in_sizes, int n_in, void* d_out, int out_size, void* d_ws, size_t ws_size, hipStream_t stream) {
    static int grid = 0;
    if (grid == 0) {
        if (n_in != 19 || ws_size < WS_END || (size_t)out_size != O_END) { fprintf(stderr, "kernel_launch: unexpected shapes n_in %d out %d ws %zu\n", n_in, out_size, ws_size); grid = -1; return; }
        int dev = 0, cus = 0, per_cu = 0;
        hipGetDevice(&dev); hipDeviceGetAttribute(&cus, hipDeviceAttributeMultiprocessorCount, dev);
        hipFuncSetAttribute((const void*)hymba_fwd, hipFuncAttributeMaxDynamicSharedMemorySize, LDS_BYTES);
        hipOccupancyMaxActiveBlocksPerMultiprocessor(&per_cu, (const void*)hymba_fwd, 512, LDS_BYTES);
        if (per_cu < 1) { fprintf(stderr, "kernel_launch: occupancy query says %d blocks per CU\n", per_cu); grid = -1; return; }
        grid = cus;
    }
    if (grid < 0) return;
    hipMemsetAsync((char*)d_ws + WS_CTL, 0, CTL_BYTES, stream);
    Args a{};
    for (int i = 0; i < 19; ++i) a.in[i] = (const float*)d_in[i];
    a.out = (float*)d_out; a.ws = (unsigned char*)d_ws;
    void* kargs[] = {&a};
    hipError_t e = hipLaunchCooperativeKernel((const void*)hymba_fwd, dim3(grid), dim3(512), kargs, LDS_BYTES, stream);
    if (e != hipSuccess) fprintf(stderr, "cooperative launch failed: %s (grid %d)\n", hipGetErrorString(e), grid);
}
```

```cpp
#include <hip/hip_runtime.h>
#include <hip/hip_cooperative_groups.h>
#include <cstdio>
#include <cstdint>
namespace cg = cooperative_groups;

#define LAS __attribute__((address_space(3)))
#define GAS __attribute__((address_space(1)))
typedef unsigned short bf16_t;
typedef short bf16x8 __attribute__((ext_vector_type(8)));
typedef short s16x4 __attribute__((ext_vector_type(4)));
typedef float f32x4 __attribute__((ext_vector_type(4)));
typedef float f32x2 __attribute__((ext_vector_type(2)));
typedef float f32x16 __attribute__((ext_vector_type(16)));
typedef unsigned u32x4 __attribute__((ext_vector_type(4)));
typedef unsigned u32x2 __attribute__((ext_vector_type(2)));

constexpr int DM = 1024, NPB = 16, SEQ = 2048, NSB = 32, NST = 8;
constexpr int MP = NPB * SEQ;
constexpr int MS = NSB * NST;
constexpr int MT = MP + MS;
constexpr int NIN = 3328;
constexpr int DIN = 3088;
constexpr int DFF = 2816;
constexpr int WINB = 2048;
constexpr float EPS = 1e-6f;
constexpr float QSCALE = 0.125f * 1.4426950408889634f;

constexpr size_t MiB = 1u << 20;
constexpr size_t WS_CTL = 0, CTL_BYTES = 65536;
constexpr int XBST_OFF = 131072 + 8192;
constexpr size_t WS_WIN = 1 * MiB, WS_WO = 8 * MiB, WS_WUP = 10 * MiB, WS_WD = 22 * MiB;
constexpr size_t WS_SSQ1 = 28 * MiB, WS_SSQ2 = 31 * MiB;
constexpr size_t WS_XN = 34 * MiB;
constexpr size_t WS_MO = 104 * MiB;
constexpr size_t WS_QA = 172 * MiB, WS_KA = 206 * MiB, WS_VA = 240 * MiB, WS_QB = 274 * MiB, WS_KB = 291 * MiB, WS_VB = 308 * MiB, WS_RB = 342 * MiB, WS_LF = 376 * MiB, WS_MIX = 410 * MiB;
constexpr size_t WS_H = 172 * MiB;
constexpr size_t WS_ACC1 = 478 * MiB, WS_ACC2 = 482 * MiB;
constexpr size_t WS_END = 494 * MiB;
static_assert(WS_H + (size_t)MT * DFF * 2 <= WS_MIX, "h overlay");
static_assert(WS_XN + 4096 + (size_t)(131 * 254 + 260) * DM * 2 <= WS_MO, "xn2");

constexpr size_t O_YP = 0, O_YS = O_YP + (size_t)MP * DM, O_KP = O_YS + (size_t)MS * DM, O_VP = O_KP + (size_t)MP * 512, O_GP = O_VP + (size_t)MP * 512,
                 O_CP = O_GP + (size_t)NPB * 4 * 64 * 128, O_KS = O_CP + (size_t)NPB * 2 * DFF, O_VS = O_KS + (size_t)MS * 512, O_GS = O_VS + (size_t)MS * 512,
                 O_CS = O_GS + (size_t)NSB * 4 * 64 * 128, O_END = O_CS + (size_t)NSB * 2 * DFF;

__device__ __forceinline__ unsigned cvt_pk_bf16(float lo, float hi) { unsigned r; asm volatile("v_cvt_pk_bf16_f32 %0, %1, %2" : "=v"(r) : "v"(lo), "v"(hi)); return r; }
__device__ __forceinline__ float bf2f(unsigned short b) { return __uint_as_float((unsigned)b << 16); }
__device__ __forceinline__ float wave_sum(float v) {
#pragma unroll
    for (int o = 1; o < 64; o <<= 1) v += __shfl_xor(v, o);
    return v;
}

__device__ __forceinline__ int lane_id_v() { int l; asm volatile("v_mbcnt_lo_u32_b32 %0, -1, 0\n\tv_mbcnt_hi_u32_b32 %0, -1, %0" : "=v"(l)); return l; }

struct Args {
    const float* in[19];
    float* out;
    unsigned char* ws;
};

namespace pg8 {
constexpr int BM = 256, BK = 64, HALF = 128, HTB = HALF * BK * 2, STAGE_BYTES = 8 * HTB, NXCD = 8, WGM = 8;
__host__ __device__ __forceinline__ int lds_byte(int r, int c) { const int st = (r >> 4) * 2 + (c >> 5), rr = r & 15, cc = c & 31, ob = rr * 64 + cc * 2; return st * 1024 + (ob ^ (((ob >> 9) & 1) << 5)); }
__host__ __device__ __forceinline__ void stage_rc(int b, int& R, int& C) { const int st = b / 1024, sb = b % 1024, swz = sb ^ (((sb >> 9) & 1) << 5); R = (st >> 1) * 16 + swz / 64; C = (st & 1) * 32 + (swz % 64) / 2; }
__host__ __device__ __forceinline__ int perm32(int rho) { const int n = rho >> 4, i = rho & 15; return 8 * (i >> 2) + 4 * n + (i & 3); }

struct Unit { int pm, pn, kofs; };
struct Gemm { const bf16_t* A; const bf16_t* Bt; int K; int a_rows; int ldk; };

struct StaticOrder {
    int nM, nN, nwg, G, c;
    __device__ void init(int nM_, int nN_, int G_, int c_) { nM = nM_; nN = nN_; nwg = nM * nN; G = G_; c = c_; }
    __device__ bool next(int i, Unit& u) const {
        const long L = (long)i * G + c; if (L >= nwg) return false;
        int wgid = (int)L; { const int q = nwg / NXCD, r = nwg % NXCD, xcd = wgid % NXCD, off = wgid / NXCD; wgid = (xcd < r ? xcd * (q + 1) : r * (q + 1) + (xcd - r) * q) + off; }
        const int nig = WGM * nN, gid = wgid / nig, fm = gid * WGM, gsz = (nM - fm) < WGM ? (nM - fm) : WGM;
        u.pm = fm + ((wgid % nig) % gsz); u.pn = (wgid % nig) / gsz; u.kofs = 0; return true;
    }
};
struct SplitOrder {
    int nsub, G, c, pm, ksub;
    __device__ bool next(int i, Unit& u) const { const int L = i * G + c; if (L >= nsub) return false; u.pm = pm; u.pn = L & 3; u.kofs = (L >> 2) * ksub; return true; }
};

__device__ __forceinline__ f32x2 gelu_pk(f32x2 v) {
    const f32x2 av = __builtin_elementwise_abs(v), d = av * 0.2316418882f + 1.0f;
    f32x2 t; t.x = __builtin_amdgcn_rcpf(d.x); t.y = __builtin_amdgcn_rcpf(d.y);
    f32x2 q = t * 0.5307027145f + (-0.7265760135f); q = q * t + 0.7107068705f; q = q * t + (-0.142248368f); q = q * t + 0.127414796f; q = q * t;
    const f32x2 s = (v * v) * (-0.72134752044f);
    f32x2 e; e.x = __builtin_amdgcn_exp2f(s.x); e.y = __builtin_amdgcn_exp2f(s.y);
    const f32x2 m = v * (q * e), r = v - m;
    f32x2 o; o.x = v.x < 0.f ? m.x : r.x; o.y = v.y < 0.f ? m.y : r.y; return o;
}

template <class Epi, class Sched>
__device__ __forceinline__ void gemm_phase(LAS unsigned char* lds, const Gemm g, const Sched& S, const Epi& E, int wid) {
    const int lane = lane_id_v(); const int tid = wid * 64 + lane;
    const int wr = wid >> 2, wc = wid & 3, fr = lane & 15, fq = lane >> 4;
    const int K = g.ldk, nt = g.K / BK;
    unsigned voffA[2], voffB[2];
#pragma unroll
    for (int i = 0; i < 2; ++i) { int R, C; stage_rc(tid * 16 + i * 8192, R, C); const int Rb = Epi::PERM ? ((R & ~31) + perm32(R & 31)) : R;
        voffA[i] = (unsigned)(R * K + C) * 2u; voffB[i] = (unsigned)(Rb * K + C) * 2u; }
    const size_t kstep = (size_t)(BK * 2);
    const size_t hstep = (size_t)HALF * K * 2;
    const size_t tstepB = 2 * hstep;
    const size_t tstepA = (size_t)g.a_rows * K * 2;
    const unsigned ldsw = (unsigned)wid * 1024u;
    const int aoff = lds_byte(wr * 64 + fr, fq * 8), boff = lds_byte(wc * 32 + fr, fq * 8);
#define PG8_SA(b, h) (((b) * 2 + (h)) * HTB)
#define PG8_SB(b, h) ((4 + (b) * 2 + (h)) * HTB)
#define PG8_STAGE(bufoff, gbase, voff) do { _Pragma("unroll") for (int _i = 0; _i < 2; ++_i) \
        __builtin_amdgcn_global_load_lds((const unsigned*)((const char*)(gbase) + (voff)[_i]), (LAS unsigned*)(lds + (bufoff) + ldsw + _i * 8192), 16, 0, 0); } while (0)
#define PG8_LDA(dst, b, h) do { _Pragma("unroll") for (int m = 0; m < 4; ++m) _Pragma("unroll") for (int k = 0; k < 2; ++k) dst[m][k] = *(const LAS bf16x8*)(lds + PG8_SA(b, h) + aoff + m * 2048 + k * 1024); } while (0)
#define PG8_LDB(dst, b, h) do { _Pragma("unroll") for (int n = 0; n < 2; ++n) _Pragma("unroll") for (int k = 0; k < 2; ++k) dst[n][k] = *(const LAS bf16x8*)(lds + PG8_SB(b, h) + boff + n * 2048 + k * 1024); } while (0)
#define PG8_MMA(ai, bj, At, Bt) do { __builtin_amdgcn_s_setprio(1); _Pragma("unroll") for (int m = 0; m < 4; ++m) _Pragma("unroll") for (int n = 0; n < 2; ++n) _Pragma("unroll") for (int k = 0; k < 2; ++k) \
        acc[ai][bj][m][n] = __builtin_amdgcn_mfma_f32_16x16x32_bf16(Bt[n][k], At[m][k], acc[ai][bj][m][n], 0, 0, 0); __builtin_amdgcn_s_setprio(0); } while (0)
#define PG8_WAIT_V(n) asm volatile("s_waitcnt vmcnt(" #n ")" ::: "memory")
#define PG8_WAIT_L(n) asm volatile("s_waitcnt lgkmcnt(" #n ")" ::: "memory")
#define PG8_BAR __builtin_amdgcn_s_barrier()
#define PG8_SCHED __builtin_amdgcn_sched_barrier(0)
    Unit cur, nxt; int ui = 0;
    if (!S.next(0, cur)) return;
    f32x4 acc[2][2][4][2];
#pragma unroll
    for (int a = 0; a < 2; ++a)
#pragma unroll
        for (int b = 0; b < 2; ++b)
#pragma unroll
            for (int m = 0; m < 4; ++m)
#pragma unroll
                for (int n = 0; n < 2; ++n) acc[a][b][m][n] = (f32x4){0.f, 0.f, 0.f, 0.f};
    bf16x8 At[4][2], B0[2][2], B1[2][2];
    const char* cA = (const char*)g.A + (size_t)cur.pm * tstepA + (size_t)cur.kofs * 2; const char* cB = (const char*)g.Bt + (size_t)cur.pn * tstepB + (size_t)cur.kofs * 2;
    PG8_STAGE(PG8_SB(0, 0), cB, voffB); PG8_STAGE(PG8_SB(0, 1), cB + hstep, voffB); PG8_STAGE(PG8_SA(0, 0), cA, voffA); PG8_STAGE(PG8_SA(0, 1), cA + hstep, voffA);
    if (wr == 1) PG8_BAR;
    PG8_WAIT_V(2); PG8_BAR;
    PG8_STAGE(PG8_SB(1, 0), cB + kstep, voffB); PG8_STAGE(PG8_SA(1, 0), cA + kstep, voffA); PG8_STAGE(PG8_SB(1, 1), cB + hstep + kstep, voffB);
    PG8_WAIT_V(6); PG8_BAR;
    for (;;) {
        const bool has_next = S.next(ui + 1, nxt);
        const char* nA = has_next ? (const char*)g.A + (size_t)nxt.pm * tstepA + (size_t)nxt.kofs * 2 : cA; const char* nB = has_next ? (const char*)g.Bt + (size_t)nxt.pn * tstepB + (size_t)nxt.kofs * 2 : cB;
        for (int t = 0; t < nt; t += 2) {
            const bool last = (t == nt - 2);
            const char* a1 = cA + (size_t)(t + 1) * kstep;
            const char* a2 = last ? nA : cA + (size_t)(t + 2) * kstep; const char* b2 = last ? nB : cB + (size_t)(t + 2) * kstep;
            const char* a3 = a2 + kstep; const char* b3 = b2 + kstep;
            PG8_LDB(B0, 0, 0); PG8_LDB(B1, 0, 1); PG8_SCHED; PG8_LDA(At, 0, 0); PG8_STAGE(PG8_SA(1, 1), a1 + hstep, voffA);
            PG8_WAIT_V(8); PG8_WAIT_L(0); PG8_BAR; PG8_MMA(0, 0, At, B0); PG8_MMA(0, 1, At, B1); PG8_BAR; PG8_SCHED;
            PG8_LDA(At, 0, 1); PG8_STAGE(PG8_SB(0, 0), b2, voffB); PG8_STAGE(PG8_SB(0, 1), b2 + hstep, voffB); PG8_STAGE(PG8_SA(0, 0), a2, voffA);
            PG8_WAIT_V(8); PG8_WAIT_L(0); PG8_BAR; PG8_MMA(1, 0, At, B0); PG8_MMA(1, 1, At, B1); PG8_BAR; PG8_SCHED;
            PG8_LDB(B0, 1, 0); PG8_LDB(B1, 1, 1); PG8_SCHED; PG8_LDA(At, 1, 0); PG8_STAGE(PG8_SA(0, 1), a2 + hstep, voffA);
            PG8_WAIT_V(8); PG8_WAIT_L(0); PG8_BAR; PG8_MMA(0, 0, At, B0); PG8_MMA(0, 1, At, B1); PG8_BAR; PG8_SCHED;
            PG8_LDA(At, 1, 1); PG8_STAGE(PG8_SB(1, 0), b3, voffB); PG8_STAGE(PG8_SB(1, 1), b3 + hstep, voffB); PG8_STAGE(PG8_SA(1, 0), a3, voffA);
            PG8_WAIT_V(8); PG8_WAIT_L(0); PG8_BAR; PG8_MMA(1, 0, At, B0); PG8_MMA(1, 1, At, B1); PG8_BAR; PG8_SCHED;
        }
        if (wr == 0) PG8_BAR;
        E(acc, cur, wr, wc, fr, fq);
        if (!has_next) break;
#pragma unroll
        for (int a = 0; a < 2; ++a)
#pragma unroll
            for (int b = 0; b < 2; ++b)
#pragma unroll
                for (int m = 0; m < 4; ++m)
#pragma unroll
                    for (int n = 0; n < 2; ++n) acc[a][b][m][n] = (f32x4){0.f, 0.f, 0.f, 0.f};
        cur = nxt; cA = nA; cB = nB; ++ui;
        if (wr == 1) PG8_BAR;
    }
    PG8_WAIT_V(0);
    PG8_BAR;
#undef PG8_SA
#undef PG8_SB
#undef PG8_STAGE
#undef PG8_LDA
#undef PG8_LDB
#undef PG8_MMA
#undef PG8_WAIT_V
#undef PG8_WAIT_L
#undef PG8_BAR
#undef PG8_SCHED
}
}

struct EpiInProj {
    static constexpr bool PERM = true;
    bf16_t *QA, *KA, *VA, *QB, *KB, *VB, *RB; float* LF; float* out; const float* b_a;
    __device__ __forceinline__ void operator()(const f32x4 (&acc)[2][2][4][2], const pg8::Unit& u, int wr, int wc, int fr, int fq) const {
        const int pn = u.pn;
        const int row0 = u.pm * 256 + wr * 64 + fr;
        const int cl = wc * 32 + 8 * fq;
        if (pn == 12) {
#pragma unroll
            for (int bj = 0; bj < 2; ++bj) {
                const f32x4 b0 = *(const f32x4*)(b_a + cl + bj * 128), b1 = *(const f32x4*)(b_a + cl + bj * 128 + 4);
#pragma unroll
                for (int ai = 0; ai < 2; ++ai)
#pragma unroll
                    for (int m = 0; m < 4; ++m) {
                        f32x4 v0 = acc[ai][bj][m][0] + b0, v1 = acc[ai][bj][m][1] + b1;
#pragma unroll
                        for (int e = 0; e < 4; ++e) {
                            float z = v0[e]; v0[e] = (fminf(z, 0.f) - 0.69314718f * __builtin_amdgcn_logf(1.f + __builtin_amdgcn_exp2f(-1.44269504f * fabsf(z)))) * 0.0625f;
                            z = v1[e]; v1[e] = (fminf(z, 0.f) - 0.69314718f * __builtin_amdgcn_logf(1.f + __builtin_amdgcn_exp2f(-1.44269504f * fabsf(z)))) * 0.0625f; }
                        float* p = LF + (size_t)(row0 + ai * 128 + m * 16) * 256 + cl + bj * 128;
                        *(f32x4*)p = v0; *(f32x4*)(p + 4) = v1;
                    }
            }
            return;
        }
        bf16_t* base; int ld, cb; float sc = 1.f; float* fo = nullptr;
        if (pn < 2) { base = QA; ld = 512; cb = pn * 256; sc = QSCALE; }
        else if (pn < 4) { base = KA; ld = 512; cb = (pn - 2) * 256; fo = out + (u.pm < 128 ? O_KP : O_KS - (size_t)MP * 512); }
        else if (pn < 6) { base = VA; ld = 512; cb = (pn - 4) * 256; fo = out + (u.pm < 128 ? O_VP : O_VS - (size_t)MP * 512); }
        else if (pn == 6) { base = QB; ld = 256; cb = 0; }
        else if (pn == 7) { base = KB; ld = 256; cb = 0; }
        else if (pn < 10) { base = VB; ld = 512; cb = (pn - 8) * 256; }
        else { base = RB; ld = 512; cb = (pn - 10) * 256; }
#pragma unroll
        for (int ai = 0; ai < 2; ++ai)
#pragma unroll
            for (int m = 0; m < 4; ++m) {
                const size_t r = (size_t)(row0 + ai * 128 + m * 16);
#pragma unroll
                for (int bj = 0; bj < 2; ++bj) {
                    const f32x4 a0 = acc[ai][bj][m][0], a1 = acc[ai][bj][m][1];
                    const f32x4 v0 = a0 * sc, v1 = a1 * sc;
                    u32x4 w; w.x = cvt_pk_bf16(v0[0], v0[1]); w.y = cvt_pk_bf16(v0[2], v0[3]); w.z = cvt_pk_bf16(v1[0], v1[1]); w.w = cvt_pk_bf16(v1[2], v1[3]);
                    *(u32x4*)(base + r * ld + cb + cl + bj * 128) = w;
                    if (fo) { float* p = fo + r * 512 + cb + cl + bj * 128; *(f32x4*)p = a0; *(f32x4*)(p + 4) = a1; }
                }
            }
    }
};


struct EpiRowOut {
    static constexpr bool PERM = true;
    bf16_t* O; float* SSQ;
    __device__ __forceinline__ void operator()(const f32x4 (&acc)[2][2][4][2], const pg8::Unit& u, int wr, int wc, int fr, int fq) const {
        const int row0 = u.pm * 256 + wr * 64 + fr; const int cl = u.pn * 256 + wc * 32 + 8 * fq;
#pragma unroll
        for (int ai = 0; ai < 2; ++ai)
#pragma unroll
            for (int m = 0; m < 4; ++m) {
                const size_t r = (size_t)(row0 + ai * 128 + m * 16); float s = 0.f;
#pragma unroll
                for (int bj = 0; bj < 2; ++bj) {
                    const f32x4 v0 = acc[ai][bj][m][0], v1 = acc[ai][bj][m][1];
                    s += (v0[0] * v0[0] + v0[1] * v0[1]) + (v0[2] * v0[2] + v0[3] * v0[3]) + (v1[0] * v1[0] + v1[1] * v1[1]) + (v1[2] * v1[2] + v1[3] * v1[3]);
                    u32x4 w; w.x = cvt_pk_bf16(v0[0], v0[1]); w.y = cvt_pk_bf16(v0[2], v0[3]); w.z = cvt_pk_bf16(v1[0], v1[1]); w.w = cvt_pk_bf16(v1[2], v1[3]);
                    *(u32x4*)(O + r * 1024 + cl + bj * 128) = w;
                }
                s += __shfl_xor(s, 16); s += __shfl_xor(s, 32);
                if (fq == 0) SSQ[r * 16 + u.pn * 4 + wc] = s;
            }
    }
};

struct EpiSlice {
    static constexpr bool PERM = false;
    float* SL; int ksub;
    __device__ __forceinline__ void operator()(const f32x4 (&acc)[2][2][4][2], const pg8::Unit& u, int wr, int wc, int fr, int fq) const {
        float* base = SL + (size_t)(u.kofs / ksub) * (256 * 1024) + (unsigned)((wr * 64 + fr) * 1024 + u.pn * 256 + wc * 32 + 4 * fq);
#pragma unroll
        for (int ai = 0; ai < 2; ++ai)
#pragma unroll
            for (int m = 0; m < 4; ++m) { float* rowp = base + (ai * 128 + m * 16) * 1024;
#pragma unroll
                for (int bj = 0; bj < 2; ++bj)
#pragma unroll
                    for (int n = 0; n < 2; ++n) *(f32x4*)(rowp + bj * 128 + n * 16) = acc[ai][bj][m][n]; }
    }
};

__device__ __forceinline__ float dpp_ror1(float v) { return __int_as_float(__builtin_amdgcn_update_dpp(0, __float_as_int(v), 0x121, 0xf, 0xf, false)); }
__device__ __forceinline__ float dpp_ror2(float v) { return __int_as_float(__builtin_amdgcn_update_dpp(0, __float_as_int(v), 0x122, 0xf, 0xf, false)); }

constexpr int CONVX_OFF = 131072;
struct EpiUp {
    static constexpr bool PERM = true;
    bf16_t* H; float* out; const float* conv_w; const float* conv_b; const float* cbuf; LAS unsigned char* lds;
    __device__ __forceinline__ void operator()(const f32x4 (&acc)[2][2][4][2], const pg8::Unit& u, int wr, int wc, int fr, int fq) const {
        LAS float* X = (LAS float*)(lds + CONVX_OFF);
        const int cg_ = wc * 32 + 8 * fq;
        const int col = u.pn * 128 + cg_;
        if (fr >= 14) {
#pragma unroll
            for (int ai = 0; ai < 2; ++ai) { LAS float* p = X + ((ai * 2 + wr) * 2 + (fr - 14)) * 128 + cg_; *(LAS f32x4*)p = acc[ai][0][3][0]; *(LAS f32x4*)(p + 4) = acc[ai][0][3][1]; }
        }
        f32x4 w0[2], w1[2], w2[2], cb[2];
#pragma unroll
        for (int n = 0; n < 2; ++n) { w0[n] = *(const f32x4*)(conv_w + col + 4 * n); w1[n] = *(const f32x4*)(conv_w + DFF + col + 4 * n); w2[n] = *(const f32x4*)(conv_w + 2 * DFF + col + 4 * n); cb[n] = *(const f32x4*)(conv_b + col + 4 * n); }
        asm volatile("s_waitcnt lgkmcnt(0)" ::: "memory"); __builtin_amdgcn_s_barrier(); asm volatile("" ::: "memory");
#pragma unroll
        for (int ai = 0; ai < 2; ++ai) {
            const int pai = (wr == 1) ? ai : ai - 1, pwr = wr ^ 1;
            f32x4 pr1[2], pr2[2];
#pragma unroll
            for (int n = 0; n < 2; ++n) {
                if (pai >= 0) { pr1[n] = *(const LAS f32x4*)(X + ((pai * 2 + pwr) * 2 + 1) * 128 + cg_ + 4 * n); pr2[n] = *(const LAS f32x4*)(X + ((pai * 2 + pwr) * 2 + (fr & 1)) * 128 + cg_ + 4 * n); }
                else { pr1[n] = (f32x4){0.f, 0.f, 0.f, 0.f}; pr2[n] = pr1[n]; }
            }
#pragma unroll
            for (int m = 0; m < 4; ++m) {
                const int lr = ai * 128 + wr * 64 + m * 16 + fr; const int gr = u.pm * 254 - 2 + lr;
                const bool store = (lr >= 2) && (gr < MT);
                int pos, bidx; const bool samp = gr >= MP;
                if (!samp) { pos = gr & (SEQ - 1); bidx = gr >> 11; } else { pos = (gr - MP) & 7; bidx = (gr - MP) >> 3; }
                const bool head_rows = __builtin_amdgcn_ballot_w64(pos < 2) != 0ull;
                const bool tail_rows = __builtin_amdgcn_ballot_w64(store && (samp ? pos >= 6 : pos >= SEQ - 2)) != 0ull;
                u32x4 hw;
#pragma unroll
                for (int n = 0; n < 2; ++n) {
                    const f32x4 g0 = acc[ai][0][m][n], uu = acc[ai][1][m][n]; f32x4 gm1, gm2, nr1, nr2;
#pragma unroll
                    for (int e = 0; e < 4; ++e) {
                        gm1[e] = __int_as_float(__builtin_amdgcn_update_dpp(__float_as_int(pr1[n][e]), __float_as_int(g0[e]), 0x111, 0xf, 0xf, false));
                        gm2[e] = __int_as_float(__builtin_amdgcn_update_dpp(__float_as_int(pr2[n][e]), __float_as_int(g0[e]), 0x112, 0xf, 0xf, false));
                        nr1[e] = dpp_ror1(g0[e]); nr2[e] = dpp_ror2(g0[e]);
                    }
                    pr1[n] = nr1; pr2[n] = nr2;
                    if (head_rows) {
                        if (!samp) { if (pos == 0) { gm1 = (f32x4){0.f, 0.f, 0.f, 0.f}; gm2 = gm1; } else if (pos == 1) gm2 = (f32x4){0.f, 0.f, 0.f, 0.f}; }
                        else if (store) { if (pos == 0) { gm1 = *(const f32x4*)(cbuf + (size_t)(bidx * 2 + 1) * DFF + col + 4 * n); gm2 = *(const f32x4*)(cbuf + (size_t)(bidx * 2) * DFF + col + 4 * n); }
                                          else if (pos == 1) gm2 = *(const f32x4*)(cbuf + (size_t)(bidx * 2 + 1) * DFF + col + 4 * n); }
                    }
                    const f32x4 c = cb[n] + w0[n] * gm2 + w1[n] * gm1 + w2[n] * g0;
                    const f32x2 ga = pg8::gelu_pk((f32x2){c[0], c[1]}), gb = pg8::gelu_pk((f32x2){c[2], c[3]});
                    const float h0 = ga.x * uu[0], h1 = ga.y * uu[1], h2 = gb.x * uu[2], h3 = gb.y * uu[3];
                    if (n == 0) { hw.x = cvt_pk_bf16(h0, h1); hw.y = cvt_pk_bf16(h2, h3); } else { hw.z = cvt_pk_bf16(h0, h1); hw.w = cvt_pk_bf16(h2, h3); }
                    if (tail_rows && store) {
                        if (!samp) { if (pos >= SEQ - 2) *(f32x4*)(out + O_CP + (size_t)(bidx * 2 + (pos - (SEQ - 2))) * DFF + col + 4 * n) = g0; }
                        else { if (pos >= 6) *(f32x4*)(out + O_CS + (size_t)(bidx * 2 + (pos - 6)) * DFF + col + 4 * n) = g0; }
                    }
                }
                if (store) *(u32x4*)(H + (size_t)gr * DFF + col) = hw;
            }
        }
    }
};

__device__ __forceinline__ unsigned pk2(float lo, float hi) { return cvt_pk_bf16(lo, hi); }
__device__ __forceinline__ void p0_transpose_item(const float* W, int ldw, int scol0, int k0, bf16_t* WT, int dK, int drow0, LAS float* scr, int lane) {
#pragma unroll 8
    for (int i = 0; i < 32; ++i) { const int kk = 2 * i + (lane >> 5); scr[kk * 33 + (lane & 31)] = W[(size_t)(k0 + kk) * ldw + scol0 + (lane & 31)]; }
    asm volatile("s_waitcnt lgkmcnt(0)" ::: "memory");
    const int c = lane & 7;
#pragma unroll
    for (int j = 0; j < 4; ++j) { const int n = (lane >> 3) + 8 * j; const LAS float* s = scr + (8 * c) * 33 + n;
        u32x4 o; o.x = pk2(s[0 * 33], s[1 * 33]); o.y = pk2(s[2 * 33], s[3 * 33]); o.z = pk2(s[4 * 33], s[5 * 33]); o.w = pk2(s[6 * 33], s[7 * 33]);
        *(u32x4*)(WT + (size_t)(drow0 + n) * dK + k0 + 8 * c) = o; }
    asm volatile("s_waitcnt lgkmcnt(0)" ::: "memory");
}
__device__ __forceinline__ void p0_gate_item(const float* w_in, const float* w_a2, int k0, int n0, bf16_t* WT, LAS float* scr, int lane) {
    float w2[16];
#pragma unroll
    for (int r = 0; r < 16; ++r) w2[r] = w_a2[r * 256 + n0 + (lane & 31)];
    for (int i = 0; i < 32; ++i) { const int kk = 2 * i + (lane >> 5); const float* a = w_in + (size_t)(k0 + kk) * DIN + 3072; float s = 0.f;
#pragma unroll
        for (int r = 0; r < 16; ++r) s += a[r] * w2[r];
        scr[kk * 33 + (lane & 31)] = s; }
    asm volatile("s_waitcnt lgkmcnt(0)" ::: "memory");
    const int c = lane & 7;
#pragma unroll
    for (int j = 0; j < 4; ++j) { const int n = (lane >> 3) + 8 * j; const LAS float* s = scr + (8 * c) * 33 + n;
        u32x4 o; o.x = pk2(s[0 * 33], s[1 * 33]); o.y = pk2(s[2 * 33], s[3 * 33]); o.z = pk2(s[4 * 33], s[5 * 33]); o.w = pk2(s[6 * 33], s[7 * 33]);
        *(u32x4*)(WT + (size_t)(3072 + n0 + n) * 1024 + k0 + 8 * c) = o; }
    asm volatile("s_waitcnt lgkmcnt(0)" ::: "memory");
}
__device__ __forceinline__ void rms_row_to_bf16(const float* xrow, const float* g, bf16_t* orow, int lane) {
    const f32x4* xr = (const f32x4*)xrow + lane; const f32x4* gr = (const f32x4*)g + lane;
    f32x4 v[4]; float s = 0.f;
#pragma unroll
    for (int j = 0; j < 4; ++j) { v[j] = xr[64 * j]; s += (v[j].x * v[j].x + v[j].y * v[j].y) + (v[j].z * v[j].z + v[j].w * v[j].w); }
    const float rs = rsqrtf(wave_sum(s) * (1.f / DM) + EPS);
    u32x2* o8 = (u32x2*)orow + lane;
#pragma unroll
    for (int j = 0; j < 4; ++j) { const f32x4 gg = gr[64 * j]; const f32x4 y = v[j] * rs * gg; u32x2 w; w.x = pk2(y.x, y.y); w.y = pk2(y.z, y.w); o8[64 * j] = w; }
}


__device__ __forceinline__ int crow(int r, int hi) { return (r & 3) + 8 * (r >> 2) + 4 * hi; }
typedef short v4i16_t __attribute__((ext_vector_type(4)));
__device__ __forceinline__ s16x4 vtr(const LAS unsigned char* p) { return __builtin_bit_cast(s16x4, __builtin_amdgcn_ds_read_tr16_b64_v4i16((LAS v4i16_t*)p)); }
__device__ __forceinline__ float swapmax(float v) { auto rr = __builtin_amdgcn_permlane32_swap(__float_as_uint(v), __float_as_uint(v), false, false); return fmaxf(__uint_as_float(rr[0]), __uint_as_float(rr[1])); }
__device__ __forceinline__ float swapsum(float v) { auto rr = __builtin_amdgcn_permlane32_swap(__float_as_uint(v), __float_as_uint(v), false, false); return __uint_as_float(rr[0]) + __uint_as_float(rr[1]); }
__device__ __forceinline__ u32x4 pack8(f32x4 a, f32x4 b) { u32x4 w; w.x = cvt_pk_bf16(a.x, a.y); w.y = cvt_pk_bf16(a.z, a.w); w.z = cvt_pk_bf16(b.x, b.y); w.w = cvt_pk_bf16(b.z, b.w); return w; }

constexpr float NEGF = -1e30f;
constexpr int VPITCH = 192;
constexpr int ATT_WLDS = 32 * VPITCH + 256;

struct AttnCtx { const bf16_t *QA, *KA, *VA; bf16_t* MIX; const float *ck, *cv; };

struct TileRegs { u32x4 k[8]; u32x4 v[8]; };

template <bool SAMPLE> __device__ __forceinline__ int tile_key(int ti, int j, int g, int r4, int ncls) {
    if (SAMPLE) { if (ti < 17) return 1536 + 32 * (16 - ti) + j; const int kk = ti - 17; return 16 * (4 * kk + (j >> 3)) + (j & 7); }
    if (ti < ncls) return 4 * (32 * (g - ti) + j) + r4;
    const int jj = ti - ncls + (g == 0 ? 4 : 0); return 128 * g - 128 + 32 * jj + j;
}
template <bool SAMPLE> __device__ __forceinline__ void tile_load(const AttnCtx& C, TileRegs& T, int ti, int b, int h, int g, int r4, int ncls, int lane) {
    const int r32 = lane & 31, hi = lane >> 5;
    if (SAMPLE && ti > 0) {
        { const int idx = tile_key<SAMPLE>(ti, r32, g, r4, ncls); const float* p = C.ck + (((unsigned)(b * WINB + idx) * 8u + h) * 64u + 8 * hi);
#pragma unroll
          for (int d0 = 0; d0 < 4; ++d0) { T.k[2 * d0] = *(const GAS u32x4*)(p + 16 * d0); T.k[2 * d0 + 1] = *(const GAS u32x4*)(p + 16 * d0 + 4); } }
#pragma unroll
        for (int i = 0; i < 4; ++i) { const int key = (lane >> 3) + 8 * i; const int idx = tile_key<SAMPLE>(ti, key, g, r4, ncls);
            const float* p = C.cv + (((unsigned)(b * WINB + idx) * 8u + h) * 64u + 8 * (lane & 7)); T.v[2 * i] = *(const GAS u32x4*)p; T.v[2 * i + 1] = *(const GAS u32x4*)(p + 4); }
    } else {
        unsigned rowb;
        { int key = tile_key<SAMPLE>(ti, r32, g, r4, ncls); if (SAMPLE) { key -= WINB; key = key > 7 ? 7 : key; rowb = (unsigned)(MP + b * 8 + key); } else rowb = (unsigned)(b * SEQ + key);
          const bf16_t* p = C.KA + (rowb * 512u + h * 64 + 8 * hi);
#pragma unroll
          for (int d0 = 0; d0 < 4; ++d0) T.k[d0] = *(const GAS u32x4*)(p + 16 * d0); }
#pragma unroll
        for (int i = 0; i < 4; ++i) { int key = tile_key<SAMPLE>(ti, (lane >> 3) + 8 * i, g, r4, ncls); if (SAMPLE) { key -= WINB; key = key > 7 ? 7 : key; rowb = (unsigned)(MP + b * 8 + key); } else rowb = (unsigned)(b * SEQ + key);
            T.v[i] = *(const GAS u32x4*)(C.VA + (rowb * 512u + h * 64 + 8 * (lane & 7))); }
    }
}

template <bool SAMPLE>
__device__ __forceinline__ void attn_item(const AttnCtx& C, int b, int h, int g, int r4, LAS unsigned char* wl, int lane_in) {
    int lane = lane_in; asm volatile("" : "+v"(lane));
    const int r32 = lane & 31, hi = lane >> 5;
    LAS float* wsf = (LAS float*)(wl + 32 * VPITCH);
    const int ncls = g + 1;
    const int nt = SAMPLE ? 41 : (ncls + (g == 0 ? 4 : 8));
    bf16x8 qf[4];
    {
        unsigned qrow; if (SAMPLE) qrow = (unsigned)(MP + b * 8 + (r32 & 7)); else qrow = (unsigned)(b * SEQ + 4 * (32 * g + r32) + r4);
        const bf16_t* p = C.QA + (qrow * 512u + h * 64 + 8 * hi);
#pragma unroll
        for (int d0 = 0; d0 < 4; ++d0) qf[d0] = *(const bf16x8*)(p + 16 * d0);
    }
    float mrun = NEGF, lrun = 0.f;
    f32x16 o0 = {}, o1 = {};
    TileRegs T;
    tile_load<SAMPLE>(C, T, 0, b, h, g, r4, ncls, lane);
    const int vrd = (4 * hi + ((lane & 15) >> 2)) * VPITCH + (((lane >> 4) & 1) * 16 + (lane & 3) * 4) * 2;
    for (int ti = 0; ti < nt; ++ti) {
        bf16x8 kf[4];
        const bool f32path = SAMPLE && ti > 0;
        if (f32path) {
#pragma unroll
            for (int d0 = 0; d0 < 4; ++d0) kf[d0] = __builtin_bit_cast(bf16x8, pack8(__builtin_bit_cast(f32x4, T.k[2 * d0]), __builtin_bit_cast(f32x4, T.k[2 * d0 + 1])));
#pragma unroll
            for (int i = 0; i < 4; ++i) *(LAS u32x4*)(wl + ((lane >> 3) + 8 * i) * VPITCH + (lane & 7) * 16) = pack8(__builtin_bit_cast(f32x4, T.v[2 * i]), __builtin_bit_cast(f32x4, T.v[2 * i + 1]));
        } else {
#pragma unroll
            for (int d0 = 0; d0 < 4; ++d0) kf[d0] = __builtin_bit_cast(bf16x8, T.k[d0]);
#pragma unroll
            for (int i = 0; i < 4; ++i) *(LAS u32x4*)(wl + ((lane >> 3) + 8 * i) * VPITCH + (lane & 7) * 16) = T.v[i];
        }
        if (ti + 1 < nt) tile_load<SAMPLE>(C, T, ti + 1, b, h, g, r4, ncls, lane);
        f32x16 p = {};
#pragma unroll
        for (int d0 = 0; d0 < 4; ++d0) p = __builtin_amdgcn_mfma_f32_32x32x16_bf16(kf[d0], qf[d0], p, 0, 0, 0);
        if (SAMPLE) {
            if (ti < 17) { const int dbase = (WINB + r32) - (1536 + 32 * (16 - ti));
#pragma unroll
                for (int r = 0; r < 16; ++r) { const int d = dbase - crow(r, hi); const int mult = (d >= 0 && d <= 128) + (d >= 0 && d <= 512 && !(d & 3)) + (d >= 0 && !(d & 15));
                    p[r] = (mult == 0 || r32 >= 8) ? NEGF : p[r] + (mult == 1 ? 0.f : (mult == 2 ? 1.f : 1.5849625f)); } }
            else {
#pragma unroll
                for (int r = 0; r < 16; ++r) p[r] = ((crow(r, hi) & 7) == r32) ? p[r] : NEGF; }
        } else {
            if (ti < ncls) { const int dbase = (32 * g + r32) - 32 * (g - ti);
#pragma unroll
                for (int r = 0; r < 16; ++r) { const int d = dbase - crow(r, hi); const int mult = (d >= 0 && d <= 128) + (d >= 0 && !(d & 3));
                    p[r] = mult == 0 ? NEGF : p[r] + (mult == 2 ? 1.f : 0.f); } }
            else { const int jj = ti - ncls + (g == 0 ? 4 : 0); const int dbase = (128 * g + 4 * r32 + r4) - (128 * g - 128 + 32 * jj);
#pragma unroll
                for (int r = 0; r < 16; ++r) { const int d = dbase - crow(r, hi); p[r] = (d >= 0 && d <= 128) ? p[r] : NEGF; } }
        }
        float rm = p[0];
#pragma unroll
        for (int r = 1; r < 16; ++r) rm = fmaxf(rm, p[r]);
        rm = swapmax(rm);
        const float mnew = fmaxf(mrun, rm);
        const float f = __builtin_amdgcn_exp2f(mrun - mnew);
        mrun = mnew;
        float ls = 0.f;
#pragma unroll
        for (int r = 0; r < 16; ++r) { p[r] = __builtin_amdgcn_exp2f(p[r] - mnew); ls += p[r]; }
        lrun = lrun * f + ls;
        if (hi == 0) wsf[r32] = f;
        u32x4 pa0, pa1;
        pa0.x = cvt_pk_bf16(p[0], p[1]); pa0.y = cvt_pk_bf16(p[2], p[3]); pa0.z = cvt_pk_bf16(p[4], p[5]); pa0.w = cvt_pk_bf16(p[6], p[7]);
        pa1.x = cvt_pk_bf16(p[8], p[9]); pa1.y = cvt_pk_bf16(p[10], p[11]); pa1.z = cvt_pk_bf16(p[12], p[13]); pa1.w = cvt_pk_bf16(p[14], p[15]);
#pragma unroll
        for (int r = 0; r < 16; ++r) { const float fr_ = wsf[crow(r, hi)]; o0[r] *= fr_; o1[r] *= fr_; }
#pragma unroll
        for (int sl = 0; sl < 2; ++sl) {
            const bf16x8 pa = __builtin_bit_cast(bf16x8, sl == 0 ? pa0 : pa1);
#pragma unroll
            for (int c = 0; c < 2; ++c) {
                const s16x4 lo = vtr(wl + vrd + (16 * sl) * VPITCH + 64 * c), hi4 = vtr(wl + vrd + (16 * sl + 8) * VPITCH + 64 * c);
                const bf16x8 vf = (bf16x8){lo[0], lo[1], lo[2], lo[3], hi4[0], hi4[1], hi4[2], hi4[3]};
                if (c == 0) o0 = __builtin_amdgcn_mfma_f32_32x32x16_bf16(pa, vf, o0, 0, 0, 0); else o1 = __builtin_amdgcn_mfma_f32_32x32x16_bf16(pa, vf, o1, 0, 0, 0);
            }
        }
    }
    const float lt = swapsum(lrun);
    if (hi == 0) wsf[32 + r32] = 1.f / lt;
#pragma unroll
    for (int r = 0; r < 16; ++r) {
        const int q = crow(r, hi); const float rl = wsf[32 + q];
        unsigned orow; bool ok = true;
        if (SAMPLE) { ok = q < 8; orow = (unsigned)(MP + b * 8 + (q & 7)); } else orow = (unsigned)(b * SEQ + 4 * (32 * g + q) + r4);
        if (ok) { bf16_t* op = C.MIX + (orow * 1024u + h * 64 + r32);
            op[0] = (bf16_t)(cvt_pk_bf16(o0[r] * rl, 0.f) & 0xffffu); op[32] = (bf16_t)(cvt_pk_bf16(o1[r] * rl, 0.f) & 0xffffu); }
    }
}

struct GlaCtx { const bf16_t *QB, *KB, *VB, *RB; const float* LF; bf16_t* MIX; const float* gnorm; };
constexpr int GQ_P = 72, GT_P = 40;
constexpr int G_QE = 0, G_KE = 32 * GQ_P * 2, G_KT = G_KE + 32 * GQ_P * 2, G_EB = G_KT + 64 * GT_P * 2, G_BUF = G_EB + 256;
constexpr int GL_V = 2 * G_BUF;
constexpr int GL_O = GL_V + 2 * 4 * 2048;
constexpr int GL_END = GL_O + 2 * 4 * 4608;
static_assert(GL_END <= 131072, "gla lds");
#define LDS_BARRIER() do { asm volatile("s_waitcnt lgkmcnt(0)" ::: "memory"); __builtin_amdgcn_s_barrier(); asm volatile("" ::: "memory"); } while (0)
typedef float f32x8 __attribute__((ext_vector_type(8)));
typedef unsigned u32x8 __attribute__((ext_vector_type(8)));
typedef unsigned u32x16 __attribute__((ext_vector_type(16)));
struct GlaPre { f32x8 lf; u32x8 q, k; u32x4 v0, v1; };

template <int nvalid> __device__ __forceinline__ void gla_h_loads(const GlaCtx& C, GlaPre& P, unsigned t0, int h, int dk, int tg, int dvs, int lane) {
    const bool ok = 8 * tg < nvalid;
    const unsigned off = (t0 + (ok ? 8 * tg : 0)) * 256u + h * 64 + dk;
    const GAS float* lp = (const GAS float*)(C.LF + off); const GAS bf16_t* qp = (const GAS bf16_t*)(C.QB + off); const GAS bf16_t* kp = (const GAS bf16_t*)(C.KB + off);
#pragma unroll
    for (int e = 0; e < 8; ++e) { P.lf[e] = lp[e * 256]; P.q[e] = (unsigned)qp[e * 256]; P.k[e] = (unsigned)kp[e * 256]; }
    const int i = lane >> 1; const bool okv = i < nvalid; const GAS bf16_t* p = (const GAS bf16_t*)(C.VB + ((t0 + (okv ? i : 0)) * 512u + h * 128 + 32 * dvs + 16 * (lane & 1)));
    P.v0 = *(const GAS u32x4*)p; P.v1 = *(const GAS u32x4*)(p + 8);
}
struct GlaGate { u32x4 g0, g1; };
template <int nvalid> __device__ __forceinline__ void gla_h_interval(const GlaCtx& C, LAS unsigned char* lds, GlaPre& P, GlaGate& G, const f32x4 (&gn)[4], int j, int nchunk, int hw, int lane, unsigned row0, int h) {
    const int tg = lane >> 4, dkl = lane & 15, dk = 16 * hw + dkl;
    const int ft = lane >> 3, dvg = lane & 7;
    const bool fin_ok = 8 * hw < nvalid;
    if (j >= 2 && fin_ok) {
        const int c = j - 2; const int ob = c & 1;
        const LAS float* op = (const LAS float*)(lds + GL_O + (ob * 4 + (dvg >> 1)) * 4608) + (8 * hw + ft) * 36 + 16 * (dvg & 1);
        f32x4 o[4]; float s = 0.f;
#pragma unroll
        for (int k4 = 0; k4 < 4; ++k4) { o[k4] = *(const LAS f32x4*)(op + 4 * k4); s += (o[k4].x * o[k4].x + o[k4].y * o[k4].y) + (o[k4].z * o[k4].z + o[k4].w * o[k4].w); }
        s += __shfl_xor(s, 1); s += __shfl_xor(s, 2); s += __shfl_xor(s, 4);
        const float rs = rsqrtf(s * (1.f / 128.f) + EPS);
        const u32x4 g0 = G.g0, g1 = G.g1;
        float gt[16];
        gt[0] = __uint_as_float(g0.x << 16); gt[1] = __uint_as_float(g0.x & 0xffff0000u); gt[2] = __uint_as_float(g0.y << 16); gt[3] = __uint_as_float(g0.y & 0xffff0000u);
        gt[4] = __uint_as_float(g0.z << 16); gt[5] = __uint_as_float(g0.z & 0xffff0000u); gt[6] = __uint_as_float(g0.w << 16); gt[7] = __uint_as_float(g0.w & 0xffff0000u);
        gt[8] = __uint_as_float(g1.x << 16); gt[9] = __uint_as_float(g1.x & 0xffff0000u); gt[10] = __uint_as_float(g1.y << 16); gt[11] = __uint_as_float(g1.y & 0xffff0000u);
        gt[12] = __uint_as_float(g1.z << 16); gt[13] = __uint_as_float(g1.z & 0xffff0000u); gt[14] = __uint_as_float(g1.w << 16); gt[15] = __uint_as_float(g1.w & 0xffff0000u);
        float val[16];
#pragma unroll
        for (int k = 0; k < 16; ++k) { const float rg = gt[k]; val[k] = o[k >> 2][k & 3] * rs * gn[k >> 2][k & 3] * rg * __builtin_amdgcn_rcpf(1.f + __expf(-rg)); }
        u32x4 w0, w1;
        w0.x = cvt_pk_bf16(val[0], val[1]); w0.y = cvt_pk_bf16(val[2], val[3]); w0.z = cvt_pk_bf16(val[4], val[5]); w0.w = cvt_pk_bf16(val[6], val[7]);
        w1.x = cvt_pk_bf16(val[8], val[9]); w1.y = cvt_pk_bf16(val[10], val[11]); w1.z = cvt_pk_bf16(val[12], val[13]); w1.w = cvt_pk_bf16(val[14], val[15]);
        bf16_t* mp = C.MIX + ((row0 + 32u * c + 8 * hw + ft) * 1024u + 512 + h * 128 + 16 * dvg);
        *(GAS u32x4*)mp = w0; *(GAS u32x4*)(mp + 8) = w1;
    }
    if (j < nchunk) {
        const int buf = j & 1;
        LAS unsigned char* sh = lds + buf * G_BUF;
        LAS bf16_t* qe_l = (LAS bf16_t*)(sh + G_QE); LAS bf16_t* ke_l = (LAS bf16_t*)(sh + G_KE); LAS bf16_t* kt_l = (LAS bf16_t*)(sh + G_KT); LAS float* eb_l = (LAS float*)(sh + G_EB);
        LAS unsigned char* vl = lds + GL_V + (buf * 4 + hw) * 2048;
        const bool okp = 8 * tg < nvalid, okv = (lane >> 1) < nvalid;
        if (!okp) { P.lf = (f32x8){0.f, 0.f, 0.f, 0.f, 0.f, 0.f, 0.f, 0.f}; P.q = (u32x8){0u, 0u, 0u, 0u, 0u, 0u, 0u, 0u}; P.k = P.q; }
        if (!okv) { P.v0 = (u32x4){0u, 0u, 0u, 0u}; P.v1 = P.v0; }
        f32x8 cs; float run = 0.f;
#pragma unroll
        for (int e = 0; e < 8; ++e) { run += P.lf[e]; cs[e] = run; }
        float offs = 0.f, tot = 0.f;
#pragma unroll
        for (int t = 0; t < 4; ++t) { const float Tt = __shfl(run, dkl + 16 * t); tot += Tt; offs += (t < tg) ? Tt : 0.f; }
        u32x8 kb;
#pragma unroll
        for (int e = 0; e < 8; ++e) { const float bb = offs + cs[e]; const float eb = __expf(bb), ei = __expf(-bb); const int i = 8 * tg + e;
            qe_l[i * GQ_P + dk] = (bf16_t)(cvt_pk_bf16(__uint_as_float(P.q[e] << 16) * 0.125f * eb, 0.f) & 0xffffu);
            kb[e] = cvt_pk_bf16(__uint_as_float(P.k[e] << 16) * ei, 0.f) & 0xffffu;
            ke_l[i * GQ_P + dk] = (bf16_t)kb[e]; }
        u32x4 w; w.x = kb[0] | (kb[1] << 16); w.y = kb[2] | (kb[3] << 16); w.z = kb[4] | (kb[5] << 16); w.w = kb[6] | (kb[7] << 16);
        *(LAS u32x4*)(kt_l + dk * GT_P + 8 * tg) = w;
        if (tg == 0) eb_l[dk] = __expf(tot);
        *(LAS u32x4*)(vl + (lane >> 1) * 64 + (lane & 1) * 32) = P.v0; *(LAS u32x4*)(vl + (lane >> 1) * 64 + (lane & 1) * 32 + 16) = P.v1;
    }
    if (j + 3 < nchunk) gla_h_loads<nvalid>(C, P, row0 + 32u * (j + 3), h, dk, tg, hw, lane);
    if (j + 1 < nchunk && fin_ok) { const bf16_t* rp = C.RB + ((row0 + 32u * (j + 1) + 8 * hw + ft) * 512u + h * 128 + 16 * dvg); G.g0 = *(const GAS u32x4*)rp; G.g1 = *(const GAS u32x4*)(rp + 8); }
    if (j <= nchunk) LDS_BARRIER();
}
template <int nvalid> __device__ __forceinline__ void gla_h_wave(const GlaCtx& C, LAS unsigned char* lds, int hw  , int lane, unsigned row0, int h, int nchunk) {
    const int tg = lane >> 4, dkl = lane & 15, dk = 16 * hw + dkl;
    const int ft = lane >> 3, dvg = lane & 7;
    f32x4 gn[4];
#pragma unroll
    for (int k4 = 0; k4 < 4; ++k4) gn[k4] = *(const f32x4*)(C.gnorm + h * 128 + 16 * dvg + 4 * k4);
    GlaPre P0, P1, P2; GlaGate G0 = {}, G1 = {}, G2 = {};
    gla_h_loads<nvalid>(C, P0, row0, h, dk, tg, hw, lane);
    if (1 < nchunk) gla_h_loads<nvalid>(C, P1, row0 + 32u, h, dk, tg, hw, lane);
    if (2 < nchunk) gla_h_loads<nvalid>(C, P2, row0 + 64u, h, dk, tg, hw, lane);
    if (8 * hw < nvalid) { const bf16_t* rp = C.RB + ((row0 + 8 * hw + ft) * 512u + h * 128 + 16 * dvg); G0.g0 = *(const GAS u32x4*)rp; G0.g1 = *(const GAS u32x4*)(rp + 8); }
    for (int j = 0; j <= nchunk + 1; j += 3) {
        gla_h_interval<nvalid>(C, lds, P0, G1, gn, j, nchunk, hw, lane, row0, h);
        if (j + 1 <= nchunk + 1) gla_h_interval<nvalid>(C, lds, P1, G2, gn, j + 1, nchunk, hw, lane, row0, h);
        if (j + 2 <= nchunk + 1) gla_h_interval<nvalid>(C, lds, P2, G0, gn, j + 2, nchunk, hw, lane, row0, h);
    }
}
template <int nvalid> __device__ __forceinline__ void gla_m_wave(LAS unsigned char* lds, int dvs, int lane, int nchunk, const float* s_in, float* s_out) {
    const int r32 = lane & 31, hi = lane >> 5;
    f32x16 S0 = {}, S1 = {};
    unsigned soff = (unsigned)(4 * hi * 128 + 32 * dvs + r32); asm volatile("" : "+v"(soff));
    if (s_in) {
#pragma unroll
        for (int r = 0; r < 16; ++r) { const unsigned o_ = soff + (unsigned)(((r & 3) + 8 * (r >> 2)) * 128); S0[r] = s_in[o_]; S1[r] = s_in[o_ + 4096u]; }
    }
    const int vrd = (4 * hi + ((lane & 15) >> 2)) * 64 + (((lane >> 4) & 1) * 16 + (lane & 3) * 4) * 2;
    LDS_BARRIER();
    for (int c = 0; c < nchunk; ++c) {
        const int buf = c & 1;
        LAS unsigned char* sh = lds + buf * G_BUF;
        LAS bf16_t* qe_l = (LAS bf16_t*)(sh + G_QE); LAS bf16_t* ke_l = (LAS bf16_t*)(sh + G_KE); LAS bf16_t* kt_l = (LAS bf16_t*)(sh + G_KT); LAS float* eb_l = (LAS float*)(sh + G_EB);
        const LAS unsigned char* vl = lds + GL_V + (buf * 4 + dvs) * 2048;
        f32x16 at = {};
#pragma unroll
        for (int s = 0; s < 4; ++s) { const bf16x8 a = *(const LAS bf16x8*)(ke_l + r32 * GQ_P + 16 * s + 8 * hi), bq = *(const LAS bf16x8*)(qe_l + r32 * GQ_P + 16 * s + 8 * hi);
            at = __builtin_amdgcn_mfma_f32_32x32x16_bf16(a, bq, at, 0, 0, 0); }
#pragma unroll
        for (int r = 0; r < 16; ++r) at[r] = (crow(r, hi) <= r32) ? at[r] : 0.f;
        u32x4 pa0, pa1;
        pa0.x = cvt_pk_bf16(at[0], at[1]); pa0.y = cvt_pk_bf16(at[2], at[3]); pa0.z = cvt_pk_bf16(at[4], at[5]); pa0.w = cvt_pk_bf16(at[6], at[7]);
        pa1.x = cvt_pk_bf16(at[8], at[9]); pa1.y = cvt_pk_bf16(at[10], at[11]); pa1.z = cvt_pk_bf16(at[12], at[13]); pa1.w = cvt_pk_bf16(at[14], at[15]);
        bf16x8 vf0, vf1;
        { const s16x4 lo = vtr(vl + vrd), h4 = vtr(vl + vrd + 8 * 64); vf0 = (bf16x8){lo[0], lo[1], lo[2], lo[3], h4[0], h4[1], h4[2], h4[3]}; }
        { const s16x4 lo = vtr(vl + vrd + 16 * 64), h4 = vtr(vl + vrd + 24 * 64); vf1 = (bf16x8){lo[0], lo[1], lo[2], lo[3], h4[0], h4[1], h4[2], h4[3]}; }
        f32x16 o = {};
        o = __builtin_amdgcn_mfma_f32_32x32x16_bf16(__builtin_bit_cast(bf16x8, pa0), vf0, o, 0, 0, 0);
        o = __builtin_amdgcn_mfma_f32_32x32x16_bf16(__builtin_bit_cast(bf16x8, pa1), vf1, o, 0, 0, 0);
#pragma unroll
        for (int s = 0; s < 4; ++s) {
            const u32x2 q0 = *(const LAS u32x2*)(qe_l + r32 * GQ_P + 16 * s + 4 * hi), q1 = *(const LAS u32x2*)(qe_l + r32 * GQ_P + 16 * s + 8 + 4 * hi);
            const u32x4 qa = (u32x4){q0.x, q0.y, q1.x, q1.y};
            u32x4 sb;
            if (s == 0) { sb.x = cvt_pk_bf16(S0[0], S0[1]); sb.y = cvt_pk_bf16(S0[2], S0[3]); sb.z = cvt_pk_bf16(S0[4], S0[5]); sb.w = cvt_pk_bf16(S0[6], S0[7]); }
            else if (s == 1) { sb.x = cvt_pk_bf16(S0[8], S0[9]); sb.y = cvt_pk_bf16(S0[10], S0[11]); sb.z = cvt_pk_bf16(S0[12], S0[13]); sb.w = cvt_pk_bf16(S0[14], S0[15]); }
            else if (s == 2) { sb.x = cvt_pk_bf16(S1[0], S1[1]); sb.y = cvt_pk_bf16(S1[2], S1[3]); sb.z = cvt_pk_bf16(S1[4], S1[5]); sb.w = cvt_pk_bf16(S1[6], S1[7]); }
            else { sb.x = cvt_pk_bf16(S1[8], S1[9]); sb.y = cvt_pk_bf16(S1[10], S1[11]); sb.z = cvt_pk_bf16(S1[12], S1[13]); sb.w = cvt_pk_bf16(S1[14], S1[15]); }
            o = __builtin_amdgcn_mfma_f32_32x32x16_bf16(__builtin_bit_cast(bf16x8, qa), __builtin_bit_cast(bf16x8, sb), o, 0, 0, 0);
        }
        { LAS float* ol = (LAS float*)(lds + GL_O + (buf * 4 + dvs) * 4608);
#pragma unroll
          for (int r = 0; r < 16; ++r) ol[crow(r, hi) * 36 + r32] = o[r]; }
        {
            const u32x2 a0 = *(const LAS u32x2*)(kt_l + r32 * GT_P + 4 * hi), a1 = *(const LAS u32x2*)(kt_l + r32 * GT_P + 8 + 4 * hi);
            const u32x2 c0 = *(const LAS u32x2*)(kt_l + (32 + r32) * GT_P + 4 * hi), c1 = *(const LAS u32x2*)(kt_l + (32 + r32) * GT_P + 8 + 4 * hi);
            S0 = __builtin_amdgcn_mfma_f32_32x32x16_bf16(__builtin_bit_cast(bf16x8, (u32x4){a0.x, a0.y, a1.x, a1.y}), vf0, S0, 0, 0, 0);
            S1 = __builtin_amdgcn_mfma_f32_32x32x16_bf16(__builtin_bit_cast(bf16x8, (u32x4){c0.x, c0.y, c1.x, c1.y}), vf0, S1, 0, 0, 0);
        }
        {
            const u32x2 a0 = *(const LAS u32x2*)(kt_l + r32 * GT_P + 16 + 4 * hi), a1 = *(const LAS u32x2*)(kt_l + r32 * GT_P + 24 + 4 * hi);
            const u32x2 c0 = *(const LAS u32x2*)(kt_l + (32 + r32) * GT_P + 16 + 4 * hi), c1 = *(const LAS u32x2*)(kt_l + (32 + r32) * GT_P + 24 + 4 * hi);
            S0 = __builtin_amdgcn_mfma_f32_32x32x16_bf16(__builtin_bit_cast(bf16x8, (u32x4){a0.x, a0.y, a1.x, a1.y}), vf1, S0, 0, 0, 0);
            S1 = __builtin_amdgcn_mfma_f32_32x32x16_bf16(__builtin_bit_cast(bf16x8, (u32x4){c0.x, c0.y, c1.x, c1.y}), vf1, S1, 0, 0, 0);
        }
#pragma unroll
        for (int r = 0; r < 16; ++r) { S0[r] *= eb_l[crow(r, hi)]; S1[r] *= eb_l[32 + crow(r, hi)]; }
        LDS_BARRIER();
    }
    if (s_out) {
        unsigned soff2 = (unsigned)(4 * hi * 128 + 32 * dvs + r32); asm volatile("" : "+v"(soff2));
#pragma unroll
        for (int r = 0; r < 16; ++r) { const unsigned o_ = soff2 + (unsigned)(((r & 3) + 8 * (r >> 2)) * 128); s_out[o_] = S0[r]; s_out[o_ + 4096u] = S1[r]; }
    }
}

#define XB_TMO      128
#define XB_XCNT(j)  (256  + 64 * (j))
#define XB_XSUB(j)  (1280 + 64 * (j))
#define XB_XGEN(j)  (2304 + 64 * (j))
#define XB_TOP      3328
#define XB_TOPGEN   3392
#define XCD_BAR_WORDS 3456
#define XB_SPIN_CAP (1u << 18)
__device__ __forceinline__ unsigned xb_ld(unsigned* p)              { return __hip_atomic_load(p, __ATOMIC_RELAXED, __HIP_MEMORY_SCOPE_AGENT); }
__device__ __forceinline__ unsigned xb_add(unsigned* p, unsigned v) { return __hip_atomic_fetch_add(p, v, __ATOMIC_RELAXED, __HIP_MEMORY_SCOPE_AGENT); }
__device__ __forceinline__ unsigned xb_xcc_id() { return (unsigned)__builtin_amdgcn_s_getreg((3 << 11) | 20) & 0xFu; }
#define XB_SPIN(cond, bar) do { unsigned _sp = 0; while (cond) { __builtin_amdgcn_s_sleep(1); \
    if ((++_sp & 255u) == 0u) { if (xb_ld(&(bar)[XB_TMO])) break; if (_sp > XB_SPIN_CAP) { atomicAdd(&(bar)[XB_TMO], 1u); break; } } } } while (0)
struct XcdBarrier { unsigned* bar; unsigned x; volatile LAS unsigned* st; };
__device__ __forceinline__ XcdBarrier xcd_barrier_post(unsigned* bar, volatile LAS unsigned* st) {
    XcdBarrier b; b.bar = bar; b.x = xb_xcc_id(); b.st = st;
    if (threadIdx.x == 0) (void)xb_add(&bar[XB_XCNT(b.x)], 1u);
    return b;
}
__device__ __forceinline__ void xcd_barrier_complete(unsigned* bar, unsigned x, unsigned& nloc, unsigned& nx) {
    const unsigned G = gridDim.x * gridDim.y * gridDim.z;
    unsigned sum, cnt, mine, sp = 0u;
    for (;;) {
        sum = 0u; cnt = 0u; mine = 0u;
#pragma unroll
        for (unsigned j = 0; j < 16; ++j) { const unsigned c = xb_ld(&bar[XB_XCNT(j)]); sum += c; cnt += (c > 0u) ? 1u : 0u; mine = (j == x) ? c : mine; }
        if (sum == G) break;
        __builtin_amdgcn_s_sleep(1);
        if ((++sp & 255u) == 0u) { if (xb_ld(&bar[XB_TMO])) break; if (sp > XB_SPIN_CAP) { atomicAdd(&bar[XB_TMO], 1u); break; } }
    }
    nloc = mine > 0u ? mine : 1u; nx = cnt > 0u ? cnt : 1u;
}
__device__ __forceinline__ void xcd_barrier(const XcdBarrier& b, int wave0) {
    asm volatile("s_waitcnt vmcnt(0)" ::: "memory");
    __syncthreads();
    if (wave0 == 0 && lane_id_v() == 0) {
        unsigned* bar = b.bar;
        __builtin_amdgcn_s_waitcnt(0);
        unsigned nloc = b.st[0], nx = b.st[1];
        if (nloc == 0u) { xcd_barrier_complete(bar, b.x, nloc, nx); b.st[0] = nloc; b.st[1] = nx; }
        const unsigned old = xb_add(&bar[XB_XSUB(b.x)], 1u);
        const unsigned gen = old / nloc;
        if (old + 1u == (gen + 1u) * nloc) {
            __builtin_amdgcn_fence(__ATOMIC_RELEASE, "agent");
            asm volatile("s_waitcnt vmcnt(0)" ::: "memory");
            const unsigned og = xb_add(&bar[XB_TOP], 1u);
            const unsigned tg = og / nx;
            if (og + 1u == (tg + 1u) * nx) xb_add(&bar[XB_TOPGEN], 1u);
            else XB_SPIN(xb_ld(&bar[XB_TOPGEN]) == tg, bar);
            __builtin_amdgcn_fence(__ATOMIC_ACQUIRE, "agent");
            xb_add(&bar[XB_XGEN(b.x)], 1u);
            asm volatile("s_waitcnt vmcnt(0)" ::: "memory");
        } else {
            XB_SPIN(xb_ld(&bar[XB_XGEN(b.x)]) == gen, bar);
            __builtin_amdgcn_fence(__ATOMIC_ACQUIRE, "agent");
            asm volatile("s_waitcnt vmcnt(0)" ::: "memory");
        }
    }
    __syncthreads();
}

constexpr int LDS_BYTES = 147456;

__global__ void __launch_bounds__(512, 2) hymba_fwd(Args args) {
    extern __shared__ __attribute__((aligned(16))) unsigned char lds_raw[];
    LAS unsigned char* lds = (LAS unsigned char*)lds_raw;
#define PHASE_IDS() const int lane = lane_id_v(); const int wave = wave0; (void)lane; (void)wave
    const int G = gridDim.x, bx = blockIdx.x;
    const int wave0 = __builtin_amdgcn_readfirstlane((int)(threadIdx.x >> 6));
    if (threadIdx.x < 4) ((LAS unsigned*)(lds + XBST_OFF))[threadIdx.x] = 0u;
    __syncthreads();
    const XcdBarrier xbar = xcd_barrier_post((unsigned*)(args.ws + WS_CTL) + 4096, (volatile LAS unsigned*)(lds + XBST_OFF));
    const int vcu = (G % 8 == 0) ? (bx % 8) * (G / 8) + bx / 8 : bx;
    const float* x_prompt = args.in[0]; const float* x_sample = args.in[1];
    const float* w_in = args.in[6]; const float* w_a2 = args.in[7]; const float* b_a = args.in[8];
    const float* w_o = args.in[10]; const float* g_pre_mix = args.in[11];
    const float* w_up = args.in[15]; const float* w_down = args.in[18];
#define PHASE_WS() unsigned char* ws = args.ws; asm volatile("" : "+s"(ws))

    {
        PHASE_IDS(); PHASE_WS();
        bf16_t* WinT = (bf16_t*)(ws + WS_WIN); bf16_t* WoT = (bf16_t*)(ws + WS_WO); bf16_t* WupT = (bf16_t*)(ws + WS_WUP); bf16_t* WdT = (bf16_t*)(ws + WS_WD); bf16_t* XN = (bf16_t*)(ws + WS_XN + 4096);
        LAS float* scr = (LAS float*)(lds + wave * 16384);
        const int gw = vcu * 8 + wave, NGW = G * 8;
        constexpr int I_IN = 16 * 96, I_G = 16 * 8, I_O = 16 * 32, I_UP = 16 * 176, I_D = 44 * 32;
        constexpr int NITEMS = I_IN + I_G + I_O + I_UP + I_D;
        for (int it = gw; it < NITEMS; it += NGW) {
            int r = it;
            if (r < I_IN) { const int kb = r / 96, nb = r % 96; p0_transpose_item(w_in, DIN, 32 * nb, 64 * kb, WinT, 1024, 32 * nb, scr, lane); continue; } r -= I_IN;
            if (r < I_G) { const int kb = r / 8, nb = r % 8; p0_gate_item(w_in, w_a2, 64 * kb, 32 * nb, WinT, scr, lane); continue; } r -= I_G;
            if (r < I_O) { const int kb = r / 32, nb = r % 32; p0_transpose_item(w_o, 1024, 32 * nb, 64 * kb, WoT, 1024, 32 * nb, scr, lane); continue; } r -= I_O;
            if (r < I_UP) { const int kb = r / 176, nb = r % 176; const int n0 = 32 * nb, t = n0 >> 8, w = n0 & 255;
                const int sc = (w < 128) ? (128 * t + w) : (DFF + 128 * t + (w - 128));
                p0_transpose_item(w_up, 2 * DFF, sc, 64 * kb, WupT, 1024, n0, scr, lane); continue; } r -= I_UP;
            { const int kb = r / 32, nb = r % 32; p0_transpose_item(w_down, 1024, 32 * nb, 64 * kb, WdT, DFF, 32 * nb, scr, lane); }
        }
        for (int m = gw; m < MT; m += NGW) {
            const float* xr = (m < MP) ? x_prompt + (size_t)m * DM : x_sample + (size_t)(m - MP) * DM;
            rms_row_to_bf16(xr, g_pre_mix, XN + (size_t)m * DM, lane);
        }
    }
    xcd_barrier(xbar, wave0);

    {
        PHASE_WS();
        pg8::Gemm g{(bf16_t*)(ws + WS_XN + 4096), (bf16_t*)(ws + WS_WIN), 1024, 256, 1024}; pg8::StaticOrder S; S.init(MT / 256, NIN / 256, G, bx);
        EpiInProj E{(bf16_t*)(ws + WS_QA), (bf16_t*)(ws + WS_KA), (bf16_t*)(ws + WS_VA), (bf16_t*)(ws + WS_QB), (bf16_t*)(ws + WS_KB), (bf16_t*)(ws + WS_VB), (bf16_t*)(ws + WS_RB),
                    (float*)(ws + WS_LF), args.out, b_a};
        pg8::gemm_phase<EpiInProj, pg8::StaticOrder>(lds, g, S, E, wave0);
    }
    xcd_barrier(xbar, wave0);

    {
        PHASE_IDS(); PHASE_WS();
        bf16_t* MIX = (bf16_t*)(ws + WS_MIX);
        GlaCtx GC{(const bf16_t*)(ws + WS_QB), (const bf16_t*)(ws + WS_KB), (const bf16_t*)(ws + WS_VB), (const bf16_t*)(ws + WS_RB), (const float*)(ws + WS_LF), MIX, args.in[9]};
        const float* state_gla = args.in[4];
#ifndef NO_GLA
        for (int it = bx; it < 64 + 128; it += G) {
            const bool pr = it < 64; const int seq = pr ? it : it - 64; const int b = seq >> 2, h = seq & 3;
            const size_t row0 = pr ? (size_t)b * SEQ : (size_t)MP + (size_t)b * 8;
            const float* s_in = pr ? nullptr : state_gla + (size_t)seq * 8192;
            float* s_out = args.out + (pr ? O_GP : O_GS) + (size_t)seq * 8192;
            const int nchunk = pr ? SEQ / 32 : 1;
            if (wave < 4) { if (pr) gla_m_wave<32>(lds, wave, lane, nchunk, s_in, s_out); else gla_m_wave<8>(lds, wave, lane, nchunk, s_in, s_out); }
            else { if (pr) gla_h_wave<32>(GC, lds, wave - 4, lane, (unsigned)row0, h, nchunk); else gla_h_wave<8>(GC, lds, wave - 4, lane, (unsigned)row0, h, nchunk); }
            __syncthreads();
        }
#endif
        AttnCtx AC{(const bf16_t*)(ws + WS_QA), (const bf16_t*)(ws + WS_KA), (const bf16_t*)(ws + WS_VA), MIX, args.in[2], args.in[3]};
        unsigned* counter = (unsigned*)(ws + WS_CTL);
        LAS unsigned char* wl = lds + wave * 8192;
        const int lane2 = lane_id_v();
        for (int sb = (bx + 64) % G; sb < NSB; sb += G) attn_item<true>(AC, sb, wave, 0, 0, wl, lane2);
        const unsigned xq0 = xb_xcc_id() & 7u;
        for (unsigned kq = 0; kq < 8u; ++kq) {
            const unsigned xq = (xq0 + kq) & 7u;
            unsigned* head = counter + 64 * xq;
            for (;;) {
                unsigned loc = 0; if (lane2 == 0) loc = atomicAdd(head, 1u);
                loc = (unsigned)__builtin_amdgcn_readfirstlane((int)loc);
                if (loc >= 1024u) break;
                { const unsigned p = loc; const unsigned grp = p >> 8, q = p & 255u; const int g = 15 - (int)(q >> 4); const unsigned bhl = (q >> 2) & 3u; const int r4 = (int)(q & 3u);
                    const int bh = (int)(xq + 8u * (4u * grp + bhl));
                    attn_item<false>(AC, bh >> 3, bh & 7, g, r4, wl, lane2); }
            }
        }
    }
    xcd_barrier(xbar, wave0);

    {
        PHASE_WS();
        bf16_t* MO = (bf16_t*)(ws + WS_MO); float* SSQ1 = (float*)(ws + WS_SSQ1);
        pg8::Gemm g{(bf16_t*)(ws + WS_MIX), (bf16_t*)(ws + WS_WO), 1024, 256, 1024}; pg8::StaticOrder S; S.init(MP / 256, 4, G, bx);
        EpiRowOut E{MO, SSQ1};
        pg8::gemm_phase<EpiRowOut, pg8::StaticOrder>(lds, g, S, E, wave0);
        pg8::Gemm g2{(bf16_t*)(ws + WS_MIX), (bf16_t*)(ws + WS_WO), 256, 256, 1024}; pg8::SplitOrder S2{16, G, bx, 128, 256};
        EpiSlice E2{(float*)(ws + WS_ACC1), 256};
        pg8::gemm_phase<EpiSlice, pg8::SplitOrder>(lds, g2, S2, E2, wave0);
    }
    xcd_barrier(xbar, wave0);
    {
        PHASE_IDS(); PHASE_WS();
        bf16_t* MO = (bf16_t*)(ws + WS_MO); float* SSQ1 = (float*)(ws + WS_SSQ1); bf16_t* XN = (bf16_t*)(ws + WS_XN + 4096);
        const float* g_post = args.in[12]; const float* g_pre = args.in[13];
        const int gw = vcu * 8 + wave, NGW = G * 8;
        {
            f32x4 gp4[4], gq4[4];
#pragma unroll
            for (int j = 0; j < 4; ++j) { gp4[j] = ((const GAS f32x4*)g_post)[64 * j + lane]; gq4[j] = ((const GAS f32x4*)g_pre)[64 * j + lane]; }
            for (int m0 = gw; m0 < MP; m0 += 2 * NGW) {
                const int m1 = (m0 + NGW < MP) ? m0 + NGW : m0;
                f32x4 sp[2], xv[2][4]; u32x2 mw[2][4];
#pragma unroll
                for (int r = 0; r < 2; ++r) { const int m = r ? m1 : m0; sp[r] = *((const GAS f32x4*)(SSQ1 + (size_t)m * 16) + (lane & 3));
#pragma unroll
                    for (int j = 0; j < 4; ++j) { xv[r][j] = ((const GAS f32x4*)(x_prompt + (size_t)m * DM))[64 * j + lane]; mw[r][j] = ((const GAS u32x2*)(MO + (size_t)m * DM))[64 * j + lane]; } }
#pragma unroll
                for (int r = 0; r < 2; ++r) if (r == 0 || m1 != m0) { const int m = r ? m1 : m0;
                    float ss = (sp[r].x + sp[r].y) + (sp[r].z + sp[r].w); ss += __shfl_xor(ss, 1); ss += __shfl_xor(ss, 2);
                    const float rs = rsqrtf(ss * (1.f / DM) + EPS);
                    f32x4 x1[4]; float s2 = 0.f;
#pragma unroll
                    for (int j = 0; j < 4; ++j) { f32x4 mv; mv.x = __uint_as_float(mw[r][j].x << 16); mv.y = __uint_as_float(mw[r][j].x & 0xffff0000u); mv.z = __uint_as_float(mw[r][j].y << 16); mv.w = __uint_as_float(mw[r][j].y & 0xffff0000u);
                        x1[j] = xv[r][j] + mv * rs * gp4[j]; s2 += (x1[j].x * x1[j].x + x1[j].y * x1[j].y) + (x1[j].z * x1[j].z + x1[j].w * x1[j].w);
                        ((GAS f32x4*)(args.out + (size_t)m * DM))[64 * j + lane] = x1[j]; }
                    const float rs2 = rsqrtf(wave_sum(s2) * (1.f / DM) + EPS);
#pragma unroll
                    for (int j = 0; j < 4; ++j) { const f32x4 y = x1[j] * rs2 * gq4[j]; u32x2 w; w.x = pk2(y.x, y.y); w.y = pk2(y.z, y.w); ((GAS u32x2*)(XN + (size_t)m * DM))[64 * j + lane] = w; }
                }
            }
        }
        for (int m = MP + gw; m < MT; m += NGW) {
            const float* xr = (m < MP) ? x_prompt + (size_t)m * DM : x_sample + (size_t)(m - MP) * DM;
            float* orow = args.out + (size_t)m * DM;
            f32x4 mvv[4]; float ss;
            if (m < MP) {
                const f32x4 sp = *((const f32x4*)(SSQ1 + (size_t)m * 16) + (lane & 3));
                ss = (sp.x + sp.y) + (sp.z + sp.w); ss += __shfl_xor(ss, 1); ss += __shfl_xor(ss, 2);
#pragma unroll
                for (int j = 0; j < 4; ++j) { const u32x2 mw = ((const u32x2*)(MO + (size_t)m * DM))[64 * j + lane];
                    mvv[j].x = __uint_as_float(mw.x << 16); mvv[j].y = __uint_as_float(mw.x & 0xffff0000u); mvv[j].z = __uint_as_float(mw.y << 16); mvv[j].w = __uint_as_float(mw.y & 0xffff0000u); }
            } else {
                const f32x4* ar = (const f32x4*)(ws + WS_ACC1) + (size_t)(m - MP) * 256; float s = 0.f;
#pragma unroll
                for (int j = 0; j < 4; ++j) { f32x4 a = ar[64 * j + lane];
                    for (int sl = 1; sl < 4; ++sl) a += ar[(size_t)sl * 65536 + 64 * j + lane];
                    mvv[j] = a; s += (a.x * a.x + a.y * a.y) + (a.z * a.z + a.w * a.w); }
                ss = wave_sum(s);
            }
            const float rs = rsqrtf(ss * (1.f / DM) + EPS);
            f32x4 x1[4]; float s2 = 0.f;
#pragma unroll
            for (int j = 0; j < 4; ++j) { const int c4 = 64 * j + lane; const f32x4 xv = ((const f32x4*)xr)[c4]; const f32x4 gp = ((const f32x4*)g_post)[c4];
                const f32x4 mv = mvv[j];
                x1[j] = xv + mv * rs * gp; s2 += (x1[j].x * x1[j].x + x1[j].y * x1[j].y) + (x1[j].z * x1[j].z + x1[j].w * x1[j].w);
                ((f32x4*)orow)[c4] = x1[j]; }
            const float rs2 = rsqrtf(wave_sum(s2) * (1.f / DM) + EPS);
#pragma unroll
            for (int j = 0; j < 4; ++j) { const int c4 = 64 * j + lane; const f32x4 gq = ((const f32x4*)g_pre)[c4]; const f32x4 y = x1[j] * rs2 * gq; u32x2 w; w.x = pk2(y.x, y.y); w.y = pk2(y.z, y.w); ((u32x2*)(XN + (size_t)m * DM))[c4] = w; }
        }
    }
    xcd_barrier(xbar, wave0);
    {
        PHASE_WS();
        bf16_t* Hb = (bf16_t*)(ws + WS_H);
        pg8::Gemm g{(bf16_t*)(ws + WS_XN + 4096) - 2 * DM, (bf16_t*)(ws + WS_WUP), 1024, 254, 1024}; pg8::StaticOrder S; S.init(131, 22, G, bx);
        EpiUp E{Hb, args.out, args.in[16], args.in[17], args.in[5], lds};
        pg8::gemm_phase<EpiUp, pg8::StaticOrder>(lds, g, S, E, wave0);
    }
    xcd_barrier(xbar, wave0);
    {
        PHASE_WS();
        bf16_t* MO = (bf16_t*)(ws + WS_MO); float* SSQ2 = (float*)(ws + WS_SSQ2);
        pg8::Gemm g{(bf16_t*)(ws + WS_H), (bf16_t*)(ws + WS_WD), DFF, 256, DFF}; pg8::StaticOrder S; S.init(MP / 256, 4, G, bx);
        EpiRowOut E{MO, SSQ2};
        pg8::gemm_phase<EpiRowOut, pg8::StaticOrder>(lds, g, S, E, wave0);
        pg8::Gemm g2{(bf16_t*)(ws + WS_H), (bf16_t*)(ws + WS_WD), 256, 256, DFF}; pg8::SplitOrder S2{44, G, bx, 128, 256};
        EpiSlice E2{(float*)(ws + WS_ACC2), 256};
        pg8::gemm_phase<EpiSlice, pg8::SplitOrder>(lds, g2, S2, E2, wave0);
    }
    xcd_barrier(xbar, wave0);
    {
        PHASE_IDS(); PHASE_WS();
        bf16_t* MO = (bf16_t*)(ws + WS_MO); float* SSQ2 = (float*)(ws + WS_SSQ2);
        const float* g_post = args.in[14];
        const int gw = vcu * 8 + wave, NGW = G * 8;
        {
            const f32x4 gp4[4] = {((const GAS f32x4*)g_post)[lane], ((const GAS f32x4*)g_post)[64 + lane], ((const GAS f32x4*)g_post)[128 + lane], ((const GAS f32x4*)g_post)[192 + lane]};
            for (int m0 = gw; m0 < MP; m0 += 2 * NGW) {
                const int m1 = (m0 + NGW < MP) ? m0 + NGW : m0;
                GAS float* ro[2] = {(GAS float*)(args.out + (size_t)m0 * DM), (GAS float*)(args.out + (size_t)m1 * DM)};
                f32x4 sp[2], xv[2][4]; u32x2 mw[2][4];
#pragma unroll
                for (int r = 0; r < 2; ++r) { const int m = r ? m1 : m0; sp[r] = *((const GAS f32x4*)(SSQ2 + (size_t)m * 16) + (lane & 3));
#pragma unroll
                    for (int j = 0; j < 4; ++j) { xv[r][j] = ((const GAS f32x4*)ro[r])[64 * j + lane]; mw[r][j] = ((const GAS u32x2*)(MO + (size_t)m * DM))[64 * j + lane]; } }
                f32x4 yv[2][4];
#pragma unroll
                for (int r = 0; r < 2; ++r) { float ss = (sp[r].x + sp[r].y) + (sp[r].z + sp[r].w); ss += __shfl_xor(ss, 1); ss += __shfl_xor(ss, 2);
                    const float rs = rsqrtf(ss * (1.f / DM) + EPS);
#pragma unroll
                    for (int j = 0; j < 4; ++j) { f32x4 mv; mv.x = __uint_as_float(mw[r][j].x << 16); mv.y = __uint_as_float(mw[r][j].x & 0xffff0000u); mv.z = __uint_as_float(mw[r][j].y << 16); mv.w = __uint_as_float(mw[r][j].y & 0xffff0000u);
                        yv[r][j] = xv[r][j] + mv * rs * gp4[j]; } }
#pragma unroll
                for (int r = 0; r < 2; ++r) if (r == 0 || m1 != m0) {
#pragma unroll
                    for (int j = 0; j < 4; ++j) ((GAS f32x4*)ro[r])[64 * j + lane] = yv[r][j]; }
            }
        }
        for (int m = MP + gw; m < MT; m += NGW) {
            float* orow = args.out + (size_t)m * DM;
            f32x4 mvv[4]; float ss;
            if (m < MP) {
                const f32x4 sp = *((const f32x4*)(SSQ2 + (size_t)m * 16) + (lane & 3));
                ss = (sp.x + sp.y) + (sp.z + sp.w); ss += __shfl_xor(ss, 1); ss += __shfl_xor(ss, 2);
#pragma unroll
                for (int j = 0; j < 4; ++j) { const u32x2 mw = ((const u32x2*)(MO + (size_t)m * DM))[64 * j + lane];
                    mvv[j].x = __uint_as_float(mw.x << 16); mvv[j].y = __uint_as_float(mw.x & 0xffff0000u); mvv[j].z = __uint_as_float(mw.y << 16); mvv[j].w = __uint_as_float(mw.y & 0xffff0000u); }
            } else {
                const f32x4* ar = (const f32x4*)(ws + WS_ACC2) + (size_t)(m - MP) * 256; float s = 0.f;
#pragma unroll
                for (int j = 0; j < 4; ++j) { f32x4 a = ar[64 * j + lane];
                    for (int sl = 1; sl < 11; ++sl) a += ar[(size_t)sl * 65536 + 64 * j + lane];
                    mvv[j] = a; s += (a.x * a.x + a.y * a.y) + (a.z * a.z + a.w * a.w); }
                ss = wave_sum(s);
            }
            const float rs = rsqrtf(ss * (1.f / DM) + EPS);
#pragma unroll
            for (int j = 0; j < 4; ++j) { const int c4 = 64 * j + lane; const f32x4 xv = ((const f32x4*)orow)[c4]; const f32x4 gp = ((const f32x4*)g_post)[c4];
                ((f32x4*)orow)[c4] = xv + mvv[j] * rs * gp; }
        }
    }
}

extern "C" void kernel_launch(void* const* d_in, const int* in_sizes, int n_in, void* d_out, int out_size, void* d_ws, size_t ws_size, hipStream_t stream) {
    static int grid = 0;
    if (grid == 0) {
        if (n_in != 19 || ws_size < WS_END || (size_t)out_size != O_END) { fprintf(stderr, "kernel_launch: unexpected shapes n_in %d out %d ws %zu\n", n_in, out_size, ws_size); grid = -1; return; }
        int dev = 0, cus = 0, per_cu = 0;
        hipGetDevice(&dev); hipDeviceGetAttribute(&cus, hipDeviceAttributeMultiprocessorCount, dev);
        hipFuncSetAttribute((const void*)hymba_fwd, hipFuncAttributeMaxDynamicSharedMemorySize, LDS_BYTES);
        hipOccupancyMaxActiveBlocksPerMultiprocessor(&per_cu, (const void*)hymba_fwd, 512, LDS_BYTES);
        if (per_cu < 1) { fprintf(stderr, "kernel_launch: occupancy query says %d blocks per CU\n", per_cu); grid = -1; return; }
        grid = cus;
    }
    if (grid < 0) return;
    hipMemsetAsync((char*)d_ws + WS_CTL, 0, CTL_BYTES, stream);
    Args a{};
    for (int i = 0; i < 19; ++i) a.in[i] = (const float*)d_in[i];
    a.out = (float*)d_out; a.ws = (unsigned char*)d_ws;
    void* kargs[] = {&a};
    hipError_t e = hipLaunchCooperativeKernel((const void*)hymba_fwd, dim3(grid), dim3(512), kargs, LDS_BYTES, stream);
    if (e != hipSuccess) fprintf(stderr, "cooperative launch failed: %s (grid %d)\n", hipGetErrorString(e), grid);
}
```

```cpp
#include <hip/hip_runtime.h>
#include <hip/hip_cooperative_groups.h>
#include <cstdio>
#include <cstdint>
namespace cg = cooperative_groups;

#define LAS __attribute__((address_space(3)))
#define GAS __attribute__((address_space(1)))
typedef unsigned short bf16_t;
typedef short bf16x8 __attribute__((ext_vector_type(8)));
typedef short s16x4 __attribute__((ext_vector_type(4)));
typedef float f32x4 __attribute__((ext_vector_type(4)));
typedef float f32x2 __attribute__((ext_vector_type(2)));
typedef float f32x16 __attribute__((ext_vector_type(16)));
typedef unsigned u32x4 __attribute__((ext_vector_type(4)));
typedef unsigned u32x2 __attribute__((ext_vector_type(2)));

constexpr int DM = 1024, NPB = 16, SEQ = 2048, NSB = 32, NST = 8;
constexpr int MP = NPB * SEQ;
constexpr int MS = NSB * NST;
constexpr int MT = MP + MS;
constexpr int NIN = 3328;
constexpr int DIN = 3088;
constexpr int DFF = 2816;
constexpr int WINB = 2048;
constexpr float EPS = 1e-6f;
constexpr float QSCALE = 0.125f * 1.4426950408889634f;

constexpr size_t MiB = 1u << 20;
constexpr size_t WS_CTL = 0, CTL_BYTES = 65536;
constexpr int XBST_OFF = 131072 + 8192;
constexpr size_t WS_WIN = 1 * MiB, WS_WO = 8 * MiB, WS_WUP = 10 * MiB, WS_WD = 22 * MiB;
constexpr size_t WS_SSQ1 = 28 * MiB, WS_SSQ2 = 31 * MiB;
constexpr size_t WS_XN = 34 * MiB;
constexpr size_t WS_MO = 104 * MiB;
constexpr size_t WS_QA = 172 * MiB, WS_KA = 206 * MiB, WS_VA = 240 * MiB, WS_QB = 274 * MiB, WS_KB = 291 * MiB, WS_VB = 308 * MiB, WS_RB = 342 * MiB, WS_LF = 376 * MiB, WS_MIX = 410 * MiB;
constexpr size_t WS_H = 172 * MiB;
constexpr size_t WS_ACC1 = 478 * MiB, WS_ACC2 = 482 * MiB;
constexpr size_t WS_END = 494 * MiB;
static_assert(WS_H + (size_t)MT * DFF * 2 <= WS_MIX, "h overlay");
static_assert(WS_XN + 4096 + (size_t)(131 * 254 + 260) * DM * 2 <= WS_MO, "xn2");

constexpr size_t O_YP = 0, O_YS = O_YP + (size_t)MP * DM, O_KP = O_YS + (size_t)MS * DM, O_VP = O_KP + (size_t)MP * 512, O_GP = O_VP + (size_t)MP * 512,
                 O_CP = O_GP + (size_t)NPB * 4 * 64 * 128, O_KS = O_CP + (size_t)NPB * 2 * DFF, O_VS = O_KS + (size_t)MS * 512, O_GS = O_VS + (size_t)MS * 512,
                 O_CS = O_GS + (size_t)NSB * 4 * 64 * 128, O_END = O_CS + (size_t)NSB * 2 * DFF;

__device__ __forceinline__ unsigned cvt_pk_bf16(float lo, float hi) { unsigned r; asm volatile("v_cvt_pk_bf16_f32 %0, %1, %2" : "=v"(r) : "v"(lo), "v"(hi)); return r; }
__device__ __forceinline__ float bf2f(unsigned short b) { return __uint_as_float((unsigned)b << 16); }
__device__ __forceinline__ float wave_sum(float v) {
#pragma unroll
    for (int o = 1; o < 64; o <<= 1) v += __shfl_xor(v, o);
    return v;
}

__device__ __forceinline__ int lane_id_v() { int l; asm volatile("v_mbcnt_lo_u32_b32 %0, -1, 0\n\tv_mbcnt_hi_u32_b32 %0, -1, %0" : "=v"(l)); return l; }

struct Args {
    const float* in[19];
    float* out;
    unsigned char* ws;
};

namespace pg8 {
constexpr int BM = 256, BK = 64, HALF = 128, HTB = HALF * BK * 2, STAGE_BYTES = 8 * HTB, NXCD = 8, WGM = 8;
__host__ __device__ __forceinline__ int lds_byte(int r, int c) { const int st = (r >> 4) * 2 + (c >> 5), rr = r & 15, cc = c & 31, ob = rr * 64 + cc * 2; return st * 1024 + (ob ^ (((ob >> 9) & 1) << 5)); }
__host__ __device__ __forceinline__ void stage_rc(int b, int& R, int& C) { const int st = b / 1024, sb = b % 1024, swz = sb ^ (((sb >> 9) & 1) << 5); R = (st >> 1) * 16 + swz / 64; C = (st & 1) * 32 + (swz % 64) / 2; }
__host__ __device__ __forceinline__ int perm32(int rho) { const int n = rho >> 4, i = rho & 15; return 8 * (i >> 2) + 4 * n + (i & 3); }

struct Unit { int pm, pn, kofs; };
struct Gemm { const bf16_t* A; const bf16_t* Bt; int K; int a_rows; int ldk; };

struct StaticOrder {
    int nM, nN, nwg, G, c;
    __device__ void init(int nM_, int nN_, int G_, int c_) { nM = nM_; nN = nN_; nwg = nM * nN; G = G_; c = c_; }
    __device__ bool next(int i, Unit& u) const {
        const long L = (long)i * G + c; if (L >= nwg) return false;
        int wgid = (int)L; { const int q = nwg / NXCD, r = nwg % NXCD, xcd = wgid % NXCD, off = wgid / NXCD; wgid = (xcd < r ? xcd * (q + 1) : r * (q + 1) + (xcd - r) * q) + off; }
        const int nig = WGM * nN, gid = wgid / nig, fm = gid * WGM, gsz = (nM - fm) < WGM ? (nM - fm) : WGM;
        u.pm = fm + ((wgid % nig) % gsz); u.pn = (wgid % nig) / gsz; u.kofs = 0; return true;
    }
};
struct SplitOrder {
    int nsub, G, c, pm, ksub;
    __device__ bool next(int i, Unit& u) const { const int L = i * G + c; if (L >= nsub) return false; u.pm = pm; u.pn = L & 3; u.kofs = (L >> 2) * ksub; return true; }
};

__device__ __forceinline__ f32x2 gelu_pk(f32x2 v) {
    const f32x2 av = __builtin_elementwise_abs(v), d = av * 0.2316418882f + 1.0f;
    f32x2 t; t.x = __builtin_amdgcn_rcpf(d.x); t.y = __builtin_amdgcn_rcpf(d.y);
    f32x2 q = t * 0.5307027145f + (-0.7265760135f); q = q * t + 0.7107068705f; q = q * t + (-0.142248368f); q = q * t + 0.127414796f; q = q * t;
    const f32x2 s = (v * v) * (-0.72134752044f);
    f32x2 e; e.x = __builtin_amdgcn_exp2f(s.x); e.y = __builtin_amdgcn_exp2f(s.y);
    const f32x2 m = v * (q * e), r = v - m;
    f32x2 o; o.x = v.x < 0.f ? m.x : r.x; o.y = v.y < 0.f ? m.y : r.y; return o;
}

template <class Epi, class Sched>
__device__ __forceinline__ void gemm_phase(LAS unsigned char* lds, const Gemm g, const Sched& S, const Epi& E, int wid) {
    const int lane = lane_id_v(); const int tid = wid * 64 + lane;
    const int wr = wid >> 2, wc = wid & 3, fr = lane & 15, fq = lane >> 4;
    const int K = g.ldk, nt = g.K / BK;
    unsigned voffA[2], voffB[2];
#pragma unroll
    for (int i = 0; i < 2; ++i) { int R, C; stage_rc(tid * 16 + i * 8192, R, C); const int Rb = Epi::PERM ? ((R & ~31) + perm32(R & 31)) : R;
        voffA[i] = (unsigned)(R * K + C) * 2u; voffB[i] = (unsigned)(Rb * K + C) * 2u; }
    const size_t kstep = (size_t)(BK * 2);
    const size_t hstep = (size_t)HALF * K * 2;
    const size_t tstepB = 2 * hstep;
    const size_t tstepA = (size_t)g.a_rows * K * 2;
    const unsigned ldsw = (unsigned)wid * 1024u;
    const int aoff = lds_byte(wr * 64 + fr, fq * 8), boff = lds_byte(wc * 32 + fr, fq * 8);
#define PG8_SA(b, h) (((b) * 2 + (h)) * HTB)
#define PG8_SB(b, h) ((4 + (b) * 2 + (h)) * HTB)
#define PG8_STAGE(bufoff, gbase, voff) do { _Pragma("unroll") for (int _i = 0; _i < 2; ++_i) \
        __builtin_amdgcn_global_load_lds((const unsigned*)((const char*)(gbase) + (voff)[_i]), (LAS unsigned*)(lds + (bufoff) + ldsw + _i * 8192), 16, 0, 0); } while (0)
#define PG8_LDA(dst, b, h) do { _Pragma("unroll") for (int m = 0; m < 4; ++m) _Pragma("unroll") for (int k = 0; k < 2; ++k) dst[m][k] = *(const LAS bf16x8*)(lds + PG8_SA(b, h) + aoff + m * 2048 + k * 1024); } while (0)
#define PG8_LDB(dst, b, h) do { _Pragma("unroll") for (int n = 0; n < 2; ++n) _Pragma("unroll") for (int k = 0; k < 2; ++k) dst[n][k] = *(const LAS bf16x8*)(lds + PG8_SB(b, h) + boff + n * 2048 + k * 1024); } while (0)
#define PG8_MMA(ai, bj, At, Bt) do { __builtin_amdgcn_s_setprio(1); _Pragma("unroll") for (int m = 0; m < 4; ++m) _Pragma("unroll") for (int n = 0; n < 2; ++n) _Pragma("unroll") for (int k = 0; k < 2; ++k) \
        acc[ai][bj][m][n] = __builtin_amdgcn_mfma_f32_16x16x32_bf16(Bt[n][k], At[m][k], acc[ai][bj][m][n], 0, 0, 0); __builtin_amdgcn_s_setprio(0); } while (0)
#define PG8_WAIT_V(n) asm volatile("s_waitcnt vmcnt(" #n ")" ::: "memory")
#define PG8_WAIT_L(n) asm volatile("s_waitcnt lgkmcnt(" #n ")" ::: "memory")
#define PG8_BAR __builtin_amdgcn_s_barrier()
#define PG8_SCHED __builtin_amdgcn_sched_barrier(0)
    Unit cur, nxt; int ui = 0;
    if (!S.next(0, cur)) return;
    f32x4 acc[2][2][4][2];
#pragma unroll
    for (int a = 0; a < 2; ++a)
#pragma unroll
        for (int b = 0; b < 2; ++b)
#pragma unroll
            for (int m = 0; m < 4; ++m)
#pragma unroll
                for (int n = 0; n < 2; ++n) acc[a][b][m][n] = (f32x4){0.f, 0.f, 0.f, 0.f};
    bf16x8 At[4][2], B0[2][2], B1[2][2];
    const char* cA = (const char*)g.A + (size_t)cur.pm * tstepA + (size_t)cur.kofs * 2; const char* cB = (const char*)g.Bt + (size_t)cur.pn * tstepB + (size_t)cur.kofs * 2;
    PG8_STAGE(PG8_SB(0, 0), cB, voffB); PG8_STAGE(PG8_SB(0, 1), cB + hstep, voffB); PG8_STAGE(PG8_SA(0, 0), cA, voffA); PG8_STAGE(PG8_SA(0, 1), cA + hstep, voffA);
    if (wr == 1) PG8_BAR;
    PG8_WAIT_V(2); PG8_BAR;
    PG8_STAGE(PG8_SB(1, 0), cB + kstep, voffB); PG8_STAGE(PG8_SA(1, 0), cA + kstep, voffA); PG8_STAGE(PG8_SB(1, 1), cB + hstep + kstep, voffB);
    PG8_WAIT_V(6); PG8_BAR;
    for (;;) {
        const bool has_next = S.next(ui + 1, nxt);
        const char* nA = has_next ? (const char*)g.A + (size_t)nxt.pm * tstepA + (size_t)nxt.kofs * 2 : cA; const char* nB = has_next ? (const char*)g.Bt + (size_t)nxt.pn * tstepB + (size_t)nxt.kofs * 2 : cB;
        for (int t = 0; t < nt; t += 2) {
            const bool last = (t == nt - 2);
            const char* a1 = cA + (size_t)(t + 1) * kstep;
            const char* a2 = last ? nA : cA + (size_t)(t + 2) * kstep; const char* b2 = last ? nB : cB + (size_t)(t + 2) * kstep;
            const char* a3 = a2 + kstep; const char* b3 = b2 + kstep;
            PG8_LDB(B0, 0, 0); PG8_LDB(B1, 0, 1); PG8_SCHED; PG8_LDA(At, 0, 0); PG8_STAGE(PG8_SA(1, 1), a1 + hstep, voffA);
            PG8_WAIT_V(8); PG8_WAIT_L(0); PG8_BAR; PG8_MMA(0, 0, At, B0); PG8_MMA(0, 1, At, B1); PG8_BAR; PG8_SCHED;
            PG8_LDA(At, 0, 1); PG8_STAGE(PG8_SB(0, 0), b2, voffB); PG8_STAGE(PG8_SB(0, 1), b2 + hstep, voffB); PG8_STAGE(PG8_SA(0, 0), a2, voffA);
            PG8_WAIT_V(8); PG8_WAIT_L(0); PG8_BAR; PG8_MMA(1, 0, At, B0); PG8_MMA(1, 1, At, B1); PG8_BAR; PG8_SCHED;
            PG8_LDB(B0, 1, 0); PG8_LDB(B1, 1, 1); PG8_SCHED; PG8_LDA(At, 1, 0); PG8_STAGE(PG8_SA(0, 1), a2 + hstep, voffA);
            PG8_WAIT_V(8); PG8_WAIT_L(0); PG8_BAR; PG8_MMA(0, 0, At, B0); PG8_MMA(0, 1, At, B1); PG8_BAR; PG8_SCHED;
            PG8_LDA(At, 1, 1); PG8_STAGE(PG8_SB(1, 0), b3, voffB); PG8_STAGE(PG8_SB(1, 1), b3 + hstep, voffB); PG8_STAGE(PG8_SA(1, 0), a3, voffA);
            PG8_WAIT_V(8); PG8_WAIT_L(0); PG8_BAR; PG8_MMA(1, 0, At, B0); PG8_MMA(1, 1, At, B1); PG8_BAR; PG8_SCHED;
        }
        if (wr == 0) PG8_BAR;
        E(acc, cur, wr, wc, fr, fq);
        if (!has_next) break;
#pragma unroll
        for (int a = 0; a < 2; ++a)
#pragma unroll
            for (int b = 0; b < 2; ++b)
#pragma unroll
                for (int m = 0; m < 4; ++m)
#pragma unroll
                    for (int n = 0; n < 2; ++n) acc[a][b][m][n] = (f32x4){0.f, 0.f, 0.f, 0.f};
        cur = nxt; cA = nA; cB = nB; ++ui;
        if (wr == 1) PG8_BAR;
    }
    PG8_WAIT_V(0);
    PG8_BAR;
#undef PG8_SA
#undef PG8_SB
#undef PG8_STAGE
#undef PG8_LDA
#undef PG8_LDB
#undef PG8_MMA
#undef PG8_WAIT_V
#undef PG8_WAIT_L
#undef PG8_BAR
#undef PG8_SCHED
}
}

struct EpiInProj {
    static constexpr bool PERM = true;
    bf16_t *QA, *KA, *VA, *QB, *KB, *VB, *RB; float* LF; float* out; const float* b_a;
    __device__ __forceinline__ void operator()(const f32x4 (&acc)[2][2][4][2], const pg8::Unit& u, int wr, int wc, int fr, int fq) const {
        const int pn = u.pn;
        const int row0 = u.pm * 256 + wr * 64 + fr;
        const int cl = wc * 32 + 8 * fq;
        if (pn == 12) {
#pragma unroll
            for (int bj = 0; bj < 2; ++bj) {
                const f32x4 b0 = *(const f32x4*)(b_a + cl + bj * 128), b1 = *(const f32x4*)(b_a + cl + bj * 128 + 4);
#pragma unroll
                for (int ai = 0; ai < 2; ++ai)
#pragma unroll
                    for (int m = 0; m < 4; ++m) {
                        f32x4 v0 = acc[ai][bj][m][0] + b0, v1 = acc[ai][bj][m][1] + b1;
#pragma unroll
                        for (int e = 0; e < 4; ++e) {
                            float z = v0[e]; v0[e] = (fminf(z, 0.f) - 0.69314718f * __builtin_amdgcn_logf(1.f + __builtin_amdgcn_exp2f(-1.44269504f * fabsf(z)))) * 0.0625f;
                            z = v1[e]; v1[e] = (fminf(z, 0.f) - 0.69314718f * __builtin_amdgcn_logf(1.f + __builtin_amdgcn_exp2f(-1.44269504f * fabsf(z)))) * 0.0625f; }
                        float* p = LF + (size_t)(row0 + ai * 128 + m * 16) * 256 + cl + bj * 128;
                        *(f32x4*)p = v0; *(f32x4*)(p + 4) = v1;
                    }
            }
            return;
        }
        bf16_t* base; int ld, cb; float sc = 1.f; float* fo = nullptr;
        if (pn < 2) { base = QA; ld = 512; cb = pn * 256; sc = QSCALE; }
        else if (pn < 4) { base = KA; ld = 512; cb = (pn - 2) * 256; fo = out + (u.pm < 128 ? O_KP : O_KS - (size_t)MP * 512); }
        else if (pn < 6) { base = VA; ld = 512; cb = (pn - 4) * 256; fo = out + (u.pm < 128 ? O_VP : O_VS - (size_t)MP * 512); }
        else if (pn == 6) { base = QB; ld = 256; cb = 0; }
        else if (pn == 7) { base = KB; ld = 256; cb = 0; }
        else if (pn < 10) { base = VB; ld = 512; cb = (pn - 8) * 256; }
        else { base = RB; ld = 512; cb = (pn - 10) * 256; }
#pragma unroll
        for (int ai = 0; ai < 2; ++ai)
#pragma unroll
            for (int m = 0; m < 4; ++m) {
                const size_t r = (size_t)(row0 + ai * 128 + m * 16);
#pragma unroll
                for (int bj = 0; bj < 2; ++bj) {
                    const f32x4 a0 = acc[ai][bj][m][0], a1 = acc[ai][bj][m][1];
                    const f32x4 v0 = a0 * sc, v1 = a1 * sc;
                    u32x4 w; w.x = cvt_pk_bf16(v0[0], v0[1]); w.y = cvt_pk_bf16(v0[2], v0[3]); w.z = cvt_pk_bf16(v1[0], v1[1]); w.w = cvt_pk_bf16(v1[2], v1[3]);
                    *(u32x4*)(base + r * ld + cb + cl + bj * 128) = w;
                    if (fo) { float* p = fo + r * 512 + cb + cl + bj * 128; *(f32x4*)p = a0; *(f32x4*)(p + 4) = a1; }
                }
            }
    }
};


struct EpiRowOut {
    static constexpr bool PERM = true;
    bf16_t* O; float* SSQ;
    __device__ __forceinline__ void operator()(const f32x4 (&acc)[2][2][4][2], const pg8::Unit& u, int wr, int wc, int fr, int fq) const {
        const int row0 = u.pm * 256 + wr * 64 + fr; const int cl = u.pn * 256 + wc * 32 + 8 * fq;
#pragma unroll
        for (int ai = 0; ai < 2; ++ai)
#pragma unroll
            for (int m = 0; m < 4; ++m) {
                const size_t r = (size_t)(row0 + ai * 128 + m * 16); float s = 0.f;
#pragma unroll
                for (int bj = 0; bj < 2; ++bj) {
                    const f32x4 v0 = acc[ai][bj][m][0], v1 = acc[ai][bj][m][1];
                    s += (v0[0] * v0[0] + v0[1] * v0[1]) + (v0[2] * v0[2] + v0[3] * v0[3]) + (v1[0] * v1[0] + v1[1] * v1[1]) + (v1[2] * v1[2] + v1[3] * v1[3]);
                    u32x4 w; w.x = cvt_pk_bf16(v0[0], v0[1]); w.y = cvt_pk_bf16(v0[2], v0[3]); w.z = cvt_pk_bf16(v1[0], v1[1]); w.w = cvt_pk_bf16(v1[2], v1[3]);
                    *(u32x4*)(O + r * 1024 + cl + bj * 128) = w;
                }
                s += __shfl_xor(s, 16); s += __shfl_xor(s, 32);
                if (fq == 0) SSQ[r * 16 + u.pn * 4 + wc] = s;
            }
    }
};

struct EpiSlice {
    static constexpr bool PERM = false;
    float* SL; int ksub;
    __device__ __forceinline__ void operator()(const f32x4 (&acc)[2][2][4][2], const pg8::Unit& u, int wr, int wc, int fr, int fq) const {
        float* base = SL + (size_t)(u.kofs / ksub) * (256 * 1024) + (unsigned)((wr * 64 + fr) * 1024 + u.pn * 256 + wc * 32 + 4 * fq);
#pragma unroll
        for (int ai = 0; ai < 2; ++ai)
#pragma unroll
            for (int m = 0; m < 4; ++m) { float* rowp = base + (ai * 128 + m * 16) * 1024;
#pragma unroll
                for (int bj = 0; bj < 2; ++bj)
#pragma unroll
                    for (int n = 0; n < 2; ++n) *(f32x4*)(rowp + bj * 128 + n * 16) = acc[ai][bj][m][n]; }
    }
};

__device__ __forceinline__ float dpp_ror1(float v) { return __int_as_float(__builtin_amdgcn_update_dpp(0, __float_as_int(v), 0x121, 0xf, 0xf, false)); }
__device__ __forceinline__ float dpp_ror2(float v) { return __int_as_float(__builtin_amdgcn_update_dpp(0, __float_as_int(v), 0x122, 0xf, 0xf, false)); }

constexpr int CONVX_OFF = 131072;
struct EpiUp {
    static constexpr bool PERM = true;
    bf16_t* H; float* out; const float* conv_w; const float* conv_b; const float* cbuf; LAS unsigned char* lds;
    __device__ __forceinline__ void operator()(const f32x4 (&acc)[2][2][4][2], const pg8::Unit& u, int wr, int wc, int fr, int fq) const {
        LAS float* X = (LAS float*)(lds + CONVX_OFF);
        const int cg_ = wc * 32 + 8 * fq;
        const int col = u.pn * 128 + cg_;
        if (fr >= 14) {
#pragma unroll
            for (int ai = 0; ai < 2; ++ai) { LAS float* p = X + ((ai * 2 + wr) * 2 + (fr - 14)) * 128 + cg_; *(LAS f32x4*)p = acc[ai][0][3][0]; *(LAS f32x4*)(p + 4) = acc[ai][0][3][1]; }
        }
        f32x4 w0[2], w1[2], w2[2], cb[2];
#pragma unroll
        for (int n = 0; n < 2; ++n) { w0[n] = *(const f32x4*)(conv_w + col + 4 * n); w1[n] = *(const f32x4*)(conv_w + DFF + col + 4 * n); w2[n] = *(const f32x4*)(conv_w + 2 * DFF + col + 4 * n); cb[n] = *(const f32x4*)(conv_b + col + 4 * n); }
        asm volatile("s_waitcnt lgkmcnt(0)" ::: "memory"); __builtin_amdgcn_s_barrier(); asm volatile("" ::: "memory");
#pragma unroll
        for (int ai = 0; ai < 2; ++ai) {
            const int pai = (wr == 1) ? ai : ai - 1, pwr = wr ^ 1;
            f32x4 pr1[2], pr2[2];
#pragma unroll
            for (int n = 0; n < 2; ++n) {
                if (pai >= 0) { pr1[n] = *(const LAS f32x4*)(X + ((pai * 2 + pwr) * 2 + 1) * 128 + cg_ + 4 * n); pr2[n] = *(const LAS f32x4*)(X + ((pai * 2 + pwr) * 2 + (fr & 1)) * 128 + cg_ + 4 * n); }
                else { pr1[n] = (f32x4){0.f, 0.f, 0.f, 0.f}; pr2[n] = pr1[n]; }
            }
#pragma unroll
            for (int m = 0; m < 4; ++m) {
                const int lr = ai * 128 + wr * 64 + m * 16 + fr; const int gr = u.pm * 254 - 2 + lr;
                const bool store = (lr >= 2) && (gr < MT);
                int pos, bidx; const bool samp = gr >= MP;
                if (!samp) { pos = gr & (SEQ - 1); bidx = gr >> 11; } else { pos = (gr - MP) & 7; bidx = (gr - MP) >> 3; }
                const bool head_rows = __builtin_amdgcn_ballot_w64(pos < 2) != 0ull;
                const bool tail_rows = __builtin_amdgcn_ballot_w64(store && (samp ? pos >= 6 : pos >= SEQ - 2)) != 0ull;
                u32x4 hw;
#pragma unroll
                for (int n = 0; n < 2; ++n) {
                    const f32x4 g0 = acc[ai][0][m][n], uu = acc[ai][1][m][n]; f32x4 gm1, gm2, nr1, nr2;
#pragma unroll
                    for (int e = 0; e < 4; ++e) {
                        gm1[e] = __int_as_float(__builtin_amdgcn_update_dpp(__float_as_int(pr1[n][e]), __float_as_int(g0[e]), 0x111, 0xf, 0xf, false));
                        gm2[e] = __int_as_float(__builtin_amdgcn_update_dpp(__float_as_int(pr2[n][e]), __float_as_int(g0[e]), 0x112, 0xf, 0xf, false));
                        nr1[e] = dpp_ror1(g0[e]); nr2[e] = dpp_ror2(g0[e]);
                    }
                    pr1[n] = nr1; pr2[n] = nr2;
                    if (head_rows) {
                        if (!samp) { if (pos == 0) { gm1 = (f32x4){0.f, 0.f, 0.f, 0.f}; gm2 = gm1; } else if (pos == 1) gm2 = (f32x4){0.f, 0.f, 0.f, 0.f}; }
                        else if (store) { if (pos == 0) { gm1 = *(const f32x4*)(cbuf + (size_t)(bidx * 2 + 1) * DFF + col + 4 * n); gm2 = *(const f32x4*)(cbuf + (size_t)(bidx * 2) * DFF + col + 4 * n); }
                                          else if (pos == 1) gm2 = *(const f32x4*)(cbuf + (size_t)(bidx * 2 + 1) * DFF + col + 4 * n); }
                    }
                    const f32x4 c = cb[n] + w0[n] * gm2 + w1[n] * gm1 + w2[n] * g0;
                    const f32x2 ga = pg8::gelu_pk((f32x2){c[0], c[1]}), gb = pg8::gelu_pk((f32x2){c[2], c[3]});
                    const float h0 = ga.x * uu[0], h1 = ga.y * uu[1], h2 = gb.x * uu[2], h3 = gb.y * uu[3];
                    if (n == 0) { hw.x = cvt_pk_bf16(h0, h1); hw.y = cvt_pk_bf16(h2, h3); } else { hw.z = cvt_pk_bf16(h0, h1); hw.w = cvt_pk_bf16(h2, h3); }
                    if (tail_rows && store) {
                        if (!samp) { if (pos >= SEQ - 2) *(f32x4*)(out + O_CP + (size_t)(bidx * 2 + (pos - (SEQ - 2))) * DFF + col + 4 * n) = g0; }
                        else { if (pos >= 6) *(f32x4*)(out + O_CS + (size_t)(bidx * 2 + (pos - 6)) * DFF + col + 4 * n) = g0; }
                    }
                }
                if (store) *(u32x4*)(H + (size_t)gr * DFF + col) = hw;
            }
        }
    }
};

__device__ __forceinline__ unsigned pk2(float lo, float hi) { return cvt_pk_bf16(lo, hi); }
__device__ __forceinline__ void p0_transpose_item(const float* W, int ldw, int scol0, int k0, bf16_t* WT, int dK, int drow0, LAS float* scr, int lane) {
#pragma unroll 8
    for (int i = 0; i < 32; ++i) { const int kk = 2 * i + (lane >> 5); scr[kk * 33 + (lane & 31)] = W[(size_t)(k0 + kk) * ldw + scol0 + (lane & 31)]; }
    asm volatile("s_waitcnt lgkmcnt(0)" ::: "memory");
    const int c = lane & 7;
#pragma unroll
    for (int j = 0; j < 4; ++j) { const int n = (lane >> 3) + 8 * j; const LAS float* s = scr + (8 * c) * 33 + n;
        u32x4 o; o.x = pk2(s[0 * 33], s[1 * 33]); o.y = pk2(s[2 * 33], s[3 * 33]); o.z = pk2(s[4 * 33], s[5 * 33]); o.w = pk2(s[6 * 33], s[7 * 33]);
        *(u32x4*)(WT + (size_t)(drow0 + n) * dK + k0 + 8 * c) = o; }
    asm volatile("s_waitcnt lgkmcnt(0)" ::: "memory");
}
__device__ __forceinline__ void p0_gate_item(const float* w_in, const float* w_a2, int k0, int n0, bf16_t* WT, LAS float* scr, int lane) {
    float w2[16];
#pragma unroll
    for (int r = 0; r < 16; ++r) w2[r] = w_a2[r * 256 + n0 + (lane & 31)];
    for (int i = 0; i < 32; ++i) { const int kk = 2 * i + (lane >> 5); const float* a = w_in + (size_t)(k0 + kk) * DIN + 3072; float s = 0.f;
#pragma unroll
        for (int r = 0; r < 16; ++r) s += a[r] * w2[r];
        scr[kk * 33 + (lane & 31)] = s; }
    asm volatile("s_waitcnt lgkmcnt(0)" ::: "memory");
    const int c = lane & 7;
#pragma unroll
    for (int j = 0; j < 4; ++j) { const int n = (lane >> 3) + 8 * j; const LAS float* s = scr + (8 * c) * 33 + n;
        u32x4 o; o.x = pk2(s[0 * 33], s[1 * 33]); o.y = pk2(s[2 * 33], s[3 * 33]); o.z = pk2(s[4 * 33], s[5 * 33]); o.w = pk2(s[6 * 33], s[7 * 33]);
        *(u32x4*)(WT + (size_t)(3072 + n0 + n) * 1024 + k0 + 8 * c) = o; }
    asm volatile("s_waitcnt lgkmcnt(0)" ::: "memory");
}
__device__ __forceinline__ void rms_row_to_bf16(const float* xrow, const float* g, bf16_t* orow, int lane) {
    const f32x4* xr = (const f32x4*)xrow + lane; const f32x4* gr = (const f32x4*)g + lane;
    f32x4 v[4]; float s = 0.f;
#pragma unroll
    for (int j = 0; j < 4; ++j) { v[j] = xr[64 * j]; s += (v[j].x * v[j].x + v[j].y * v[j].y) + (v[j].z * v[j].z + v[j].w * v[j].w); }
    const float rs = rsqrtf(wave_sum(s) * (1.f / DM) + EPS);
    u32x2* o8 = (u32x2*)orow + lane;
#pragma unroll
    for (int j = 0; j < 4; ++j) { const f32x4 gg = gr[64 * j]; const f32x4 y = v[j] * rs * gg; u32x2 w; w.x = pk2(y.x, y.y); w.y = pk2(y.z, y.w); o8[64 * j] = w; }
}


__device__ __forceinline__ int crow(int r, int hi) { return (r & 3) + 8 * (r >> 2) + 4 * hi; }
typedef short v4i16_t __attribute__((ext_vector_type(4)));
__device__ __forceinline__ s16x4 vtr(const LAS unsigned char* p) { return __builtin_bit_cast(s16x4, __builtin_amdgcn_ds_read_tr16_b64_v4i16((LAS v4i16_t*)p)); }
__device__ __forceinline__ float swapmax(float v) { auto rr = __builtin_amdgcn_permlane32_swap(__float_as_uint(v), __float_as_uint(v), false, false); return fmaxf(__uint_as_float(rr[0]), __uint_as_float(rr[1])); }
__device__ __forceinline__ float swapsum(float v) { auto rr = __builtin_amdgcn_permlane32_swap(__float_as_uint(v), __float_as_uint(v), false, false); return __uint_as_float(rr[0]) + __uint_as_float(rr[1]); }
__device__ __forceinline__ u32x4 pack8(f32x4 a, f32x4 b) { u32x4 w; w.x = cvt_pk_bf16(a.x, a.y); w.y = cvt_pk_bf16(a.z, a.w); w.z = cvt_pk_bf16(b.x, b.y); w.w = cvt_pk_bf16(b.z, b.w); return w; }

constexpr float NEGF = -1e30f;
constexpr int VPITCH = 192;
constexpr int ATT_WLDS = 32 * VPITCH + 256;

struct AttnCtx { const bf16_t *QA, *KA, *VA; bf16_t* MIX; const float *ck, *cv; };

struct TileRegs { u32x4 k[8]; u32x4 v[8]; };

template <bool SAMPLE> __device__ __forceinline__ int tile_key(int ti, int j, int g, int r4, int ncls) {
    if (SAMPLE) { if (ti < 17) return 1536 + 32 * (16 - ti) + j; const int kk = ti - 17; return 16 * (4 * kk + (j >> 3)) + (j & 7); }
    if (ti < ncls) return 4 * (32 * (g - ti) + j) + r4;
    const int jj = ti - ncls + (g == 0 ? 4 : 0); return 128 * g - 128 + 32 * jj + j;
}
template <bool SAMPLE> __device__ __forceinline__ void tile_load(const AttnCtx& C, TileRegs& T, int ti, int b, int h, int g, int r4, int ncls, int lane) {
    const int r32 = lane & 31, hi = lane >> 5;
    if (SAMPLE && ti > 0) {
        { const int idx = tile_key<SAMPLE>(ti, r32, g, r4, ncls); const float* p = C.ck + (((unsigned)(b * WINB + idx) * 8u + h) * 64u + 8 * hi);
#pragma unroll
          for (int d0 = 0; d0 < 4; ++d0) { T.k[2 * d0] = *(const GAS u32x4*)(p + 16 * d0); T.k[2 * d0 + 1] = *(const GAS u32x4*)(p + 16 * d0 + 4); } }
#pragma unroll
        for (int i = 0; i < 4; ++i) { const int key = (lane >> 3) + 8 * i; const int idx = tile_key<SAMPLE>(ti, key, g, r4, ncls);
            const float* p = C.cv + (((unsigned)(b * WINB + idx) * 8u + h) * 64u + 8 * (lane & 7)); T.v[2 * i] = *(const GAS u32x4*)p; T.v[2 * i + 1] = *(const GAS u32x4*)(p + 4); }
    } else {
        unsigned rowb;
        { int key = tile_key<SAMPLE>(ti, r32, g, r4, ncls); if (SAMPLE) { key -= WINB; key = key > 7 ? 7 : key; rowb = (unsigned)(MP + b * 8 + key); } else rowb = (unsigned)(b * SEQ + key);
          const bf16_t* p = C.KA + (rowb * 512u + h * 64 + 8 * hi);
#pragma unroll
          for (int d0 = 0; d0 < 4; ++d0) T.k[d0] = *(const GAS u32x4*)(p + 16 * d0); }
#pragma unroll
        for (int i = 0; i < 4; ++i) { int key = tile_key<SAMPLE>(ti, (lane >> 3) + 8 * i, g, r4, ncls); if (SAMPLE) { key -= WINB; key = key > 7 ? 7 : key; rowb = (unsigned)(MP + b * 8 + key); } else rowb = (unsigned)(b * SEQ + key);
            T.v[i] = *(const GAS u32x4*)(C.VA + (rowb * 512u + h * 64 + 8 * (lane & 7))); }
    }
}

template <bool SAMPLE>
__device__ __forceinline__ void attn_item(const AttnCtx& C, int b, int h, int g, int r4, LAS unsigned char* wl, int lane_in) {
    int lane = lane_in; asm volatile("" : "+v"(lane));
    const int r32 = lane & 31, hi = lane >> 5;
    LAS float* wsf = (LAS float*)(wl + 32 * VPITCH);
    const int ncls = g + 1;
    const int nt = SAMPLE ? 41 : (ncls + (g == 0 ? 4 : 8));
    bf16x8 qf[4];
    {
        unsigned qrow; if (SAMPLE) qrow = (unsigned)(MP + b * 8 + (r32 & 7)); else qrow = (unsigned)(b * SEQ + 4 * (32 * g + r32) + r4);
        const bf16_t* p = C.QA + (qrow * 512u + h * 64 + 8 * hi);
#pragma unroll
        for (int d0 = 0; d0 < 4; ++d0) qf[d0] = *(const bf16x8*)(p + 16 * d0);
    }
    float mrun = NEGF, lrun = 0.f;
    f32x16 o0 = {}, o1 = {};
    TileRegs T;
    tile_load<SAMPLE>(C, T, 0, b, h, g, r4, ncls, lane);
    const int vrd = (4 * hi + ((lane & 15) >> 2)) * VPITCH + (((lane >> 4) & 1) * 16 + (lane & 3) * 4) * 2;
    for (int ti = 0; ti < nt; ++ti) {
        bf16x8 kf[4];
        const bool f32path = SAMPLE && ti > 0;
        if (f32path) {
#pragma unroll
            for (int d0 = 0; d0 < 4; ++d0) kf[d0] = __builtin_bit_cast(bf16x8, pack8(__builtin_bit_cast(f32x4, T.k[2 * d0]), __builtin_bit_cast(f32x4, T.k[2 * d0 + 1])));
#pragma unroll
            for (int i = 0; i < 4; ++i) *(LAS u32x4*)(wl + ((lane >> 3) + 8 * i) * VPITCH + (lane & 7) * 16) = pack8(__builtin_bit_cast(f32x4, T.v[2 * i]), __builtin_bit_cast(f32x4, T.v[2 * i + 1]));
        } else {
#pragma unroll
            for (int d0 = 0; d0 < 4; ++d0) kf[d0] = __builtin_bit_cast(bf16x8, T.k[d0]);
#pragma unroll
            for (int i = 0; i < 4; ++i) *(LAS u32x4*)(wl + ((lane >> 3) + 8 * i) * VPITCH + (lane & 7) * 16) = T.v[i];
        }
        if (ti + 1 < nt) tile_load<SAMPLE>(C, T, ti + 1, b, h, g, r4, ncls, lane);
        f32x16 p = {};
#pragma unroll
        for (int d0 = 0; d0 < 4; ++d0) p = __builtin_amdgcn_mfma_f32_32x32x16_bf16(kf[d0], qf[d0], p, 0, 0, 0);
        if (SAMPLE) {
            if (ti < 17) { const int dbase = (WINB + r32) - (1536 + 32 * (16 - ti));
#pragma unroll
                for (int r = 0; r < 16; ++r) { const int d = dbase - crow(r, hi); const int mult = (d >= 0 && d <= 128) + (d >= 0 && d <= 512 && !(d & 3)) + (d >= 0 && !(d & 15));
                    p[r] = (mult == 0 || r32 >= 8) ? NEGF : p[r] + (mult == 1 ? 0.f : (mult == 2 ? 1.f : 1.5849625f)); } }
            else {
#pragma unroll
                for (int r = 0; r < 16; ++r) p[r] = ((crow(r, hi) & 7) == r32) ? p[r] : NEGF; }
        } else {
            if (ti < ncls) { const int dbase = (32 * g + r32) - 32 * (g - ti);
#pragma unroll
                for (int r = 0; r < 16; ++r) { const int d = dbase - crow(r, hi); const int mult = (d >= 0 && d <= 128) + (d >= 0 && !(d & 3));
                    p[r] = mult == 0 ? NEGF : p[r] + (mult == 2 ? 1.f : 0.f); } }
            else { const int jj = ti - ncls + (g == 0 ? 4 : 0); const int dbase = (128 * g + 4 * r32 + r4) - (128 * g - 128 + 32 * jj);
#pragma unroll
                for (int r = 0; r < 16; ++r) { const int d = dbase - crow(r, hi); p[r] = (d >= 0 && d <= 128) ? p[r] : NEGF; } }
        }
        float rm = p[0];
#pragma unroll
        for (int r = 1; r < 16; ++r) rm = fmaxf(rm, p[r]);
        rm = swapmax(rm);
        const float mnew = fmaxf(mrun, rm);
        const float f = __builtin_amdgcn_exp2f(mrun - mnew);
        mrun = mnew;
        float ls = 0.f;
#pragma unroll
        for (int r = 0; r < 16; ++r) { p[r] = __builtin_amdgcn_exp2f(p[r] - mnew); ls += p[r]; }
        lrun = lrun * f + ls;
        if (hi == 0) wsf[r32] = f;
        u32x4 pa0, pa1;
        pa0.x = cvt_pk_bf16(p[0], p[1]); pa0.y = cvt_pk_bf16(p[2], p[3]); pa0.z = cvt_pk_bf16(p[4], p[5]); pa0.w = cvt_pk_bf16(p[6], p[7]);
        pa1.x = cvt_pk_bf16(p[8], p[9]); pa1.y = cvt_pk_bf16(p[10], p[11]); pa1.z = cvt_pk_bf16(p[12], p[13]); pa1.w = cvt_pk_bf16(p[14], p[15]);
#pragma unroll
        for (int r = 0; r < 16; ++r) { const float fr_ = wsf[crow(r, hi)]; o0[r] *= fr_; o1[r] *= fr_; }
#pragma unroll
        for (int sl = 0; sl < 2; ++sl) {
            const bf16x8 pa = __builtin_bit_cast(bf16x8, sl == 0 ? pa0 : pa1);
#pragma unroll
            for (int c = 0; c < 2; ++c) {
                const s16x4 lo = vtr(wl + vrd + (16 * sl) * VPITCH + 64 * c), hi4 = vtr(wl + vrd + (16 * sl + 8) * VPITCH + 64 * c);
                const bf16x8 vf = (bf16x8){lo[0], lo[1], lo[2], lo[3], hi4[0], hi4[1], hi4[2], hi4[3]};
                if (c == 0) o0 = __builtin_amdgcn_mfma_f32_32x32x16_bf16(pa, vf, o0, 0, 0, 0); else o1 = __builtin_amdgcn_mfma_f32_32x32x16_bf16(pa, vf, o1, 0, 0, 0);
            }
        }
    }
    const float lt = swapsum(lrun);
    if (hi == 0) wsf[32 + r32] = 1.f / lt;
#pragma unroll
    for (int r = 0; r < 16; ++r) {
        const int q = crow(r, hi); const float rl = wsf[32 + q];
        unsigned orow; bool ok = true;
        if (SAMPLE) { ok = q < 8; orow = (unsigned)(MP + b * 8 + (q & 7)); } else orow = (unsigned)(b * SEQ + 4 * (32 * g + q) + r4);
        if (ok) { bf16_t* op = C.MIX + (orow * 1024u + h * 64 + r32);
            op[0] = (bf16_t)(cvt_pk_bf16(o0[r] * rl, 0.f) & 0xffffu); op[32] = (bf16_t)(cvt_pk_bf16(o1[r] * rl, 0.f) & 0xffffu); }
    }
}

struct GlaCtx { const bf16_t *QB, *KB, *VB, *RB; const float* LF; bf16_t* MIX; const float* gnorm; };
constexpr int GQ_P = 72, GT_P = 40;
constexpr int G_QE = 0, G_KE = 32 * GQ_P * 2, G_KT = G_KE + 32 * GQ_P * 2, G_EB = G_KT + 64 * GT_P * 2, G_BUF = G_EB + 256;
constexpr int GL_V = 2 * G_BUF;
constexpr int GL_O = GL_V + 2 * 4 * 2048;
constexpr int GL_END = GL_O + 2 * 4 * 4608;
static_assert(GL_END <= 131072, "gla lds");
#define LDS_BARRIER() do { asm volatile("s_waitcnt lgkmcnt(0)" ::: "memory"); __builtin_amdgcn_s_barrier(); asm volatile("" ::: "memory"); } while (0)
typedef float f32x8 __attribute__((ext_vector_type(8)));
typedef unsigned u32x8 __attribute__((ext_vector_type(8)));
typedef unsigned u32x16 __attribute__((ext_vector_type(16)));
struct GlaPre { f32x8 lf; u32x8 q, k; u32x4 v0, v1; };

template <int nvalid> __device__ __forceinline__ void gla_h_loads(const GlaCtx& C, GlaPre& P, unsigned t0, int h, int dk, int tg, int dvs, int lane) {
    const bool ok = 8 * tg < nvalid;
    const unsigned off = (t0 + (ok ? 8 * tg : 0)) * 256u + h * 64 + dk;
    const GAS float* lp = (const GAS float*)(C.LF + off); const GAS bf16_t* qp = (const GAS bf16_t*)(C.QB + off); const GAS bf16_t* kp = (const GAS bf16_t*)(C.KB + off);
#pragma unroll
    for (int e = 0; e < 8; ++e) { P.lf[e] = lp[e * 256]; P.q[e] = (unsigned)qp[e * 256]; P.k[e] = (unsigned)kp[e * 256]; }
    const int i = lane >> 1; const bool okv = i < nvalid; const GAS bf16_t* p = (const GAS bf16_t*)(C.VB + ((t0 + (okv ? i : 0)) * 512u + h * 128 + 32 * dvs + 16 * (lane & 1)));
    P.v0 = *(const GAS u32x4*)p; P.v1 = *(const GAS u32x4*)(p + 8);
}
struct GlaGate { u32x4 g0, g1; };
template <int nvalid> __device__ __forceinline__ void gla_h_interval(const GlaCtx& C, LAS unsigned char* lds, GlaPre& P, GlaGate& G, const f32x4 (&gn)[4], int j, int nchunk, int hw, int lane, unsigned row0, int h) {
    const int tg = lane >> 4, dkl = lane & 15, dk = 16 * hw + dkl;
    const int ft = lane >> 3, dvg = lane & 7;
    const bool fin_ok = 8 * hw < nvalid;
    if (j >= 2 && fin_ok) {
        const int c = j - 2; const int ob = c & 1;
        const LAS float* op = (const LAS float*)(lds + GL_O + (ob * 4 + (dvg >> 1)) * 4608) + (8 * hw + ft) * 36 + 16 * (dvg & 1);
        f32x4 o[4]; float s = 0.f;
#pragma unroll
        for (int k4 = 0; k4 < 4; ++k4) { o[k4] = *(const LAS f32x4*)(op + 4 * k4); s += (o[k4].x * o[k4].x + o[k4].y * o[k4].y) + (o[k4].z * o[k4].z + o[k4].w * o[k4].w); }
        s += __shfl_xor(s, 1); s += __shfl_xor(s, 2); s += __shfl_xor(s, 4);
        const float rs = rsqrtf(s * (1.f / 128.f) + EPS);
        const u32x4 g0 = G.g0, g1 = G.g1;
        float gt[16];
        gt[0] = __uint_as_float(g0.x << 16); gt[1] = __uint_as_float(g0.x & 0xffff0000u); gt[2] = __uint_as_float(g0.y << 16); gt[3] = __uint_as_float(g0.y & 0xffff0000u);
        gt[4] = __uint_as_float(g0.z << 16); gt[5] = __uint_as_float(g0.z & 0xffff0000u); gt[6] = __uint_as_float(g0.w << 16); gt[7] = __uint_as_float(g0.w & 0xffff0000u);
        gt[8] = __uint_as_float(g1.x << 16); gt[9] = __uint_as_float(g1.x & 0xffff0000u); gt[10] = __uint_as_float(g1.y << 16); gt[11] = __uint_as_float(g1.y & 0xffff0000u);
        gt[12] = __uint_as_float(g1.z << 16); gt[13] = __uint_as_float(g1.z & 0xffff0000u); gt[14] = __uint_as_float(g1.w << 16); gt[15] = __uint_as_float(g1.w & 0xffff0000u);
        float val[16];
#pragma unroll
        for (int k = 0; k < 16; ++k) { const float rg = gt[k]; val[k] = o[k >> 2][k & 3] * rs * gn[k >> 2][k & 3] * rg * __builtin_amdgcn_rcpf(1.f + __expf(-rg)); }
        u32x4 w0, w1;
        w0.x = cvt_pk_bf16(val[0], val[1]); w0.y = cvt_pk_bf16(val[2], val[3]); w0.z = cvt_pk_bf16(val[4], val[5]); w0.w = cvt_pk_bf16(val[6], val[7]);
        w1.x = cvt_pk_bf16(val[8], val[9]); w1.y = cvt_pk_bf16(val[10], val[11]); w1.z = cvt_pk_bf16(val[12], val[13]); w1.w = cvt_pk_bf16(val[14], val[15]);
        bf16_t* mp = C.MIX + ((row0 + 32u * c + 8 * hw + ft) * 1024u + 512 + h * 128 + 16 * dvg);
        *(GAS u32x4*)mp = w0; *(GAS u32x4*)(mp + 8) = w1;
    }
    if (j < nchunk) {
        const int buf = j & 1;
        LAS unsigned char* sh = lds + buf * G_BUF;
        LAS bf16_t* qe_l = (LAS bf16_t*)(sh + G_QE); LAS bf16_t* ke_l = (LAS bf16_t*)(sh + G_KE); LAS bf16_t* kt_l = (LAS bf16_t*)(sh + G_KT); LAS float* eb_l = (LAS float*)(sh + G_EB);
        LAS unsigned char* vl = lds + GL_V + (buf * 4 + hw) * 2048;
        const bool okp = 8 * tg < nvalid, okv = (lane >> 1) < nvalid;
        if (!okp) { P.lf = (f32x8){0.f, 0.f, 0.f, 0.f, 0.f, 0.f, 0.f, 0.f}; P.q = (u32x8){0u, 0u, 0u, 0u, 0u, 0u, 0u, 0u}; P.k = P.q; }
        if (!okv) { P.v0 = (u32x4){0u, 0u, 0u, 0u}; P.v1 = P.v0; }
        f32x8 cs; float run = 0.f;
#pragma unroll
        for (int e = 0; e < 8; ++e) { run += P.lf[e]; cs[e] = run; }
        float offs = 0.f, tot = 0.f;
#pragma unroll
        for (int t = 0; t < 4; ++t) { const float Tt = __shfl(run, dkl + 16 * t); tot += Tt; offs += (t < tg) ? Tt : 0.f; }
        u32x8 kb;
#pragma unroll
        for (int e = 0; e < 8; ++e) { const float bb = offs + cs[e]; const float eb = __expf(bb), ei = __expf(-bb); const int i = 8 * tg + e;
            qe_l[i * GQ_P + dk] = (bf16_t)(cvt_pk_bf16(__uint_as_float(P.q[e] << 16) * 0.125f * eb, 0.f) & 0xffffu);
            kb[e] = cvt_pk_bf16(__uint_as_float(P.k[e] << 16) * ei, 0.f) & 0xffffu;
            ke_l[i * GQ_P + dk] = (bf16_t)kb[e]; }
        u32x4 w; w.x = kb[0] | (kb[1] << 16); w.y = kb[2] | (kb[3] << 16); w.z = kb[4] | (kb[5] << 16); w.w = kb[6] | (kb[7] << 16);
        *(LAS u32x4*)(kt_l + dk * GT_P + 8 * tg) = w;
        if (tg == 0) eb_l[dk] = __expf(tot);
        *(LAS u32x4*)(vl + (lane >> 1) * 64 + (lane & 1) * 32) = P.v0; *(LAS u32x4*)(vl + (lane >> 1) * 64 + (lane & 1) * 32 + 16) = P.v1;
    }
    if (j + 3 < nchunk) gla_h_loads<nvalid>(C, P, row0 + 32u * (j + 3), h, dk, tg, hw, lane);
    if (j + 1 < nchunk && fin_ok) { const bf16_t* rp = C.RB + ((row0 + 32u * (j + 1) + 8 * hw + ft) * 512u + h * 128 + 16 * dvg); G.g0 = *(const GAS u32x4*)rp; G.g1 = *(const GAS u32x4*)(rp + 8); }
    if (j <= nchunk) LDS_BARRIER();
}
template <int nvalid> __device__ __forceinline__ void gla_h_wave(const GlaCtx& C, LAS unsigned char* lds, int hw  , int lane, unsigned row0, int h, int nchunk) {
    const int tg = lane >> 4, dkl = lane & 15, dk = 16 * hw + dkl;
    const int ft = lane >> 3, dvg = lane & 7;
    f32x4 gn[4];
#pragma unroll
    for (int k4 = 0; k4 < 4; ++k4) gn[k4] = *(const f32x4*)(C.gnorm + h * 128 + 16 * dvg + 4 * k4);
    GlaPre P0, P1, P2; GlaGate G0 = {}, G1 = {}, G2 = {};
    gla_h_loads<nvalid>(C, P0, row0, h, dk, tg, hw, lane);
    if (1 < nchunk) gla_h_loads<nvalid>(C, P1, row0 + 32u, h, dk, tg, hw, lane);
    if (2 < nchunk) gla_h_loads<nvalid>(C, P2, row0 + 64u, h, dk, tg, hw, lane);
    if (8 * hw < nvalid) { const bf16_t* rp = C.RB + ((row0 + 8 * hw + ft) * 512u + h * 128 + 16 * dvg); G0.g0 = *(const GAS u32x4*)rp; G0.g1 = *(const GAS u32x4*)(rp + 8); }
    for (int j = 0; j <= nchunk + 1; j += 3) {
        gla_h_interval<nvalid>(C, lds, P0, G1, gn, j, nchunk, hw, lane, row0, h);
        if (j + 1 <= nchunk + 1) gla_h_interval<nvalid>(C, lds, P1, G2, gn, j + 1, nchunk, hw, lane, row0, h);
        if (j + 2 <= nchunk + 1) gla_h_interval<nvalid>(C, lds, P2, G0, gn, j + 2, nchunk, hw, lane, row0, h);
    }
}
template <int nvalid> __device__ __forceinline__ void gla_m_wave(LAS unsigned char* lds, int dvs, int lane, int nchunk, const float* s_in, float* s_out) {
    const int r32 = lane & 31, hi = lane >> 5;
    f32x16 S0 = {}, S1 = {};
    unsigned soff = (unsigned)(4 * hi * 128 + 32 * dvs + r32); asm volatile("" : "+v"(soff));
    if (s_in) {
#pragma unroll
        for (int r = 0; r < 16; ++r) { const unsigned o_ = soff + (unsigned)(((r & 3) + 8 * (r >> 2)) * 128); S0[r] = s_in[o_]; S1[r] = s_in[o_ + 4096u]; }
    }
    const int vrd = (4 * hi + ((lane & 15) >> 2)) * 64 + (((lane >> 4) & 1) * 16 + (lane & 3) * 4) * 2;
    LDS_BARRIER();
    for (int c = 0; c < nchunk; ++c) {
        const int buf = c & 1;
        LAS unsigned char* sh = lds + buf * G_BUF;
        LAS bf16_t* qe_l = (LAS bf16_t*)(sh + G_QE); LAS bf16_t* ke_l = (LAS bf16_t*)(sh + G_KE); LAS bf16_t* kt_l = (LAS bf16_t*)(sh + G_KT); LAS float* eb_l = (LAS float*)(sh + G_EB);
        const LAS unsigned char* vl = lds + GL_V + (buf * 4 + dvs) * 2048;
        f32x16 at = {};
#pragma unroll
        for (int s = 0; s < 4; ++s) { const bf16x8 a = *(const LAS bf16x8*)(ke_l + r32 * GQ_P + 16 * s + 8 * hi), bq = *(const LAS bf16x8*)(qe_l + r32 * GQ_P + 16 * s + 8 * hi);
            at = __builtin_amdgcn_mfma_f32_32x32x16_bf16(a, bq, at, 0, 0, 0); }
#pragma unroll
        for (int r = 0; r < 16; ++r) at[r] = (crow(r, hi) <= r32) ? at[r] : 0.f;
        u32x4 pa0, pa1;
        pa0.x = cvt_pk_bf16(at[0], at[1]); pa0.y = cvt_pk_bf16(at[2], at[3]); pa0.z = cvt_pk_bf16(at[4], at[5]); pa0.w = cvt_pk_bf16(at[6], at[7]);
        pa1.x = cvt_pk_bf16(at[8], at[9]); pa1.y = cvt_pk_bf16(at[10], at[11]); pa1.z = cvt_pk_bf16(at[12], at[13]); pa1.w = cvt_pk_bf16(at[14], at[15]);
        bf16x8 vf0, vf1;
        { const s16x4 lo = vtr(vl + vrd), h4 = vtr(vl + vrd + 8 * 64); vf0 = (bf16x8){lo[0], lo[1], lo[2], lo[3], h4[0], h4[1], h4[2], h4[3]}; }
        { const s16x4 lo = vtr(vl + vrd + 16 * 64), h4 = vtr(vl + vrd + 24 * 64); vf1 = (bf16x8){lo[0], lo[1], lo[2], lo[3], h4[0], h4[1], h4[2], h4[3]}; }
        f32x16 o = {};
        o = __builtin_amdgcn_mfma_f32_32x32x16_bf16(__builtin_bit_cast(bf16x8, pa0), vf0, o, 0, 0, 0);
        o = __builtin_amdgcn_mfma_f32_32x32x16_bf16(__builtin_bit_cast(bf16x8, pa1), vf1, o, 0, 0, 0);
#pragma unroll
        for (int s = 0; s < 4; ++s) {
            const u32x2 q0 = *(const LAS u32x2*)(qe_l + r32 * GQ_P + 16 * s + 4 * hi), q1 = *(const LAS u32x2*)(qe_l + r32 * GQ_P + 16 * s + 8 + 4 * hi);
            const u32x4 qa = (u32x4){q0.x, q0.y, q1.x, q1.y};
            u32x4 sb;
            if (s == 0) { sb.x = cvt_pk_bf16(S0[0], S0[1]); sb.y = cvt_pk_bf16(S0[2], S0[3]); sb.z = cvt_pk_bf16(S0[4], S0[5]); sb.w = cvt_pk_bf16(S0[6], S0[7]); }
            else if (s == 1) { sb.x = cvt_pk_bf16(S0[8], S0[9]); sb.y = cvt_pk_bf16(S0[10], S0[11]); sb.z = cvt_pk_bf16(S0[12], S0[13]); sb.w = cvt_pk_bf16(S0[14], S0[15]); }
            else if (s == 2) { sb.x = cvt_pk_bf16(S1[0], S1[1]); sb.y = cvt_pk_bf16(S1[2], S1[3]); sb.z = cvt_pk_bf16(S1[4], S1[5]); sb.w = cvt_pk_bf16(S1[6], S1[7]); }
            else { sb.x = cvt_pk_bf16(S1[8], S1[9]); sb.y = cvt_pk_bf16(S1[10], S1[11]); sb.z = cvt_pk_bf16(S1[12], S1[13]); sb.w = cvt_pk_bf16(S1[14], S1[15]); }
            o = __builtin_amdgcn_mfma_f32_32x32x16_bf16(__builtin_bit_cast(bf16x8, qa), __builtin_bit_cast(bf16x8, sb), o, 0, 0, 0);
        }
        { LAS float* ol = (LAS float*)(lds + GL_O + (buf * 4 + dvs) * 4608);
#pragma unroll
          for (int r = 0; r < 16; ++r) ol[crow(r, hi) * 36 + r32] = o[r]; }
        {
            const u32x2 a0 = *(const LAS u32x2*)(kt_l + r32 * GT_P + 4 * hi), a1 = *(const LAS u32x2*)(kt_l + r32 * GT_P + 8 + 4 * hi);
            const u32x2 c0 = *(const LAS u32x2*)(kt_l + (32 + r32) * GT_P + 4 * hi), c1 = *(const LAS u32x2*)(kt_l + (32 + r32) * GT_P + 8 + 4 * hi);
            S0 = __builtin_amdgcn_mfma_f32_32x32x16_bf16(__builtin_bit_cast(bf16x8, (u32x4){a0.x, a0.y, a1.x, a1.y}), vf0, S0, 0, 0, 0);
            S1 = __builtin_amdgcn_mfma_f32_32x32x16_bf16(__builtin_bit_cast(bf16x8, (u32x4){c0.x, c0.y, c1.x, c1.y}), vf0, S1, 0, 0, 0);
        }
        {
            const u32x2 a0 = *(const LAS u32x2*)(kt_l + r32 * GT_P + 16 + 4 * hi), a1 = *(const LAS u32x2*)(kt_l + r32 * GT_P + 24 + 4 * hi);
            const u32x2 c0 = *(const LAS u32x2*)(kt_l + (32 + r32) * GT_P + 16 + 4 * hi), c1 = *(const LAS u32x2*)(kt_l + (32 + r32) * GT_P + 24 + 4 * hi);
            S0 = __builtin_amdgcn_mfma_f32_32x32x16_bf16(__builtin_bit_cast(bf16x8, (u32x4){a0.x, a0.y, a1.x, a1.y}), vf1, S0, 0, 0, 0);
            S1 = __builtin_amdgcn_mfma_f32_32x32x16_bf16(__builtin_bit_cast(bf16x8, (u32x4){c0.x, c0.y, c1.x, c1.y}), vf1, S1, 0, 0, 0);
        }
#pragma unroll
        for (int r = 0; r < 16; ++r) { S0[r] *= eb_l[crow(r, hi)]; S1[r] *= eb_l[32 + crow(r, hi)]; }
        LDS_BARRIER();
    }
    if (s_out) {
        unsigned soff2 = (unsigned)(4 * hi * 128 + 32 * dvs + r32); asm volatile("" : "+v"(soff2));
#pragma unroll
        for (int r = 0; r < 16; ++r) { const unsigned o_ = soff2 + (unsigned)(((r & 3) + 8 * (r >> 2)) * 128); s_out[o_] = S0[r]; s_out[o_ + 4096u] = S1[r]; }
    }
}

#define XB_TMO      128
#define XB_XCNT(j)  (256  + 64 * (j))
#define XB_XSUB(j)  (1280 + 64 * (j))
#define XB_XGEN(j)  (2304 + 64 * (j))
#define XB_TOP      3328
#define XB_TOPGEN   3392
#define XCD_BAR_WORDS 3456
#define XB_SPIN_CAP (1u << 18)
__device__ __forceinline__ unsigned xb_ld(unsigned* p)              { return __hip_atomic_load(p, __ATOMIC_RELAXED, __HIP_MEMORY_SCOPE_AGENT); }
__device__ __forceinline__ unsigned xb_add(unsigned* p, unsigned v) { return __hip_atomic_fetch_add(p, v, __ATOMIC_RELAXED, __HIP_MEMORY_SCOPE_AGENT); }
__device__ __forceinline__ unsigned xb_xcc_id() { return (unsigned)__builtin_amdgcn_s_getreg((3 << 11) | 20) & 0xFu; }
#define XB_SPIN(cond, bar) do { unsigned _sp = 0; while (cond) { __builtin_amdgcn_s_sleep(1); \
    if ((++_sp & 255u) == 0u) { if (xb_ld(&(bar)[XB_TMO])) break; if (_sp > XB_SPIN_CAP) { atomicAdd(&(bar)[XB_TMO], 1u); break; } } } } while (0)
struct XcdBarrier { unsigned* bar; unsigned x; volatile LAS unsigned* st; };
__device__ __forceinline__ XcdBarrier xcd_barrier_post(unsigned* bar, volatile LAS unsigned* st) {
    XcdBarrier b; b.bar = bar; b.x = xb_xcc_id(); b.st = st;
    if (threadIdx.x == 0) (void)xb_add(&bar[XB_XCNT(b.x)], 1u);
    return b;
}
__device__ __forceinline__ void xcd_barrier_complete(unsigned* bar, unsigned x, unsigned& nloc, unsigned& nx) {
    const unsigned G = gridDim.x * gridDim.y * gridDim.z;
    unsigned sum, cnt, mine, sp = 0u;
    for (;;) {
        sum = 0u; cnt = 0u; mine = 0u;
#pragma unroll
        for (unsigned j = 0; j < 16; ++j) { const unsigned c = xb_ld(&bar[XB_XCNT(j)]); sum += c; cnt += (c > 0u) ? 1u : 0u; mine = (j == x) ? c : mine; }
        if (sum == G) break;
        __builtin_amdgcn_s_sleep(1);
        if ((++sp & 255u) == 0u) { if (xb_ld(&bar[XB_TMO])) break; if (sp > XB_SPIN_CAP) { atomicAdd(&bar[XB_TMO], 1u); break; } }
    }
    nloc = mine > 0u ? mine : 1u; nx = cnt > 0u ? cnt : 1u;
}
__device__ __forceinline__ void xcd_barrier(const XcdBarrier& b, int wave0) {
    asm volatile("s_waitcnt vmcnt(0)" ::: "memory");
    __syncthreads();
    if (wave0 == 0 && lane_id_v() == 0) {
        unsigned* bar = b.bar;
        __builtin_amdgcn_s_waitcnt(0);
        unsigned nloc = b.st[0], nx = b.st[1];
        if (nloc == 0u) { xcd_barrier_complete(bar, b.x, nloc, nx); b.st[0] = nloc; b.st[1] = nx; }
        const unsigned old = xb_add(&bar[XB_XSUB(b.x)], 1u);
        const unsigned gen = old / nloc;
        if (old + 1u == (gen + 1u) * nloc) {
            __builtin_amdgcn_fence(__ATOMIC_RELEASE, "agent");
            asm volatile("s_waitcnt vmcnt(0)" ::: "memory");
            const unsigned og = xb_add(&bar[XB_TOP], 1u);
            const unsigned tg = og / nx;
            if (og + 1u == (tg + 1u) * nx) xb_add(&bar[XB_TOPGEN], 1u);
            else XB_SPIN(xb_ld(&bar[XB_TOPGEN]) == tg, bar);
            __builtin_amdgcn_fence(__ATOMIC_ACQUIRE, "agent");
            xb_add(&bar[XB_XGEN(b.x)], 1u);
            asm volatile("s_waitcnt vmcnt(0)" ::: "memory");
        } else {
            XB_SPIN(xb_ld(&bar[XB_XGEN(b.x)]) == gen, bar);
            __builtin_amdgcn_fence(__ATOMIC_ACQUIRE, "agent");
            asm volatile("s_waitcnt vmcnt(0)" ::: "memory");
        }
    }
    __syncthreads();
}

constexpr int LDS_BYTES = 147456;

__global__ void __launch_bounds__(512, 2) hymba_fwd(Args args) {
    extern __shared__ __attribute__((aligned(16))) unsigned char lds_raw[];
    LAS unsigned char* lds = (LAS unsigned char*)lds_raw;
#define PHASE_IDS() const int lane = lane_id_v(); const int wave = wave0; (void)lane; (void)wave
    const int G = gridDim.x, bx = blockIdx.x;
    const int wave0 = __builtin_amdgcn_readfirstlane((int)(threadIdx.x >> 6));
    if (threadIdx.x < 4) ((LAS unsigned*)(lds + XBST_OFF))[threadIdx.x] = 0u;
    __syncthreads();
    const XcdBarrier xbar = xcd_barrier_post((unsigned*)(args.ws + WS_CTL) + 4096, (volatile LAS unsigned*)(lds + XBST_OFF));
    const int vcu = (G % 8 == 0) ? (bx % 8) * (G / 8) + bx / 8 : bx;
    const float* x_prompt = args.in[0]; const float* x_sample = args.in[1];
    const float* w_in = args.in[6]; const float* w_a2 = args.in[7]; const float* b_a = args.in[8];
    const float* w_o = args.in[10]; const float* g_pre_mix = args.in[11];
    const float* w_up = args.in[15]; const float* w_down = args.in[18];
#define PHASE_WS() unsigned char* ws = args.ws; asm volatile("" : "+s"(ws))

    {
        PHASE_IDS(); PHASE_WS();
        bf16_t* WinT = (bf16_t*)(ws + WS_WIN); bf16_t* WoT = (bf16_t*)(ws + WS_WO); bf16_t* WupT = (bf16_t*)(ws + WS_WUP); bf16_t* WdT = (bf16_t*)(ws + WS_WD); bf16_t* XN = (bf16_t*)(ws + WS_XN + 4096);
        LAS float* scr = (LAS float*)(lds + wave * 16384);
        const int gw = vcu * 8 + wave, NGW = G * 8;
        constexpr int I_IN = 16 * 96, I_G = 16 * 8, I_O = 16 * 32, I_UP = 16 * 176, I_D = 44 * 32;
        constexpr int NITEMS = I_IN + I_G + I_O + I_UP + I_D;
        for (int it = gw; it < NITEMS; it += NGW) {
            int r = it;
            if (r < I_IN) { const int kb = r / 96, nb = r % 96; p0_transpose_item(w_in, DIN, 32 * nb, 64 * kb, WinT, 1024, 32 * nb, scr, lane); continue; } r -= I_IN;
            if (r < I_G) { const int kb = r / 8, nb = r % 8; p0_gate_item(w_in, w_a2, 64 * kb, 32 * nb, WinT, scr, lane); continue; } r -= I_G;
            if (r < I_O) { const int kb = r / 32, nb = r % 32; p0_transpose_item(w_o, 1024, 32 * nb, 64 * kb, WoT, 1024, 32 * nb, scr, lane); continue; } r -= I_O;
            if (r < I_UP) { const int kb = r / 176, nb = r % 176; const int n0 = 32 * nb, t = n0 >> 8, w = n0 & 255;
                const int sc = (w < 128) ? (128 * t + w) : (DFF + 128 * t + (w - 128));
                p0_transpose_item(w_up, 2 * DFF, sc, 64 * kb, WupT, 1024, n0, scr, lane); continue; } r -= I_UP;
            { const int kb = r / 32, nb = r % 32; p0_transpose_item(w_down, 1024, 32 * nb, 64 * kb, WdT, DFF, 32 * nb, scr, lane); }
        }
        for (int m = gw; m < MT; m += NGW) {
            const float* xr = (m < MP) ? x_prompt + (size_t)m * DM : x_sample + (size_t)(m - MP) * DM;
            rms_row_to_bf16(xr, g_pre_mix, XN + (size_t)m * DM, lane);
        }
    }
    xcd_barrier(xbar, wave0);

    {
        PHASE_WS();
        pg8::Gemm g{(bf16_t*)(ws + WS_XN + 4096), (bf16_t*)(ws + WS_WIN), 1024, 256, 1024}; pg8::StaticOrder S; S.init(MT / 256, NIN / 256, G, bx);
        EpiInProj E{(bf16_t*)(ws + WS_QA), (bf16_t*)(ws + WS_KA), (bf16_t*)(ws + WS_VA), (bf16_t*)(ws + WS_QB), (bf16_t*)(ws + WS_KB), (bf16_t*)(ws + WS_VB), (bf16_t*)(ws + WS_RB),
                    (float*)(ws + WS_LF), args.out, b_a};
        pg8::gemm_phase<EpiInProj, pg8::StaticOrder>(lds, g, S, E, wave0);
    }
    xcd_barrier(xbar, wave0);

    {
        PHASE_IDS(); PHASE_WS();
        bf16_t* MIX = (bf16_t*)(ws + WS_MIX);
        GlaCtx GC{(const bf16_t*)(ws + WS_QB), (const bf16_t*)(ws + WS_KB), (const bf16_t*)(ws + WS_VB), (const bf16_t*)(ws + WS_RB), (const float*)(ws + WS_LF), MIX, args.in[9]};
        const float* state_gla = args.in[4];
#ifndef NO_GLA
        for (int it = bx; it < 64 + 128; it += G) {
            const bool pr = it < 64; const int seq = pr ? it : it - 64; const int b = seq >> 2, h = seq & 3;
            const size_t row0 = pr ? (size_t)b * SEQ : (size_t)MP + (size_t)b * 8;
            const float* s_in = pr ? nullptr : state_gla + (size_t)seq * 8192;
            float* s_out = args.out + (pr ? O_GP : O_GS) + (size_t)seq * 8192;
            const int nchunk = pr ? SEQ / 32 : 1;
            if (wave < 4) { if (pr) gla_m_wave<32>(lds, wave, lane, nchunk, s_in, s_out); else gla_m_wave<8>(lds, wave, lane, nchunk, s_in, s_out); }
            else { if (pr) gla_h_wave<32>(GC, lds, wave - 4, lane, (unsigned)row0, h, nchunk); else gla_h_wave<8>(GC, lds, wave - 4, lane, (unsigned)row0, h, nchunk); }
            __syncthreads();
        }
#endif
        AttnCtx AC{(const bf16_t*)(ws + WS_QA), (const bf16_t*)(ws + WS_KA), (const bf16_t*)(ws + WS_VA), MIX, args.in[2], args.in[3]};
        unsigned* counter = (unsigned*)(ws + WS_CTL);
        LAS unsigned char* wl = lds + wave * 8192;
        const int lane2 = lane_id_v();
        for (int sb = (bx + 64) % G; sb < NSB; sb += G) attn_item<true>(AC, sb, wave, 0, 0, wl, lane2);
        const unsigned xq0 = xb_xcc_id() & 7u;
        for (unsigned kq = 0; kq < 8u; ++kq) {
            const unsigned xq = (xq0 + kq) & 7u;
            unsigned* head = counter + 64 * xq;
            for (;;) {
                unsigned loc = 0; if (lane2 == 0) loc = atomicAdd(head, 1u);
                loc = (unsigned)__builtin_amdgcn_readfirstlane((int)loc);
                if (loc >= 1024u) break;
                { const unsigned p = loc; const unsigned grp = p >> 8, q = p & 255u; const int g = 15 - (int)(q >> 4); const unsigned bhl = (q >> 2) & 3u; const int r4 = (int)(q & 3u);
                    const int bh = (int)(xq + 8u * (4u * grp + bhl));
                    attn_item<false>(AC, bh >> 3, bh & 7, g, r4, wl, lane2); }
            }
        }
    }
    xcd_barrier(xbar, wave0);

    {
        PHASE_WS();
        bf16_t* MO = (bf16_t*)(ws + WS_MO); float* SSQ1 = (float*)(ws + WS_SSQ1);
        pg8::Gemm g{(bf16_t*)(ws + WS_MIX), (bf16_t*)(ws + WS_WO), 1024, 256, 1024}; pg8::StaticOrder S; S.init(MP / 256, 4, G, bx);
        EpiRowOut E{MO, SSQ1};
        pg8::gemm_phase<EpiRowOut, pg8::StaticOrder>(lds, g, S, E, wave0);
        pg8::Gemm g2{(bf16_t*)(ws + WS_MIX), (bf16_t*)(ws + WS_WO), 256, 256, 1024}; pg8::SplitOrder S2{16, G, bx, 128, 256};
        EpiSlice E2{(float*)(ws + WS_ACC1), 256};
        pg8::gemm_phase<EpiSlice, pg8::SplitOrder>(lds, g2, S2, E2, wave0);
    }
    xcd_barrier(xbar, wave0);
    {
        PHASE_IDS(); PHASE_WS();
        bf16_t* MO = (bf16_t*)(ws + WS_MO); float* SSQ1 = (float*)(ws + WS_SSQ1); bf16_t* XN = (bf16_t*)(ws + WS_XN + 4096);
        const float* g_post = args.in[12]; const float* g_pre = args.in[13];
        const int gw = vcu * 8 + wave, NGW = G * 8;
        {
            f32x4 gp4[4], gq4[4];
#pragma unroll
            for (int j = 0; j < 4; ++j) { gp4[j] = ((const GAS f32x4*)g_post)[64 * j + lane]; gq4[j] = ((const GAS f32x4*)g_pre)[64 * j + lane]; }
            for (int m0 = gw; m0 < MP; m0 += 2 * NGW) {
                const int m1 = (m0 + NGW < MP) ? m0 + NGW : m0;
                f32x4 sp[2], xv[2][4]; u32x2 mw[2][4];
#pragma unroll
                for (int r = 0; r < 2; ++r) { const int m = r ? m1 : m0; sp[r] = *((const GAS f32x4*)(SSQ1 + (size_t)m * 16) + (lane & 3));
#pragma unroll
                    for (int j = 0; j < 4; ++j) { xv[r][j] = ((const GAS f32x4*)(x_prompt + (size_t)m * DM))[64 * j + lane]; mw[r][j] = ((const GAS u32x2*)(MO + (size_t)m * DM))[64 * j + lane]; } }
#pragma unroll
                for (int r = 0; r < 2; ++r) if (r == 0 || m1 != m0) { const int m = r ? m1 : m0;
                    float ss = (sp[r].x + sp[r].y) + (sp[r].z + sp[r].w); ss += __shfl_xor(ss, 1); ss += __shfl_xor(ss, 2);
                    const float rs = rsqrtf(ss * (1.f / DM) + EPS);
                    f32x4 x1[4]; float s2 = 0.f;
#pragma unroll
                    for (int j = 0; j < 4; ++j) { f32x4 mv; mv.x = __uint_as_float(mw[r][j].x << 16); mv.y = __uint_as_float(mw[r][j].x & 0xffff0000u); mv.z = __uint_as_float(mw[r][j].y << 16); mv.w = __uint_as_float(mw[r][j].y & 0xffff0000u);
                        x1[j] = xv[r][j] + mv * rs * gp4[j]; s2 += (x1[j].x * x1[j].x + x1[j].y * x1[j].y) + (x1[j].z * x1[j].z + x1[j].w * x1[j].w);
                        }
                    const float rs2 = rsqrtf(wave_sum(s2) * (1.f / DM) + EPS);
#pragma unroll
                    for (int j = 0; j < 4; ++j) { const f32x4 y = x1[j] * rs2 * gq4[j]; u32x2 w; w.x = pk2(y.x, y.y); w.y = pk2(y.z, y.w); ((GAS u32x2*)(XN + (size_t)m * DM))[64 * j + lane] = w; }
                }
            }
        }
        for (int m = MP + gw; m < MT; m += NGW) {
            const float* xr = (m < MP) ? x_prompt + (size_t)m * DM : x_sample + (size_t)(m - MP) * DM;
            float* orow = args.out + (size_t)m * DM;
            f32x4 mvv[4]; float ss;
            if (m < MP) {
                const f32x4 sp = *((const f32x4*)(SSQ1 + (size_t)m * 16) + (lane & 3));
                ss = (sp.x + sp.y) + (sp.z + sp.w); ss += __shfl_xor(ss, 1); ss += __shfl_xor(ss, 2);
#pragma unroll
                for (int j = 0; j < 4; ++j) { const u32x2 mw = ((const u32x2*)(MO + (size_t)m * DM))[64 * j + lane];
                    mvv[j].x = __uint_as_float(mw.x << 16); mvv[j].y = __uint_as_float(mw.x & 0xffff0000u); mvv[j].z = __uint_as_float(mw.y << 16); mvv[j].w = __uint_as_float(mw.y & 0xffff0000u); }
            } else {
                const f32x4* ar = (const f32x4*)(ws + WS_ACC1) + (size_t)(m - MP) * 256; float s = 0.f;
#pragma unroll
                for (int j = 0; j < 4; ++j) { f32x4 a = ar[64 * j + lane];
                    for (int sl = 1; sl < 4; ++sl) a += ar[(size_t)sl * 65536 + 64 * j + lane];
                    mvv[j] = a; s += (a.x * a.x + a.y * a.y) + (a.z * a.z + a.w * a.w); }
                ss = wave_sum(s);
            }
            const float rs = rsqrtf(ss * (1.f / DM) + EPS);
            f32x4 x1[4]; float s2 = 0.f;
#pragma unroll
            for (int j = 0; j < 4; ++j) { const int c4 = 64 * j + lane; const f32x4 xv = ((const f32x4*)xr)[c4]; const f32x4 gp = ((const f32x4*)g_post)[c4];
                const f32x4 mv = mvv[j];
                x1[j] = xv + mv * rs * gp; s2 += (x1[j].x * x1[j].x + x1[j].y * x1[j].y) + (x1[j].z * x1[j].z + x1[j].w * x1[j].w);
                ((f32x4*)orow)[c4] = x1[j]; }
            const float rs2 = rsqrtf(wave_sum(s2) * (1.f / DM) + EPS);
#pragma unroll
            for (int j = 0; j < 4; ++j) { const int c4 = 64 * j + lane; const f32x4 gq = ((const f32x4*)g_pre)[c4]; const f32x4 y = x1[j] * rs2 * gq; u32x2 w; w.x = pk2(y.x, y.y); w.y = pk2(y.z, y.w); ((u32x2*)(XN + (size_t)m * DM))[c4] = w; }
        }
    }
    xcd_barrier(xbar, wave0);
    {
        PHASE_WS();
        bf16_t* Hb = (bf16_t*)(ws + WS_H);
        pg8::Gemm g{(bf16_t*)(ws + WS_XN + 4096) - 2 * DM, (bf16_t*)(ws + WS_WUP), 1024, 254, 1024}; pg8::StaticOrder S; S.init(131, 22, G, bx);
        EpiUp E{Hb, args.out, args.in[16], args.in[17], args.in[5], lds};
        pg8::gemm_phase<EpiUp, pg8::StaticOrder>(lds, g, S, E, wave0);
    }
    xcd_barrier(xbar, wave0);
    {
        PHASE_WS();
        bf16_t* MO = (bf16_t*)(ws + WS_XN + 4096); float* SSQ2 = (float*)(ws + WS_SSQ2);
        pg8::Gemm g{(bf16_t*)(ws + WS_H), (bf16_t*)(ws + WS_WD), DFF, 256, DFF}; pg8::StaticOrder S; S.init(MP / 256, 4, G, bx);
        EpiRowOut E{MO, SSQ2};
        pg8::gemm_phase<EpiRowOut, pg8::StaticOrder>(lds, g, S, E, wave0);
        pg8::Gemm g2{(bf16_t*)(ws + WS_H), (bf16_t*)(ws + WS_WD), 256, 256, DFF}; pg8::SplitOrder S2{44, G, bx, 128, 256};
        EpiSlice E2{(float*)(ws + WS_ACC2), 256};
        pg8::gemm_phase<EpiSlice, pg8::SplitOrder>(lds, g2, S2, E2, wave0);
    }
    xcd_barrier(xbar, wave0);
    {
        PHASE_IDS(); PHASE_WS();
        bf16_t* MO = (bf16_t*)(ws + WS_MO); float* SSQ2 = (float*)(ws + WS_SSQ2);
        const float* g_post = args.in[14];
        const int gw = vcu * 8 + wave, NGW = G * 8;
        {
            const bf16_t* MO1 = (const bf16_t*)(ws + WS_MO); const bf16_t* FO = (const bf16_t*)(ws + WS_XN + 4096); const float* SSQ1 = (const float*)(ws + WS_SSQ1);
            const float* g_mix = args.in[12];
            f32x4 ga[4], gb[4];
#pragma unroll
            for (int j = 0; j < 4; ++j) { ga[j] = ((const GAS f32x4*)g_mix)[64 * j + lane]; gb[j] = ((const GAS f32x4*)g_post)[64 * j + lane]; }
            for (int m0 = gw; m0 < MP; m0 += 2 * NGW) {
                const int m1 = (m0 + NGW < MP) ? m0 + NGW : m0;
                f32x4 sa[2], sb[2], xv[2][4]; u32x2 mw[2][4], fw[2][4];
#pragma unroll
                for (int r = 0; r < 2; ++r) { const int m = r ? m1 : m0; sa[r] = *((const GAS f32x4*)(SSQ1 + (size_t)m * 16) + (lane & 3)); sb[r] = *((const GAS f32x4*)(SSQ2 + (size_t)m * 16) + (lane & 3));
#pragma unroll
                    for (int j = 0; j < 4; ++j) { xv[r][j] = ((const GAS f32x4*)(x_prompt + (size_t)m * DM))[64 * j + lane]; mw[r][j] = ((const GAS u32x2*)(MO1 + (size_t)m * DM))[64 * j + lane]; fw[r][j] = ((const GAS u32x2*)(FO + (size_t)m * DM))[64 * j + lane]; } }
#pragma unroll
                for (int r = 0; r < 2; ++r) if (r == 0 || m1 != m0) { const int m = r ? m1 : m0;
                    float s1 = (sa[r].x + sa[r].y) + (sa[r].z + sa[r].w); s1 += __shfl_xor(s1, 1); s1 += __shfl_xor(s1, 2);
                    float s2 = (sb[r].x + sb[r].y) + (sb[r].z + sb[r].w); s2 += __shfl_xor(s2, 1); s2 += __shfl_xor(s2, 2);
                    const float rs1 = rsqrtf(s1 * (1.f / DM) + EPS), rs2 = rsqrtf(s2 * (1.f / DM) + EPS);
#pragma unroll
                    for (int j = 0; j < 4; ++j) { f32x4 mv, fv;
                        mv.x = __uint_as_float(mw[r][j].x << 16); mv.y = __uint_as_float(mw[r][j].x & 0xffff0000u); mv.z = __uint_as_float(mw[r][j].y << 16); mv.w = __uint_as_float(mw[r][j].y & 0xffff0000u);
                        fv.x = __uint_as_float(fw[r][j].x << 16); fv.y = __uint_as_float(fw[r][j].x & 0xffff0000u); fv.z = __uint_as_float(fw[r][j].y << 16); fv.w = __uint_as_float(fw[r][j].y & 0xffff0000u);
                        const f32x4 x1 = xv[r][j] + mv * rs1 * ga[j];
                        ((GAS f32x4*)(args.out + (size_t)m * DM))[64 * j + lane] = x1 + fv * rs2 * gb[j]; }
                }
            }
        }
        for (int m = MP + gw; m < MT; m += NGW) {
            float* orow = args.out + (size_t)m * DM;
            f32x4 mvv[4]; float ss;
            if (m < MP) {
                const f32x4 sp = *((const f32x4*)(SSQ2 + (size_t)m * 16) + (lane & 3));
                ss = (sp.x + sp.y) + (sp.z + sp.w); ss += __shfl_xor(ss, 1); ss += __shfl_xor(ss, 2);
#pragma unroll
                for (int j = 0; j < 4; ++j) { const u32x2 mw = ((const u32x2*)(MO + (size_t)m * DM))[64 * j + lane];
                    mvv[j].x = __uint_as_float(mw.x << 16); mvv[j].y = __uint_as_float(mw.x & 0xffff0000u); mvv[j].z = __uint_as_float(mw.y << 16); mvv[j].w = __uint_as_float(mw.y & 0xffff0000u); }
            } else {
                const f32x4* ar = (const f32x4*)(ws + WS_ACC2) + (size_t)(m - MP) * 256; float s = 0.f;
#pragma unroll
                for (int j = 0; j < 4; ++j) { f32x4 a = ar[64 * j + lane];
                    for (int sl = 1; sl < 11; ++sl) a += ar[(size_t)sl * 65536 + 64 * j + lane];
                    mvv[j] = a; s += (a.x * a.x + a.y * a.y) + (a.z * a.z + a.w * a.w); }
                ss = wave_sum(s);
            }
            const float rs = rsqrtf(ss * (1.f / DM) + EPS);
#pragma unroll
            for (int j = 0; j < 4; ++j) { const int c4 = 64 * j + lane; const f32x4 xv = ((const f32x4*)orow)[c4]; const f32x4 gp = ((const f32x4*)g_post)[c4];
                ((f32x4*)orow)[c4] = xv + mvv[j] * rs * gp; }
        }
    }
}

extern "C" void kernel_launch(void* const* d_in, const int* in_sizes, int n_in, void* d_out, int out_size, void* d_ws, size_t ws_size, hipStream_t stream) {
    static int grid = 0;
    if (grid == 0) {
        if (n_in != 19 || ws_size < WS_END || (size_t)out_size != O_END) { fprintf(stderr, "kernel_launch: unexpected shapes n_in %d out %d ws %zu\n", n_in, out_size, ws_size); grid = -1; return; }
        int dev = 0, cus = 0, per_cu = 0;
        hipGetDevice(&dev); hipDeviceGetAttribute(&cus, hipDeviceAttributeMultiprocessorCount, dev);
        hipFuncSetAttribute((const void*)hymba_fwd, hipFuncAttributeMaxDynamicSharedMemorySize, LDS_BYTES);
        hipOccupancyMaxActiveBlocksPerMultiprocessor(&per_cu, (const void*)hymba_fwd, 512, LDS_BYTES);
        if (per_cu < 1) { fprintf(stderr, "kernel_launch: occupancy query says %d blocks per CU\n", per_cu); grid = -1; return; }
        grid = cus;
    }
    if (grid < 0) return;
    hipMemsetAsync((char*)d_ws + WS_CTL, 0, CTL_BYTES, stream);
    Args a{};
    for (int i = 0; i < 19; ++i) a.in[i] = (const float*)d_in[i];
    a.out = (float*)d_out; a.ws = (unsigned char*)d_ws;
    void* kargs[] = {&a};
    hipError_t e = hipLaunchCooperativeKernel((const void*)hymba_fwd, dim3(grid), dim3(512), kargs, LDS_BYTES, stream);
    if (e != hipSuccess) fprintf(stderr, "cooperative launch failed: %s (grid %d)\n", hipGetErrorString(e), grid);
}
```

```cpp
#include <hip/hip_runtime.h>
#include <hip/hip_cooperative_groups.h>
#include <cstdio>
#include <cstdint>
namespace cg = cooperative_groups;

#define LAS __attribute__((address_space(3)))
#define GAS __attribute__((address_space(1)))
typedef unsigned short bf16_t;
typedef short bf16x8 __attribute__((ext_vector_type(8)));
typedef short s16x4 __attribute__((ext_vector_type(4)));
typedef float f32x4 __attribute__((ext_vector_type(4)));
typedef float f32x2 __attribute__((ext_vector_type(2)));
typedef float f32x16 __attribute__((ext_vector_type(16)));
typedef unsigned u32x4 __attribute__((ext_vector_type(4)));
typedef unsigned u32x2 __attribute__((ext_vector_type(2)));

constexpr int DM = 1024, NPB = 16, SEQ = 2048, NSB = 32, NST = 8;
constexpr int MP = NPB * SEQ;
constexpr int MS = NSB * NST;
constexpr int MT = MP + MS;
constexpr int NIN = 3328;
constexpr int DIN = 3088;
constexpr int DFF = 2816;
constexpr int WINB = 2048;
constexpr float EPS = 1e-6f;
constexpr float QSCALE = 0.125f * 1.4426950408889634f;

constexpr size_t MiB = 1u << 20;
constexpr size_t WS_CTL = 0, CTL_BYTES = 65536;
constexpr int XBST_OFF = 131072 + 8192;
constexpr size_t WS_WIN = 1 * MiB, WS_WO = 8 * MiB, WS_WUP = 10 * MiB, WS_WD = 22 * MiB;
constexpr size_t WS_SSQ1 = 28 * MiB, WS_SSQ2 = 31 * MiB;
constexpr size_t WS_XN = 34 * MiB;
constexpr size_t WS_MO = 104 * MiB;
constexpr size_t WS_QA = 172 * MiB, WS_KA = 206 * MiB, WS_VA = 240 * MiB, WS_QB = 274 * MiB, WS_KB = 291 * MiB, WS_VB = 308 * MiB, WS_RB = 342 * MiB, WS_LF = 376 * MiB, WS_MIX = 410 * MiB;
constexpr size_t WS_H = 172 * MiB;
constexpr size_t WS_ACC1 = 478 * MiB, WS_ACC2 = 482 * MiB;
constexpr size_t WS_END = 494 * MiB;
static_assert(WS_H + (size_t)MT * DFF * 2 <= WS_MIX, "h overlay");
static_assert(WS_XN + 4096 + (size_t)(131 * 254 + 260) * DM * 2 <= WS_MO, "xn2");

constexpr size_t O_YP = 0, O_YS = O_YP + (size_t)MP * DM, O_KP = O_YS + (size_t)MS * DM, O_VP = O_KP + (size_t)MP * 512, O_GP = O_VP + (size_t)MP * 512,
                 O_CP = O_GP + (size_t)NPB * 4 * 64 * 128, O_KS = O_CP + (size_t)NPB * 2 * DFF, O_VS = O_KS + (size_t)MS * 512, O_GS = O_VS + (size_t)MS * 512,
                 O_CS = O_GS + (size_t)NSB * 4 * 64 * 128, O_END = O_CS + (size_t)NSB * 2 * DFF;

__device__ __forceinline__ unsigned cvt_pk_bf16(float lo, float hi) { unsigned r; asm volatile("v_cvt_pk_bf16_f32 %0, %1, %2" : "=v"(r) : "v"(lo), "v"(hi)); return r; }
__device__ __forceinline__ float bf2f(unsigned short b) { return __uint_as_float((unsigned)b << 16); }
__device__ __forceinline__ float wave_sum(float v) {
#pragma unroll
    for (int o = 1; o < 64; o <<= 1) v += __shfl_xor(v, o);
    return v;
}

__device__ __forceinline__ int lane_id_v() { int l; asm volatile("v_mbcnt_lo_u32_b32 %0, -1, 0\n\tv_mbcnt_hi_u32_b32 %0, -1, %0" : "=v"(l)); return l; }

struct Args {
    const float* in[19];
    float* out;
    unsigned char* ws;
};

namespace pg8 {
constexpr int BM = 256, BK = 64, HALF = 128, HTB = HALF * BK * 2, STAGE_BYTES = 8 * HTB, NXCD = 8, WGM = 4;
__host__ __device__ __forceinline__ int lds_byte(int r, int c) { const int st = (r >> 4) * 2 + (c >> 5), rr = r & 15, cc = c & 31, ob = rr * 64 + cc * 2; return st * 1024 + (ob ^ (((ob >> 9) & 1) << 5)); }
__host__ __device__ __forceinline__ void stage_rc(int b, int& R, int& C) { const int st = b / 1024, sb = b % 1024, swz = sb ^ (((sb >> 9) & 1) << 5); R = (st >> 1) * 16 + swz / 64; C = (st & 1) * 32 + (swz % 64) / 2; }
__host__ __device__ __forceinline__ int perm32(int rho) { const int n = rho >> 4, i = rho & 15; return 8 * (i >> 2) + 4 * n + (i & 3); }

struct Unit { int pm, pn, kofs; };
struct Gemm { const bf16_t* A; const bf16_t* Bt; int K; int a_rows; int ldk; };

struct StaticOrder {
    int nM, nN, nwg, G, c;
    __device__ void init(int nM_, int nN_, int G_, int c_) { nM = nM_; nN = nN_; nwg = nM * nN; G = G_; c = c_; }
    __device__ bool next(int i, Unit& u) const {
        const long L = (long)i * G + c; if (L >= nwg) return false;
        int wgid = (int)L; { const int q = nwg / NXCD, r = nwg % NXCD, xcd = wgid % NXCD, off = wgid / NXCD; wgid = (xcd < r ? xcd * (q + 1) : r * (q + 1) + (xcd - r) * q) + off; }
        const int nig = WGM * nN, gid = wgid / nig, fm = gid * WGM, gsz = (nM - fm) < WGM ? (nM - fm) : WGM;
        u.pm = fm + ((wgid % nig) % gsz); u.pn = (wgid % nig) / gsz; u.kofs = 0; return true;
    }
};
struct SplitOrder {
    int nsub, G, c, pm, ksub;
    __device__ bool next(int i, Unit& u) const { const int L = i * G + c; if (L >= nsub) return false; u.pm = pm; u.pn = L & 3; u.kofs = (L >> 2) * ksub; return true; }
};

__device__ __forceinline__ f32x2 gelu_pk(f32x2 v) {
    const f32x2 av = __builtin_elementwise_abs(v), d = av * 0.2316418882f + 1.0f;
    f32x2 t; t.x = __builtin_amdgcn_rcpf(d.x); t.y = __builtin_amdgcn_rcpf(d.y);
    f32x2 q = t * 0.5307027145f + (-0.7265760135f); q = q * t + 0.7107068705f; q = q * t + (-0.142248368f); q = q * t + 0.127414796f; q = q * t;
    const f32x2 s = (v * v) * (-0.72134752044f);
    f32x2 e; e.x = __builtin_amdgcn_exp2f(s.x); e.y = __builtin_amdgcn_exp2f(s.y);
    const f32x2 m = v * (q * e), r = v - m;
    f32x2 o; o.x = v.x < 0.f ? m.x : r.x; o.y = v.y < 0.f ? m.y : r.y; return o;
}

template <class Epi, class Sched>
__device__ __forceinline__ void gemm_phase(LAS unsigned char* lds, const Gemm g, const Sched& S, const Epi& E, int wid) {
    const int lane = lane_id_v(); const int tid = wid * 64 + lane;
    const int wr = wid >> 2, wc = wid & 3, fr = lane & 15, fq = lane >> 4;
    const int K = g.ldk, nt = g.K / BK;
    unsigned voffA[2], voffB[2];
#pragma unroll
    for (int i = 0; i < 2; ++i) { int R, C; stage_rc(tid * 16 + i * 8192, R, C); const int Rb = Epi::PERM ? ((R & ~31) + perm32(R & 31)) : R;
        voffA[i] = (unsigned)(R * K + C) * 2u; voffB[i] = (unsigned)(Rb * K + C) * 2u; }
    const size_t kstep = (size_t)(BK * 2);
    const size_t hstep = (size_t)HALF * K * 2;
    const size_t tstepB = 2 * hstep;
    const size_t tstepA = (size_t)g.a_rows * K * 2;
    const unsigned ldsw = (unsigned)wid * 1024u;
    const int aoff = lds_byte(wr * 64 + fr, fq * 8), boff = lds_byte(wc * 32 + fr, fq * 8);
#define PG8_SA(b, h) (((b) * 2 + (h)) * HTB)
#define PG8_SB(b, h) ((4 + (b) * 2 + (h)) * HTB)
#define PG8_STAGE(bufoff, gbase, voff) do { _Pragma("unroll") for (int _i = 0; _i < 2; ++_i) \
        __builtin_amdgcn_global_load_lds((const unsigned*)((const char*)(gbase) + (voff)[_i]), (LAS unsigned*)(lds + (bufoff) + ldsw + _i * 8192), 16, 0, 0); } while (0)
#define PG8_LDA(dst, b, h) do { _Pragma("unroll") for (int m = 0; m < 4; ++m) _Pragma("unroll") for (int k = 0; k < 2; ++k) dst[m][k] = *(const LAS bf16x8*)(lds + PG8_SA(b, h) + aoff + m * 2048 + k * 1024); } while (0)
#define PG8_LDB(dst, b, h) do { _Pragma("unroll") for (int n = 0; n < 2; ++n) _Pragma("unroll") for (int k = 0; k < 2; ++k) dst[n][k] = *(const LAS bf16x8*)(lds + PG8_SB(b, h) + boff + n * 2048 + k * 1024); } while (0)
#define PG8_MMA(ai, bj, At, Bt) do { __builtin_amdgcn_s_setprio(1); _Pragma("unroll") for (int m = 0; m < 4; ++m) _Pragma("unroll") for (int n = 0; n < 2; ++n) _Pragma("unroll") for (int k = 0; k < 2; ++k) \
        acc[ai][bj][m][n] = __builtin_amdgcn_mfma_f32_16x16x32_bf16(Bt[n][k], At[m][k], acc[ai][bj][m][n], 0, 0, 0); __builtin_amdgcn_s_setprio(0); } while (0)
#define PG8_WAIT_V(n) asm volatile("s_waitcnt vmcnt(" #n ")" ::: "memory")
#define PG8_WAIT_L(n) asm volatile("s_waitcnt lgkmcnt(" #n ")" ::: "memory")
#define PG8_BAR __builtin_amdgcn_s_barrier()
#define PG8_SCHED __builtin_amdgcn_sched_barrier(0)
    Unit cur, nxt; int ui = 0;
    if (!S.next(0, cur)) return;
    f32x4 acc[2][2][4][2];
#pragma unroll
    for (int a = 0; a < 2; ++a)
#pragma unroll
        for (int b = 0; b < 2; ++b)
#pragma unroll
            for (int m = 0; m < 4; ++m)
#pragma unroll
                for (int n = 0; n < 2; ++n) acc[a][b][m][n] = (f32x4){0.f, 0.f, 0.f, 0.f};
    bf16x8 At[4][2], B0[2][2], B1[2][2];
    const char* cA = (const char*)g.A + (size_t)cur.pm * tstepA + (size_t)cur.kofs * 2; const char* cB = (const char*)g.Bt + (size_t)cur.pn * tstepB + (size_t)cur.kofs * 2;
    PG8_STAGE(PG8_SB(0, 0), cB, voffB); PG8_STAGE(PG8_SB(0, 1), cB + hstep, voffB); PG8_STAGE(PG8_SA(0, 0), cA, voffA); PG8_STAGE(PG8_SA(0, 1), cA + hstep, voffA);
    if (wr == 1) PG8_BAR;
    PG8_WAIT_V(2); PG8_BAR;
    PG8_STAGE(PG8_SB(1, 0), cB + kstep, voffB); PG8_STAGE(PG8_SA(1, 0), cA + kstep, voffA); PG8_STAGE(PG8_SB(1, 1), cB + hstep + kstep, voffB);
    PG8_WAIT_V(6); PG8_BAR;
    for (;;) {
        const bool has_next = S.next(ui + 1, nxt);
        const char* nA = has_next ? (const char*)g.A + (size_t)nxt.pm * tstepA + (size_t)nxt.kofs * 2 : cA; const char* nB = has_next ? (const char*)g.Bt + (size_t)nxt.pn * tstepB + (size_t)nxt.kofs * 2 : cB;
        for (int t = 0; t < nt; t += 2) {
            const bool last = (t == nt - 2);
            const char* a1 = cA + (size_t)(t + 1) * kstep;
            const char* a2 = last ? nA : cA + (size_t)(t + 2) * kstep; const char* b2 = last ? nB : cB + (size_t)(t + 2) * kstep;
            const char* a3 = a2 + kstep; const char* b3 = b2 + kstep;
            PG8_LDB(B0, 0, 0); PG8_LDB(B1, 0, 1); PG8_SCHED; PG8_LDA(At, 0, 0); PG8_STAGE(PG8_SA(1, 1), a1 + hstep, voffA);
            PG8_WAIT_V(8); PG8_WAIT_L(0); PG8_BAR; PG8_MMA(0, 0, At, B0); PG8_MMA(0, 1, At, B1); PG8_BAR; PG8_SCHED;
            PG8_LDA(At, 0, 1); PG8_STAGE(PG8_SB(0, 0), b2, voffB); PG8_STAGE(PG8_SB(0, 1), b2 + hstep, voffB); PG8_STAGE(PG8_SA(0, 0), a2, voffA);
            PG8_WAIT_V(8); PG8_WAIT_L(0); PG8_BAR; PG8_MMA(1, 0, At, B0); PG8_MMA(1, 1, At, B1); PG8_BAR; PG8_SCHED;
            PG8_LDB(B0, 1, 0); PG8_LDB(B1, 1, 1); PG8_SCHED; PG8_LDA(At, 1, 0); PG8_STAGE(PG8_SA(0, 1), a2 + hstep, voffA);
            PG8_WAIT_V(8); PG8_WAIT_L(0); PG8_BAR; PG8_MMA(0, 0, At, B0); PG8_MMA(0, 1, At, B1); PG8_BAR; PG8_SCHED;
            PG8_LDA(At, 1, 1); PG8_STAGE(PG8_SB(1, 0), b3, voffB); PG8_STAGE(PG8_SB(1, 1), b3 + hstep, voffB); PG8_STAGE(PG8_SA(1, 0), a3, voffA);
            PG8_WAIT_V(8); PG8_WAIT_L(0); PG8_BAR; PG8_MMA(1, 0, At, B0); PG8_MMA(1, 1, At, B1); PG8_BAR; PG8_SCHED;
        }
        if (wr == 0) PG8_BAR;
        E(acc, cur, wr, wc, fr, fq);
        if (!has_next) break;
#pragma unroll
        for (int a = 0; a < 2; ++a)
#pragma unroll
            for (int b = 0; b < 2; ++b)
#pragma unroll
                for (int m = 0; m < 4; ++m)
#pragma unroll
                    for (int n = 0; n < 2; ++n) acc[a][b][m][n] = (f32x4){0.f, 0.f, 0.f, 0.f};
        cur = nxt; cA = nA; cB = nB; ++ui;
        if (wr == 1) PG8_BAR;
    }
    PG8_WAIT_V(0);
    PG8_BAR;
#undef PG8_SA
#undef PG8_SB
#undef PG8_STAGE
#undef PG8_LDA
#undef PG8_LDB
#undef PG8_MMA
#undef PG8_WAIT_V
#undef PG8_WAIT_L
#undef PG8_BAR
#undef PG8_SCHED
}
}

struct EpiInProj {
    static constexpr bool PERM = true;
    bf16_t *QA, *KA, *VA, *QB, *KB, *VB, *RB; float* LF; float* out; const float* b_a;
    __device__ __forceinline__ void operator()(const f32x4 (&acc)[2][2][4][2], const pg8::Unit& u, int wr, int wc, int fr, int fq) const {
        const int pn = u.pn;
        const int row0 = u.pm * 256 + wr * 64 + fr;
        const int cl = wc * 32 + 8 * fq;
        if (pn == 12) {
#pragma unroll
            for (int bj = 0; bj < 2; ++bj) {
                const f32x4 b0 = *(const f32x4*)(b_a + cl + bj * 128), b1 = *(const f32x4*)(b_a + cl + bj * 128 + 4);
#pragma unroll
                for (int ai = 0; ai < 2; ++ai)
#pragma unroll
                    for (int m = 0; m < 4; ++m) {
                        f32x4 v0 = acc[ai][bj][m][0] + b0, v1 = acc[ai][bj][m][1] + b1;
#pragma unroll
                        for (int e = 0; e < 4; ++e) {
                            float z = v0[e]; v0[e] = (fminf(z, 0.f) - 0.69314718f * __builtin_amdgcn_logf(1.f + __builtin_amdgcn_exp2f(-1.44269504f * fabsf(z)))) * 0.0625f;
                            z = v1[e]; v1[e] = (fminf(z, 0.f) - 0.69314718f * __builtin_amdgcn_logf(1.f + __builtin_amdgcn_exp2f(-1.44269504f * fabsf(z)))) * 0.0625f; }
                        float* p = LF + (size_t)(row0 + ai * 128 + m * 16) * 256 + cl + bj * 128;
                        *(f32x4*)p = v0; *(f32x4*)(p + 4) = v1;
                    }
            }
            return;
        }
        bf16_t* base; int ld, cb; float sc = 1.f; float* fo = nullptr;
        if (pn < 2) { base = QA; ld = 512; cb = pn * 256; sc = QSCALE; }
        else if (pn < 4) { base = KA; ld = 512; cb = (pn - 2) * 256; fo = out + (u.pm < 128 ? O_KP : O_KS - (size_t)MP * 512); }
        else if (pn < 6) { base = VA; ld = 512; cb = (pn - 4) * 256; fo = out + (u.pm < 128 ? O_VP : O_VS - (size_t)MP * 512); }
        else if (pn == 6) { base = QB; ld = 256; cb = 0; }
        else if (pn == 7) { base = KB; ld = 256; cb = 0; }
        else if (pn < 10) { base = VB; ld = 512; cb = (pn - 8) * 256; }
        else { base = RB; ld = 512; cb = (pn - 10) * 256; }
#pragma unroll
        for (int ai = 0; ai < 2; ++ai)
#pragma unroll
            for (int m = 0; m < 4; ++m) {
                const size_t r = (size_t)(row0 + ai * 128 + m * 16);
#pragma unroll
                for (int bj = 0; bj < 2; ++bj) {
                    const f32x4 a0 = acc[ai][bj][m][0], a1 = acc[ai][bj][m][1];
                    const f32x4 v0 = a0 * sc, v1 = a1 * sc;
                    u32x4 w; w.x = cvt_pk_bf16(v0[0], v0[1]); w.y = cvt_pk_bf16(v0[2], v0[3]); w.z = cvt_pk_bf16(v1[0], v1[1]); w.w = cvt_pk_bf16(v1[2], v1[3]);
                    *(u32x4*)(base + r * ld + cb + cl + bj * 128) = w;
                    if (fo) { float* p = fo + r * 512 + cb + cl + bj * 128; *(f32x4*)p = a0; *(f32x4*)(p + 4) = a1; }
                }
            }
    }
};


struct EpiRowOut {
    static constexpr bool PERM = true;
    bf16_t* O; float* SSQ;
    __device__ __forceinline__ void operator()(const f32x4 (&acc)[2][2][4][2], const pg8::Unit& u, int wr, int wc, int fr, int fq) const {
        const int row0 = u.pm * 256 + wr * 64 + fr; const int cl = u.pn * 256 + wc * 32 + 8 * fq;
#pragma unroll
        for (int ai = 0; ai < 2; ++ai)
#pragma unroll
            for (int m = 0; m < 4; ++m) {
                const size_t r = (size_t)(row0 + ai * 128 + m * 16); float s = 0.f;
#pragma unroll
                for (int bj = 0; bj < 2; ++bj) {
                    const f32x4 v0 = acc[ai][bj][m][0], v1 = acc[ai][bj][m][1];
                    s += (v0[0] * v0[0] + v0[1] * v0[1]) + (v0[2] * v0[2] + v0[3] * v0[3]) + (v1[0] * v1[0] + v1[1] * v1[1]) + (v1[2] * v1[2] + v1[3] * v1[3]);
                    u32x4 w; w.x = cvt_pk_bf16(v0[0], v0[1]); w.y = cvt_pk_bf16(v0[2], v0[3]); w.z = cvt_pk_bf16(v1[0], v1[1]); w.w = cvt_pk_bf16(v1[2], v1[3]);
                    *(u32x4*)(O + r * 1024 + cl + bj * 128) = w;
                }
                s += __shfl_xor(s, 16); s += __shfl_xor(s, 32);
                if (fq == 0) SSQ[r * 16 + u.pn * 4 + wc] = s;
            }
    }
};

struct EpiSlice {
    static constexpr bool PERM = false;
    float* SL; int ksub;
    __device__ __forceinline__ void operator()(const f32x4 (&acc)[2][2][4][2], const pg8::Unit& u, int wr, int wc, int fr, int fq) const {
        float* base = SL + (size_t)(u.kofs / ksub) * (256 * 1024) + (unsigned)((wr * 64 + fr) * 1024 + u.pn * 256 + wc * 32 + 4 * fq);
#pragma unroll
        for (int ai = 0; ai < 2; ++ai)
#pragma unroll
            for (int m = 0; m < 4; ++m) { float* rowp = base + (ai * 128 + m * 16) * 1024;
#pragma unroll
                for (int bj = 0; bj < 2; ++bj)
#pragma unroll
                    for (int n = 0; n < 2; ++n) *(f32x4*)(rowp + bj * 128 + n * 16) = acc[ai][bj][m][n]; }
    }
};

__device__ __forceinline__ float dpp_ror1(float v) { return __int_as_float(__builtin_amdgcn_update_dpp(0, __float_as_int(v), 0x121, 0xf, 0xf, false)); }
__device__ __forceinline__ float dpp_ror2(float v) { return __int_as_float(__builtin_amdgcn_update_dpp(0, __float_as_int(v), 0x122, 0xf, 0xf, false)); }

constexpr int CONVX_OFF = 131072;
struct EpiUp {
    static constexpr bool PERM = true;
    bf16_t* H; float* out; const float* conv_w; const float* conv_b; const float* cbuf; LAS unsigned char* lds;
    __device__ __forceinline__ void operator()(const f32x4 (&acc)[2][2][4][2], const pg8::Unit& u, int wr, int wc, int fr, int fq) const {
        LAS float* X = (LAS float*)(lds + CONVX_OFF);
        const int cg_ = wc * 32 + 8 * fq;
        const int col = u.pn * 128 + cg_;
        if (fr >= 14) {
#pragma unroll
            for (int ai = 0; ai < 2; ++ai) { LAS float* p = X + ((ai * 2 + wr) * 2 + (fr - 14)) * 128 + cg_; *(LAS f32x4*)p = acc[ai][0][3][0]; *(LAS f32x4*)(p + 4) = acc[ai][0][3][1]; }
        }
        f32x4 w0[2], w1[2], w2[2], cb[2];
#pragma unroll
        for (int n = 0; n < 2; ++n) { w0[n] = *(const f32x4*)(conv_w + col + 4 * n); w1[n] = *(const f32x4*)(conv_w + DFF + col + 4 * n); w2[n] = *(const f32x4*)(conv_w + 2 * DFF + col + 4 * n); cb[n] = *(const f32x4*)(conv_b + col + 4 * n); }
        asm volatile("s_waitcnt lgkmcnt(0)" ::: "memory"); __builtin_amdgcn_s_barrier(); asm volatile("" ::: "memory");
#pragma unroll
        for (int ai = 0; ai < 2; ++ai) {
            const int pai = (wr == 1) ? ai : ai - 1, pwr = wr ^ 1;
            f32x4 pr1[2], pr2[2];
#pragma unroll
            for (int n = 0; n < 2; ++n) {
                if (pai >= 0) { pr1[n] = *(const LAS f32x4*)(X + ((pai * 2 + pwr) * 2 + 1) * 128 + cg_ + 4 * n); pr2[n] = *(const LAS f32x4*)(X + ((pai * 2 + pwr) * 2 + (fr & 1)) * 128 + cg_ + 4 * n); }
                else { pr1[n] = (f32x4){0.f, 0.f, 0.f, 0.f}; pr2[n] = pr1[n]; }
            }
#pragma unroll
            for (int m = 0; m < 4; ++m) {
                const int lr = ai * 128 + wr * 64 + m * 16 + fr; const int gr = u.pm * 254 - 2 + lr;
                const bool store = (lr >= 2) && (gr < MT);
                int pos, bidx; const bool samp = gr >= MP;
                if (!samp) { pos = gr & (SEQ - 1); bidx = gr >> 11; } else { pos = (gr - MP) & 7; bidx = (gr - MP) >> 3; }
                const bool head_rows = __builtin_amdgcn_ballot_w64(pos < 2) != 0ull;
                const bool tail_rows = __builtin_amdgcn_ballot_w64(store && (samp ? pos >= 6 : pos >= SEQ - 2)) != 0ull;
                u32x4 hw;
#pragma unroll
                for (int n = 0; n < 2; ++n) {
                    const f32x4 g0 = acc[ai][0][m][n], uu = acc[ai][1][m][n]; f32x4 gm1, gm2, nr1, nr2;
#pragma unroll
                    for (int e = 0; e < 4; ++e) {
                        gm1[e] = __int_as_float(__builtin_amdgcn_update_dpp(__float_as_int(pr1[n][e]), __float_as_int(g0[e]), 0x111, 0xf, 0xf, false));
                        gm2[e] = __int_as_float(__builtin_amdgcn_update_dpp(__float_as_int(pr2[n][e]), __float_as_int(g0[e]), 0x112, 0xf, 0xf, false));
                        nr1[e] = dpp_ror1(g0[e]); nr2[e] = dpp_ror2(g0[e]);
                    }
                    pr1[n] = nr1; pr2[n] = nr2;
                    if (head_rows) {
                        if (!samp) { if (pos == 0) { gm1 = (f32x4){0.f, 0.f, 0.f, 0.f}; gm2 = gm1; } else if (pos == 1) gm2 = (f32x4){0.f, 0.f, 0.f, 0.f}; }
                        else if (store) { if (pos == 0) { gm1 = *(const f32x4*)(cbuf + (size_t)(bidx * 2 + 1) * DFF + col + 4 * n); gm2 = *(const f32x4*)(cbuf + (size_t)(bidx * 2) * DFF + col + 4 * n); }
                                          else if (pos == 1) gm2 = *(const f32x4*)(cbuf + (size_t)(bidx * 2 + 1) * DFF + col + 4 * n); }
                    }
                    const f32x4 c = cb[n] + w0[n] * gm2 + w1[n] * gm1 + w2[n] * g0;
                    const f32x2 ga = pg8::gelu_pk((f32x2){c[0], c[1]}), gb = pg8::gelu_pk((f32x2){c[2], c[3]});
                    const float h0 = ga.x * uu[0], h1 = ga.y * uu[1], h2 = gb.x * uu[2], h3 = gb.y * uu[3];
                    if (n == 0) { hw.x = cvt_pk_bf16(h0, h1); hw.y = cvt_pk_bf16(h2, h3); } else { hw.z = cvt_pk_bf16(h0, h1); hw.w = cvt_pk_bf16(h2, h3); }
                    if (tail_rows && store) {
                        if (!samp) { if (pos >= SEQ - 2) *(f32x4*)(out + O_CP + (size_t)(bidx * 2 + (pos - (SEQ - 2))) * DFF + col + 4 * n) = g0; }
                        else { if (pos >= 6) *(f32x4*)(out + O_CS + (size_t)(bidx * 2 + (pos - 6)) * DFF + col + 4 * n) = g0; }
                    }
                }
                if (store) *(u32x4*)(H + (size_t)gr * DFF + col) = hw;
            }
        }
    }
};

__device__ __forceinline__ unsigned pk2(float lo, float hi) { return cvt_pk_bf16(lo, hi); }
__device__ __forceinline__ void p0_transpose_item(const float* W, int ldw, int scol0, int k0, bf16_t* WT, int dK, int drow0, LAS float* scr, int lane) {
#pragma unroll 8
    for (int i = 0; i < 32; ++i) { const int kk = 2 * i + (lane >> 5); scr[kk * 33 + (lane & 31)] = W[(size_t)(k0 + kk) * ldw + scol0 + (lane & 31)]; }
    asm volatile("s_waitcnt lgkmcnt(0)" ::: "memory");
    const int c = lane & 7;
#pragma unroll
    for (int j = 0; j < 4; ++j) { const int n = (lane >> 3) + 8 * j; const LAS float* s = scr + (8 * c) * 33 + n;
        u32x4 o; o.x = pk2(s[0 * 33], s[1 * 33]); o.y = pk2(s[2 * 33], s[3 * 33]); o.z = pk2(s[4 * 33], s[5 * 33]); o.w = pk2(s[6 * 33], s[7 * 33]);
        *(u32x4*)(WT + (size_t)(drow0 + n) * dK + k0 + 8 * c) = o; }
    asm volatile("s_waitcnt lgkmcnt(0)" ::: "memory");
}
__device__ __forceinline__ void p0_gate_item(const float* w_in, const float* w_a2, int k0, int n0, bf16_t* WT, LAS float* scr, int lane) {
    float w2[16];
#pragma unroll
    for (int r = 0; r < 16; ++r) w2[r] = w_a2[r * 256 + n0 + (lane & 31)];
    for (int i = 0; i < 32; ++i) { const int kk = 2 * i + (lane >> 5); const float* a = w_in + (size_t)(k0 + kk) * DIN + 3072; float s = 0.f;
#pragma unroll
        for (int r = 0; r < 16; ++r) s += a[r] * w2[r];
        scr[kk * 33 + (lane & 31)] = s; }
    asm volatile("s_waitcnt lgkmcnt(0)" ::: "memory");
    const int c = lane & 7;
#pragma unroll
    for (int j = 0; j < 4; ++j) { const int n = (lane >> 3) + 8 * j; const LAS float* s = scr + (8 * c) * 33 + n;
        u32x4 o; o.x = pk2(s[0 * 33], s[1 * 33]); o.y = pk2(s[2 * 33], s[3 * 33]); o.z = pk2(s[4 * 33], s[5 * 33]); o.w = pk2(s[6 * 33], s[7 * 33]);
        *(u32x4*)(WT + (size_t)(3072 + n0 + n) * 1024 + k0 + 8 * c) = o; }
    asm volatile("s_waitcnt lgkmcnt(0)" ::: "memory");
}
__device__ __forceinline__ void rms_row_to_bf16(const float* xrow, const float* g, bf16_t* orow, int lane) {
    const f32x4* xr = (const f32x4*)xrow + lane; const f32x4* gr = (const f32x4*)g + lane;
    f32x4 v[4]; float s = 0.f;
#pragma unroll
    for (int j = 0; j < 4; ++j) { v[j] = xr[64 * j]; s += (v[j].x * v[j].x + v[j].y * v[j].y) + (v[j].z * v[j].z + v[j].w * v[j].w); }
    const float rs = rsqrtf(wave_sum(s) * (1.f / DM) + EPS);
    u32x2* o8 = (u32x2*)orow + lane;
#pragma unroll
    for (int j = 0; j < 4; ++j) { const f32x4 gg = gr[64 * j]; const f32x4 y = v[j] * rs * gg; u32x2 w; w.x = pk2(y.x, y.y); w.y = pk2(y.z, y.w); o8[64 * j] = w; }
}


__device__ __forceinline__ int crow(int r, int hi) { return (r & 3) + 8 * (r >> 2) + 4 * hi; }
typedef short v4i16_t __attribute__((ext_vector_type(4)));
__device__ __forceinline__ s16x4 vtr(const LAS unsigned char* p) { return __builtin_bit_cast(s16x4, __builtin_amdgcn_ds_read_tr16_b64_v4i16((LAS v4i16_t*)p)); }
__device__ __forceinline__ float swapmax(float v) { auto rr = __builtin_amdgcn_permlane32_swap(__float_as_uint(v), __float_as_uint(v), false, false); return fmaxf(__uint_as_float(rr[0]), __uint_as_float(rr[1])); }
__device__ __forceinline__ float swapsum(float v) { auto rr = __builtin_amdgcn_permlane32_swap(__float_as_uint(v), __float_as_uint(v), false, false); return __uint_as_float(rr[0]) + __uint_as_float(rr[1]); }
__device__ __forceinline__ u32x4 pack8(f32x4 a, f32x4 b) { u32x4 w; w.x = cvt_pk_bf16(a.x, a.y); w.y = cvt_pk_bf16(a.z, a.w); w.z = cvt_pk_bf16(b.x, b.y); w.w = cvt_pk_bf16(b.z, b.w); return w; }

constexpr float NEGF = -1e30f;
constexpr int VPITCH = 192;
constexpr int ATT_WLDS = 32 * VPITCH + 256;

struct AttnCtx { const bf16_t *QA, *KA, *VA; bf16_t* MIX; const float *ck, *cv; };

struct TileRegs { u32x4 k[8]; u32x4 v[8]; };

template <bool SAMPLE> __device__ __forceinline__ int tile_key(int ti, int j, int g, int r4, int ncls) {
    if (SAMPLE) { if (ti < 17) return 1536 + 32 * (16 - ti) + j; const int kk = ti - 17; return 16 * (4 * kk + (j >> 3)) + (j & 7); }
    if (ti < ncls) return 4 * (32 * (g - ti) + j) + r4;
    const int jj = ti - ncls + (g == 0 ? 4 : 0); return 128 * g - 128 + 32 * jj + j;
}
template <bool SAMPLE> __device__ __forceinline__ void tile_load(const AttnCtx& C, TileRegs& T, int ti, int b, int h, int g, int r4, int ncls, int lane) {
    const int r32 = lane & 31, hi = lane >> 5;
    if (SAMPLE && ti > 0) {
        { const int idx = tile_key<SAMPLE>(ti, r32, g, r4, ncls); const float* p = C.ck + (((unsigned)(b * WINB + idx) * 8u + h) * 64u + 8 * hi);
#pragma unroll
          for (int d0 = 0; d0 < 4; ++d0) { T.k[2 * d0] = *(const GAS u32x4*)(p + 16 * d0); T.k[2 * d0 + 1] = *(const GAS u32x4*)(p + 16 * d0 + 4); } }
#pragma unroll
        for (int i = 0; i < 4; ++i) { const int key = (lane >> 3) + 8 * i; const int idx = tile_key<SAMPLE>(ti, key, g, r4, ncls);
            const float* p = C.cv + (((unsigned)(b * WINB + idx) * 8u + h) * 64u + 8 * (lane & 7)); T.v[2 * i] = *(const GAS u32x4*)p; T.v[2 * i + 1] = *(const GAS u32x4*)(p + 4); }
    } else {
        unsigned rowb;
        { int key = tile_key<SAMPLE>(ti, r32, g, r4, ncls); if (SAMPLE) { key -= WINB; key = key > 7 ? 7 : key; rowb = (unsigned)(MP + b * 8 + key); } else rowb = (unsigned)(b * SEQ + key);
          const bf16_t* p = C.KA + (rowb * 512u + h * 64 + 8 * hi);
#pragma unroll
          for (int d0 = 0; d0 < 4; ++d0) T.k[d0] = *(const GAS u32x4*)(p + 16 * d0); }
#pragma unroll
        for (int i = 0; i < 4; ++i) { int key = tile_key<SAMPLE>(ti, (lane >> 3) + 8 * i, g, r4, ncls); if (SAMPLE) { key -= WINB; key = key > 7 ? 7 : key; rowb = (unsigned)(MP + b * 8 + key); } else rowb = (unsigned)(b * SEQ + key);
            T.v[i] = *(const GAS u32x4*)(C.VA + (rowb * 512u + h * 64 + 8 * (lane & 7))); }
    }
}

template <bool SAMPLE>
__device__ __forceinline__ void attn_item(const AttnCtx& C, int b, int h, int g, int r4, LAS unsigned char* wl, int lane_in) {
    int lane = lane_in; asm volatile("" : "+v"(lane));
    const int r32 = lane & 31, hi = lane >> 5;
    LAS float* wsf = (LAS float*)(wl + 32 * VPITCH);
    const int ncls = g + 1;
    const int nt = SAMPLE ? 41 : (ncls + (g == 0 ? 4 : 8));
    bf16x8 qf[4];
    {
        unsigned qrow; if (SAMPLE) qrow = (unsigned)(MP + b * 8 + (r32 & 7)); else qrow = (unsigned)(b * SEQ + 4 * (32 * g + r32) + r4);
        const bf16_t* p = C.QA + (qrow * 512u + h * 64 + 8 * hi);
#pragma unroll
        for (int d0 = 0; d0 < 4; ++d0) qf[d0] = *(const bf16x8*)(p + 16 * d0);
    }
    float mrun = NEGF, lrun = 0.f;
    f32x16 o0 = {}, o1 = {};
    TileRegs T;
    tile_load<SAMPLE>(C, T, 0, b, h, g, r4, ncls, lane);
    const int vrd = (4 * hi + ((lane & 15) >> 2)) * VPITCH + (((lane >> 4) & 1) * 16 + (lane & 3) * 4) * 2;
    for (int ti = 0; ti < nt; ++ti) {
        bf16x8 kf[4];
        const bool f32path = SAMPLE && ti > 0;
        if (f32path) {
#pragma unroll
            for (int d0 = 0; d0 < 4; ++d0) kf[d0] = __builtin_bit_cast(bf16x8, pack8(__builtin_bit_cast(f32x4, T.k[2 * d0]), __builtin_bit_cast(f32x4, T.k[2 * d0 + 1])));
#pragma unroll
            for (int i = 0; i < 4; ++i) *(LAS u32x4*)(wl + ((lane >> 3) + 8 * i) * VPITCH + (lane & 7) * 16) = pack8(__builtin_bit_cast(f32x4, T.v[2 * i]), __builtin_bit_cast(f32x4, T.v[2 * i + 1]));
        } else {
#pragma unroll
            for (int d0 = 0; d0 < 4; ++d0) kf[d0] = __builtin_bit_cast(bf16x8, T.k[d0]);
#pragma unroll
            for (int i = 0; i < 4; ++i) *(LAS u32x4*)(wl + ((lane >> 3) + 8 * i) * VPITCH + (lane & 7) * 16) = T.v[i];
        }
        if (ti + 1 < nt) tile_load<SAMPLE>(C, T, ti + 1, b, h, g, r4, ncls, lane);
        f32x16 p = {};
#pragma unroll
        for (int d0 = 0; d0 < 4; ++d0) p = __builtin_amdgcn_mfma_f32_32x32x16_bf16(kf[d0], qf[d0], p, 0, 0, 0);
        if (SAMPLE) {
            if (ti < 17) { const int dbase = (WINB + r32) - (1536 + 32 * (16 - ti));
#pragma unroll
                for (int r = 0; r < 16; ++r) { const int d = dbase - crow(r, hi); const int mult = (d >= 0 && d <= 128) + (d >= 0 && d <= 512 && !(d & 3)) + (d >= 0 && !(d & 15));
                    p[r] = (mult == 0 || r32 >= 8) ? NEGF : p[r] + (mult == 1 ? 0.f : (mult == 2 ? 1.f : 1.5849625f)); } }
            else {
#pragma unroll
                for (int r = 0; r < 16; ++r) p[r] = ((crow(r, hi) & 7) == r32) ? p[r] : NEGF; }
        } else {
            if (ti < ncls) { const int dbase = (32 * g + r32) - 32 * (g - ti);
#pragma unroll
                for (int r = 0; r < 16; ++r) { const int d = dbase - crow(r, hi); const int mult = (d >= 0 && d <= 128) + (d >= 0 && !(d & 3));
                    p[r] = mult == 0 ? NEGF : p[r] + (mult == 2 ? 1.f : 0.f); } }
            else { const int jj = ti - ncls + (g == 0 ? 4 : 0); const int dbase = (128 * g + 4 * r32 + r4) - (128 * g - 128 + 32 * jj);
#pragma unroll
                for (int r = 0; r < 16; ++r) { const int d = dbase - crow(r, hi); p[r] = (d >= 0 && d <= 128) ? p[r] : NEGF; } }
        }
        float rm = p[0];
#pragma unroll
        for (int r = 1; r < 16; ++r) rm = fmaxf(rm, p[r]);
        rm = swapmax(rm);
        const float mnew = fmaxf(mrun, rm);
        const float f = __builtin_amdgcn_exp2f(mrun - mnew);
        mrun = mnew;
        float ls = 0.f;
#pragma unroll
        for (int r = 0; r < 16; ++r) { p[r] = __builtin_amdgcn_exp2f(p[r] - mnew); ls += p[r]; }
        lrun = lrun * f + ls;
        if (hi == 0) wsf[r32] = f;
        u32x4 pa0, pa1;
        pa0.x = cvt_pk_bf16(p[0], p[1]); pa0.y = cvt_pk_bf16(p[2], p[3]); pa0.z = cvt_pk_bf16(p[4], p[5]); pa0.w = cvt_pk_bf16(p[6], p[7]);
        pa1.x = cvt_pk_bf16(p[8], p[9]); pa1.y = cvt_pk_bf16(p[10], p[11]); pa1.z = cvt_pk_bf16(p[12], p[13]); pa1.w = cvt_pk_bf16(p[14], p[15]);
#pragma unroll
        for (int r = 0; r < 16; ++r) { const float fr_ = wsf[crow(r, hi)]; o0[r] *= fr_; o1[r] *= fr_; }
#pragma unroll
        for (int sl = 0; sl < 2; ++sl) {
            const bf16x8 pa = __builtin_bit_cast(bf16x8, sl == 0 ? pa0 : pa1);
#pragma unroll
            for (int c = 0; c < 2; ++c) {
                const s16x4 lo = vtr(wl + vrd + (16 * sl) * VPITCH + 64 * c), hi4 = vtr(wl + vrd + (16 * sl + 8) * VPITCH + 64 * c);
                const bf16x8 vf = (bf16x8){lo[0], lo[1], lo[2], lo[3], hi4[0], hi4[1], hi4[2], hi4[3]};
                if (c == 0) o0 = __builtin_amdgcn_mfma_f32_32x32x16_bf16(pa, vf, o0, 0, 0, 0); else o1 = __builtin_amdgcn_mfma_f32_32x32x16_bf16(pa, vf, o1, 0, 0, 0);
            }
        }
    }
    const float lt = swapsum(lrun);
    if (hi == 0) wsf[32 + r32] = 1.f / lt;
#pragma unroll
    for (int r = 0; r < 16; ++r) {
        const int q = crow(r, hi); const float rl = wsf[32 + q];
        unsigned orow; bool ok = true;
        if (SAMPLE) { ok = q < 8; orow = (unsigned)(MP + b * 8 + (q & 7)); } else orow = (unsigned)(b * SEQ + 4 * (32 * g + q) + r4);
        if (ok) { bf16_t* op = C.MIX + (orow * 1024u + h * 64 + r32);
            op[0] = (bf16_t)(cvt_pk_bf16(o0[r] * rl, 0.f) & 0xffffu); op[32] = (bf16_t)(cvt_pk_bf16(o1[r] * rl, 0.f) & 0xffffu); }
    }
}

struct GlaCtx { const bf16_t *QB, *KB, *VB, *RB; const float* LF; bf16_t* MIX; const float* gnorm; };
constexpr int GQ_P = 72, GT_P = 40;
constexpr int G_QE = 0, G_KE = 32 * GQ_P * 2, G_KT = G_KE + 32 * GQ_P * 2, G_EB = G_KT + 64 * GT_P * 2, G_BUF = G_EB + 256;
constexpr int GL_V = 2 * G_BUF;
constexpr int GL_O = GL_V + 2 * 4 * 2048;
constexpr int GL_END = GL_O + 2 * 4 * 4608;
static_assert(GL_END <= 131072, "gla lds");
#define LDS_BARRIER() do { asm volatile("s_waitcnt lgkmcnt(0)" ::: "memory"); __builtin_amdgcn_s_barrier(); asm volatile("" ::: "memory"); } while (0)
typedef float f32x8 __attribute__((ext_vector_type(8)));
typedef unsigned u32x8 __attribute__((ext_vector_type(8)));
typedef unsigned u32x16 __attribute__((ext_vector_type(16)));
struct GlaPre { f32x8 lf; u32x8 q, k; u32x4 v0, v1; };

template <int nvalid> __device__ __forceinline__ void gla_h_loads(const GlaCtx& C, GlaPre& P, unsigned t0, int h, int dk, int tg, int dvs, int lane) {
    const bool ok = 8 * tg < nvalid;
    const unsigned off = (t0 + (ok ? 8 * tg : 0)) * 256u + h * 64 + dk;
    const GAS float* lp = (const GAS float*)(C.LF + off); const GAS bf16_t* qp = (const GAS bf16_t*)(C.QB + off); const GAS bf16_t* kp = (const GAS bf16_t*)(C.KB + off);
#pragma unroll
    for (int e = 0; e < 8; ++e) { P.lf[e] = lp[e * 256]; P.q[e] = (unsigned)qp[e * 256]; P.k[e] = (unsigned)kp[e * 256]; }
    const int i = lane >> 1; const bool okv = i < nvalid; const GAS bf16_t* p = (const GAS bf16_t*)(C.VB + ((t0 + (okv ? i : 0)) * 512u + h * 128 + 32 * dvs + 16 * (lane & 1)));
    P.v0 = *(const GAS u32x4*)p; P.v1 = *(const GAS u32x4*)(p + 8);
}
struct GlaGate { u32x4 g0, g1; };
template <int nvalid> __device__ __forceinline__ void gla_h_interval(const GlaCtx& C, LAS unsigned char* lds, GlaPre& P, GlaGate& G, const f32x4 (&gn)[4], int j, int nchunk, int hw, int lane, unsigned row0, int h) {
    const int tg = lane >> 4, dkl = lane & 15, dk = 16 * hw + dkl;
    const int ft = lane >> 3, dvg = lane & 7;
    const bool fin_ok = 8 * hw < nvalid;
    if (j >= 2 && fin_ok) {
        const int c = j - 2; const int ob = c & 1;
        const LAS float* op = (const LAS float*)(lds + GL_O + (ob * 4 + (dvg >> 1)) * 4608) + (8 * hw + ft) * 36 + 16 * (dvg & 1);
        f32x4 o[4]; float s = 0.f;
#pragma unroll
        for (int k4 = 0; k4 < 4; ++k4) { o[k4] = *(const LAS f32x4*)(op + 4 * k4); s += (o[k4].x * o[k4].x + o[k4].y * o[k4].y) + (o[k4].z * o[k4].z + o[k4].w * o[k4].w); }
        s += __shfl_xor(s, 1); s += __shfl_xor(s, 2); s += __shfl_xor(s, 4);
        const float rs = rsqrtf(s * (1.f / 128.f) + EPS);
        const u32x4 g0 = G.g0, g1 = G.g1;
        float gt[16];
        gt[0] = __uint_as_float(g0.x << 16); gt[1] = __uint_as_float(g0.x & 0xffff0000u); gt[2] = __uint_as_float(g0.y << 16); gt[3] = __uint_as_float(g0.y & 0xffff0000u);
        gt[4] = __uint_as_float(g0.z << 16); gt[5] = __uint_as_float(g0.z & 0xffff0000u); gt[6] = __uint_as_float(g0.w << 16); gt[7] = __uint_as_float(g0.w & 0xffff0000u);
        gt[8] = __uint_as_float(g1.x << 16); gt[9] = __uint_as_float(g1.x & 0xffff0000u); gt[10] = __uint_as_float(g1.y << 16); gt[11] = __uint_as_float(g1.y & 0xffff0000u);
        gt[12] = __uint_as_float(g1.z << 16); gt[13] = __uint_as_float(g1.z & 0xffff0000u); gt[14] = __uint_as_float(g1.w << 16); gt[15] = __uint_as_float(g1.w & 0xffff0000u);
        float val[16];
#pragma unroll
        for (int k = 0; k < 16; ++k) { const float rg = gt[k]; val[k] = o[k >> 2][k & 3] * rs * gn[k >> 2][k & 3] * rg * __builtin_amdgcn_rcpf(1.f + __expf(-rg)); }
        u32x4 w0, w1;
        w0.x = cvt_pk_bf16(val[0], val[1]); w0.y = cvt_pk_bf16(val[2], val[3]); w0.z = cvt_pk_bf16(val[4], val[5]); w0.w = cvt_pk_bf16(val[6], val[7]);
        w1.x = cvt_pk_bf16(val[8], val[9]); w1.y = cvt_pk_bf16(val[10], val[11]); w1.z = cvt_pk_bf16(val[12], val[13]); w1.w = cvt_pk_bf16(val[14], val[15]);
        bf16_t* mp = C.MIX + ((row0 + 32u * c + 8 * hw + ft) * 1024u + 512 + h * 128 + 16 * dvg);
        *(GAS u32x4*)mp = w0; *(GAS u32x4*)(mp + 8) = w1;
    }
    if (j < nchunk) {
        const int buf = j & 1;
        LAS unsigned char* sh = lds + buf * G_BUF;
        LAS bf16_t* qe_l = (LAS bf16_t*)(sh + G_QE); LAS bf16_t* ke_l = (LAS bf16_t*)(sh + G_KE); LAS bf16_t* kt_l = (LAS bf16_t*)(sh + G_KT); LAS float* eb_l = (LAS float*)(sh + G_EB);
        LAS unsigned char* vl = lds + GL_V + (buf * 4 + hw) * 2048;
        const bool okp = 8 * tg < nvalid, okv = (lane >> 1) < nvalid;
        if (!okp) { P.lf = (f32x8){0.f, 0.f, 0.f, 0.f, 0.f, 0.f, 0.f, 0.f}; P.q = (u32x8){0u, 0u, 0u, 0u, 0u, 0u, 0u, 0u}; P.k = P.q; }
        if (!okv) { P.v0 = (u32x4){0u, 0u, 0u, 0u}; P.v1 = P.v0; }
        f32x8 cs; float run = 0.f;
#pragma unroll
        for (int e = 0; e < 8; ++e) { run += P.lf[e]; cs[e] = run; }
        float offs = 0.f, tot = 0.f;
#pragma unroll
        for (int t = 0; t < 4; ++t) { const float Tt = __shfl(run, dkl + 16 * t); tot += Tt; offs += (t < tg) ? Tt : 0.f; }
        u32x8 kb;
#pragma unroll
        for (int e = 0; e < 8; ++e) { const float bb = offs + cs[e]; const float eb = __expf(bb), ei = __expf(-bb); const int i = 8 * tg + e;
            qe_l[i * GQ_P + dk] = (bf16_t)(cvt_pk_bf16(__uint_as_float(P.q[e] << 16) * 0.125f * eb, 0.f) & 0xffffu);
            kb[e] = cvt_pk_bf16(__uint_as_float(P.k[e] << 16) * ei, 0.f) & 0xffffu;
            ke_l[i * GQ_P + dk] = (bf16_t)kb[e]; }
        u32x4 w; w.x = kb[0] | (kb[1] << 16); w.y = kb[2] | (kb[3] << 16); w.z = kb[4] | (kb[5] << 16); w.w = kb[6] | (kb[7] << 16);
        *(LAS u32x4*)(kt_l + dk * GT_P + 8 * tg) = w;
        if (tg == 0) eb_l[dk] = __expf(tot);
        *(LAS u32x4*)(vl + (lane >> 1) * 64 + (lane & 1) * 32) = P.v0; *(LAS u32x4*)(vl + (lane >> 1) * 64 + (lane & 1) * 32 + 16) = P.v1;
    }
    if (j + 3 < nchunk) gla_h_loads<nvalid>(C, P, row0 + 32u * (j + 3), h, dk, tg, hw, lane);
    if (j + 1 < nchunk && fin_ok) { const bf16_t* rp = C.RB + ((row0 + 32u * (j + 1) + 8 * hw + ft) * 512u + h * 128 + 16 * dvg); G.g0 = *(const GAS u32x4*)rp; G.g1 = *(const GAS u32x4*)(rp + 8); }
    if (j <= nchunk) LDS_BARRIER();
}
template <int nvalid> __device__ __forceinline__ void gla_h_wave(const GlaCtx& C, LAS unsigned char* lds, int hw  , int lane, unsigned row0, int h, int nchunk) {
    const int tg = lane >> 4, dkl = lane & 15, dk = 16 * hw + dkl;
    const int ft = lane >> 3, dvg = lane & 7;
    f32x4 gn[4];
#pragma unroll
    for (int k4 = 0; k4 < 4; ++k4) gn[k4] = *(const f32x4*)(C.gnorm + h * 128 + 16 * dvg + 4 * k4);
    GlaPre P0, P1, P2; GlaGate G0 = {}, G1 = {}, G2 = {};
    gla_h_loads<nvalid>(C, P0, row0, h, dk, tg, hw, lane);
    if (1 < nchunk) gla_h_loads<nvalid>(C, P1, row0 + 32u, h, dk, tg, hw, lane);
    if (2 < nchunk) gla_h_loads<nvalid>(C, P2, row0 + 64u, h, dk, tg, hw, lane);
    if (8 * hw < nvalid) { const bf16_t* rp = C.RB + ((row0 + 8 * hw + ft) * 512u + h * 128 + 16 * dvg); G0.g0 = *(const GAS u32x4*)rp; G0.g1 = *(const GAS u32x4*)(rp + 8); }
    for (int j = 0; j <= nchunk + 1; j += 3) {
        gla_h_interval<nvalid>(C, lds, P0, G1, gn, j, nchunk, hw, lane, row0, h);
        if (j + 1 <= nchunk + 1) gla_h_interval<nvalid>(C, lds, P1, G2, gn, j + 1, nchunk, hw, lane, row0, h);
        if (j + 2 <= nchunk + 1) gla_h_interval<nvalid>(C, lds, P2, G0, gn, j + 2, nchunk, hw, lane, row0, h);
    }
}
template <int nvalid> __device__ __forceinline__ void gla_m_wave(LAS unsigned char* lds, int dvs, int lane, int nchunk, const float* s_in, float* s_out) {
    const int r32 = lane & 31, hi = lane >> 5;
    f32x16 S0 = {}, S1 = {};
    unsigned soff = (unsigned)(4 * hi * 128 + 32 * dvs + r32); asm volatile("" : "+v"(soff));
    if (s_in) {
#pragma unroll
        for (int r = 0; r < 16; ++r) { const unsigned o_ = soff + (unsigned)(((r & 3) + 8 * (r >> 2)) * 128); S0[r] = s_in[o_]; S1[r] = s_in[o_ + 4096u]; }
    }
    const int vrd = (4 * hi + ((lane & 15) >> 2)) * 64 + (((lane >> 4) & 1) * 16 + (lane & 3) * 4) * 2;
    LDS_BARRIER();
    for (int c = 0; c < nchunk; ++c) {
        const int buf = c & 1;
        LAS unsigned char* sh = lds + buf * G_BUF;
        LAS bf16_t* qe_l = (LAS bf16_t*)(sh + G_QE); LAS bf16_t* ke_l = (LAS bf16_t*)(sh + G_KE); LAS bf16_t* kt_l = (LAS bf16_t*)(sh + G_KT); LAS float* eb_l = (LAS float*)(sh + G_EB);
        const LAS unsigned char* vl = lds + GL_V + (buf * 4 + dvs) * 2048;
        f32x16 at = {};
#pragma unroll
        for (int s = 0; s < 4; ++s) { const bf16x8 a = *(const LAS bf16x8*)(ke_l + r32 * GQ_P + 16 * s + 8 * hi), bq = *(const LAS bf16x8*)(qe_l + r32 * GQ_P + 16 * s + 8 * hi);
            at = __builtin_amdgcn_mfma_f32_32x32x16_bf16(a, bq, at, 0, 0, 0); }
#pragma unroll
        for (int r = 0; r < 16; ++r) at[r] = (crow(r, hi) <= r32) ? at[r] : 0.f;
        u32x4 pa0, pa1;
        pa0.x = cvt_pk_bf16(at[0], at[1]); pa0.y = cvt_pk_bf16(at[2], at[3]); pa0.z = cvt_pk_bf16(at[4], at[5]); pa0.w = cvt_pk_bf16(at[6], at[7]);
        pa1.x = cvt_pk_bf16(at[8], at[9]); pa1.y = cvt_pk_bf16(at[10], at[11]); pa1.z = cvt_pk_bf16(at[12], at[13]); pa1.w = cvt_pk_bf16(at[14], at[15]);
        bf16x8 vf0, vf1;
        { const s16x4 lo = vtr(vl + vrd), h4 = vtr(vl + vrd + 8 * 64); vf0 = (bf16x8){lo[0], lo[1], lo[2], lo[3], h4[0], h4[1], h4[2], h4[3]}; }
        { const s16x4 lo = vtr(vl + vrd + 16 * 64), h4 = vtr(vl + vrd + 24 * 64); vf1 = (bf16x8){lo[0], lo[1], lo[2], lo[3], h4[0], h4[1], h4[2], h4[3]}; }
        f32x16 o = {};
        o = __builtin_amdgcn_mfma_f32_32x32x16_bf16(__builtin_bit_cast(bf16x8, pa0), vf0, o, 0, 0, 0);
        o = __builtin_amdgcn_mfma_f32_32x32x16_bf16(__builtin_bit_cast(bf16x8, pa1), vf1, o, 0, 0, 0);
#pragma unroll
        for (int s = 0; s < 4; ++s) {
            const u32x2 q0 = *(const LAS u32x2*)(qe_l + r32 * GQ_P + 16 * s + 4 * hi), q1 = *(const LAS u32x2*)(qe_l + r32 * GQ_P + 16 * s + 8 + 4 * hi);
            const u32x4 qa = (u32x4){q0.x, q0.y, q1.x, q1.y};
            u32x4 sb;
            if (s == 0) { sb.x = cvt_pk_bf16(S0[0], S0[1]); sb.y = cvt_pk_bf16(S0[2], S0[3]); sb.z = cvt_pk_bf16(S0[4], S0[5]); sb.w = cvt_pk_bf16(S0[6], S0[7]); }
            else if (s == 1) { sb.x = cvt_pk_bf16(S0[8], S0[9]); sb.y = cvt_pk_bf16(S0[10], S0[11]); sb.z = cvt_pk_bf16(S0[12], S0[13]); sb.w = cvt_pk_bf16(S0[14], S0[15]); }
            else if (s == 2) { sb.x = cvt_pk_bf16(S1[0], S1[1]); sb.y = cvt_pk_bf16(S1[2], S1[3]); sb.z = cvt_pk_bf16(S1[4], S1[5]); sb.w = cvt_pk_bf16(S1[6], S1[7]); }
            else { sb.x = cvt_pk_bf16(S1[8], S1[9]); sb.y = cvt_pk_bf16(S1[10], S1[11]); sb.z = cvt_pk_bf16(S1[12], S1[13]); sb.w = cvt_pk_bf16(S1[14], S1[15]); }
            o = __builtin_amdgcn_mfma_f32_32x32x16_bf16(__builtin_bit_cast(bf16x8, qa), __builtin_bit_cast(bf16x8, sb), o, 0, 0, 0);
        }
        { LAS float* ol = (LAS float*)(lds + GL_O + (buf * 4 + dvs) * 4608);
#pragma unroll
          for (int r = 0; r < 16; ++r) ol[crow(r, hi) * 36 + r32] = o[r]; }
        {
            const u32x2 a0 = *(const LAS u32x2*)(kt_l + r32 * GT_P + 4 * hi), a1 = *(const LAS u32x2*)(kt_l + r32 * GT_P + 8 + 4 * hi);
            const u32x2 c0 = *(const LAS u32x2*)(kt_l + (32 + r32) * GT_P + 4 * hi), c1 = *(const LAS u32x2*)(kt_l + (32 + r32) * GT_P + 8 + 4 * hi);
            S0 = __builtin_amdgcn_mfma_f32_32x32x16_bf16(__builtin_bit_cast(bf16x8, (u32x4){a0.x, a0.y, a1.x, a1.y}), vf0, S0, 0, 0, 0);
            S1 = __builtin_amdgcn_mfma_f32_32x32x16_bf16(__builtin_bit_cast(bf16x8, (u32x4){c0.x, c0.y, c1.x, c1.y}), vf0, S1, 0, 0, 0);
        }
        {
            const u32x2 a0 = *(const LAS u32x2*)(kt_l + r32 * GT_P + 16 + 4 * hi), a1 = *(const LAS u32x2*)(kt_l + r32 * GT_P + 24 + 4 * hi);
            const u32x2 c0 = *(const LAS u32x2*)(kt_l + (32 + r32) * GT_P + 16 + 4 * hi), c1 = *(const LAS u32x2*)(kt_l + (32 + r32) * GT_P + 24 + 4 * hi);
            S0 = __builtin_amdgcn_mfma_f32_32x32x16_bf16(__builtin_bit_cast(bf16x8, (u32x4){a0.x, a0.y, a1.x, a1.y}), vf1, S0, 0, 0, 0);
            S1 = __builtin_amdgcn_mfma_f32_32x32x16_bf16(__builtin_bit_cast(bf16x8, (u32x4){c0.x, c0.y, c1.x, c1.y}), vf1, S1, 0, 0, 0);
        }
#pragma unroll
        for (int r = 0; r < 16; ++r) { S0[r] *= eb_l[crow(r, hi)]; S1[r] *= eb_l[32 + crow(r, hi)]; }
        LDS_BARRIER();
    }
    if (s_out) {
        unsigned soff2 = (unsigned)(4 * hi * 128 + 32 * dvs + r32); asm volatile("" : "+v"(soff2));
#pragma unroll
        for (int r = 0; r < 16; ++r) { const unsigned o_ = soff2 + (unsigned)(((r & 3) + 8 * (r >> 2)) * 128); s_out[o_] = S0[r]; s_out[o_ + 4096u] = S1[r]; }
    }
}

#define XB_TMO      128
#define XB_XCNT(j)  (256  + 64 * (j))
#define XB_XSUB(j)  (1280 + 64 * (j))
#define XB_XGEN(j)  (2304 + 64 * (j))
#define XB_TOP      3328
#define XB_TOPGEN   3392
#define XCD_BAR_WORDS 3456
#define XB_SPIN_CAP (1u << 18)
__device__ __forceinline__ unsigned xb_ld(unsigned* p)              { return __hip_atomic_load(p, __ATOMIC_RELAXED, __HIP_MEMORY_SCOPE_AGENT); }
__device__ __forceinline__ unsigned xb_add(unsigned* p, unsigned v) { return __hip_atomic_fetch_add(p, v, __ATOMIC_RELAXED, __HIP_MEMORY_SCOPE_AGENT); }
__device__ __forceinline__ unsigned xb_xcc_id() { return (unsigned)__builtin_amdgcn_s_getreg((3 << 11) | 20) & 0xFu; }
#define XB_SPIN(cond, bar) do { unsigned _sp = 0; while (cond) { __builtin_amdgcn_s_sleep(1); \
    if ((++_sp & 255u) == 0u) { if (xb_ld(&(bar)[XB_TMO])) break; if (_sp > XB_SPIN_CAP) { atomicAdd(&(bar)[XB_TMO], 1u); break; } } } } while (0)
struct XcdBarrier { unsigned* bar; unsigned x; volatile LAS unsigned* st; };
__device__ __forceinline__ XcdBarrier xcd_barrier_post(unsigned* bar, volatile LAS unsigned* st) {
    XcdBarrier b; b.bar = bar; b.x = xb_xcc_id(); b.st = st;
    if (threadIdx.x == 0) (void)xb_add(&bar[XB_XCNT(b.x)], 1u);
    return b;
}
__device__ __forceinline__ void xcd_barrier_complete(unsigned* bar, unsigned x, unsigned& nloc, unsigned& nx) {
    const unsigned G = gridDim.x * gridDim.y * gridDim.z;
    unsigned sum, cnt, mine, sp = 0u;
    for (;;) {
        sum = 0u; cnt = 0u; mine = 0u;
#pragma unroll
        for (unsigned j = 0; j < 16; ++j) { const unsigned c = xb_ld(&bar[XB_XCNT(j)]); sum += c; cnt += (c > 0u) ? 1u : 0u; mine = (j == x) ? c : mine; }
        if (sum == G) break;
        __builtin_amdgcn_s_sleep(1);
        if ((++sp & 255u) == 0u) { if (xb_ld(&bar[XB_TMO])) break; if (sp > XB_SPIN_CAP) { atomicAdd(&bar[XB_TMO], 1u); break; } }
    }
    nloc = mine > 0u ? mine : 1u; nx = cnt > 0u ? cnt : 1u;
}
__device__ __forceinline__ void xcd_barrier(const XcdBarrier& b, int wave0) {
    asm volatile("s_waitcnt vmcnt(0)" ::: "memory");
    __syncthreads();
    if (wave0 == 0 && lane_id_v() == 0) {
        unsigned* bar = b.bar;
        __builtin_amdgcn_s_waitcnt(0);
        unsigned nloc = b.st[0], nx = b.st[1];
        if (nloc == 0u) { xcd_barrier_complete(bar, b.x, nloc, nx); b.st[0] = nloc; b.st[1] = nx; }
        const unsigned old = xb_add(&bar[XB_XSUB(b.x)], 1u);
        const unsigned gen = old / nloc;
        if (old + 1u == (gen + 1u) * nloc) {
            __builtin_amdgcn_fence(__ATOMIC_RELEASE, "agent");
            asm volatile("s_waitcnt vmcnt(0)" ::: "memory");
            const unsigned og = xb_add(&bar[XB_TOP], 1u);
            const unsigned tg = og / nx;
            if (og + 1u == (tg + 1u) * nx) xb_add(&bar[XB_TOPGEN], 1u);
            else XB_SPIN(xb_ld(&bar[XB_TOPGEN]) == tg, bar);
            __builtin_amdgcn_fence(__ATOMIC_ACQUIRE, "agent");
            xb_add(&bar[XB_XGEN(b.x)], 1u);
            asm volatile("s_waitcnt vmcnt(0)" ::: "memory");
        } else {
            XB_SPIN(xb_ld(&bar[XB_XGEN(b.x)]) == gen, bar);
            __builtin_amdgcn_fence(__ATOMIC_ACQUIRE, "agent");
            asm volatile("s_waitcnt vmcnt(0)" ::: "memory");
        }
    }
    __syncthreads();
}

constexpr int LDS_BYTES = 147456;

__global__ void __launch_bounds__(512, 2) hymba_fwd(Args args) {
    extern __shared__ __attribute__((aligned(16))) unsigned char lds_raw[];
    LAS unsigned char* lds = (LAS unsigned char*)lds_raw;
#define PHASE_IDS() const int lane = lane_id_v(); const int wave = wave0; (void)lane; (void)wave
    const int G = gridDim.x, bx = blockIdx.x;
    const int wave0 = __builtin_amdgcn_readfirstlane((int)(threadIdx.x >> 6));
    if (threadIdx.x < 4) ((LAS unsigned*)(lds + XBST_OFF))[threadIdx.x] = 0u;
    __syncthreads();
    const XcdBarrier xbar = xcd_barrier_post((unsigned*)(args.ws + WS_CTL) + 4096, (volatile LAS unsigned*)(lds + XBST_OFF));
    const int vcu = (G % 8 == 0) ? (bx % 8) * (G / 8) + bx / 8 : bx;
    const float* x_prompt = args.in[0]; const float* x_sample = args.in[1];
    const float* w_in = args.in[6]; const float* w_a2 = args.in[7]; const float* b_a = args.in[8];
    const float* w_o = args.in[10]; const float* g_pre_mix = args.in[11];
    const float* w_up = args.in[15]; const float* w_down = args.in[18];
#define PHASE_WS() unsigned char* ws = args.ws; asm volatile("" : "+s"(ws))

    {
        PHASE_IDS(); PHASE_WS();
        bf16_t* WinT = (bf16_t*)(ws + WS_WIN); bf16_t* WoT = (bf16_t*)(ws + WS_WO); bf16_t* WupT = (bf16_t*)(ws + WS_WUP); bf16_t* WdT = (bf16_t*)(ws + WS_WD); bf16_t* XN = (bf16_t*)(ws + WS_XN + 4096);
        LAS float* scr = (LAS float*)(lds + wave * 16384);
        const int gw = vcu * 8 + wave, NGW = G * 8;
        constexpr int I_IN = 16 * 96, I_G = 16 * 8, I_O = 16 * 32, I_UP = 16 * 176, I_D = 44 * 32;
        constexpr int NITEMS = I_IN + I_G + I_O + I_UP + I_D;
        for (int it = gw; it < NITEMS; it += NGW) {
            int r = it;
            if (r < I_IN) { const int kb = r / 96, nb = r % 96; p0_transpose_item(w_in, DIN, 32 * nb, 64 * kb, WinT, 1024, 32 * nb, scr, lane); continue; } r -= I_IN;
            if (r < I_G) { const int kb = r / 8, nb = r % 8; p0_gate_item(w_in, w_a2, 64 * kb, 32 * nb, WinT, scr, lane); continue; } r -= I_G;
            if (r < I_O) { const int kb = r / 32, nb = r % 32; p0_transpose_item(w_o, 1024, 32 * nb, 64 * kb, WoT, 1024, 32 * nb, scr, lane); continue; } r -= I_O;
            if (r < I_UP) { const int kb = r / 176, nb = r % 176; const int n0 = 32 * nb, t = n0 >> 8, w = n0 & 255;
                const int sc = (w < 128) ? (128 * t + w) : (DFF + 128 * t + (w - 128));
                p0_transpose_item(w_up, 2 * DFF, sc, 64 * kb, WupT, 1024, n0, scr, lane); continue; } r -= I_UP;
            { const int kb = r / 32, nb = r % 32; p0_transpose_item(w_down, 1024, 32 * nb, 64 * kb, WdT, DFF, 32 * nb, scr, lane); }
        }
        for (int m = gw; m < MT; m += NGW) {
            const float* xr = (m < MP) ? x_prompt + (size_t)m * DM : x_sample + (size_t)(m - MP) * DM;
            rms_row_to_bf16(xr, g_pre_mix, XN + (size_t)m * DM, lane);
        }
    }
    xcd_barrier(xbar, wave0);

    {
        PHASE_WS();
        pg8::Gemm g{(bf16_t*)(ws + WS_XN + 4096), (bf16_t*)(ws + WS_WIN), 1024, 256, 1024}; pg8::StaticOrder S; S.init(MT / 256, NIN / 256, G, bx);
        EpiInProj E{(bf16_t*)(ws + WS_QA), (bf16_t*)(ws + WS_KA), (bf16_t*)(ws + WS_VA), (bf16_t*)(ws + WS_QB), (bf16_t*)(ws + WS_KB), (bf16_t*)(ws + WS_VB), (bf16_t*)(ws + WS_RB),
                    (float*)(ws + WS_LF), args.out, b_a};
        pg8::gemm_phase<EpiInProj, pg8::StaticOrder>(lds, g, S, E, wave0);
    }
    xcd_barrier(xbar, wave0);

    {
        PHASE_IDS(); PHASE_WS();
        bf16_t* MIX = (bf16_t*)(ws + WS_MIX);
        GlaCtx GC{(const bf16_t*)(ws + WS_QB), (const bf16_t*)(ws + WS_KB), (const bf16_t*)(ws + WS_VB), (const bf16_t*)(ws + WS_RB), (const float*)(ws + WS_LF), MIX, args.in[9]};
        const float* state_gla = args.in[4];
#ifndef NO_GLA
        for (int it = bx; it < 64 + 128; it += G) {
            const bool pr = it < 64; const int seq = pr ? it : it - 64; const int b = seq >> 2, h = seq & 3;
            const size_t row0 = pr ? (size_t)b * SEQ : (size_t)MP + (size_t)b * 8;
            const float* s_in = pr ? nullptr : state_gla + (size_t)seq * 8192;
            float* s_out = args.out + (pr ? O_GP : O_GS) + (size_t)seq * 8192;
            const int nchunk = pr ? SEQ / 32 : 1;
            if (wave < 4) { if (pr) gla_m_wave<32>(lds, wave, lane, nchunk, s_in, s_out); else gla_m_wave<8>(lds, wave, lane, nchunk, s_in, s_out); }
            else { if (pr) gla_h_wave<32>(GC, lds, wave - 4, lane, (unsigned)row0, h, nchunk); else gla_h_wave<8>(GC, lds, wave - 4, lane, (unsigned)row0, h, nchunk); }
            __syncthreads();
        }
#endif
        AttnCtx AC{(const bf16_t*)(ws + WS_QA), (const bf16_t*)(ws + WS_KA), (const bf16_t*)(ws + WS_VA), MIX, args.in[2], args.in[3]};
        unsigned* counter = (unsigned*)(ws + WS_CTL);
        LAS unsigned char* wl = lds + wave * 8192;
        const int lane2 = lane_id_v();
        for (int sb = (bx + 64) % G; sb < NSB; sb += G) attn_item<true>(AC, sb, wave, 0, 0, wl, lane2);
        const unsigned xq0 = xb_xcc_id() & 7u;
        for (unsigned kq = 0; kq < 8u; ++kq) {
            const unsigned xq = (xq0 + kq) & 7u;
            unsigned* head = counter + 64 * xq;
            for (;;) {
                unsigned loc = 0; if (lane2 == 0) loc = atomicAdd(head, 1u);
                loc = (unsigned)__builtin_amdgcn_readfirstlane((int)loc);
                if (loc >= 1024u) break;
                { const unsigned p = loc; const unsigned grp = p >> 8, q = p & 255u; const int g = 15 - (int)(q >> 4); const unsigned bhl = (q >> 2) & 3u; const int r4 = (int)(q & 3u);
                    const int bh = (int)(xq + 8u * (4u * grp + bhl));
                    attn_item<false>(AC, bh >> 3, bh & 7, g, r4, wl, lane2); }
            }
        }
    }
    xcd_barrier(xbar, wave0);

    {
        PHASE_WS();
        bf16_t* MO = (bf16_t*)(ws + WS_MO); float* SSQ1 = (float*)(ws + WS_SSQ1);
        pg8::Gemm g{(bf16_t*)(ws + WS_MIX), (bf16_t*)(ws + WS_WO), 1024, 256, 1024}; pg8::StaticOrder S; S.init(MP / 256, 4, G, bx);
        EpiRowOut E{MO, SSQ1};
        pg8::gemm_phase<EpiRowOut, pg8::StaticOrder>(lds, g, S, E, wave0);
        pg8::Gemm g2{(bf16_t*)(ws + WS_MIX), (bf16_t*)(ws + WS_WO), 256, 256, 1024}; pg8::SplitOrder S2{16, G, bx, 128, 256};
        EpiSlice E2{(float*)(ws + WS_ACC1), 256};
        pg8::gemm_phase<EpiSlice, pg8::SplitOrder>(lds, g2, S2, E2, wave0);
    }
    xcd_barrier(xbar, wave0);
    {
        PHASE_IDS(); PHASE_WS();
        bf16_t* MO = (bf16_t*)(ws + WS_MO); float* SSQ1 = (float*)(ws + WS_SSQ1); bf16_t* XN = (bf16_t*)(ws + WS_XN + 4096);
        const float* g_post = args.in[12]; const float* g_pre = args.in[13];
        const int gw = vcu * 8 + wave, NGW = G * 8;
        {
            f32x4 gp4[4], gq4[4];
#pragma unroll
            for (int j = 0; j < 4; ++j) { gp4[j] = ((const GAS f32x4*)g_post)[64 * j + lane]; gq4[j] = ((const GAS f32x4*)g_pre)[64 * j + lane]; }
            for (int m0 = gw; m0 < MP; m0 += 2 * NGW) {
                const int m1 = (m0 + NGW < MP) ? m0 + NGW : m0;
                f32x4 sp[2], xv[2][4]; u32x2 mw[2][4];
#pragma unroll
                for (int r = 0; r < 2; ++r) { const int m = r ? m1 : m0; sp[r] = *((const GAS f32x4*)(SSQ1 + (size_t)m * 16) + (lane & 3));
#pragma unroll
                    for (int j = 0; j < 4; ++j) { xv[r][j] = ((const GAS f32x4*)(x_prompt + (size_t)m * DM))[64 * j + lane]; mw[r][j] = ((const GAS u32x2*)(MO + (size_t)m * DM))[64 * j + lane]; } }
#pragma unroll
                for (int r = 0; r < 2; ++r) if (r == 0 || m1 != m0) { const int m = r ? m1 : m0;
                    float ss = (sp[r].x + sp[r].y) + (sp[r].z + sp[r].w); ss += __shfl_xor(ss, 1); ss += __shfl_xor(ss, 2);
                    const float rs = rsqrtf(ss * (1.f / DM) + EPS);
                    f32x4 x1[4]; float s2 = 0.f;
#pragma unroll
                    for (int j = 0; j < 4; ++j) { f32x4 mv; mv.x = __uint_as_float(mw[r][j].x << 16); mv.y = __uint_as_float(mw[r][j].x & 0xffff0000u); mv.z = __uint_as_float(mw[r][j].y << 16); mv.w = __uint_as_float(mw[r][j].y & 0xffff0000u);
                        x1[j] = xv[r][j] + mv * rs * gp4[j]; s2 += (x1[j].x * x1[j].x + x1[j].y * x1[j].y) + (x1[j].z * x1[j].z + x1[j].w * x1[j].w);
                        }
                    const float rs2 = rsqrtf(wave_sum(s2) * (1.f / DM) + EPS);
#pragma unroll
                    for (int j = 0; j < 4; ++j) { const f32x4 y = x1[j] * rs2 * gq4[j]; u32x2 w; w.x = pk2(y.x, y.y); w.y = pk2(y.z, y.w); ((GAS u32x2*)(XN + (size_t)m * DM))[64 * j + lane] = w; }
                }
            }
        }
        for (int m = MP + gw; m < MT; m += NGW) {
            const float* xr = (m < MP) ? x_prompt + (size_t)m * DM : x_sample + (size_t)(m - MP) * DM;
            float* orow = args.out + (size_t)m * DM;
            f32x4 mvv[4]; float ss;
            if (m < MP) {
                const f32x4 sp = *((const f32x4*)(SSQ1 + (size_t)m * 16) + (lane & 3));
                ss = (sp.x + sp.y) + (sp.z + sp.w); ss += __shfl_xor(ss, 1); ss += __shfl_xor(ss, 2);
#pragma unroll
                for (int j = 0; j < 4; ++j) { const u32x2 mw = ((const u32x2*)(MO + (size_t)m * DM))[64 * j + lane];
                    mvv[j].x = __uint_as_float(mw.x << 16); mvv[j].y = __uint_as_float(mw.x & 0xffff0000u); mvv[j].z = __uint_as_float(mw.y << 16); mvv[j].w = __uint_as_float(mw.y & 0xffff0000u); }
            } else {
                const f32x4* ar = (const f32x4*)(ws + WS_ACC1) + (size_t)(m - MP) * 256; float s = 0.f;
#pragma unroll
                for (int j = 0; j < 4; ++j) { f32x4 a = ar[64 * j + lane];
                    for (int sl = 1; sl < 4; ++sl) a += ar[(size_t)sl * 65536 + 64 * j + lane];
                    mvv[j] = a; s += (a.x * a.x + a.y * a.y) + (a.z * a.z + a.w * a.w); }
                ss = wave_sum(s);
            }
            const float rs = rsqrtf(ss * (1.f / DM) + EPS);
            f32x4 x1[4]; float s2 = 0.f;
#pragma unroll
            for (int j = 0; j < 4; ++j) { const int c4 = 64 * j + lane; const f32x4 xv = ((const f32x4*)xr)[c4]; const f32x4 gp = ((const f32x4*)g_post)[c4];
                const f32x4 mv = mvv[j];
                x1[j] = xv + mv * rs * gp; s2 += (x1[j].x * x1[j].x + x1[j].y * x1[j].y) + (x1[j].z * x1[j].z + x1[j].w * x1[j].w);
                ((f32x4*)orow)[c4] = x1[j]; }
            const float rs2 = rsqrtf(wave_sum(s2) * (1.f / DM) + EPS);
#pragma unroll
            for (int j = 0; j < 4; ++j) { const int c4 = 64 * j + lane; const f32x4 gq = ((const f32x4*)g_pre)[c4]; const f32x4 y = x1[j] * rs2 * gq; u32x2 w; w.x = pk2(y.x, y.y); w.y = pk2(y.z, y.w); ((u32x2*)(XN + (size_t)m * DM))[c4] = w; }
        }
    }
    xcd_barrier(xbar, wave0);
    {
        PHASE_WS();
        bf16_t* Hb = (bf16_t*)(ws + WS_H);
        pg8::Gemm g{(bf16_t*)(ws + WS_XN + 4096) - 2 * DM, (bf16_t*)(ws + WS_WUP), 1024, 254, 1024}; pg8::StaticOrder S; S.init(131, 22, G, bx);
        EpiUp E{Hb, args.out, args.in[16], args.in[17], args.in[5], lds};
        pg8::gemm_phase<EpiUp, pg8::StaticOrder>(lds, g, S, E, wave0);
    }
    xcd_barrier(xbar, wave0);
    {
        PHASE_WS();
        bf16_t* MO = (bf16_t*)(ws + WS_XN + 4096); float* SSQ2 = (float*)(ws + WS_SSQ2);
        pg8::Gemm g{(bf16_t*)(ws + WS_H), (bf16_t*)(ws + WS_WD), DFF, 256, DFF}; pg8::StaticOrder S; S.init(MP / 256, 4, G, bx);
        EpiRowOut E{MO, SSQ2};
        pg8::gemm_phase<EpiRowOut, pg8::StaticOrder>(lds, g, S, E, wave0);
        pg8::Gemm g2{(bf16_t*)(ws + WS_H), (bf16_t*)(ws + WS_WD), 256, 256, DFF}; pg8::SplitOrder S2{44, G, bx, 128, 256};
        EpiSlice E2{(float*)(ws + WS_ACC2), 256};
        pg8::gemm_phase<EpiSlice, pg8::SplitOrder>(lds, g2, S2, E2, wave0);
    }
    xcd_barrier(xbar, wave0);
    {
        PHASE_IDS(); PHASE_WS();
        bf16_t* MO = (bf16_t*)(ws + WS_MO); float* SSQ2 = (float*)(ws + WS_SSQ2);
        const float* g_post = args.in[14];
        const int gw = vcu * 8 + wave, NGW = G * 8;
        {
            const bf16_t* MO1 = (const bf16_t*)(ws + WS_MO); const bf16_t* FO = (const bf16_t*)(ws + WS_XN + 4096); const float* SSQ1 = (const float*)(ws + WS_SSQ1);
            const float* g_mix = args.in[12];
            f32x4 ga[4], gb[4];
#pragma unroll
            for (int j = 0; j < 4; ++j) { ga[j] = ((const GAS f32x4*)g_mix)[64 * j + lane]; gb[j] = ((const GAS f32x4*)g_post)[64 * j + lane]; }
            for (int m0 = gw; m0 < MP; m0 += 2 * NGW) {
                const int m1 = (m0 + NGW < MP) ? m0 + NGW : m0;
                f32x4 sa[2], sb[2], xv[2][4]; u32x2 mw[2][4], fw[2][4];
#pragma unroll
                for (int r = 0; r < 2; ++r) { const int m = r ? m1 : m0; sa[r] = *((const GAS f32x4*)(SSQ1 + (size_t)m * 16) + (lane & 3)); sb[r] = *((const GAS f32x4*)(SSQ2 + (size_t)m * 16) + (lane & 3));
#pragma unroll
                    for (int j = 0; j < 4; ++j) { xv[r][j] = ((const GAS f32x4*)(x_prompt + (size_t)m * DM))[64 * j + lane]; mw[r][j] = ((const GAS u32x2*)(MO1 + (size_t)m * DM))[64 * j + lane]; fw[r][j] = ((const GAS u32x2*)(FO + (size_t)m * DM))[64 * j + lane]; } }
#pragma unroll
                for (int r = 0; r < 2; ++r) if (r == 0 || m1 != m0) { const int m = r ? m1 : m0;
                    float s1 = (sa[r].x + sa[r].y) + (sa[r].z + sa[r].w); s1 += __shfl_xor(s1, 1); s1 += __shfl_xor(s1, 2);
                    float s2 = (sb[r].x + sb[r].y) + (sb[r].z + sb[r].w); s2 += __shfl_xor(s2, 1); s2 += __shfl_xor(s2, 2);
                    const float rs1 = rsqrtf(s1 * (1.f / DM) + EPS), rs2 = rsqrtf(s2 * (1.f / DM) + EPS);
#pragma unroll
                    for (int j = 0; j < 4; ++j) { f32x4 mv, fv;
                        mv.x = __uint_as_float(mw[r][j].x << 16); mv.y = __uint_as_float(mw[r][j].x & 0xffff0000u); mv.z = __uint_as_float(mw[r][j].y << 16); mv.w = __uint_as_float(mw[r][j].y & 0xffff0000u);
                        fv.x = __uint_as_float(fw[r][j].x << 16); fv.y = __uint_as_float(fw[r][j].x & 0xffff0000u); fv.z = __uint_as_float(fw[r][j].y << 16); fv.w = __uint_as_float(fw[r][j].y & 0xffff0000u);
                        const f32x4 x1 = xv[r][j] + mv * rs1 * ga[j];
                        ((GAS f32x4*)(args.out + (size_t)m * DM))[64 * j + lane] = x1 + fv * rs2 * gb[j]; }
                }
            }
        }
        for (int m = MP + gw; m < MT; m += NGW) {
            float* orow = args.out + (size_t)m * DM;
            f32x4 mvv[4]; float ss;
            if (m < MP) {
                const f32x4 sp = *((const f32x4*)(SSQ2 + (size_t)m * 16) + (lane & 3));
                ss = (sp.x + sp.y) + (sp.z + sp.w); ss += __shfl_xor(ss, 1); ss += __shfl_xor(ss, 2);
#pragma unroll
                for (int j = 0; j < 4; ++j) { const u32x2 mw = ((const u32x2*)(MO + (size_t)m * DM))[64 * j + lane];
                    mvv[j].x = __uint_as_float(mw.x << 16); mvv[j].y = __uint_as_float(mw.x & 0xffff0000u); mvv[j].z = __uint_as_float(mw.y << 16); mvv[j].w = __uint_as_float(mw.y & 0xffff0000u); }
            } else {
                const f32x4* ar = (const f32x4*)(ws + WS_ACC2) + (size_t)(m - MP) * 256; float s = 0.f;
#pragma unroll
                for (int j = 0; j < 4; ++j) { f32x4 a = ar[64 * j + lane];
                    for (int sl = 1; sl < 11; ++sl) a += ar[(size_t)sl * 65536 + 64 * j + lane];
                    mvv[j] = a; s += (a.x * a.x + a.y * a.y) + (a.z * a.z + a.w * a.w); }
                ss = wave_sum(s);
            }
            const float rs = rsqrtf(ss * (1.f / DM) + EPS);
#pragma unroll
            for (int j = 0; j < 4; ++j) { const int c4 = 64 * j + lane; const f32x4 xv = ((const f32x4*)orow)[c4]; const f32x4 gp = ((const f32x4*)g_post)[c4];
                ((f32x4*)orow)[c4] = xv + mvv[j] * rs * gp; }
        }
    }
}

extern "C" void kernel_launch(void* const* d_in, const int* in_sizes, int n_in, void* d_out, int out_size, void* d_ws, size_t ws_size, hipStream_t stream) {
    static int grid = 0;
    if (grid == 0) {
        if (n_in != 19 || ws_size < WS_END || (size_t)out_size != O_END) { fprintf(stderr, "kernel_launch: unexpected shapes n_in %d out %d ws %zu\n", n_in, out_size, ws_size); grid = -1; return; }
        int dev = 0, cus = 0, per_cu = 0;
        hipGetDevice(&dev); hipDeviceGetAttribute(&cus, hipDeviceAttributeMultiprocessorCount, dev);
        hipFuncSetAttribute((const void*)hymba_fwd, hipFuncAttributeMaxDynamicSharedMemorySize, LDS_BYTES);
        hipOccupancyMaxActiveBlocksPerMultiprocessor(&per_cu, (const void*)hymba_fwd, 512, LDS_BYTES);
        if (per_cu < 1) { fprintf(stderr, "kernel_launch: occupancy query says %d blocks per CU\n", per_cu); grid = -1; return; }
        grid = cus;
    }
    if (grid < 0) return;
    hipMemsetAsync((char*)d_ws + WS_CTL, 0, CTL_BYTES, stream);
    Args a{};
    for (int i = 0; i < 19; ++i) a.in[i] = (const float*)d_in[i];
    a.out = (float*)d_out; a.ws = (unsigned char*)d_ws;
    void* kargs[] = {&a};
    hipError_t e = hipLaunchCooperativeKernel((const void*)hymba_fwd, dim3(grid), dim3(512), kargs, LDS_BYTES, stream);
    if (e != hipSuccess) fprintf(stderr, "cooperative launch failed: %s (grid %d)\n", hipGetErrorString(e), grid);
}
```

```cpp
#include <hip/hip_runtime.h>
#include <hip/hip_cooperative_groups.h>
#include <cstdio>
#include <cstdint>
namespace cg = cooperative_groups;

#define LAS __attribute__((address_space(3)))
#define GAS __attribute__((address_space(1)))
typedef unsigned short bf16_t;
typedef short bf16x8 __attribute__((ext_vector_type(8)));
typedef short s16x4 __attribute__((ext_vector_type(4)));
typedef float f32x4 __attribute__((ext_vector_type(4)));
typedef float f32x2 __attribute__((ext_vector_type(2)));
typedef float f32x16 __attribute__((ext_vector_type(16)));
typedef unsigned u32x4 __attribute__((ext_vector_type(4)));
typedef unsigned u32x2 __attribute__((ext_vector_type(2)));

constexpr int DM = 1024, NPB = 16, SEQ = 2048, NSB = 32, NST = 8;
constexpr int MP = NPB * SEQ;
constexpr int MS = NSB * NST;
constexpr int MT = MP + MS;
constexpr int NIN = 3328;
constexpr int DIN = 3088;
constexpr int DFF = 2816;
constexpr int WINB = 2048;
constexpr float EPS = 1e-6f;
constexpr float QSCALE = 0.125f * 1.4426950408889634f;

constexpr size_t MiB = 1u << 20;
constexpr size_t WS_CTL = 0, CTL_BYTES = 65536;
constexpr int XBST_OFF = 131072 + 8192;
constexpr size_t WS_WIN = 1 * MiB, WS_WO = 8 * MiB, WS_WUP = 10 * MiB, WS_WD = 22 * MiB;
constexpr size_t WS_SSQ1 = 28 * MiB, WS_SSQ2 = 31 * MiB;
constexpr size_t WS_XN = 34 * MiB;
constexpr size_t WS_MO = 104 * MiB;
constexpr size_t WS_QA = 172 * MiB, WS_KA = 206 * MiB, WS_VA = 240 * MiB, WS_QB = 274 * MiB, WS_KB = 291 * MiB, WS_VB = 308 * MiB, WS_RB = 342 * MiB, WS_LF = 376 * MiB, WS_MIX = 410 * MiB;
constexpr size_t WS_H = 172 * MiB;
constexpr size_t WS_ACC1 = 478 * MiB, WS_ACC2 = 482 * MiB;
constexpr size_t WS_END = 494 * MiB;
static_assert(WS_H + (size_t)MT * DFF * 2 <= WS_MIX, "h overlay");
static_assert(WS_XN + 4096 + (size_t)(131 * 254 + 260) * DM * 2 <= WS_MO, "xn2");

constexpr size_t O_YP = 0, O_YS = O_YP + (size_t)MP * DM, O_KP = O_YS + (size_t)MS * DM, O_VP = O_KP + (size_t)MP * 512, O_GP = O_VP + (size_t)MP * 512,
                 O_CP = O_GP + (size_t)NPB * 4 * 64 * 128, O_KS = O_CP + (size_t)NPB * 2 * DFF, O_VS = O_KS + (size_t)MS * 512, O_GS = O_VS + (size_t)MS * 512,
                 O_CS = O_GS + (size_t)NSB * 4 * 64 * 128, O_END = O_CS + (size_t)NSB * 2 * DFF;

__device__ __forceinline__ unsigned cvt_pk_bf16(float lo, float hi) { unsigned r; asm volatile("v_cvt_pk_bf16_f32 %0, %1, %2" : "=v"(r) : "v"(lo), "v"(hi)); return r; }
__device__ __forceinline__ float bf2f(unsigned short b) { return __uint_as_float((unsigned)b << 16); }
__device__ __forceinline__ float wave_sum(float v) {
#pragma unroll
    for (int o = 1; o < 64; o <<= 1) v += __shfl_xor(v, o);
    return v;
}

__device__ __forceinline__ int lane_id_v() { int l; asm volatile("v_mbcnt_lo_u32_b32 %0, -1, 0\n\tv_mbcnt_hi_u32_b32 %0, -1, %0" : "=v"(l)); return l; }

struct Args {
    const float* in[19];
    float* out;
    unsigned char* ws;
};

namespace pg8 {
constexpr int BM = 256, BK = 64, HALF = 128, HTB = HALF * BK * 2, STAGE_BYTES = 8 * HTB, NXCD = 8, WGM = 4;
__host__ __device__ __forceinline__ int lds_byte(int r, int c) { const int st = (r >> 4) * 2 + (c >> 5), rr = r & 15, cc = c & 31, ob = rr * 64 + cc * 2; return st * 1024 + (ob ^ (((ob >> 9) & 1) << 5)); }
__host__ __device__ __forceinline__ void stage_rc(int b, int& R, int& C) { const int st = b / 1024, sb = b % 1024, swz = sb ^ (((sb >> 9) & 1) << 5); R = (st >> 1) * 16 + swz / 64; C = (st & 1) * 32 + (swz % 64) / 2; }
__host__ __device__ __forceinline__ int perm32(int rho) { const int n = rho >> 4, i = rho & 15; return 8 * (i >> 2) + 4 * n + (i & 3); }

struct Unit { int pm, pn, kofs; };
struct Gemm { const bf16_t* A; const bf16_t* Bt; int K; int a_rows; int ldk; };

struct StaticOrder {
    int nM, nN, nwg, G, c;
    __device__ void init(int nM_, int nN_, int G_, int c_) { nM = nM_; nN = nN_; nwg = nM * nN; G = G_; c = c_; }
    __device__ bool next(int i, Unit& u) const {
        const long L = (long)i * G + c; if (L >= nwg) return false;
        int wgid = (int)L; { const int q = nwg / NXCD, r = nwg % NXCD, xcd = wgid % NXCD, off = wgid / NXCD; wgid = (xcd < r ? xcd * (q + 1) : r * (q + 1) + (xcd - r) * q) + off; }
        const int nig = WGM * nN, gid = wgid / nig, fm = gid * WGM, gsz = (nM - fm) < WGM ? (nM - fm) : WGM;
        u.pm = fm + ((wgid % nig) % gsz); u.pn = (wgid % nig) / gsz; u.kofs = 0; return true;
    }
};
struct SplitOrder {
    int nsub, G, c, pm, ksub;
    __device__ bool next(int i, Unit& u) const { const int L = i * G + c; if (L >= nsub) return false; u.pm = pm; u.pn = L & 3; u.kofs = (L >> 2) * ksub; return true; }
};

__device__ __forceinline__ f32x2 gelu_pk(f32x2 v) {
    const f32x2 av = __builtin_elementwise_abs(v), d = av * 0.2316418882f + 1.0f;
    f32x2 t; t.x = __builtin_amdgcn_rcpf(d.x); t.y = __builtin_amdgcn_rcpf(d.y);
    f32x2 q = t * 0.5307027145f + (-0.7265760135f); q = q * t + 0.7107068705f; q = q * t + (-0.142248368f); q = q * t + 0.127414796f; q = q * t;
    const f32x2 s = (v * v) * (-0.72134752044f);
    f32x2 e; e.x = __builtin_amdgcn_exp2f(s.x); e.y = __builtin_amdgcn_exp2f(s.y);
    const f32x2 m = v * (q * e), r = v - m;
    f32x2 o; o.x = v.x < 0.f ? m.x : r.x; o.y = v.y < 0.f ? m.y : r.y; return o;
}

template <class Epi, class Sched>
__device__ __forceinline__ void gemm_phase(LAS unsigned char* lds, const Gemm g, const Sched& S, const Epi& E, int wid) {
    const int lane = lane_id_v(); const int tid = wid * 64 + lane;
    const int wr = wid >> 2, wc = wid & 3, fr = lane & 15, fq = lane >> 4;
    const int K = g.ldk, nt = g.K / BK;
    unsigned voffA[2], voffB[2];
#pragma unroll
    for (int i = 0; i < 2; ++i) { int R, C; stage_rc(tid * 16 + i * 8192, R, C); const int Rb = Epi::PERM ? ((R & ~31) + perm32(R & 31)) : R;
        voffA[i] = (unsigned)(R * K + C) * 2u; voffB[i] = (unsigned)(Rb * K + C) * 2u; }
    const size_t kstep = (size_t)(BK * 2);
    const size_t hstep = (size_t)HALF * K * 2;
    const size_t tstepB = 2 * hstep;
    const size_t tstepA = (size_t)g.a_rows * K * 2;
    const unsigned ldsw = (unsigned)wid * 1024u;
    const int aoff = lds_byte(wr * 64 + fr, fq * 8), boff = lds_byte(wc * 32 + fr, fq * 8);
#define PG8_SA(b, h) (((b) * 2 + (h)) * HTB)
#define PG8_SB(b, h) ((4 + (b) * 2 + (h)) * HTB)
#define PG8_STAGE(bufoff, gbase, voff) do { _Pragma("unroll") for (int _i = 0; _i < 2; ++_i) \
        __builtin_amdgcn_global_load_lds((const unsigned*)((const char*)(gbase) + (voff)[_i]), (LAS unsigned*)(lds + (bufoff) + ldsw + _i * 8192), 16, 0, 0); } while (0)
#define PG8_LDA(dst, b, h) do { _Pragma("unroll") for (int m = 0; m < 4; ++m) _Pragma("unroll") for (int k = 0; k < 2; ++k) dst[m][k] = *(const LAS bf16x8*)(lds + PG8_SA(b, h) + aoff + m * 2048 + k * 1024); } while (0)
#define PG8_LDB(dst, b, h) do { _Pragma("unroll") for (int n = 0; n < 2; ++n) _Pragma("unroll") for (int k = 0; k < 2; ++k) dst[n][k] = *(const LAS bf16x8*)(lds + PG8_SB(b, h) + boff + n * 2048 + k * 1024); } while (0)
#define PG8_MMA(ai, bj, At, Bt) do { __builtin_amdgcn_s_setprio(1); _Pragma("unroll") for (int m = 0; m < 4; ++m) _Pragma("unroll") for (int n = 0; n < 2; ++n) _Pragma("unroll") for (int k = 0; k < 2; ++k) \
        acc[ai][bj][m][n] = __builtin_amdgcn_mfma_f32_16x16x32_bf16(Bt[n][k], At[m][k], acc[ai][bj][m][n], 0, 0, 0); __builtin_amdgcn_s_setprio(0); } while (0)
#define PG8_WAIT_V(n) asm volatile("s_waitcnt vmcnt(" #n ")" ::: "memory")
#define PG8_WAIT_L(n) asm volatile("s_waitcnt lgkmcnt(" #n ")" ::: "memory")
#define PG8_BAR __builtin_amdgcn_s_barrier()
#define PG8_SCHED __builtin_amdgcn_sched_barrier(0)
    Unit cur, nxt; int ui = 0;
    if (!S.next(0, cur)) return;
    f32x4 acc[2][2][4][2];
#pragma unroll
    for (int a = 0; a < 2; ++a)
#pragma unroll
        for (int b = 0; b < 2; ++b)
#pragma unroll
            for (int m = 0; m < 4; ++m)
#pragma unroll
                for (int n = 0; n < 2; ++n) acc[a][b][m][n] = (f32x4){0.f, 0.f, 0.f, 0.f};
    bf16x8 At[4][2], B0[2][2], B1[2][2];
    const char* cA = (const char*)g.A + (size_t)cur.pm * tstepA + (size_t)cur.kofs * 2; const char* cB = (const char*)g.Bt + (size_t)cur.pn * tstepB + (size_t)cur.kofs * 2;
    PG8_STAGE(PG8_SB(0, 0), cB, voffB); PG8_STAGE(PG8_SB(0, 1), cB + hstep, voffB); PG8_STAGE(PG8_SA(0, 0), cA, voffA); PG8_STAGE(PG8_SA(0, 1), cA + hstep, voffA);
    if (wr == 1) PG8_BAR;
    PG8_WAIT_V(2); PG8_BAR;
    PG8_STAGE(PG8_SB(1, 0), cB + kstep, voffB); PG8_STAGE(PG8_SA(1, 0), cA + kstep, voffA); PG8_STAGE(PG8_SB(1, 1), cB + hstep + kstep, voffB);
    PG8_WAIT_V(6); PG8_BAR;
    for (;;) {
        const bool has_next = S.next(ui + 1, nxt);
        const char* nA = has_next ? (const char*)g.A + (size_t)nxt.pm * tstepA + (size_t)nxt.kofs * 2 : cA; const char* nB = has_next ? (const char*)g.Bt + (size_t)nxt.pn * tstepB + (size_t)nxt.kofs * 2 : cB;
        for (int t = 0; t < nt; t += 2) {
            const bool last = (t == nt - 2);
            const char* a1 = cA + (size_t)(t + 1) * kstep;
            const char* a2 = last ? nA : cA + (size_t)(t + 2) * kstep; const char* b2 = last ? nB : cB + (size_t)(t + 2) * kstep;
            const char* a3 = a2 + kstep; const char* b3 = b2 + kstep;
            PG8_LDB(B0, 0, 0); PG8_LDB(B1, 0, 1); PG8_SCHED; PG8_LDA(At, 0, 0); PG8_STAGE(PG8_SA(1, 1), a1 + hstep, voffA);
            PG8_WAIT_V(8); PG8_WAIT_L(0); PG8_BAR; PG8_MMA(0, 0, At, B0); PG8_MMA(0, 1, At, B1); PG8_BAR; PG8_SCHED;
            PG8_LDA(At, 0, 1); PG8_STAGE(PG8_SB(0, 0), b2, voffB); PG8_STAGE(PG8_SB(0, 1), b2 + hstep, voffB); PG8_STAGE(PG8_SA(0, 0), a2, voffA);
            PG8_WAIT_V(8); PG8_WAIT_L(0); PG8_BAR; PG8_MMA(1, 0, At, B0); PG8_MMA(1, 1, At, B1); PG8_BAR; PG8_SCHED;
            PG8_LDB(B0, 1, 0); PG8_LDB(B1, 1, 1); PG8_SCHED; PG8_LDA(At, 1, 0); PG8_STAGE(PG8_SA(0, 1), a2 + hstep, voffA);
            PG8_WAIT_V(8); PG8_WAIT_L(0); PG8_BAR; PG8_MMA(0, 0, At, B0); PG8_MMA(0, 1, At, B1); PG8_BAR; PG8_SCHED;
            PG8_LDA(At, 1, 1); PG8_STAGE(PG8_SB(1, 0), b3, voffB); PG8_STAGE(PG8_SB(1, 1), b3 + hstep, voffB); PG8_STAGE(PG8_SA(1, 0), a3, voffA);
            PG8_WAIT_V(8); PG8_WAIT_L(0); PG8_BAR; PG8_MMA(1, 0, At, B0); PG8_MMA(1, 1, At, B1); PG8_BAR; PG8_SCHED;
        }
        if (wr == 0) PG8_BAR;
        E(acc, cur, wr, wc, fr, fq);
        if (!has_next) break;
#pragma unroll
        for (int a = 0; a < 2; ++a)
#pragma unroll
            for (int b = 0; b < 2; ++b)
#pragma unroll
                for (int m = 0; m < 4; ++m)
#pragma unroll
                    for (int n = 0; n < 2; ++n) acc[a][b][m][n] = (f32x4){0.f, 0.f, 0.f, 0.f};
        cur = nxt; cA = nA; cB = nB; ++ui;
        if (wr == 1) PG8_BAR;
    }
    PG8_WAIT_V(0);
    PG8_BAR;
#undef PG8_SA
#undef PG8_SB
#undef PG8_STAGE
#undef PG8_LDA
#undef PG8_LDB
#undef PG8_MMA
#undef PG8_WAIT_V
#undef PG8_WAIT_L
#undef PG8_BAR
#undef PG8_SCHED
}
}

struct EpiInProj {
    static constexpr bool PERM = true;
    bf16_t *QA, *KA, *VA, *QB, *KB, *VB, *RB; float* LF; float* out; const float* b_a;
    __device__ __forceinline__ void operator()(const f32x4 (&acc)[2][2][4][2], const pg8::Unit& u, int wr, int wc, int fr, int fq) const {
        const int pn = u.pn;
        const int row0 = u.pm * 256 + wr * 64 + fr;
        const int cl = wc * 32 + 8 * fq;
        if (pn == 12) {
#pragma unroll
            for (int bj = 0; bj < 2; ++bj) {
                const f32x4 b0 = *(const f32x4*)(b_a + cl + bj * 128), b1 = *(const f32x4*)(b_a + cl + bj * 128 + 4);
#pragma unroll
                for (int ai = 0; ai < 2; ++ai)
#pragma unroll
                    for (int m = 0; m < 4; ++m) {
                        f32x4 v0 = acc[ai][bj][m][0] + b0, v1 = acc[ai][bj][m][1] + b1;
#pragma unroll
                        for (int e = 0; e < 4; ++e) {
                            float z = v0[e]; v0[e] = (fminf(z, 0.f) - 0.69314718f * __builtin_amdgcn_logf(1.f + __builtin_amdgcn_exp2f(-1.44269504f * fabsf(z)))) * 0.0625f;
                            z = v1[e]; v1[e] = (fminf(z, 0.f) - 0.69314718f * __builtin_amdgcn_logf(1.f + __builtin_amdgcn_exp2f(-1.44269504f * fabsf(z)))) * 0.0625f; }
                        float* p = LF + (size_t)(row0 + ai * 128 + m * 16) * 256 + cl + bj * 128;
                        *(f32x4*)p = v0; *(f32x4*)(p + 4) = v1;
                    }
            }
            return;
        }
        bf16_t* base; int ld, cb; float sc = 1.f; float* fo = nullptr;
        if (pn < 2) { base = QA; ld = 512; cb = pn * 256; sc = QSCALE; }
        else if (pn < 4) { base = KA; ld = 512; cb = (pn - 2) * 256; fo = out + (u.pm < 128 ? O_KP : O_KS - (size_t)MP * 512); }
        else if (pn < 6) { base = VA; ld = 512; cb = (pn - 4) * 256; fo = out + (u.pm < 128 ? O_VP : O_VS - (size_t)MP * 512); }
        else if (pn == 6) { base = QB; ld = 256; cb = 0; }
        else if (pn == 7) { base = KB; ld = 256; cb = 0; }
        else if (pn < 10) { base = VB; ld = 512; cb = (pn - 8) * 256; }
        else { base = RB; ld = 512; cb = (pn - 10) * 256; }
#pragma unroll
        for (int ai = 0; ai < 2; ++ai)
#pragma unroll
            for (int m = 0; m < 4; ++m) {
                const size_t r = (size_t)(row0 + ai * 128 + m * 16);
#pragma unroll
                for (int bj = 0; bj < 2; ++bj) {
                    const f32x4 a0 = acc[ai][bj][m][0], a1 = acc[ai][bj][m][1];
                    const f32x4 v0 = a0 * sc, v1 = a1 * sc;
                    u32x4 w; w.x = cvt_pk_bf16(v0[0], v0[1]); w.y = cvt_pk_bf16(v0[2], v0[3]); w.z = cvt_pk_bf16(v1[0], v1[1]); w.w = cvt_pk_bf16(v1[2], v1[3]);
                    *(u32x4*)(base + r * ld + cb + cl + bj * 128) = w;
                    if (fo) { float* p = fo + r * 512 + cb + cl + bj * 128; *(f32x4*)p = a0; *(f32x4*)(p + 4) = a1; }
                }
            }
    }
};


struct EpiRowOut {
    static constexpr bool PERM = true;
    bf16_t* O; float* SSQ;
    __device__ __forceinline__ void operator()(const f32x4 (&acc)[2][2][4][2], const pg8::Unit& u, int wr, int wc, int fr, int fq) const {
        const int row0 = u.pm * 256 + wr * 64 + fr; const int cl = u.pn * 256 + wc * 32 + 8 * fq;
#pragma unroll
        for (int ai = 0; ai < 2; ++ai)
#pragma unroll
            for (int m = 0; m < 4; ++m) {
                const size_t r = (size_t)(row0 + ai * 128 + m * 16); float s = 0.f;
#pragma unroll
                for (int bj = 0; bj < 2; ++bj) {
                    const f32x4 v0 = acc[ai][bj][m][0], v1 = acc[ai][bj][m][1];
                    s += (v0[0] * v0[0] + v0[1] * v0[1]) + (v0[2] * v0[2] + v0[3] * v0[3]) + (v1[0] * v1[0] + v1[1] * v1[1]) + (v1[2] * v1[2] + v1[3] * v1[3]);
                    u32x4 w; w.x = cvt_pk_bf16(v0[0], v0[1]); w.y = cvt_pk_bf16(v0[2], v0[3]); w.z = cvt_pk_bf16(v1[0], v1[1]); w.w = cvt_pk_bf16(v1[2], v1[3]);
                    *(u32x4*)(O + r * 1024 + cl + bj * 128) = w;
                }
                s += __shfl_xor(s, 16); s += __shfl_xor(s, 32);
                if (fq == 0) SSQ[r * 16 + u.pn * 4 + wc] = s;
            }
    }
};

struct EpiSlice {
    static constexpr bool PERM = false;
    float* SL; int ksub;
    __device__ __forceinline__ void operator()(const f32x4 (&acc)[2][2][4][2], const pg8::Unit& u, int wr, int wc, int fr, int fq) const {
        float* base = SL + (size_t)(u.kofs / ksub) * (256 * 1024) + (unsigned)((wr * 64 + fr) * 1024 + u.pn * 256 + wc * 32 + 4 * fq);
#pragma unroll
        for (int ai = 0; ai < 2; ++ai)
#pragma unroll
            for (int m = 0; m < 4; ++m) { float* rowp = base + (ai * 128 + m * 16) * 1024;
#pragma unroll
                for (int bj = 0; bj < 2; ++bj)
#pragma unroll
                    for (int n = 0; n < 2; ++n) *(f32x4*)(rowp + bj * 128 + n * 16) = acc[ai][bj][m][n]; }
    }
};

__device__ __forceinline__ float dpp_ror1(float v) { return __int_as_float(__builtin_amdgcn_update_dpp(0, __float_as_int(v), 0x121, 0xf, 0xf, false)); }
__device__ __forceinline__ float dpp_ror2(float v) { return __int_as_float(__builtin_amdgcn_update_dpp(0, __float_as_int(v), 0x122, 0xf, 0xf, false)); }

constexpr int CONVX_OFF = 131072;
struct EpiUp {
    static constexpr bool PERM = true;
    bf16_t* H; float* out; const float* conv_w; const float* conv_b; const float* cbuf; LAS unsigned char* lds;
    __device__ __forceinline__ void operator()(const f32x4 (&acc)[2][2][4][2], const pg8::Unit& u, int wr, int wc, int fr, int fq) const {
        LAS float* X = (LAS float*)(lds + CONVX_OFF);
        const int cg_ = wc * 32 + 8 * fq;
        const int col = u.pn * 128 + cg_;
        if (fr >= 14) {
#pragma unroll
            for (int ai = 0; ai < 2; ++ai) { LAS float* p = X + ((ai * 2 + wr) * 2 + (fr - 14)) * 128 + cg_; *(LAS f32x4*)p = acc[ai][0][3][0]; *(LAS f32x4*)(p + 4) = acc[ai][0][3][1]; }
        }
        f32x4 w0[2], w1[2], w2[2], cb[2];
#pragma unroll
        for (int n = 0; n < 2; ++n) { w0[n] = *(const f32x4*)(conv_w + col + 4 * n); w1[n] = *(const f32x4*)(conv_w + DFF + col + 4 * n); w2[n] = *(const f32x4*)(conv_w + 2 * DFF + col + 4 * n); cb[n] = *(const f32x4*)(conv_b + col + 4 * n); }
        asm volatile("s_waitcnt lgkmcnt(0)" ::: "memory"); __builtin_amdgcn_s_barrier(); asm volatile("" ::: "memory");
#pragma unroll
        for (int ai = 0; ai < 2; ++ai) {
            const int pai = (wr == 1) ? ai : ai - 1, pwr = wr ^ 1;
            f32x4 pr1[2], pr2[2];
#pragma unroll
            for (int n = 0; n < 2; ++n) {
                if (pai >= 0) { pr1[n] = *(const LAS f32x4*)(X + ((pai * 2 + pwr) * 2 + 1) * 128 + cg_ + 4 * n); pr2[n] = *(const LAS f32x4*)(X + ((pai * 2 + pwr) * 2 + (fr & 1)) * 128 + cg_ + 4 * n); }
                else { pr1[n] = (f32x4){0.f, 0.f, 0.f, 0.f}; pr2[n] = pr1[n]; }
            }
#pragma unroll
            for (int m = 0; m < 4; ++m) {
                const int lr = ai * 128 + wr * 64 + m * 16 + fr; const int gr = u.pm * 254 - 2 + lr;
                const bool store = (lr >= 2) && (gr < MT);
                int pos, bidx; const bool samp = gr >= MP;
                if (!samp) { pos = gr & (SEQ - 1); bidx = gr >> 11; } else { pos = (gr - MP) & 7; bidx = (gr - MP) >> 3; }
                const bool head_rows = __builtin_amdgcn_ballot_w64(pos < 2) != 0ull;
                const bool tail_rows = __builtin_amdgcn_ballot_w64(store && (samp ? pos >= 6 : pos >= SEQ - 2)) != 0ull;
                u32x4 hw;
#pragma unroll
                for (int n = 0; n < 2; ++n) {
                    const f32x4 g0 = acc[ai][0][m][n], uu = acc[ai][1][m][n]; f32x4 gm1, gm2, nr1, nr2;
#pragma unroll
                    for (int e = 0; e < 4; ++e) {
                        gm1[e] = __int_as_float(__builtin_amdgcn_update_dpp(__float_as_int(pr1[n][e]), __float_as_int(g0[e]), 0x111, 0xf, 0xf, false));
                        gm2[e] = __int_as_float(__builtin_amdgcn_update_dpp(__float_as_int(pr2[n][e]), __float_as_int(g0[e]), 0x112, 0xf, 0xf, false));
                        nr1[e] = dpp_ror1(g0[e]); nr2[e] = dpp_ror2(g0[e]);
                    }
                    pr1[n] = nr1; pr2[n] = nr2;
                    if (head_rows) {
                        if (!samp) { if (pos == 0) { gm1 = (f32x4){0.f, 0.f, 0.f, 0.f}; gm2 = gm1; } else if (pos == 1) gm2 = (f32x4){0.f, 0.f, 0.f, 0.f}; }
                        else if (store) { if (pos == 0) { gm1 = *(const f32x4*)(cbuf + (size_t)(bidx * 2 + 1) * DFF + col + 4 * n); gm2 = *(const f32x4*)(cbuf + (size_t)(bidx * 2) * DFF + col + 4 * n); }
                                          else if (pos == 1) gm2 = *(const f32x4*)(cbuf + (size_t)(bidx * 2 + 1) * DFF + col + 4 * n); }
                    }
                    const f32x4 c = cb[n] + w0[n] * gm2 + w1[n] * gm1 + w2[n] * g0;
                    const f32x2 ga = pg8::gelu_pk((f32x2){c[0], c[1]}), gb = pg8::gelu_pk((f32x2){c[2], c[3]});
                    const float h0 = ga.x * uu[0], h1 = ga.y * uu[1], h2 = gb.x * uu[2], h3 = gb.y * uu[3];
                    if (n == 0) { hw.x = cvt_pk_bf16(h0, h1); hw.y = cvt_pk_bf16(h2, h3); } else { hw.z = cvt_pk_bf16(h0, h1); hw.w = cvt_pk_bf16(h2, h3); }
                    if (tail_rows && store) {
                        if (!samp) { if (pos >= SEQ - 2) *(f32x4*)(out + O_CP + (size_t)(bidx * 2 + (pos - (SEQ - 2))) * DFF + col + 4 * n) = g0; }
                        else { if (pos >= 6) *(f32x4*)(out + O_CS + (size_t)(bidx * 2 + (pos - 6)) * DFF + col + 4 * n) = g0; }
                    }
                }
                if (store) *(u32x4*)(H + (size_t)gr * DFF + col) = hw;
            }
        }
    }
};

__device__ __forceinline__ unsigned pk2(float lo, float hi) { return cvt_pk_bf16(lo, hi); }
__device__ __forceinline__ void p0_transpose_item(const float* W, int ldw, int scol0, int k0, bf16_t* WT, int dK, int drow0, LAS float* scr, int lane) {
#pragma unroll 8
    for (int i = 0; i < 32; ++i) { const int kk = 2 * i + (lane >> 5); scr[kk * 33 + (lane & 31)] = W[(size_t)(k0 + kk) * ldw + scol0 + (lane & 31)]; }
    asm volatile("s_waitcnt lgkmcnt(0)" ::: "memory");
    const int c = lane & 7;
#pragma unroll
    for (int j = 0; j < 4; ++j) { const int n = (lane >> 3) + 8 * j; const LAS float* s = scr + (8 * c) * 33 + n;
        u32x4 o; o.x = pk2(s[0 * 33], s[1 * 33]); o.y = pk2(s[2 * 33], s[3 * 33]); o.z = pk2(s[4 * 33], s[5 * 33]); o.w = pk2(s[6 * 33], s[7 * 33]);
        *(u32x4*)(WT + (size_t)(drow0 + n) * dK + k0 + 8 * c) = o; }
    asm volatile("s_waitcnt lgkmcnt(0)" ::: "memory");
}
__device__ __forceinline__ void p0_gate_item(const float* w_in, const float* w_a2, int k0, int n0, bf16_t* WT, LAS float* scr, int lane) {
    float w2[16];
#pragma unroll
    for (int r = 0; r < 16; ++r) w2[r] = w_a2[r * 256 + n0 + (lane & 31)];
    for (int i = 0; i < 32; ++i) { const int kk = 2 * i + (lane >> 5); const float* a = w_in + (size_t)(k0 + kk) * DIN + 3072; float s = 0.f;
#pragma unroll
        for (int r = 0; r < 16; ++r) s += a[r] * w2[r];
        scr[kk * 33 + (lane & 31)] = s; }
    asm volatile("s_waitcnt lgkmcnt(0)" ::: "memory");
    const int c = lane & 7;
#pragma unroll
    for (int j = 0; j < 4; ++j) { const int n = (lane >> 3) + 8 * j; const LAS float* s = scr + (8 * c) * 33 + n;
        u32x4 o; o.x = pk2(s[0 * 33], s[1 * 33]); o.y = pk2(s[2 * 33], s[3 * 33]); o.z = pk2(s[4 * 33], s[5 * 33]); o.w = pk2(s[6 * 33], s[7 * 33]);
        *(u32x4*)(WT + (size_t)(3072 + n0 + n) * 1024 + k0 + 8 * c) = o; }
    asm volatile("s_waitcnt lgkmcnt(0)" ::: "memory");
}
__device__ __forceinline__ void rms_row_to_bf16(const float* xrow, const float* g, bf16_t* orow, int lane) {
    const f32x4* xr = (const f32x4*)xrow + lane; const f32x4* gr = (const f32x4*)g + lane;
    f32x4 v[4]; float s = 0.f;
#pragma unroll
    for (int j = 0; j < 4; ++j) { v[j] = __builtin_nontemporal_load((const GAS f32x4*)xr + 64 * j); s += (v[j].x * v[j].x + v[j].y * v[j].y) + (v[j].z * v[j].z + v[j].w * v[j].w); }
    const float rs = rsqrtf(wave_sum(s) * (1.f / DM) + EPS);
    u32x2* o8 = (u32x2*)orow + lane;
#pragma unroll
    for (int j = 0; j < 4; ++j) { const f32x4 gg = gr[64 * j]; const f32x4 y = v[j] * rs * gg; u32x2 w; w.x = pk2(y.x, y.y); w.y = pk2(y.z, y.w); o8[64 * j] = w; }
}


__device__ __forceinline__ int crow(int r, int hi) { return (r & 3) + 8 * (r >> 2) + 4 * hi; }
typedef short v4i16_t __attribute__((ext_vector_type(4)));
__device__ __forceinline__ s16x4 vtr(const LAS unsigned char* p) { return __builtin_bit_cast(s16x4, __builtin_amdgcn_ds_read_tr16_b64_v4i16((LAS v4i16_t*)p)); }
__device__ __forceinline__ float swapmax(float v) { auto rr = __builtin_amdgcn_permlane32_swap(__float_as_uint(v), __float_as_uint(v), false, false); return fmaxf(__uint_as_float(rr[0]), __uint_as_float(rr[1])); }
__device__ __forceinline__ float swapsum(float v) { auto rr = __builtin_amdgcn_permlane32_swap(__float_as_uint(v), __float_as_uint(v), false, false); return __uint_as_float(rr[0]) + __uint_as_float(rr[1]); }
__device__ __forceinline__ u32x4 pack8(f32x4 a, f32x4 b) { u32x4 w; w.x = cvt_pk_bf16(a.x, a.y); w.y = cvt_pk_bf16(a.z, a.w); w.z = cvt_pk_bf16(b.x, b.y); w.w = cvt_pk_bf16(b.z, b.w); return w; }

constexpr float NEGF = -1e30f;
constexpr int VPITCH = 192;
constexpr int ATT_WLDS = 32 * VPITCH + 256;

struct AttnCtx { const bf16_t *QA, *KA, *VA; bf16_t* MIX; const float *ck, *cv; };

struct TileRegs { u32x4 k[8]; u32x4 v[8]; };

template <bool SAMPLE> __device__ __forceinline__ int tile_key(int ti, int j, int g, int r4, int ncls) {
    if (SAMPLE) { if (ti < 17) return 1536 + 32 * (16 - ti) + j; const int kk = ti - 17; return 16 * (4 * kk + (j >> 3)) + (j & 7); }
    if (ti < ncls) return 4 * (32 * (g - ti) + j) + r4;
    const int jj = ti - ncls + (g == 0 ? 4 : 0); return 128 * g - 128 + 32 * jj + j;
}
template <bool SAMPLE> __device__ __forceinline__ void tile_load(const AttnCtx& C, TileRegs& T, int ti, int b, int h, int g, int r4, int ncls, int lane) {
    const int r32 = lane & 31, hi = lane >> 5;
    if (SAMPLE && ti > 0) {
        { const int idx = tile_key<SAMPLE>(ti, r32, g, r4, ncls); const float* p = C.ck + (((unsigned)(b * WINB + idx) * 8u + h) * 64u + 8 * hi);
#pragma unroll
          for (int d0 = 0; d0 < 4; ++d0) { T.k[2 * d0] = *(const GAS u32x4*)(p + 16 * d0); T.k[2 * d0 + 1] = *(const GAS u32x4*)(p + 16 * d0 + 4); } }
#pragma unroll
        for (int i = 0; i < 4; ++i) { const int key = (lane >> 3) + 8 * i; const int idx = tile_key<SAMPLE>(ti, key, g, r4, ncls);
            const float* p = C.cv + (((unsigned)(b * WINB + idx) * 8u + h) * 64u + 8 * (lane & 7)); T.v[2 * i] = *(const GAS u32x4*)p; T.v[2 * i + 1] = *(const GAS u32x4*)(p + 4); }
    } else {
        unsigned rowb;
        { int key = tile_key<SAMPLE>(ti, r32, g, r4, ncls); if (SAMPLE) { key -= WINB; key = key > 7 ? 7 : key; rowb = (unsigned)(MP + b * 8 + key); } else rowb = (unsigned)(b * SEQ + key);
          const bf16_t* p = C.KA + (rowb * 512u + h * 64 + 8 * hi);
#pragma unroll
          for (int d0 = 0; d0 < 4; ++d0) T.k[d0] = *(const GAS u32x4*)(p + 16 * d0); }
#pragma unroll
        for (int i = 0; i < 4; ++i) { int key = tile_key<SAMPLE>(ti, (lane >> 3) + 8 * i, g, r4, ncls); if (SAMPLE) { key -= WINB; key = key > 7 ? 7 : key; rowb = (unsigned)(MP + b * 8 + key); } else rowb = (unsigned)(b * SEQ + key);
            T.v[i] = *(const GAS u32x4*)(C.VA + (rowb * 512u + h * 64 + 8 * (lane & 7))); }
    }
}

template <bool SAMPLE>
__device__ __forceinline__ void attn_item(const AttnCtx& C, int b, int h, int g, int r4, LAS unsigned char* wl, int lane_in) {
    int lane = lane_in; asm volatile("" : "+v"(lane));
    const int r32 = lane & 31, hi = lane >> 5;
    LAS float* wsf = (LAS float*)(wl + 32 * VPITCH);
    const int ncls = g + 1;
    const int nt = SAMPLE ? 41 : (ncls + (g == 0 ? 4 : 8));
    bf16x8 qf[4];
    {
        unsigned qrow; if (SAMPLE) qrow = (unsigned)(MP + b * 8 + (r32 & 7)); else qrow = (unsigned)(b * SEQ + 4 * (32 * g + r32) + r4);
        const bf16_t* p = C.QA + (qrow * 512u + h * 64 + 8 * hi);
#pragma unroll
        for (int d0 = 0; d0 < 4; ++d0) qf[d0] = *(const bf16x8*)(p + 16 * d0);
    }
    float mrun = NEGF, lrun = 0.f;
    f32x16 o0 = {}, o1 = {};
    TileRegs T;
    tile_load<SAMPLE>(C, T, 0, b, h, g, r4, ncls, lane);
    const int vrd = (4 * hi + ((lane & 15) >> 2)) * VPITCH + (((lane >> 4) & 1) * 16 + (lane & 3) * 4) * 2;
    for (int ti = 0; ti < nt; ++ti) {
        bf16x8 kf[4];
        const bool f32path = SAMPLE && ti > 0;
        if (f32path) {
#pragma unroll
            for (int d0 = 0; d0 < 4; ++d0) kf[d0] = __builtin_bit_cast(bf16x8, pack8(__builtin_bit_cast(f32x4, T.k[2 * d0]), __builtin_bit_cast(f32x4, T.k[2 * d0 + 1])));
#pragma unroll
            for (int i = 0; i < 4; ++i) *(LAS u32x4*)(wl + ((lane >> 3) + 8 * i) * VPITCH + (lane & 7) * 16) = pack8(__builtin_bit_cast(f32x4, T.v[2 * i]), __builtin_bit_cast(f32x4, T.v[2 * i + 1]));
        } else {
#pragma unroll
            for (int d0 = 0; d0 < 4; ++d0) kf[d0] = __builtin_bit_cast(bf16x8, T.k[d0]);
#pragma unroll
            for (int i = 0; i < 4; ++i) *(LAS u32x4*)(wl + ((lane >> 3) + 8 * i) * VPITCH + (lane & 7) * 16) = T.v[i];
        }
        if (ti + 1 < nt) tile_load<SAMPLE>(C, T, ti + 1, b, h, g, r4, ncls, lane);
        f32x16 p = {};
#pragma unroll
        for (int d0 = 0; d0 < 4; ++d0) p = __builtin_amdgcn_mfma_f32_32x32x16_bf16(kf[d0], qf[d0], p, 0, 0, 0);
        if (SAMPLE) {
            if (ti < 17) { const int dbase = (WINB + r32) - (1536 + 32 * (16 - ti));
#pragma unroll
                for (int r = 0; r < 16; ++r) { const int d = dbase - crow(r, hi); const int mult = (d >= 0 && d <= 128) + (d >= 0 && d <= 512 && !(d & 3)) + (d >= 0 && !(d & 15));
                    p[r] = (mult == 0 || r32 >= 8) ? NEGF : p[r] + (mult == 1 ? 0.f : (mult == 2 ? 1.f : 1.5849625f)); } }
            else {
#pragma unroll
                for (int r = 0; r < 16; ++r) p[r] = ((crow(r, hi) & 7) == r32) ? p[r] : NEGF; }
        } else {
            if (ti < ncls) { const int dbase = (32 * g + r32) - 32 * (g - ti);
#pragma unroll
                for (int r = 0; r < 16; ++r) { const int d = dbase - crow(r, hi); const int mult = (d >= 0 && d <= 128) + (d >= 0 && !(d & 3));
                    p[r] = mult == 0 ? NEGF : p[r] + (mult == 2 ? 1.f : 0.f); } }
            else { const int jj = ti - ncls + (g == 0 ? 4 : 0); const int dbase = (128 * g + 4 * r32 + r4) - (128 * g - 128 + 32 * jj);
#pragma unroll
                for (int r = 0; r < 16; ++r) { const int d = dbase - crow(r, hi); p[r] = (d >= 0 && d <= 128) ? p[r] : NEGF; } }
        }
        float rm = p[0];
#pragma unroll
        for (int r = 1; r < 16; ++r) rm = fmaxf(rm, p[r]);
        rm = swapmax(rm);
        const float mnew = fmaxf(mrun, rm);
        const float f = __builtin_amdgcn_exp2f(mrun - mnew);
        mrun = mnew;
        float ls = 0.f;
#pragma unroll
        for (int r = 0; r < 16; ++r) { p[r] = __builtin_amdgcn_exp2f(p[r] - mnew); ls += p[r]; }
        lrun = lrun * f + ls;
        if (hi == 0) wsf[r32] = f;
        u32x4 pa0, pa1;
        pa0.x = cvt_pk_bf16(p[0], p[1]); pa0.y = cvt_pk_bf16(p[2], p[3]); pa0.z = cvt_pk_bf16(p[4], p[5]); pa0.w = cvt_pk_bf16(p[6], p[7]);
        pa1.x = cvt_pk_bf16(p[8], p[9]); pa1.y = cvt_pk_bf16(p[10], p[11]); pa1.z = cvt_pk_bf16(p[12], p[13]); pa1.w = cvt_pk_bf16(p[14], p[15]);
#pragma unroll
        for (int r = 0; r < 16; ++r) { const float fr_ = wsf[crow(r, hi)]; o0[r] *= fr_; o1[r] *= fr_; }
#pragma unroll
        for (int sl = 0; sl < 2; ++sl) {
            const bf16x8 pa = __builtin_bit_cast(bf16x8, sl == 0 ? pa0 : pa1);
#pragma unroll
            for (int c = 0; c < 2; ++c) {
                const s16x4 lo = vtr(wl + vrd + (16 * sl) * VPITCH + 64 * c), hi4 = vtr(wl + vrd + (16 * sl + 8) * VPITCH + 64 * c);
                const bf16x8 vf = (bf16x8){lo[0], lo[1], lo[2], lo[3], hi4[0], hi4[1], hi4[2], hi4[3]};
                if (c == 0) o0 = __builtin_amdgcn_mfma_f32_32x32x16_bf16(pa, vf, o0, 0, 0, 0); else o1 = __builtin_amdgcn_mfma_f32_32x32x16_bf16(pa, vf, o1, 0, 0, 0);
            }
        }
    }
    const float lt = swapsum(lrun);
    if (hi == 0) wsf[32 + r32] = 1.f / lt;
#pragma unroll
    for (int r = 0; r < 16; ++r) {
        const int q = crow(r, hi); const float rl = wsf[32 + q];
        unsigned orow; bool ok = true;
        if (SAMPLE) { ok = q < 8; orow = (unsigned)(MP + b * 8 + (q & 7)); } else orow = (unsigned)(b * SEQ + 4 * (32 * g + q) + r4);
        if (ok) { bf16_t* op = C.MIX + (orow * 1024u + h * 64 + r32);
            op[0] = (bf16_t)(cvt_pk_bf16(o0[r] * rl, 0.f) & 0xffffu); op[32] = (bf16_t)(cvt_pk_bf16(o1[r] * rl, 0.f) & 0xffffu); }
    }
}

struct GlaCtx { const bf16_t *QB, *KB, *VB, *RB; const float* LF; bf16_t* MIX; const float* gnorm; };
constexpr int GQ_P = 72, GT_P = 40;
constexpr int G_QE = 0, G_KE = 32 * GQ_P * 2, G_KT = G_KE + 32 * GQ_P * 2, G_EB = G_KT + 64 * GT_P * 2, G_BUF = G_EB + 256;
constexpr int GL_V = 2 * G_BUF;
constexpr int GL_O = GL_V + 2 * 4 * 2048;
constexpr int GL_END = GL_O + 2 * 4 * 4608;
static_assert(GL_END <= 131072, "gla lds");
#define LDS_BARRIER() do { asm volatile("s_waitcnt lgkmcnt(0)" ::: "memory"); __builtin_amdgcn_s_barrier(); asm volatile("" ::: "memory"); } while (0)
typedef float f32x8 __attribute__((ext_vector_type(8)));
typedef unsigned u32x8 __attribute__((ext_vector_type(8)));
typedef unsigned u32x16 __attribute__((ext_vector_type(16)));
struct GlaPre { f32x8 lf; u32x8 q, k; u32x4 v0, v1; };

template <int nvalid> __device__ __forceinline__ void gla_h_loads(const GlaCtx& C, GlaPre& P, unsigned t0, int h, int dk, int tg, int dvs, int lane) {
    const bool ok = 8 * tg < nvalid;
    const unsigned off = (t0 + (ok ? 8 * tg : 0)) * 256u + h * 64 + dk;
    const GAS float* lp = (const GAS float*)(C.LF + off); const GAS bf16_t* qp = (const GAS bf16_t*)(C.QB + off); const GAS bf16_t* kp = (const GAS bf16_t*)(C.KB + off);
#pragma unroll
    for (int e = 0; e < 8; ++e) { P.lf[e] = lp[e * 256]; P.q[e] = (unsigned)qp[e * 256]; P.k[e] = (unsigned)kp[e * 256]; }
    const int i = lane >> 1; const bool okv = i < nvalid; const GAS bf16_t* p = (const GAS bf16_t*)(C.VB + ((t0 + (okv ? i : 0)) * 512u + h * 128 + 32 * dvs + 16 * (lane & 1)));
    P.v0 = *(const GAS u32x4*)p; P.v1 = *(const GAS u32x4*)(p + 8);
}
struct GlaGate { u32x4 g0, g1; };
template <int nvalid> __device__ __forceinline__ void gla_h_interval(const GlaCtx& C, LAS unsigned char* lds, GlaPre& P, GlaGate& G, const f32x4 (&gn)[4], int j, int nchunk, int hw, int lane, unsigned row0, int h) {
    const int tg = lane >> 4, dkl = lane & 15, dk = 16 * hw + dkl;
    const int ft = lane >> 3, dvg = lane & 7;
    const bool fin_ok = 8 * hw < nvalid;
    if (j >= 2 && fin_ok) {
        const int c = j - 2; const int ob = c & 1;
        const LAS float* op = (const LAS float*)(lds + GL_O + (ob * 4 + (dvg >> 1)) * 4608) + (8 * hw + ft) * 36 + 16 * (dvg & 1);
        f32x4 o[4]; float s = 0.f;
#pragma unroll
        for (int k4 = 0; k4 < 4; ++k4) { o[k4] = *(const LAS f32x4*)(op + 4 * k4); s += (o[k4].x * o[k4].x + o[k4].y * o[k4].y) + (o[k4].z * o[k4].z + o[k4].w * o[k4].w); }
        s += __shfl_xor(s, 1); s += __shfl_xor(s, 2); s += __shfl_xor(s, 4);
        const float rs = rsqrtf(s * (1.f / 128.f) + EPS);
        const u32x4 g0 = G.g0, g1 = G.g1;
        float gt[16];
        gt[0] = __uint_as_float(g0.x << 16); gt[1] = __uint_as_float(g0.x & 0xffff0000u); gt[2] = __uint_as_float(g0.y << 16); gt[3] = __uint_as_float(g0.y & 0xffff0000u);
        gt[4] = __uint_as_float(g0.z << 16); gt[5] = __uint_as_float(g0.z & 0xffff0000u); gt[6] = __uint_as_float(g0.w << 16); gt[7] = __uint_as_float(g0.w & 0xffff0000u);
        gt[8] = __uint_as_float(g1.x << 16); gt[9] = __uint_as_float(g1.x & 0xffff0000u); gt[10] = __uint_as_float(g1.y << 16); gt[11] = __uint_as_float(g1.y & 0xffff0000u);
        gt[12] = __uint_as_float(g1.z << 16); gt[13] = __uint_as_float(g1.z & 0xffff0000u); gt[14] = __uint_as_float(g1.w << 16); gt[15] = __uint_as_float(g1.w & 0xffff0000u);
        float val[16];
#pragma unroll
        for (int k = 0; k < 16; ++k) { const float rg = gt[k]; val[k] = o[k >> 2][k & 3] * rs * gn[k >> 2][k & 3] * rg * __builtin_amdgcn_rcpf(1.f + __expf(-rg)); }
        u32x4 w0, w1;
        w0.x = cvt_pk_bf16(val[0], val[1]); w0.y = cvt_pk_bf16(val[2], val[3]); w0.z = cvt_pk_bf16(val[4], val[5]); w0.w = cvt_pk_bf16(val[6], val[7]);
        w1.x = cvt_pk_bf16(val[8], val[9]); w1.y = cvt_pk_bf16(val[10], val[11]); w1.z = cvt_pk_bf16(val[12], val[13]); w1.w = cvt_pk_bf16(val[14], val[15]);
        bf16_t* mp = C.MIX + ((row0 + 32u * c + 8 * hw + ft) * 1024u + 512 + h * 128 + 16 * dvg);
        *(GAS u32x4*)mp = w0; *(GAS u32x4*)(mp + 8) = w1;
    }
    if (j < nchunk) {
        const int buf = j & 1;
        LAS unsigned char* sh = lds + buf * G_BUF;
        LAS bf16_t* qe_l = (LAS bf16_t*)(sh + G_QE); LAS bf16_t* ke_l = (LAS bf16_t*)(sh + G_KE); LAS bf16_t* kt_l = (LAS bf16_t*)(sh + G_KT); LAS float* eb_l = (LAS float*)(sh + G_EB);
        LAS unsigned char* vl = lds + GL_V + (buf * 4 + hw) * 2048;
        const bool okp = 8 * tg < nvalid, okv = (lane >> 1) < nvalid;
        if (!okp) { P.lf = (f32x8){0.f, 0.f, 0.f, 0.f, 0.f, 0.f, 0.f, 0.f}; P.q = (u32x8){0u, 0u, 0u, 0u, 0u, 0u, 0u, 0u}; P.k = P.q; }
        if (!okv) { P.v0 = (u32x4){0u, 0u, 0u, 0u}; P.v1 = P.v0; }
        f32x8 cs; float run = 0.f;
#pragma unroll
        for (int e = 0; e < 8; ++e) { run += P.lf[e]; cs[e] = run; }
        float offs = 0.f, tot = 0.f;
#pragma unroll
        for (int t = 0; t < 4; ++t) { const float Tt = __shfl(run, dkl + 16 * t); tot += Tt; offs += (t < tg) ? Tt : 0.f; }
        u32x8 kb;
#pragma unroll
        for (int e = 0; e < 8; ++e) { const float bb = offs + cs[e]; const float eb = __expf(bb), ei = __expf(-bb); const int i = 8 * tg + e;
            qe_l[i * GQ_P + dk] = (bf16_t)(cvt_pk_bf16(__uint_as_float(P.q[e] << 16) * 0.125f * eb, 0.f) & 0xffffu);
            kb[e] = cvt_pk_bf16(__uint_as_float(P.k[e] << 16) * ei, 0.f) & 0xffffu;
            ke_l[i * GQ_P + dk] = (bf16_t)kb[e]; }
        u32x4 w; w.x = kb[0] | (kb[1] << 16); w.y = kb[2] | (kb[3] << 16); w.z = kb[4] | (kb[5] << 16); w.w = kb[6] | (kb[7] << 16);
        *(LAS u32x4*)(kt_l + dk * GT_P + 8 * tg) = w;
        if (tg == 0) eb_l[dk] = __expf(tot);
        *(LAS u32x4*)(vl + (lane >> 1) * 64 + (lane & 1) * 32) = P.v0; *(LAS u32x4*)(vl + (lane >> 1) * 64 + (lane & 1) * 32 + 16) = P.v1;
    }
    if (j + 3 < nchunk) gla_h_loads<nvalid>(C, P, row0 + 32u * (j + 3), h, dk, tg, hw, lane);
    if (j + 1 < nchunk && fin_ok) { const bf16_t* rp = C.RB + ((row0 + 32u * (j + 1) + 8 * hw + ft) * 512u + h * 128 + 16 * dvg); G.g0 = *(const GAS u32x4*)rp; G.g1 = *(const GAS u32x4*)(rp + 8); }
    if (j <= nchunk) LDS_BARRIER();
}
template <int nvalid> __device__ __forceinline__ void gla_h_wave(const GlaCtx& C, LAS unsigned char* lds, int hw  , int lane, unsigned row0, int h, int nchunk) {
    const int tg = lane >> 4, dkl = lane & 15, dk = 16 * hw + dkl;
    const int ft = lane >> 3, dvg = lane & 7;
    f32x4 gn[4];
#pragma unroll
    for (int k4 = 0; k4 < 4; ++k4) gn[k4] = *(const f32x4*)(C.gnorm + h * 128 + 16 * dvg + 4 * k4);
    GlaPre P0, P1, P2; GlaGate G0 = {}, G1 = {}, G2 = {};
    gla_h_loads<nvalid>(C, P0, row0, h, dk, tg, hw, lane);
    if (1 < nchunk) gla_h_loads<nvalid>(C, P1, row0 + 32u, h, dk, tg, hw, lane);
    if (2 < nchunk) gla_h_loads<nvalid>(C, P2, row0 + 64u, h, dk, tg, hw, lane);
    if (8 * hw < nvalid) { const bf16_t* rp = C.RB + ((row0 + 8 * hw + ft) * 512u + h * 128 + 16 * dvg); G0.g0 = *(const GAS u32x4*)rp; G0.g1 = *(const GAS u32x4*)(rp + 8); }
    for (int j = 0; j <= nchunk + 1; j += 3) {
        gla_h_interval<nvalid>(C, lds, P0, G1, gn, j, nchunk, hw, lane, row0, h);
        if (j + 1 <= nchunk + 1) gla_h_interval<nvalid>(C, lds, P1, G2, gn, j + 1, nchunk, hw, lane, row0, h);
        if (j + 2 <= nchunk + 1) gla_h_interval<nvalid>(C, lds, P2, G0, gn, j + 2, nchunk, hw, lane, row0, h);
    }
}
template <int nvalid> __device__ __forceinline__ void gla_m_wave(LAS unsigned char* lds, int dvs, int lane, int nchunk, const float* s_in, float* s_out) {
    const int r32 = lane & 31, hi = lane >> 5;
    f32x16 S0 = {}, S1 = {};
    unsigned soff = (unsigned)(4 * hi * 128 + 32 * dvs + r32); asm volatile("" : "+v"(soff));
    if (s_in) {
#pragma unroll
        for (int r = 0; r < 16; ++r) { const unsigned o_ = soff + (unsigned)(((r & 3) + 8 * (r >> 2)) * 128); S0[r] = s_in[o_]; S1[r] = s_in[o_ + 4096u]; }
    }
    const int vrd = (4 * hi + ((lane & 15) >> 2)) * 64 + (((lane >> 4) & 1) * 16 + (lane & 3) * 4) * 2;
    LDS_BARRIER();
    for (int c = 0; c < nchunk; ++c) {
        const int buf = c & 1;
        LAS unsigned char* sh = lds + buf * G_BUF;
        LAS bf16_t* qe_l = (LAS bf16_t*)(sh + G_QE); LAS bf16_t* ke_l = (LAS bf16_t*)(sh + G_KE); LAS bf16_t* kt_l = (LAS bf16_t*)(sh + G_KT); LAS float* eb_l = (LAS float*)(sh + G_EB);
        const LAS unsigned char* vl = lds + GL_V + (buf * 4 + dvs) * 2048;
        f32x16 at = {};
#pragma unroll
        for (int s = 0; s < 4; ++s) { const bf16x8 a = *(const LAS bf16x8*)(ke_l + r32 * GQ_P + 16 * s + 8 * hi), bq = *(const LAS bf16x8*)(qe_l + r32 * GQ_P + 16 * s + 8 * hi);
            at = __builtin_amdgcn_mfma_f32_32x32x16_bf16(a, bq, at, 0, 0, 0); }
#pragma unroll
        for (int r = 0; r < 16; ++r) at[r] = (crow(r, hi) <= r32) ? at[r] : 0.f;
        u32x4 pa0, pa1;
        pa0.x = cvt_pk_bf16(at[0], at[1]); pa0.y = cvt_pk_bf16(at[2], at[3]); pa0.z = cvt_pk_bf16(at[4], at[5]); pa0.w = cvt_pk_bf16(at[6], at[7]);
        pa1.x = cvt_pk_bf16(at[8], at[9]); pa1.y = cvt_pk_bf16(at[10], at[11]); pa1.z = cvt_pk_bf16(at[12], at[13]); pa1.w = cvt_pk_bf16(at[14], at[15]);
        bf16x8 vf0, vf1;
        { const s16x4 lo = vtr(vl + vrd), h4 = vtr(vl + vrd + 8 * 64); vf0 = (bf16x8){lo[0], lo[1], lo[2], lo[3], h4[0], h4[1], h4[2], h4[3]}; }
        { const s16x4 lo = vtr(vl + vrd + 16 * 64), h4 = vtr(vl + vrd + 24 * 64); vf1 = (bf16x8){lo[0], lo[1], lo[2], lo[3], h4[0], h4[1], h4[2], h4[3]}; }
        f32x16 o = {};
        o = __builtin_amdgcn_mfma_f32_32x32x16_bf16(__builtin_bit_cast(bf16x8, pa0), vf0, o, 0, 0, 0);
        o = __builtin_amdgcn_mfma_f32_32x32x16_bf16(__builtin_bit_cast(bf16x8, pa1), vf1, o, 0, 0, 0);
#pragma unroll
        for (int s = 0; s < 4; ++s) {
            const u32x2 q0 = *(const LAS u32x2*)(qe_l + r32 * GQ_P + 16 * s + 4 * hi), q1 = *(const LAS u32x2*)(qe_l + r32 * GQ_P + 16 * s + 8 + 4 * hi);
            const u32x4 qa = (u32x4){q0.x, q0.y, q1.x, q1.y};
            u32x4 sb;
            if (s == 0) { sb.x = cvt_pk_bf16(S0[0], S0[1]); sb.y = cvt_pk_bf16(S0[2], S0[3]); sb.z = cvt_pk_bf16(S0[4], S0[5]); sb.w = cvt_pk_bf16(S0[6], S0[7]); }
            else if (s == 1) { sb.x = cvt_pk_bf16(S0[8], S0[9]); sb.y = cvt_pk_bf16(S0[10], S0[11]); sb.z = cvt_pk_bf16(S0[12], S0[13]); sb.w = cvt_pk_bf16(S0[14], S0[15]); }
            else if (s == 2) { sb.x = cvt_pk_bf16(S1[0], S1[1]); sb.y = cvt_pk_bf16(S1[2], S1[3]); sb.z = cvt_pk_bf16(S1[4], S1[5]); sb.w = cvt_pk_bf16(S1[6], S1[7]); }
            else { sb.x = cvt_pk_bf16(S1[8], S1[9]); sb.y = cvt_pk_bf16(S1[10], S1[11]); sb.z = cvt_pk_bf16(S1[12], S1[13]); sb.w = cvt_pk_bf16(S1[14], S1[15]); }
            o = __builtin_amdgcn_mfma_f32_32x32x16_bf16(__builtin_bit_cast(bf16x8, qa), __builtin_bit_cast(bf16x8, sb), o, 0, 0, 0);
        }
        { LAS float* ol = (LAS float*)(lds + GL_O + (buf * 4 + dvs) * 4608);
#pragma unroll
          for (int r = 0; r < 16; ++r) ol[crow(r, hi) * 36 + r32] = o[r]; }
        {
            const u32x2 a0 = *(const LAS u32x2*)(kt_l + r32 * GT_P + 4 * hi), a1 = *(const LAS u32x2*)(kt_l + r32 * GT_P + 8 + 4 * hi);
            const u32x2 c0 = *(const LAS u32x2*)(kt_l + (32 + r32) * GT_P + 4 * hi), c1 = *(const LAS u32x2*)(kt_l + (32 + r32) * GT_P + 8 + 4 * hi);
            S0 = __builtin_amdgcn_mfma_f32_32x32x16_bf16(__builtin_bit_cast(bf16x8, (u32x4){a0.x, a0.y, a1.x, a1.y}), vf0, S0, 0, 0, 0);
            S1 = __builtin_amdgcn_mfma_f32_32x32x16_bf16(__builtin_bit_cast(bf16x8, (u32x4){c0.x, c0.y, c1.x, c1.y}), vf0, S1, 0, 0, 0);
        }
        {
            const u32x2 a0 = *(const LAS u32x2*)(kt_l + r32 * GT_P + 16 + 4 * hi), a1 = *(const LAS u32x2*)(kt_l + r32 * GT_P + 24 + 4 * hi);
            const u32x2 c0 = *(const LAS u32x2*)(kt_l + (32 + r32) * GT_P + 16 + 4 * hi), c1 = *(const LAS u32x2*)(kt_l + (32 + r32) * GT_P + 24 + 4 * hi);
            S0 = __builtin_amdgcn_mfma_f32_32x32x16_bf16(__builtin_bit_cast(bf16x8, (u32x4){a0.x, a0.y, a1.x, a1.y}), vf1, S0, 0, 0, 0);
            S1 = __builtin_amdgcn_mfma_f32_32x32x16_bf16(__builtin_bit_cast(bf16x8, (u32x4){c0.x, c0.y, c1.x, c1.y}), vf1, S1, 0, 0, 0);
        }
#pragma unroll
        for (int r = 0; r < 16; ++r) { S0[r] *= eb_l[crow(r, hi)]; S1[r] *= eb_l[32 + crow(r, hi)]; }
        LDS_BARRIER();
    }
    if (s_out) {
        unsigned soff2 = (unsigned)(4 * hi * 128 + 32 * dvs + r32); asm volatile("" : "+v"(soff2));
#pragma unroll
        for (int r = 0; r < 16; ++r) { const unsigned o_ = soff2 + (unsigned)(((r & 3) + 8 * (r >> 2)) * 128); s_out[o_] = S0[r]; s_out[o_ + 4096u] = S1[r]; }
    }
}

#define XB_TMO      128
#define XB_XCNT(j)  (256  + 64 * (j))
#define XB_XSUB(j)  (1280 + 64 * (j))
#define XB_XGEN(j)  (2304 + 64 * (j))
#define XB_TOP      3328
#define XB_TOPGEN   3392
#define XCD_BAR_WORDS 3456
#define XB_SPIN_CAP (1u << 18)
__device__ __forceinline__ unsigned xb_ld(unsigned* p)              { return __hip_atomic_load(p, __ATOMIC_RELAXED, __HIP_MEMORY_SCOPE_AGENT); }
__device__ __forceinline__ unsigned xb_add(unsigned* p, unsigned v) { return __hip_atomic_fetch_add(p, v, __ATOMIC_RELAXED, __HIP_MEMORY_SCOPE_AGENT); }
__device__ __forceinline__ unsigned xb_xcc_id() { return (unsigned)__builtin_amdgcn_s_getreg((3 << 11) | 20) & 0xFu; }
#define XB_SPIN(cond, bar) do { unsigned _sp = 0; while (cond) { __builtin_amdgcn_s_sleep(1); \
    if ((++_sp & 255u) == 0u) { if (xb_ld(&(bar)[XB_TMO])) break; if (_sp > XB_SPIN_CAP) { atomicAdd(&(bar)[XB_TMO], 1u); break; } } } } while (0)
struct XcdBarrier { unsigned* bar; unsigned x; volatile LAS unsigned* st; };
__device__ __forceinline__ XcdBarrier xcd_barrier_post(unsigned* bar, volatile LAS unsigned* st) {
    XcdBarrier b; b.bar = bar; b.x = xb_xcc_id(); b.st = st;
    if (threadIdx.x == 0) (void)xb_add(&bar[XB_XCNT(b.x)], 1u);
    return b;
}
__device__ __forceinline__ void xcd_barrier_complete(unsigned* bar, unsigned x, unsigned& nloc, unsigned& nx) {
    const unsigned G = gridDim.x * gridDim.y * gridDim.z;
    unsigned sum, cnt, mine, sp = 0u;
    for (;;) {
        sum = 0u; cnt = 0u; mine = 0u;
#pragma unroll
        for (unsigned j = 0; j < 16; ++j) { const unsigned c = xb_ld(&bar[XB_XCNT(j)]); sum += c; cnt += (c > 0u) ? 1u : 0u; mine = (j == x) ? c : mine; }
        if (sum == G) break;
        __builtin_amdgcn_s_sleep(1);
        if ((++sp & 255u) == 0u) { if (xb_ld(&bar[XB_TMO])) break; if (sp > XB_SPIN_CAP) { atomicAdd(&bar[XB_TMO], 1u); break; } }
    }
    nloc = mine > 0u ? mine : 1u; nx = cnt > 0u ? cnt : 1u;
}
__device__ __forceinline__ void xcd_barrier(const XcdBarrier& b, int wave0) {
    asm volatile("s_waitcnt vmcnt(0)" ::: "memory");
    __syncthreads();
    if (wave0 == 0 && lane_id_v() == 0) {
        unsigned* bar = b.bar;
        __builtin_amdgcn_s_waitcnt(0);
        unsigned nloc = b.st[0], nx = b.st[1];
        if (nloc == 0u) { xcd_barrier_complete(bar, b.x, nloc, nx); b.st[0] = nloc; b.st[1] = nx; }
        const unsigned old = xb_add(&bar[XB_XSUB(b.x)], 1u);
        const unsigned gen = old / nloc;
        if (old + 1u == (gen + 1u) * nloc) {
            __builtin_amdgcn_fence(__ATOMIC_RELEASE, "agent");
            asm volatile("s_waitcnt vmcnt(0)" ::: "memory");
            const unsigned og = xb_add(&bar[XB_TOP], 1u);
            const unsigned tg = og / nx;
            if (og + 1u == (tg + 1u) * nx) xb_add(&bar[XB_TOPGEN], 1u);
            else XB_SPIN(xb_ld(&bar[XB_TOPGEN]) == tg, bar);
            __builtin_amdgcn_fence(__ATOMIC_ACQUIRE, "agent");
            xb_add(&bar[XB_XGEN(b.x)], 1u);
            asm volatile("s_waitcnt vmcnt(0)" ::: "memory");
        } else {
            XB_SPIN(xb_ld(&bar[XB_XGEN(b.x)]) == gen, bar);
            __builtin_amdgcn_fence(__ATOMIC_ACQUIRE, "agent");
            asm volatile("s_waitcnt vmcnt(0)" ::: "memory");
        }
    }
    __syncthreads();
}

constexpr int LDS_BYTES = 147456;

__global__ void __launch_bounds__(512, 2) hymba_fwd(Args args) {
    extern __shared__ __attribute__((aligned(16))) unsigned char lds_raw[];
    LAS unsigned char* lds = (LAS unsigned char*)lds_raw;
#define PHASE_IDS() const int lane = lane_id_v(); const int wave = wave0; (void)lane; (void)wave
    const int G = gridDim.x, bx = blockIdx.x;
    const int wave0 = __builtin_amdgcn_readfirstlane((int)(threadIdx.x >> 6));
    if (threadIdx.x < 4) ((LAS unsigned*)(lds + XBST_OFF))[threadIdx.x] = 0u;
    __syncthreads();
    const XcdBarrier xbar = xcd_barrier_post((unsigned*)(args.ws + WS_CTL) + 4096, (volatile LAS unsigned*)(lds + XBST_OFF));
    const int vcu = (G % 8 == 0) ? (bx % 8) * (G / 8) + bx / 8 : bx;
    const float* x_prompt = args.in[0]; const float* x_sample = args.in[1];
    const float* w_in = args.in[6]; const float* w_a2 = args.in[7]; const float* b_a = args.in[8];
    const float* w_o = args.in[10]; const float* g_pre_mix = args.in[11];
    const float* w_up = args.in[15]; const float* w_down = args.in[18];
#define PHASE_WS() unsigned char* ws = args.ws; asm volatile("" : "+s"(ws))

    {
        PHASE_IDS(); PHASE_WS();
        bf16_t* WinT = (bf16_t*)(ws + WS_WIN); bf16_t* WoT = (bf16_t*)(ws + WS_WO); bf16_t* WupT = (bf16_t*)(ws + WS_WUP); bf16_t* WdT = (bf16_t*)(ws + WS_WD); bf16_t* XN = (bf16_t*)(ws + WS_XN + 4096);
        LAS float* scr = (LAS float*)(lds + wave * 16384);
        const int gw = vcu * 8 + wave, NGW = G * 8;
        constexpr int I_IN = 16 * 96, I_G = 16 * 8, I_O = 16 * 32, I_UP = 16 * 176, I_D = 44 * 32;
        constexpr int NITEMS = I_IN + I_G + I_O + I_UP + I_D;
        for (int it = gw; it < NITEMS; it += NGW) {
            int r = it;
            if (r < I_IN) { const int kb = r / 96, nb = r % 96; p0_transpose_item(w_in, DIN, 32 * nb, 64 * kb, WinT, 1024, 32 * nb, scr, lane); continue; } r -= I_IN;
            if (r < I_G) { const int kb = r / 8, nb = r % 8; p0_gate_item(w_in, w_a2, 64 * kb, 32 * nb, WinT, scr, lane); continue; } r -= I_G;
            if (r < I_O) { const int kb = r / 32, nb = r % 32; p0_transpose_item(w_o, 1024, 32 * nb, 64 * kb, WoT, 1024, 32 * nb, scr, lane); continue; } r -= I_O;
            if (r < I_UP) { const int kb = r / 176, nb = r % 176; const int n0 = 32 * nb, t = n0 >> 8, w = n0 & 255;
                const int sc = (w < 128) ? (128 * t + w) : (DFF + 128 * t + (w - 128));
                p0_transpose_item(w_up, 2 * DFF, sc, 64 * kb, WupT, 1024, n0, scr, lane); continue; } r -= I_UP;
            { const int kb = r / 32, nb = r % 32; p0_transpose_item(w_down, 1024, 32 * nb, 64 * kb, WdT, DFF, 32 * nb, scr, lane); }
        }
        for (int m = gw; m < MT; m += NGW) {
            const float* xr = (m < MP) ? x_prompt + (size_t)m * DM : x_sample + (size_t)(m - MP) * DM;
            rms_row_to_bf16(xr, g_pre_mix, XN + (size_t)m * DM, lane);
        }
    }
    xcd_barrier(xbar, wave0);

    {
        PHASE_WS();
        pg8::Gemm g{(bf16_t*)(ws + WS_XN + 4096), (bf16_t*)(ws + WS_WIN), 1024, 256, 1024}; pg8::StaticOrder S; S.init(MT / 256, NIN / 256, G, bx);
        EpiInProj E{(bf16_t*)(ws + WS_QA), (bf16_t*)(ws + WS_KA), (bf16_t*)(ws + WS_VA), (bf16_t*)(ws + WS_QB), (bf16_t*)(ws + WS_KB), (bf16_t*)(ws + WS_VB), (bf16_t*)(ws + WS_RB),
                    (float*)(ws + WS_LF), args.out, b_a};
        pg8::gemm_phase<EpiInProj, pg8::StaticOrder>(lds, g, S, E, wave0);
    }
    xcd_barrier(xbar, wave0);

    {
        PHASE_IDS(); PHASE_WS();
        bf16_t* MIX = (bf16_t*)(ws + WS_MIX);
        GlaCtx GC{(const bf16_t*)(ws + WS_QB), (const bf16_t*)(ws + WS_KB), (const bf16_t*)(ws + WS_VB), (const bf16_t*)(ws + WS_RB), (const float*)(ws + WS_LF), MIX, args.in[9]};
        const float* state_gla = args.in[4];
#ifndef NO_GLA
        for (int it = bx; it < 64 + 128; it += G) {
            const bool pr = it < 64; const int seq = pr ? it : it - 64; const int b = seq >> 2, h = seq & 3;
            const size_t row0 = pr ? (size_t)b * SEQ : (size_t)MP + (size_t)b * 8;
            const float* s_in = pr ? nullptr : state_gla + (size_t)seq * 8192;
            float* s_out = args.out + (pr ? O_GP : O_GS) + (size_t)seq * 8192;
            const int nchunk = pr ? SEQ / 32 : 1;
            if (wave < 4) { if (pr) gla_m_wave<32>(lds, wave, lane, nchunk, s_in, s_out); else gla_m_wave<8>(lds, wave, lane, nchunk, s_in, s_out); }
            else { if (pr) gla_h_wave<32>(GC, lds, wave - 4, lane, (unsigned)row0, h, nchunk); else gla_h_wave<8>(GC, lds, wave - 4, lane, (unsigned)row0, h, nchunk); }
            __syncthreads();
        }
#endif
        AttnCtx AC{(const bf16_t*)(ws + WS_QA), (const bf16_t*)(ws + WS_KA), (const bf16_t*)(ws + WS_VA), MIX, args.in[2], args.in[3]};
        unsigned* counter = (unsigned*)(ws + WS_CTL);
        LAS unsigned char* wl = lds + wave * 8192;
        const int lane2 = lane_id_v();
        for (int sb = (bx + 64) % G; sb < NSB; sb += G) attn_item<true>(AC, sb, wave, 0, 0, wl, lane2);
        const unsigned xq0 = xb_xcc_id() & 7u;
        for (unsigned kq = 0; kq < 8u; ++kq) {
            const unsigned xq = (xq0 + kq) & 7u;
            unsigned* head = counter + 64 * xq;
            for (;;) {
                unsigned loc = 0; if (lane2 == 0) loc = atomicAdd(head, 1u);
                loc = (unsigned)__builtin_amdgcn_readfirstlane((int)loc);
                if (loc >= 1024u) break;
                { const unsigned p = loc; const unsigned grp = p >> 8, q = p & 255u; const int g = 15 - (int)(q >> 4); const unsigned bhl = (q >> 2) & 3u; const int r4 = (int)(q & 3u);
                    const int bh = (int)(xq + 8u * (4u * grp + bhl));
                    attn_item<false>(AC, bh >> 3, bh & 7, g, r4, wl, lane2); }
            }
        }
    }
    xcd_barrier(xbar, wave0);

    {
        PHASE_WS();
        bf16_t* MO = (bf16_t*)(ws + WS_MO); float* SSQ1 = (float*)(ws + WS_SSQ1);
        pg8::Gemm g{(bf16_t*)(ws + WS_MIX), (bf16_t*)(ws + WS_WO), 1024, 256, 1024}; pg8::StaticOrder S; S.init(MP / 256, 4, G, bx);
        EpiRowOut E{MO, SSQ1};
        pg8::gemm_phase<EpiRowOut, pg8::StaticOrder>(lds, g, S, E, wave0);
        pg8::Gemm g2{(bf16_t*)(ws + WS_MIX), (bf16_t*)(ws + WS_WO), 256, 256, 1024}; pg8::SplitOrder S2{16, G, bx, 128, 256};
        EpiSlice E2{(float*)(ws + WS_ACC1), 256};
        pg8::gemm_phase<EpiSlice, pg8::SplitOrder>(lds, g2, S2, E2, wave0);
    }
    xcd_barrier(xbar, wave0);
    {
        PHASE_IDS(); PHASE_WS();
        bf16_t* MO = (bf16_t*)(ws + WS_MO); float* SSQ1 = (float*)(ws + WS_SSQ1); bf16_t* XN = (bf16_t*)(ws + WS_XN + 4096);
        const float* g_post = args.in[12]; const float* g_pre = args.in[13];
        const int gw = vcu * 8 + wave, NGW = G * 8;
        {
            f32x4 gp4[4], gq4[4];
#pragma unroll
            for (int j = 0; j < 4; ++j) { gp4[j] = ((const GAS f32x4*)g_post)[64 * j + lane]; gq4[j] = ((const GAS f32x4*)g_pre)[64 * j + lane]; }
            for (int m0 = gw; m0 < MP; m0 += 2 * NGW) {
                const int m1 = (m0 + NGW < MP) ? m0 + NGW : m0;
                f32x4 sp[2], xv[2][4]; u32x2 mw[2][4];
#pragma unroll
                for (int r = 0; r < 2; ++r) { const int m = r ? m1 : m0; sp[r] = *((const GAS f32x4*)(SSQ1 + (size_t)m * 16) + (lane & 3));
#pragma unroll
                    for (int j = 0; j < 4; ++j) { xv[r][j] = __builtin_nontemporal_load((const GAS f32x4*)(x_prompt + (size_t)m * DM) + 64 * j + lane); mw[r][j] = ((const GAS u32x2*)(MO + (size_t)m * DM))[64 * j + lane]; } }
#pragma unroll
                for (int r = 0; r < 2; ++r) if (r == 0 || m1 != m0) { const int m = r ? m1 : m0;
                    float ss = (sp[r].x + sp[r].y) + (sp[r].z + sp[r].w); ss += __shfl_xor(ss, 1); ss += __shfl_xor(ss, 2);
                    const float rs = rsqrtf(ss * (1.f / DM) + EPS);
                    f32x4 x1[4]; float s2 = 0.f;
#pragma unroll
                    for (int j = 0; j < 4; ++j) { f32x4 mv; mv.x = __uint_as_float(mw[r][j].x << 16); mv.y = __uint_as_float(mw[r][j].x & 0xffff0000u); mv.z = __uint_as_float(mw[r][j].y << 16); mv.w = __uint_as_float(mw[r][j].y & 0xffff0000u);
                        x1[j] = xv[r][j] + mv * rs * gp4[j]; s2 += (x1[j].x * x1[j].x + x1[j].y * x1[j].y) + (x1[j].z * x1[j].z + x1[j].w * x1[j].w);
                        }
                    const float rs2 = rsqrtf(wave_sum(s2) * (1.f / DM) + EPS);
#pragma unroll
                    for (int j = 0; j < 4; ++j) { const f32x4 y = x1[j] * rs2 * gq4[j]; u32x2 w; w.x = pk2(y.x, y.y); w.y = pk2(y.z, y.w); ((GAS u32x2*)(XN + (size_t)m * DM))[64 * j + lane] = w; }
                }
            }
        }
        for (int m = MP + gw; m < MT; m += NGW) {
            const float* xr = (m < MP) ? x_prompt + (size_t)m * DM : x_sample + (size_t)(m - MP) * DM;
            float* orow = args.out + (size_t)m * DM;
            f32x4 mvv[4]; float ss;
            if (m < MP) {
                const f32x4 sp = *((const f32x4*)(SSQ1 + (size_t)m * 16) + (lane & 3));
                ss = (sp.x + sp.y) + (sp.z + sp.w); ss += __shfl_xor(ss, 1); ss += __shfl_xor(ss, 2);
#pragma unroll
                for (int j = 0; j < 4; ++j) { const u32x2 mw = ((const u32x2*)(MO + (size_t)m * DM))[64 * j + lane];
                    mvv[j].x = __uint_as_float(mw.x << 16); mvv[j].y = __uint_as_float(mw.x & 0xffff0000u); mvv[j].z = __uint_as_float(mw.y << 16); mvv[j].w = __uint_as_float(mw.y & 0xffff0000u); }
            } else {
                const f32x4* ar = (const f32x4*)(ws + WS_ACC1) + (size_t)(m - MP) * 256; float s = 0.f;
#pragma unroll
                for (int j = 0; j < 4; ++j) { f32x4 a = ar[64 * j + lane];
                    for (int sl = 1; sl < 4; ++sl) a += ar[(size_t)sl * 65536 + 64 * j + lane];
                    mvv[j] = a; s += (a.x * a.x + a.y * a.y) + (a.z * a.z + a.w * a.w); }
                ss = wave_sum(s);
            }
            const float rs = rsqrtf(ss * (1.f / DM) + EPS);
            f32x4 x1[4]; float s2 = 0.f;
#pragma unroll
            for (int j = 0; j < 4; ++j) { const int c4 = 64 * j + lane; const f32x4 xv = ((const f32x4*)xr)[c4]; const f32x4 gp = ((const f32x4*)g_post)[c4];
                const f32x4 mv = mvv[j];
                x1[j] = xv + mv * rs * gp; s2 += (x1[j].x * x1[j].x + x1[j].y * x1[j].y) + (x1[j].z * x1[j].z + x1[j].w * x1[j].w);
                ((f32x4*)orow)[c4] = x1[j]; }
            const float rs2 = rsqrtf(wave_sum(s2) * (1.f / DM) + EPS);
#pragma unroll
            for (int j = 0; j < 4; ++j) { const int c4 = 64 * j + lane; const f32x4 gq = ((const f32x4*)g_pre)[c4]; const f32x4 y = x1[j] * rs2 * gq; u32x2 w; w.x = pk2(y.x, y.y); w.y = pk2(y.z, y.w); ((u32x2*)(XN + (size_t)m * DM))[c4] = w; }
        }
    }
    xcd_barrier(xbar, wave0);
    {
        PHASE_WS();
        bf16_t* Hb = (bf16_t*)(ws + WS_H);
        pg8::Gemm g{(bf16_t*)(ws + WS_XN + 4096) - 2 * DM, (bf16_t*)(ws + WS_WUP), 1024, 254, 1024}; pg8::StaticOrder S; S.init(131, 22, G, bx);
        EpiUp E{Hb, args.out, args.in[16], args.in[17], args.in[5], lds};
        pg8::gemm_phase<EpiUp, pg8::StaticOrder>(lds, g, S, E, wave0);
    }
    xcd_barrier(xbar, wave0);
    {
        PHASE_WS();
        bf16_t* MO = (bf16_t*)(ws + WS_XN + 4096); float* SSQ2 = (float*)(ws + WS_SSQ2);
        pg8::Gemm g{(bf16_t*)(ws + WS_H), (bf16_t*)(ws + WS_WD), DFF, 256, DFF}; pg8::StaticOrder S; S.init(MP / 256, 4, G, bx);
        EpiRowOut E{MO, SSQ2};
        pg8::gemm_phase<EpiRowOut, pg8::StaticOrder>(lds, g, S, E, wave0);
        pg8::Gemm g2{(bf16_t*)(ws + WS_H), (bf16_t*)(ws + WS_WD), 256, 256, DFF}; pg8::SplitOrder S2{44, G, bx, 128, 256};
        EpiSlice E2{(float*)(ws + WS_ACC2), 256};
        pg8::gemm_phase<EpiSlice, pg8::SplitOrder>(lds, g2, S2, E2, wave0);
    }
    xcd_barrier(xbar, wave0);
    {
        PHASE_IDS(); PHASE_WS();
        bf16_t* MO = (bf16_t*)(ws + WS_MO); float* SSQ2 = (float*)(ws + WS_SSQ2);
        const float* g_post = args.in[14];
        const int gw = vcu * 8 + wave, NGW = G * 8;
        {
            const bf16_t* MO1 = (const bf16_t*)(ws + WS_MO); const bf16_t* FO = (const bf16_t*)(ws + WS_XN + 4096); const float* SSQ1 = (const float*)(ws + WS_SSQ1);
            const float* g_mix = args.in[12];
            f32x4 ga[4], gb[4];
#pragma unroll
            for (int j = 0; j < 4; ++j) { ga[j] = ((const GAS f32x4*)g_mix)[64 * j + lane]; gb[j] = ((const GAS f32x4*)g_post)[64 * j + lane]; }
            for (int m0 = gw; m0 < MP; m0 += 2 * NGW) {
                const int m1 = (m0 + NGW < MP) ? m0 + NGW : m0;
                f32x4 sa[2], sb[2], xv[2][4]; u32x2 mw[2][4], fw[2][4];
#pragma unroll
                for (int r = 0; r < 2; ++r) { const int m = r ? m1 : m0; sa[r] = *((const GAS f32x4*)(SSQ1 + (size_t)m * 16) + (lane & 3)); sb[r] = *((const GAS f32x4*)(SSQ2 + (size_t)m * 16) + (lane & 3));
#pragma unroll
                    for (int j = 0; j < 4; ++j) { xv[r][j] = __builtin_nontemporal_load((const GAS f32x4*)(x_prompt + (size_t)m * DM) + 64 * j + lane); mw[r][j] = ((const GAS u32x2*)(MO1 + (size_t)m * DM))[64 * j + lane]; fw[r][j] = ((const GAS u32x2*)(FO + (size_t)m * DM))[64 * j + lane]; } }
#pragma unroll
                for (int r = 0; r < 2; ++r) if (r == 0 || m1 != m0) { const int m = r ? m1 : m0;
                    float s1 = (sa[r].x + sa[r].y) + (sa[r].z + sa[r].w); s1 += __shfl_xor(s1, 1); s1 += __shfl_xor(s1, 2);
                    float s2 = (sb[r].x + sb[r].y) + (sb[r].z + sb[r].w); s2 += __shfl_xor(s2, 1); s2 += __shfl_xor(s2, 2);
                    const float rs1 = rsqrtf(s1 * (1.f / DM) + EPS), rs2 = rsqrtf(s2 * (1.f / DM) + EPS);
#pragma unroll
                    for (int j = 0; j < 4; ++j) { f32x4 mv, fv;
                        mv.x = __uint_as_float(mw[r][j].x << 16); mv.y = __uint_as_float(mw[r][j].x & 0xffff0000u); mv.z = __uint_as_float(mw[r][j].y << 16); mv.w = __uint_as_float(mw[r][j].y & 0xffff0000u);
                        fv.x = __uint_as_float(fw[r][j].x << 16); fv.y = __uint_as_float(fw[r][j].x & 0xffff0000u); fv.z = __uint_as_float(fw[r][j].y << 16); fv.w = __uint_as_float(fw[r][j].y & 0xffff0000u);
                        const f32x4 x1 = xv[r][j] + mv * rs1 * ga[j];
                        ((GAS f32x4*)(args.out + (size_t)m * DM))[64 * j + lane] = x1 + fv * rs2 * gb[j]; }
                }
            }
        }
        for (int m = MP + gw; m < MT; m += NGW) {
            float* orow = args.out + (size_t)m * DM;
            f32x4 mvv[4]; float ss;
            if (m < MP) {
                const f32x4 sp = *((const f32x4*)(SSQ2 + (size_t)m * 16) + (lane & 3));
                ss = (sp.x + sp.y) + (sp.z + sp.w); ss += __shfl_xor(ss, 1); ss += __shfl_xor(ss, 2);
#pragma unroll
                for (int j = 0; j < 4; ++j) { const u32x2 mw = ((const u32x2*)(MO + (size_t)m * DM))[64 * j + lane];
                    mvv[j].x = __uint_as_float(mw.x << 16); mvv[j].y = __uint_as_float(mw.x & 0xffff0000u); mvv[j].z = __uint_as_float(mw.y << 16); mvv[j].w = __uint_as_float(mw.y & 0xffff0000u); }
            } else {
                const f32x4* ar = (const f32x4*)(ws + WS_ACC2) + (size_t)(m - MP) * 256; float s = 0.f;
#pragma unroll
                for (int j = 0; j < 4; ++j) { f32x4 a = ar[64 * j + lane];
                    for (int sl = 1; sl < 11; ++sl) a += ar[(size_t)sl * 65536 + 64 * j + lane];
                    mvv[j] = a; s += (a.x * a.x + a.y * a.y) + (a.z * a.z + a.w * a.w); }
                ss = wave_sum(s);
            }
            const float rs = rsqrtf(ss * (1.f / DM) + EPS);
#pragma unroll
            for (int j = 0; j < 4; ++j) { const int c4 = 64 * j + lane; const f32x4 xv = ((const f32x4*)orow)[c4]; const f32x4 gp = ((const f32x4*)g_post)[c4];
                ((f32x4*)orow)[c4] = xv + mvv[j] * rs * gp; }
        }
    }
}

extern "C" void kernel_launch(void* const* d_in, const int* in_sizes, int n_in, void* d_out, int out_size, void* d_ws, size_t ws_size, hipStream_t stream) {
    static int grid = 0;
    if (grid == 0) {
        if (n_in != 19 || ws_size < WS_END || (size_t)out_size != O_END) { fprintf(stderr, "kernel_launch: unexpected shapes n_in %d out %d ws %zu\n", n_in, out_size, ws_size); grid = -1; return; }
        int dev = 0, cus = 0, per_cu = 0;
        hipGetDevice(&dev); hipDeviceGetAttribute(&cus, hipDeviceAttributeMultiprocessorCount, dev);
        hipFuncSetAttribute((const void*)hymba_fwd, hipFuncAttributeMaxDynamicSharedMemorySize, LDS_BYTES);
        hipOccupancyMaxActiveBlocksPerMultiprocessor(&per_cu, (const void*)hymba_fwd, 512, LDS_BYTES);
        if (per_cu < 1) { fprintf(stderr, "kernel_launch: occupancy query says %d blocks per CU\n", per_cu); grid = -1; return; }
        grid = cus;
    }
    if (grid < 0) return;
    hipMemsetAsync((char*)d_ws + WS_CTL, 0, CTL_BYTES, stream);
    Args a{};
    for (int i = 0; i < 19; ++i) a.in[i] = (const float*)d_in[i];
    a.out = (float*)d_out; a.ws = (unsigned char*)d_ws;
    void* kargs[] = {&a};
    hipError_t e = hipLaunchCooperativeKernel((const void*)hymba_fwd, dim3(grid), dim3(512), kargs, LDS_BYTES, stream);
    if (e != hipSuccess) fprintf(stderr, "cooperative launch failed: %s (grid %d)\n", hipGetErrorString(e), grid);
}
```

```cpp
#include <hip/hip_runtime.h>
#include <hip/hip_cooperative_groups.h>
#include <cstdio>
#include <cstdint>
namespace cg = cooperative_groups;

#define LAS __attribute__((address_space(3)))
#define GAS __attribute__((address_space(1)))
typedef unsigned short bf16_t;
typedef short bf16x8 __attribute__((ext_vector_type(8)));
typedef short s16x4 __attribute__((ext_vector_type(4)));
typedef float f32x4 __attribute__((ext_vector_type(4)));
typedef float f32x2 __attribute__((ext_vector_type(2)));
typedef float f32x16 __attribute__((ext_vector_type(16)));
typedef unsigned u32x4 __attribute__((ext_vector_type(4)));
typedef unsigned u32x2 __attribute__((ext_vector_type(2)));

constexpr int DM = 1024, NPB = 16, SEQ = 2048, NSB = 32, NST = 8;
constexpr int MP = NPB * SEQ;
constexpr int MS = NSB * NST;
constexpr int MT = MP + MS;
constexpr int NIN = 3328;
constexpr int DIN = 3088;
constexpr int DFF = 2816;
constexpr int WINB = 2048;
constexpr float EPS = 1e-6f;
constexpr float QSCALE = 0.125f * 1.4426950408889634f;

constexpr size_t MiB = 1u << 20;
constexpr size_t WS_CTL = 0, CTL_BYTES = 65536;
constexpr int XBST_OFF = 131072 + 8192;
constexpr size_t WS_WIN = 1 * MiB, WS_WO = 8 * MiB, WS_WUP = 10 * MiB, WS_WD = 22 * MiB;
constexpr size_t WS_SSQ1 = 28 * MiB, WS_SSQ2 = 31 * MiB;
constexpr size_t WS_XN = 34 * MiB;
constexpr size_t WS_MO = 104 * MiB;
constexpr size_t WS_QA = 172 * MiB, WS_KA = 206 * MiB, WS_VA = 240 * MiB, WS_QB = 274 * MiB, WS_KB = 291 * MiB, WS_VB = 308 * MiB, WS_RB = 342 * MiB, WS_LF = 376 * MiB, WS_MIX = 410 * MiB;
constexpr size_t WS_H = 172 * MiB;
constexpr size_t WS_ACC1 = 478 * MiB, WS_ACC2 = 482 * MiB;
constexpr size_t WS_END = 494 * MiB;
static_assert(WS_H + (size_t)MT * DFF * 2 <= WS_MIX, "h overlay");
static_assert(WS_XN + 4096 + (size_t)(131 * 254 + 260) * DM * 2 <= WS_MO, "xn2");

constexpr size_t O_YP = 0, O_YS = O_YP + (size_t)MP * DM, O_KP = O_YS + (size_t)MS * DM, O_VP = O_KP + (size_t)MP * 512, O_GP = O_VP + (size_t)MP * 512,
                 O_CP = O_GP + (size_t)NPB * 4 * 64 * 128, O_KS = O_CP + (size_t)NPB * 2 * DFF, O_VS = O_KS + (size_t)MS * 512, O_GS = O_VS + (size_t)MS * 512,
                 O_CS = O_GS + (size_t)NSB * 4 * 64 * 128, O_END = O_CS + (size_t)NSB * 2 * DFF;

__device__ __forceinline__ unsigned cvt_pk_bf16(float lo, float hi) { unsigned r; asm volatile("v_cvt_pk_bf16_f32 %0, %1, %2" : "=v"(r) : "v"(lo), "v"(hi)); return r; }
__device__ __forceinline__ float bf2f(unsigned short b) { return __uint_as_float((unsigned)b << 16); }
__device__ __forceinline__ float wave_sum(float v) {
#pragma unroll
    for (int o = 1; o < 64; o <<= 1) v += __shfl_xor(v, o);
    return v;
}

__device__ __forceinline__ int lane_id_v() { int l; asm volatile("v_mbcnt_lo_u32_b32 %0, -1, 0\n\tv_mbcnt_hi_u32_b32 %0, -1, %0" : "=v"(l)); return l; }

struct Args {
    const float* in[19];
    float* out;
    unsigned char* ws;
};

namespace pg8 {
constexpr int BM = 256, BK = 64, HALF = 128, HTB = HALF * BK * 2, STAGE_BYTES = 8 * HTB, NXCD = 8, WGM = 4;
__host__ __device__ __forceinline__ int lds_byte(int r, int c) { const int st = (r >> 4) * 2 + (c >> 5), rr = r & 15, cc = c & 31, ob = rr * 64 + cc * 2; return st * 1024 + (ob ^ (((ob >> 9) & 1) << 5)); }
__host__ __device__ __forceinline__ void stage_rc(int b, int& R, int& C) { const int st = b / 1024, sb = b % 1024, swz = sb ^ (((sb >> 9) & 1) << 5); R = (st >> 1) * 16 + swz / 64; C = (st & 1) * 32 + (swz % 64) / 2; }
__host__ __device__ __forceinline__ int perm32(int rho) { const int n = rho >> 4, i = rho & 15; return 8 * (i >> 2) + 4 * n + (i & 3); }

struct Unit { int pm, pn, kofs; };
struct Gemm { const bf16_t* A; const bf16_t* Bt; int K; int a_rows; int ldk; };

struct StaticOrder {
    int nM, nN, nwg, G, c;
    __device__ void init(int nM_, int nN_, int G_, int c_) { nM = nM_; nN = nN_; nwg = nM * nN; G = G_; c = c_; }
    __device__ bool next(int i, Unit& u) const {
        const long L = (long)i * G + c; if (L >= nwg) return false;
        int wgid = (int)L; { const int q = nwg / NXCD, r = nwg % NXCD, xcd = wgid % NXCD, off = wgid / NXCD; wgid = (xcd < r ? xcd * (q + 1) : r * (q + 1) + (xcd - r) * q) + off; }
        const int nig = WGM * nN, gid = wgid / nig, fm = gid * WGM, gsz = (nM - fm) < WGM ? (nM - fm) : WGM;
        u.pm = fm + ((wgid % nig) % gsz); u.pn = (wgid % nig) / gsz; u.kofs = 0; return true;
    }
};
struct SplitOrder {
    int nsub, G, c, pm, ksub;
    __device__ bool next(int i, Unit& u) const { const int L = i * G + c; if (L >= nsub) return false; u.pm = pm; u.pn = L & 3; u.kofs = (L >> 2) * ksub; return true; }
};

__device__ __forceinline__ f32x2 gelu_pk(f32x2 v) {
    const f32x2 av = __builtin_elementwise_abs(v), d = av * 0.2316418882f + 1.0f;
    f32x2 t; t.x = __builtin_amdgcn_rcpf(d.x); t.y = __builtin_amdgcn_rcpf(d.y);
    f32x2 q = t * 0.5307027145f + (-0.7265760135f); q = q * t + 0.7107068705f; q = q * t + (-0.142248368f); q = q * t + 0.127414796f; q = q * t;
    const f32x2 s = (v * v) * (-0.72134752044f);
    f32x2 e; e.x = __builtin_amdgcn_exp2f(s.x); e.y = __builtin_amdgcn_exp2f(s.y);
    const f32x2 m = v * (q * e), r = v - m;
    f32x2 o; o.x = v.x < 0.f ? m.x : r.x; o.y = v.y < 0.f ? m.y : r.y; return o;
}

template <class Epi, class Sched>
__device__ __forceinline__ void gemm_phase(LAS unsigned char* lds, const Gemm g, const Sched& S, const Epi& E, int wid) {
    const int lane = lane_id_v(); const int tid = wid * 64 + lane;
    const int wr = wid >> 2, wc = wid & 3, fr = lane & 15, fq = lane >> 4;
    const int K = g.ldk, nt = g.K / BK;
    unsigned voffA[2], voffB[2];
#pragma unroll
    for (int i = 0; i < 2; ++i) { int R, C; stage_rc(tid * 16 + i * 8192, R, C); const int Rb = Epi::PERM ? ((R & ~31) + perm32(R & 31)) : R;
        voffA[i] = (unsigned)(R * K + C) * 2u; voffB[i] = (unsigned)(Rb * K + C) * 2u; }
    const size_t kstep = (size_t)(BK * 2);
    const size_t hstep = (size_t)HALF * K * 2;
    const size_t tstepB = 2 * hstep;
    const size_t tstepA = (size_t)g.a_rows * K * 2;
    const unsigned ldsw = (unsigned)wid * 1024u;
    const int aoff = lds_byte(wr * 64 + fr, fq * 8), boff = lds_byte(wc * 32 + fr, fq * 8);
#define PG8_SA(b, h) (((b) * 2 + (h)) * HTB)
#define PG8_SB(b, h) ((4 + (b) * 2 + (h)) * HTB)
#define PG8_STAGE(bufoff, gbase, voff) do { _Pragma("unroll") for (int _i = 0; _i < 2; ++_i) \
        __builtin_amdgcn_global_load_lds((const unsigned*)((const char*)(gbase) + (voff)[_i]), (LAS unsigned*)(lds + (bufoff) + ldsw + _i * 8192), 16, 0, 0); } while (0)
#define PG8_LDA(dst, b, h) do { _Pragma("unroll") for (int m = 0; m < 4; ++m) _Pragma("unroll") for (int k = 0; k < 2; ++k) dst[m][k] = *(const LAS bf16x8*)(lds + PG8_SA(b, h) + aoff + m * 2048 + k * 1024); } while (0)
#define PG8_LDB(dst, b, h) do { _Pragma("unroll") for (int n = 0; n < 2; ++n) _Pragma("unroll") for (int k = 0; k < 2; ++k) dst[n][k] = *(const LAS bf16x8*)(lds + PG8_SB(b, h) + boff + n * 2048 + k * 1024); } while (0)
#define PG8_MMA(ai, bj, At, Bt) do { __builtin_amdgcn_s_setprio(1); _Pragma("unroll") for (int m = 0; m < 4; ++m) _Pragma("unroll") for (int n = 0; n < 2; ++n) _Pragma("unroll") for (int k = 0; k < 2; ++k) \
        acc[ai][bj][m][n] = __builtin_amdgcn_mfma_f32_16x16x32_bf16(Bt[n][k], At[m][k], acc[ai][bj][m][n], 0, 0, 0); __builtin_amdgcn_s_setprio(0); } while (0)
#define PG8_WAIT_V(n) asm volatile("s_waitcnt vmcnt(" #n ")" ::: "memory")
#define PG8_WAIT_L(n) asm volatile("s_waitcnt lgkmcnt(" #n ")" ::: "memory")
#define PG8_BAR __builtin_amdgcn_s_barrier()
#define PG8_SCHED __builtin_amdgcn_sched_barrier(0)
    Unit cur, nxt; int ui = 0;
    if (!S.next(0, cur)) return;
    f32x4 acc[2][2][4][2];
#pragma unroll
    for (int a = 0; a < 2; ++a)
#pragma unroll
        for (int b = 0; b < 2; ++b)
#pragma unroll
            for (int m = 0; m < 4; ++m)
#pragma unroll
                for (int n = 0; n < 2; ++n) acc[a][b][m][n] = (f32x4){0.f, 0.f, 0.f, 0.f};
    bf16x8 At[4][2], B0[2][2], B1[2][2];
    const char* cA = (const char*)g.A + (size_t)cur.pm * tstepA + (size_t)cur.kofs * 2; const char* cB = (const char*)g.Bt + (size_t)cur.pn * tstepB + (size_t)cur.kofs * 2;
    PG8_STAGE(PG8_SB(0, 0), cB, voffB); PG8_STAGE(PG8_SB(0, 1), cB + hstep, voffB); PG8_STAGE(PG8_SA(0, 0), cA, voffA); PG8_STAGE(PG8_SA(0, 1), cA + hstep, voffA);
    if (wr == 1) PG8_BAR;
    PG8_WAIT_V(2); PG8_BAR;
    PG8_STAGE(PG8_SB(1, 0), cB + kstep, voffB); PG8_STAGE(PG8_SA(1, 0), cA + kstep, voffA); PG8_STAGE(PG8_SB(1, 1), cB + hstep + kstep, voffB);
    PG8_WAIT_V(6); PG8_BAR;
    for (;;) {
        const bool has_next = S.next(ui + 1, nxt);
        const char* nA = has_next ? (const char*)g.A + (size_t)nxt.pm * tstepA + (size_t)nxt.kofs * 2 : cA; const char* nB = has_next ? (const char*)g.Bt + (size_t)nxt.pn * tstepB + (size_t)nxt.kofs * 2 : cB;
        for (int t = 0; t < nt; t += 2) {
            const bool last = (t == nt - 2);
            const char* a1 = cA + (size_t)(t + 1) * kstep;
            const char* a2 = last ? nA : cA + (size_t)(t + 2) * kstep; const char* b2 = last ? nB : cB + (size_t)(t + 2) * kstep;
            const char* a3 = a2 + kstep; const char* b3 = b2 + kstep;
            PG8_LDB(B0, 0, 0); PG8_LDB(B1, 0, 1); PG8_SCHED; PG8_LDA(At, 0, 0); PG8_STAGE(PG8_SA(1, 1), a1 + hstep, voffA);
            PG8_WAIT_V(8); PG8_WAIT_L(0); PG8_BAR; PG8_MMA(0, 0, At, B0); PG8_MMA(0, 1, At, B1); PG8_BAR; PG8_SCHED;
            PG8_LDA(At, 0, 1); PG8_STAGE(PG8_SB(0, 0), b2, voffB); PG8_STAGE(PG8_SB(0, 1), b2 + hstep, voffB); PG8_STAGE(PG8_SA(0, 0), a2, voffA);
            PG8_WAIT_V(8); PG8_WAIT_L(0); PG8_BAR; PG8_MMA(1, 0, At, B0); PG8_MMA(1, 1, At, B1); PG8_BAR; PG8_SCHED;
            PG8_LDB(B0, 1, 0); PG8_LDB(B1, 1, 1); PG8_SCHED; PG8_LDA(At, 1, 0); PG8_STAGE(PG8_SA(0, 1), a2 + hstep, voffA);
            PG8_WAIT_V(8); PG8_WAIT_L(0); PG8_BAR; PG8_MMA(0, 0, At, B0); PG8_MMA(0, 1, At, B1); PG8_BAR; PG8_SCHED;
            PG8_LDA(At, 1, 1); PG8_STAGE(PG8_SB(1, 0), b3, voffB); PG8_STAGE(PG8_SB(1, 1), b3 + hstep, voffB); PG8_STAGE(PG8_SA(1, 0), a3, voffA);
            PG8_WAIT_V(8); PG8_WAIT_L(0); PG8_BAR; PG8_MMA(1, 0, At, B0); PG8_MMA(1, 1, At, B1); PG8_BAR; PG8_SCHED;
        }
        if (wr == 0) PG8_BAR;
        E(acc, cur, wr, wc, fr, fq);
        if (!has_next) break;
#pragma unroll
        for (int a = 0; a < 2; ++a)
#pragma unroll
            for (int b = 0; b < 2; ++b)
#pragma unroll
                for (int m = 0; m < 4; ++m)
#pragma unroll
                    for (int n = 0; n < 2; ++n) acc[a][b][m][n] = (f32x4){0.f, 0.f, 0.f, 0.f};
        cur = nxt; cA = nA; cB = nB; ++ui;
        if (wr == 1) PG8_BAR;
    }
    PG8_WAIT_V(0);
    PG8_BAR;
#undef PG8_SA
#undef PG8_SB
#undef PG8_STAGE
#undef PG8_LDA
#undef PG8_LDB
#undef PG8_MMA
#undef PG8_WAIT_V
#undef PG8_WAIT_L
#undef PG8_BAR
#undef PG8_SCHED
}
}

struct EpiInProj {
    static constexpr bool PERM = true;
    bf16_t *QA, *KA, *VA, *QB, *KB, *VB, *RB; float* LF; float* out; const float* b_a;
    __device__ __forceinline__ void operator()(const f32x4 (&acc)[2][2][4][2], const pg8::Unit& u, int wr, int wc, int fr, int fq) const {
        const int pn = u.pn;
        const int row0 = u.pm * 256 + wr * 64 + fr;
        const int cl = wc * 32 + 8 * fq;
        if (pn == 12) {
#pragma unroll
            for (int bj = 0; bj < 2; ++bj) {
                const f32x4 b0 = *(const f32x4*)(b_a + cl + bj * 128), b1 = *(const f32x4*)(b_a + cl + bj * 128 + 4);
#pragma unroll
                for (int ai = 0; ai < 2; ++ai)
#pragma unroll
                    for (int m = 0; m < 4; ++m) {
                        f32x4 v0 = acc[ai][bj][m][0] + b0, v1 = acc[ai][bj][m][1] + b1;
#pragma unroll
                        for (int e = 0; e < 4; ++e) {
                            float z = v0[e]; v0[e] = (fminf(z, 0.f) - 0.69314718f * __builtin_amdgcn_logf(1.f + __builtin_amdgcn_exp2f(-1.44269504f * fabsf(z)))) * 0.0625f;
                            z = v1[e]; v1[e] = (fminf(z, 0.f) - 0.69314718f * __builtin_amdgcn_logf(1.f + __builtin_amdgcn_exp2f(-1.44269504f * fabsf(z)))) * 0.0625f; }
                        float* p = LF + (size_t)(row0 + ai * 128 + m * 16) * 256 + cl + bj * 128;
                        *(f32x4*)p = v0; *(f32x4*)(p + 4) = v1;
                    }
            }
            return;
        }
        bf16_t* base; int ld, cb; float sc = 1.f; float* fo = nullptr;
        if (pn < 2) { base = QA; ld = 512; cb = pn * 256; sc = QSCALE; }
        else if (pn < 4) { base = KA; ld = 512; cb = (pn - 2) * 256; fo = out + (u.pm < 128 ? O_KP : O_KS - (size_t)MP * 512); }
        else if (pn < 6) { base = VA; ld = 512; cb = (pn - 4) * 256; fo = out + (u.pm < 128 ? O_VP : O_VS - (size_t)MP * 512); }
        else if (pn == 6) { base = QB; ld = 256; cb = 0; }
        else if (pn == 7) { base = KB; ld = 256; cb = 0; }
        else if (pn < 10) { base = VB; ld = 512; cb = (pn - 8) * 256; }
        else { base = RB; ld = 512; cb = (pn - 10) * 256; }
#pragma unroll
        for (int ai = 0; ai < 2; ++ai)
#pragma unroll
            for (int m = 0; m < 4; ++m) {
                const size_t r = (size_t)(row0 + ai * 128 + m * 16);
#pragma unroll
                for (int bj = 0; bj < 2; ++bj) {
                    const f32x4 a0 = acc[ai][bj][m][0], a1 = acc[ai][bj][m][1];
                    const f32x4 v0 = a0 * sc, v1 = a1 * sc;
                    u32x4 w; w.x = cvt_pk_bf16(v0[0], v0[1]); w.y = cvt_pk_bf16(v0[2], v0[3]); w.z = cvt_pk_bf16(v1[0], v1[1]); w.w = cvt_pk_bf16(v1[2], v1[3]);
                    *(u32x4*)(base + r * ld + cb + cl + bj * 128) = w;
                    if (fo) { float* p = fo + r * 512 + cb + cl + bj * 128; *(f32x4*)p = a0; *(f32x4*)(p + 4) = a1; }
                }
            }
    }
};


struct EpiRowOut {
    static constexpr bool PERM = true;
    bf16_t* O; float* SSQ;
    __device__ __forceinline__ void operator()(const f32x4 (&acc)[2][2][4][2], const pg8::Unit& u, int wr, int wc, int fr, int fq) const {
        const int row0 = u.pm * 256 + wr * 64 + fr; const int cl = u.pn * 256 + wc * 32 + 8 * fq;
#pragma unroll
        for (int ai = 0; ai < 2; ++ai)
#pragma unroll
            for (int m = 0; m < 4; ++m) {
                const size_t r = (size_t)(row0 + ai * 128 + m * 16); float s = 0.f;
#pragma unroll
                for (int bj = 0; bj < 2; ++bj) {
                    const f32x4 v0 = acc[ai][bj][m][0], v1 = acc[ai][bj][m][1];
                    s += (v0[0] * v0[0] + v0[1] * v0[1]) + (v0[2] * v0[2] + v0[3] * v0[3]) + (v1[0] * v1[0] + v1[1] * v1[1]) + (v1[2] * v1[2] + v1[3] * v1[3]);
                    u32x4 w; w.x = cvt_pk_bf16(v0[0], v0[1]); w.y = cvt_pk_bf16(v0[2], v0[3]); w.z = cvt_pk_bf16(v1[0], v1[1]); w.w = cvt_pk_bf16(v1[2], v1[3]);
                    *(u32x4*)(O + r * 1024 + cl + bj * 128) = w;
                }
                s += __shfl_xor(s, 16); s += __shfl_xor(s, 32);
                if (fq == 0) SSQ[r * 16 + u.pn * 4 + wc] = s;
            }
    }
};

struct EpiSlice {
    static constexpr bool PERM = false;
    float* SL; int ksub;
    __device__ __forceinline__ void operator()(const f32x4 (&acc)[2][2][4][2], const pg8::Unit& u, int wr, int wc, int fr, int fq) const {
        float* base = SL + (size_t)(u.kofs / ksub) * (256 * 1024) + (unsigned)((wr * 64 + fr) * 1024 + u.pn * 256 + wc * 32 + 4 * fq);
#pragma unroll
        for (int ai = 0; ai < 2; ++ai)
#pragma unroll
            for (int m = 0; m < 4; ++m) { float* rowp = base + (ai * 128 + m * 16) * 1024;
#pragma unroll
                for (int bj = 0; bj < 2; ++bj)
#pragma unroll
                    for (int n = 0; n < 2; ++n) *(f32x4*)(rowp + bj * 128 + n * 16) = acc[ai][bj][m][n]; }
    }
};

__device__ __forceinline__ float dpp_ror1(float v) { return __int_as_float(__builtin_amdgcn_update_dpp(0, __float_as_int(v), 0x121, 0xf, 0xf, false)); }
__device__ __forceinline__ float dpp_ror2(float v) { return __int_as_float(__builtin_amdgcn_update_dpp(0, __float_as_int(v), 0x122, 0xf, 0xf, false)); }

constexpr int CONVX_OFF = 131072;
struct EpiUp {
    static constexpr bool PERM = true;
    bf16_t* H; float* out; const float* conv_w; const float* conv_b; const float* cbuf; LAS unsigned char* lds;
    __device__ __forceinline__ void operator()(const f32x4 (&acc)[2][2][4][2], const pg8::Unit& u, int wr, int wc, int fr, int fq) const {
        LAS float* X = (LAS float*)(lds + CONVX_OFF);
        const int cg_ = wc * 32 + 8 * fq;
        const int col = u.pn * 128 + cg_;
        if (fr >= 14) {
#pragma unroll
            for (int ai = 0; ai < 2; ++ai) { LAS float* p = X + ((ai * 2 + wr) * 2 + (fr - 14)) * 128 + cg_; *(LAS f32x4*)p = acc[ai][0][3][0]; *(LAS f32x4*)(p + 4) = acc[ai][0][3][1]; }
        }
        f32x4 w0[2], w1[2], w2[2], cb[2];
#pragma unroll
        for (int n = 0; n < 2; ++n) { w0[n] = *(const f32x4*)(conv_w + col + 4 * n); w1[n] = *(const f32x4*)(conv_w + DFF + col + 4 * n); w2[n] = *(const f32x4*)(conv_w + 2 * DFF + col + 4 * n); cb[n] = *(const f32x4*)(conv_b + col + 4 * n); }
        asm volatile("s_waitcnt lgkmcnt(0)" ::: "memory"); __builtin_amdgcn_s_barrier(); asm volatile("" ::: "memory");
#pragma unroll
        for (int ai = 0; ai < 2; ++ai) {
            const int pai = (wr == 1) ? ai : ai - 1, pwr = wr ^ 1;
            f32x4 pr1[2], pr2[2];
#pragma unroll
            for (int n = 0; n < 2; ++n) {
                if (pai >= 0) { pr1[n] = *(const LAS f32x4*)(X + ((pai * 2 + pwr) * 2 + 1) * 128 + cg_ + 4 * n); pr2[n] = *(const LAS f32x4*)(X + ((pai * 2 + pwr) * 2 + (fr & 1)) * 128 + cg_ + 4 * n); }
                else { pr1[n] = (f32x4){0.f, 0.f, 0.f, 0.f}; pr2[n] = pr1[n]; }
            }
#pragma unroll
            for (int m = 0; m < 4; ++m) {
                const int lr = ai * 128 + wr * 64 + m * 16 + fr; const int gr = u.pm * 254 - 2 + lr;
                const bool store = (lr >= 2) && (gr < MT);
                int pos, bidx; const bool samp = gr >= MP;
                if (!samp) { pos = gr & (SEQ - 1); bidx = gr >> 11; } else { pos = (gr - MP) & 7; bidx = (gr - MP) >> 3; }
                const bool head_rows = __builtin_amdgcn_ballot_w64(pos < 2) != 0ull;
                const bool tail_rows = __builtin_amdgcn_ballot_w64(store && (samp ? pos >= 6 : pos >= SEQ - 2)) != 0ull;
                u32x4 hw;
#pragma unroll
                for (int n = 0; n < 2; ++n) {
                    const f32x4 g0 = acc[ai][0][m][n], uu = acc[ai][1][m][n]; f32x4 gm1, gm2, nr1, nr2;
#pragma unroll
                    for (int e = 0; e < 4; ++e) {
                        gm1[e] = __int_as_float(__builtin_amdgcn_update_dpp(__float_as_int(pr1[n][e]), __float_as_int(g0[e]), 0x111, 0xf, 0xf, false));
                        gm2[e] = __int_as_float(__builtin_amdgcn_update_dpp(__float_as_int(pr2[n][e]), __float_as_int(g0[e]), 0x112, 0xf, 0xf, false));
                        nr1[e] = dpp_ror1(g0[e]); nr2[e] = dpp_ror2(g0[e]);
                    }
                    pr1[n] = nr1; pr2[n] = nr2;
                    if (head_rows) {
                        if (!samp) { if (pos == 0) { gm1 = (f32x4){0.f, 0.f, 0.f, 0.f}; gm2 = gm1; } else if (pos == 1) gm2 = (f32x4){0.f, 0.f, 0.f, 0.f}; }
                        else if (store) { if (pos == 0) { gm1 = *(const f32x4*)(cbuf + (size_t)(bidx * 2 + 1) * DFF + col + 4 * n); gm2 = *(const f32x4*)(cbuf + (size_t)(bidx * 2) * DFF + col + 4 * n); }
                                          else if (pos == 1) gm2 = *(const f32x4*)(cbuf + (size_t)(bidx * 2 + 1) * DFF + col + 4 * n); }
                    }
                    const f32x4 c = cb[n] + w0[n] * gm2 + w1[n] * gm1 + w2[n] * g0;
                    const f32x2 ga = pg8::gelu_pk((f32x2){c[0], c[1]}), gb = pg8::gelu_pk((f32x2){c[2], c[3]});
                    const float h0 = ga.x * uu[0], h1 = ga.y * uu[1], h2 = gb.x * uu[2], h3 = gb.y * uu[3];
                    if (n == 0) { hw.x = cvt_pk_bf16(h0, h1); hw.y = cvt_pk_bf16(h2, h3); } else { hw.z = cvt_pk_bf16(h0, h1); hw.w = cvt_pk_bf16(h2, h3); }
                    if (tail_rows && store) {
                        if (!samp) { if (pos >= SEQ - 2) *(f32x4*)(out + O_CP + (size_t)(bidx * 2 + (pos - (SEQ - 2))) * DFF + col + 4 * n) = g0; }
                        else { if (pos >= 6) *(f32x4*)(out + O_CS + (size_t)(bidx * 2 + (pos - 6)) * DFF + col + 4 * n) = g0; }
                    }
                }
                if (store) *(u32x4*)(H + (size_t)gr * DFF + col) = hw;
            }
        }
    }
};

__device__ __forceinline__ unsigned pk2(float lo, float hi) { return cvt_pk_bf16(lo, hi); }
__device__ __forceinline__ void p0_transpose_item(const float* W, int ldw, int scol0, int k0, bf16_t* WT, int dK, int drow0, LAS float* scr, int lane) {
#pragma unroll 8
    for (int i = 0; i < 32; ++i) { const int kk = 2 * i + (lane >> 5); scr[kk * 33 + (lane & 31)] = __builtin_nontemporal_load((const GAS float*)W + ((size_t)(k0 + kk) * ldw + scol0 + (lane & 31))); }
    asm volatile("s_waitcnt lgkmcnt(0)" ::: "memory");
    const int c = lane & 7;
#pragma unroll
    for (int j = 0; j < 4; ++j) { const int n = (lane >> 3) + 8 * j; const LAS float* s = scr + (8 * c) * 33 + n;
        u32x4 o; o.x = pk2(s[0 * 33], s[1 * 33]); o.y = pk2(s[2 * 33], s[3 * 33]); o.z = pk2(s[4 * 33], s[5 * 33]); o.w = pk2(s[6 * 33], s[7 * 33]);
        *(u32x4*)(WT + (size_t)(drow0 + n) * dK + k0 + 8 * c) = o; }
    asm volatile("s_waitcnt lgkmcnt(0)" ::: "memory");
}
__device__ __forceinline__ void p0_gate_item(const float* w_in, const float* w_a2, int k0, int n0, bf16_t* WT, LAS float* scr, int lane) {
    float w2[16];
#pragma unroll
    for (int r = 0; r < 16; ++r) w2[r] = w_a2[r * 256 + n0 + (lane & 31)];
    for (int i = 0; i < 32; ++i) { const int kk = 2 * i + (lane >> 5); const float* a = w_in + (size_t)(k0 + kk) * DIN + 3072; float s = 0.f;
#pragma unroll
        for (int r = 0; r < 16; ++r) s += a[r] * w2[r];
        scr[kk * 33 + (lane & 31)] = s; }
    asm volatile("s_waitcnt lgkmcnt(0)" ::: "memory");
    const int c = lane & 7;
#pragma unroll
    for (int j = 0; j < 4; ++j) { const int n = (lane >> 3) + 8 * j; const LAS float* s = scr + (8 * c) * 33 + n;
        u32x4 o; o.x = pk2(s[0 * 33], s[1 * 33]); o.y = pk2(s[2 * 33], s[3 * 33]); o.z = pk2(s[4 * 33], s[5 * 33]); o.w = pk2(s[6 * 33], s[7 * 33]);
        *(u32x4*)(WT + (size_t)(3072 + n0 + n) * 1024 + k0 + 8 * c) = o; }
    asm volatile("s_waitcnt lgkmcnt(0)" ::: "memory");
}
__device__ __forceinline__ void rms_row_to_bf16(const float* xrow, const float* g, bf16_t* orow, int lane) {
    const f32x4* xr = (const f32x4*)xrow + lane; const f32x4* gr = (const f32x4*)g + lane;
    f32x4 v[4]; float s = 0.f;
#pragma unroll
    for (int j = 0; j < 4; ++j) { v[j] = __builtin_nontemporal_load((const GAS f32x4*)xr + 64 * j); s += (v[j].x * v[j].x + v[j].y * v[j].y) + (v[j].z * v[j].z + v[j].w * v[j].w); }
    const float rs = rsqrtf(wave_sum(s) * (1.f / DM) + EPS);
    u32x2* o8 = (u32x2*)orow + lane;
#pragma unroll
    for (int j = 0; j < 4; ++j) { const f32x4 gg = gr[64 * j]; const f32x4 y = v[j] * rs * gg; u32x2 w; w.x = pk2(y.x, y.y); w.y = pk2(y.z, y.w); o8[64 * j] = w; }
}


__device__ __forceinline__ int crow(int r, int hi) { return (r & 3) + 8 * (r >> 2) + 4 * hi; }
typedef short v4i16_t __attribute__((ext_vector_type(4)));
__device__ __forceinline__ s16x4 vtr(const LAS unsigned char* p) { return __builtin_bit_cast(s16x4, __builtin_amdgcn_ds_read_tr16_b64_v4i16((LAS v4i16_t*)p)); }
__device__ __forceinline__ float swapmax(float v) { auto rr = __builtin_amdgcn_permlane32_swap(__float_as_uint(v), __float_as_uint(v), false, false); return fmaxf(__uint_as_float(rr[0]), __uint_as_float(rr[1])); }
__device__ __forceinline__ float swapsum(float v) { auto rr = __builtin_amdgcn_permlane32_swap(__float_as_uint(v), __float_as_uint(v), false, false); return __uint_as_float(rr[0]) + __uint_as_float(rr[1]); }
__device__ __forceinline__ u32x4 pack8(f32x4 a, f32x4 b) { u32x4 w; w.x = cvt_pk_bf16(a.x, a.y); w.y = cvt_pk_bf16(a.z, a.w); w.z = cvt_pk_bf16(b.x, b.y); w.w = cvt_pk_bf16(b.z, b.w); return w; }

constexpr float NEGF = -1e30f;
constexpr int VPITCH = 192;
constexpr int ATT_WLDS = 32 * VPITCH + 256;

struct AttnCtx { const bf16_t *QA, *KA, *VA; bf16_t* MIX; const float *ck, *cv; };

struct TileRegs { u32x4 k[8]; u32x4 v[8]; };

template <bool SAMPLE> __device__ __forceinline__ int tile_key(int ti, int j, int g, int r4, int ncls) {
    if (SAMPLE) { if (ti < 17) return 1536 + 32 * (16 - ti) + j; const int kk = ti - 17; return 16 * (4 * kk + (j >> 3)) + (j & 7); }
    if (ti < ncls) return 4 * (32 * (g - ti) + j) + r4;
    const int jj = ti - ncls + (g == 0 ? 4 : 0); return 128 * g - 128 + 32 * jj + j;
}
template <bool SAMPLE> __device__ __forceinline__ void tile_load(const AttnCtx& C, TileRegs& T, int ti, int b, int h, int g, int r4, int ncls, int lane) {
    const int r32 = lane & 31, hi = lane >> 5;
    if (SAMPLE && ti > 0) {
        { const int idx = tile_key<SAMPLE>(ti, r32, g, r4, ncls); const float* p = C.ck + (((unsigned)(b * WINB + idx) * 8u + h) * 64u + 8 * hi);
#pragma unroll
          for (int d0 = 0; d0 < 4; ++d0) { T.k[2 * d0] = *(const GAS u32x4*)(p + 16 * d0); T.k[2 * d0 + 1] = *(const GAS u32x4*)(p + 16 * d0 + 4); } }
#pragma unroll
        for (int i = 0; i < 4; ++i) { const int key = (lane >> 3) + 8 * i; const int idx = tile_key<SAMPLE>(ti, key, g, r4, ncls);
            const float* p = C.cv + (((unsigned)(b * WINB + idx) * 8u + h) * 64u + 8 * (lane & 7)); T.v[2 * i] = *(const GAS u32x4*)p; T.v[2 * i + 1] = *(const GAS u32x4*)(p + 4); }
    } else {
        unsigned rowb;
        { int key = tile_key<SAMPLE>(ti, r32, g, r4, ncls); if (SAMPLE) { key -= WINB; key = key > 7 ? 7 : key; rowb = (unsigned)(MP + b * 8 + key); } else rowb = (unsigned)(b * SEQ + key);
          const bf16_t* p = C.KA + (rowb * 512u + h * 64 + 8 * hi);
#pragma unroll
          for (int d0 = 0; d0 < 4; ++d0) T.k[d0] = *(const GAS u32x4*)(p + 16 * d0); }
#pragma unroll
        for (int i = 0; i < 4; ++i) { int key = tile_key<SAMPLE>(ti, (lane >> 3) + 8 * i, g, r4, ncls); if (SAMPLE) { key -= WINB; key = key > 7 ? 7 : key; rowb = (unsigned)(MP + b * 8 + key); } else rowb = (unsigned)(b * SEQ + key);
            T.v[i] = *(const GAS u32x4*)(C.VA + (rowb * 512u + h * 64 + 8 * (lane & 7))); }
    }
}

template <bool SAMPLE>
__device__ __forceinline__ void attn_item(const AttnCtx& C, int b, int h, int g, int r4, LAS unsigned char* wl, int lane_in) {
    int lane = lane_in; asm volatile("" : "+v"(lane));
    const int r32 = lane & 31, hi = lane >> 5;
    LAS float* wsf = (LAS float*)(wl + 32 * VPITCH);
    const int ncls = g + 1;
    const int nt = SAMPLE ? 41 : (ncls + (g == 0 ? 4 : 8));
    bf16x8 qf[4];
    {
        unsigned qrow; if (SAMPLE) qrow = (unsigned)(MP + b * 8 + (r32 & 7)); else qrow = (unsigned)(b * SEQ + 4 * (32 * g + r32) + r4);
        const bf16_t* p = C.QA + (qrow * 512u + h * 64 + 8 * hi);
#pragma unroll
        for (int d0 = 0; d0 < 4; ++d0) qf[d0] = *(const bf16x8*)(p + 16 * d0);
    }
    float mrun = NEGF, lrun = 0.f;
    f32x16 o0 = {}, o1 = {};
    TileRegs T;
    tile_load<SAMPLE>(C, T, 0, b, h, g, r4, ncls, lane);
    const int vrd = (4 * hi + ((lane & 15) >> 2)) * VPITCH + (((lane >> 4) & 1) * 16 + (lane & 3) * 4) * 2;
    for (int ti = 0; ti < nt; ++ti) {
        bf16x8 kf[4];
        const bool f32path = SAMPLE && ti > 0;
        if (f32path) {
#pragma unroll
            for (int d0 = 0; d0 < 4; ++d0) kf[d0] = __builtin_bit_cast(bf16x8, pack8(__builtin_bit_cast(f32x4, T.k[2 * d0]), __builtin_bit_cast(f32x4, T.k[2 * d0 + 1])));
#pragma unroll
            for (int i = 0; i < 4; ++i) *(LAS u32x4*)(wl + ((lane >> 3) + 8 * i) * VPITCH + (lane & 7) * 16) = pack8(__builtin_bit_cast(f32x4, T.v[2 * i]), __builtin_bit_cast(f32x4, T.v[2 * i + 1]));
        } else {
#pragma unroll
            for (int d0 = 0; d0 < 4; ++d0) kf[d0] = __builtin_bit_cast(bf16x8, T.k[d0]);
#pragma unroll
            for (int i = 0; i < 4; ++i) *(LAS u32x4*)(wl + ((lane >> 3) + 8 * i) * VPITCH + (lane & 7) * 16) = T.v[i];
        }
        if (ti + 1 < nt) tile_load<SAMPLE>(C, T, ti + 1, b, h, g, r4, ncls, lane);
        f32x16 p = {};
#pragma unroll
        for (int d0 = 0; d0 < 4; ++d0) p = __builtin_amdgcn_mfma_f32_32x32x16_bf16(kf[d0], qf[d0], p, 0, 0, 0);
        if (SAMPLE) {
            if (ti < 17) { const int dbase = (WINB + r32) - (1536 + 32 * (16 - ti));
#pragma unroll
                for (int r = 0; r < 16; ++r) { const int d = dbase - crow(r, hi); const int mult = (d >= 0 && d <= 128) + (d >= 0 && d <= 512 && !(d & 3)) + (d >= 0 && !(d & 15));
                    p[r] = (mult == 0 || r32 >= 8) ? NEGF : p[r] + (mult == 1 ? 0.f : (mult == 2 ? 1.f : 1.5849625f)); } }
            else {
#pragma unroll
                for (int r = 0; r < 16; ++r) p[r] = ((crow(r, hi) & 7) == r32) ? p[r] : NEGF; }
        } else {
            if (ti < ncls) { const int dbase = (32 * g + r32) - 32 * (g - ti);
#pragma unroll
                for (int r = 0; r < 16; ++r) { const int d = dbase - crow(r, hi); const int mult = (d >= 0 && d <= 128) + (d >= 0 && !(d & 3));
                    p[r] = mult == 0 ? NEGF : p[r] + (mult == 2 ? 1.f : 0.f); } }
            else { const int jj = ti - ncls + (g == 0 ? 4 : 0); const int dbase = (128 * g + 4 * r32 + r4) - (128 * g - 128 + 32 * jj);
#pragma unroll
                for (int r = 0; r < 16; ++r) { const int d = dbase - crow(r, hi); p[r] = (d >= 0 && d <= 128) ? p[r] : NEGF; } }
        }
        float rm = p[0];
#pragma unroll
        for (int r = 1; r < 16; ++r) rm = fmaxf(rm, p[r]);
        rm = swapmax(rm);
        const float mnew = fmaxf(mrun, rm);
        const float f = __builtin_amdgcn_exp2f(mrun - mnew);
        mrun = mnew;
        float ls = 0.f;
#pragma unroll
        for (int r = 0; r < 16; ++r) { p[r] = __builtin_amdgcn_exp2f(p[r] - mnew); ls += p[r]; }
        lrun = lrun * f + ls;
        if (hi == 0) wsf[r32] = f;
        u32x4 pa0, pa1;
        pa0.x = cvt_pk_bf16(p[0], p[1]); pa0.y = cvt_pk_bf16(p[2], p[3]); pa0.z = cvt_pk_bf16(p[4], p[5]); pa0.w = cvt_pk_bf16(p[6], p[7]);
        pa1.x = cvt_pk_bf16(p[8], p[9]); pa1.y = cvt_pk_bf16(p[10], p[11]); pa1.z = cvt_pk_bf16(p[12], p[13]); pa1.w = cvt_pk_bf16(p[14], p[15]);
#pragma unroll
        for (int r = 0; r < 16; ++r) { const float fr_ = wsf[crow(r, hi)]; o0[r] *= fr_; o1[r] *= fr_; }
#pragma unroll
        for (int sl = 0; sl < 2; ++sl) {
            const bf16x8 pa = __builtin_bit_cast(bf16x8, sl == 0 ? pa0 : pa1);
#pragma unroll
            for (int c = 0; c < 2; ++c) {
                const s16x4 lo = vtr(wl + vrd + (16 * sl) * VPITCH + 64 * c), hi4 = vtr(wl + vrd + (16 * sl + 8) * VPITCH + 64 * c);
                const bf16x8 vf = (bf16x8){lo[0], lo[1], lo[2], lo[3], hi4[0], hi4[1], hi4[2], hi4[3]};
                if (c == 0) o0 = __builtin_amdgcn_mfma_f32_32x32x16_bf16(pa, vf, o0, 0, 0, 0); else o1 = __builtin_amdgcn_mfma_f32_32x32x16_bf16(pa, vf, o1, 0, 0, 0);
            }
        }
    }
    const float lt = swapsum(lrun);
    if (hi == 0) wsf[32 + r32] = 1.f / lt;
#pragma unroll
    for (int r = 0; r < 16; ++r) {
        const int q = crow(r, hi); const float rl = wsf[32 + q];
        unsigned orow; bool ok = true;
        if (SAMPLE) { ok = q < 8; orow = (unsigned)(MP + b * 8 + (q & 7)); } else orow = (unsigned)(b * SEQ + 4 * (32 * g + q) + r4);
        if (ok) { bf16_t* op = C.MIX + (orow * 1024u + h * 64 + r32);
            op[0] = (bf16_t)(cvt_pk_bf16(o0[r] * rl, 0.f) & 0xffffu); op[32] = (bf16_t)(cvt_pk_bf16(o1[r] * rl, 0.f) & 0xffffu); }
    }
}

struct GlaCtx { const bf16_t *QB, *KB, *VB, *RB; const float* LF; bf16_t* MIX; const float* gnorm; };
constexpr int GQ_P = 72, GT_P = 40;
constexpr int G_QE = 0, G_KE = 32 * GQ_P * 2, G_KT = G_KE + 32 * GQ_P * 2, G_EB = G_KT + 64 * GT_P * 2, G_BUF = G_EB + 256;
constexpr int GL_V = 2 * G_BUF;
constexpr int GL_O = GL_V + 2 * 4 * 2048;
constexpr int GL_END = GL_O + 2 * 4 * 4608;
static_assert(GL_END <= 131072, "gla lds");
#define LDS_BARRIER() do { asm volatile("s_waitcnt lgkmcnt(0)" ::: "memory"); __builtin_amdgcn_s_barrier(); asm volatile("" ::: "memory"); } while (0)
typedef float f32x8 __attribute__((ext_vector_type(8)));
typedef unsigned u32x8 __attribute__((ext_vector_type(8)));
typedef unsigned u32x16 __attribute__((ext_vector_type(16)));
struct GlaPre { f32x8 lf; u32x8 q, k; u32x4 v0, v1; };

template <int nvalid> __device__ __forceinline__ void gla_h_loads(const GlaCtx& C, GlaPre& P, unsigned t0, int h, int dk, int tg, int dvs, int lane) {
    const bool ok = 8 * tg < nvalid;
    const unsigned off = (t0 + (ok ? 8 * tg : 0)) * 256u + h * 64 + dk;
    const GAS float* lp = (const GAS float*)(C.LF + off); const GAS bf16_t* qp = (const GAS bf16_t*)(C.QB + off); const GAS bf16_t* kp = (const GAS bf16_t*)(C.KB + off);
#pragma unroll
    for (int e = 0; e < 8; ++e) { P.lf[e] = lp[e * 256]; P.q[e] = (unsigned)qp[e * 256]; P.k[e] = (unsigned)kp[e * 256]; }
    const int i = lane >> 1; const bool okv = i < nvalid; const GAS bf16_t* p = (const GAS bf16_t*)(C.VB + ((t0 + (okv ? i : 0)) * 512u + h * 128 + 32 * dvs + 16 * (lane & 1)));
    P.v0 = *(const GAS u32x4*)p; P.v1 = *(const GAS u32x4*)(p + 8);
}
struct GlaGate { u32x4 g0, g1; };
template <int nvalid> __device__ __forceinline__ void gla_h_interval(const GlaCtx& C, LAS unsigned char* lds, GlaPre& P, GlaGate& G, const f32x4 (&gn)[4], int j, int nchunk, int hw, int lane, unsigned row0, int h) {
    const int tg = lane >> 4, dkl = lane & 15, dk = 16 * hw + dkl;
    const int ft = lane >> 3, dvg = lane & 7;
    const bool fin_ok = 8 * hw < nvalid;
    if (j >= 2 && fin_ok) {
        const int c = j - 2; const int ob = c & 1;
        const LAS float* op = (const LAS float*)(lds + GL_O + (ob * 4 + (dvg >> 1)) * 4608) + (8 * hw + ft) * 36 + 16 * (dvg & 1);
        f32x4 o[4]; float s = 0.f;
#pragma unroll
        for (int k4 = 0; k4 < 4; ++k4) { o[k4] = *(const LAS f32x4*)(op + 4 * k4); s += (o[k4].x * o[k4].x + o[k4].y * o[k4].y) + (o[k4].z * o[k4].z + o[k4].w * o[k4].w); }
        s += __shfl_xor(s, 1); s += __shfl_xor(s, 2); s += __shfl_xor(s, 4);
        const float rs = rsqrtf(s * (1.f / 128.f) + EPS);
        const u32x4 g0 = G.g0, g1 = G.g1;
        float gt[16];
        gt[0] = __uint_as_float(g0.x << 16); gt[1] = __uint_as_float(g0.x & 0xffff0000u); gt[2] = __uint_as_float(g0.y << 16); gt[3] = __uint_as_float(g0.y & 0xffff0000u);
        gt[4] = __uint_as_float(g0.z << 16); gt[5] = __uint_as_float(g0.z & 0xffff0000u); gt[6] = __uint_as_float(g0.w << 16); gt[7] = __uint_as_float(g0.w & 0xffff0000u);
        gt[8] = __uint_as_float(g1.x << 16); gt[9] = __uint_as_float(g1.x & 0xffff0000u); gt[10] = __uint_as_float(g1.y << 16); gt[11] = __uint_as_float(g1.y & 0xffff0000u);
        gt[12] = __uint_as_float(g1.z << 16); gt[13] = __uint_as_float(g1.z & 0xffff0000u); gt[14] = __uint_as_float(g1.w << 16); gt[15] = __uint_as_float(g1.w & 0xffff0000u);
        float val[16];
#pragma unroll
        for (int k = 0; k < 16; ++k) { const float rg = gt[k]; val[k] = o[k >> 2][k & 3] * rs * gn[k >> 2][k & 3] * rg * __builtin_amdgcn_rcpf(1.f + __expf(-rg)); }
        u32x4 w0, w1;
        w0.x = cvt_pk_bf16(val[0], val[1]); w0.y = cvt_pk_bf16(val[2], val[3]); w0.z = cvt_pk_bf16(val[4], val[5]); w0.w = cvt_pk_bf16(val[6], val[7]);
        w1.x = cvt_pk_bf16(val[8], val[9]); w1.y = cvt_pk_bf16(val[10], val[11]); w1.z = cvt_pk_bf16(val[12], val[13]); w1.w = cvt_pk_bf16(val[14], val[15]);
        bf16_t* mp = C.MIX + ((row0 + 32u * c + 8 * hw + ft) * 1024u + 512 + h * 128 + 16 * dvg);
        *(GAS u32x4*)mp = w0; *(GAS u32x4*)(mp + 8) = w1;
    }
    if (j < nchunk) {
        const int buf = j & 1;
        LAS unsigned char* sh = lds + buf * G_BUF;
        LAS bf16_t* qe_l = (LAS bf16_t*)(sh + G_QE); LAS bf16_t* ke_l = (LAS bf16_t*)(sh + G_KE); LAS bf16_t* kt_l = (LAS bf16_t*)(sh + G_KT); LAS float* eb_l = (LAS float*)(sh + G_EB);
        LAS unsigned char* vl = lds + GL_V + (buf * 4 + hw) * 2048;
        const bool okp = 8 * tg < nvalid, okv = (lane >> 1) < nvalid;
        if (!okp) { P.lf = (f32x8){0.f, 0.f, 0.f, 0.f, 0.f, 0.f, 0.f, 0.f}; P.q = (u32x8){0u, 0u, 0u, 0u, 0u, 0u, 0u, 0u}; P.k = P.q; }
        if (!okv) { P.v0 = (u32x4){0u, 0u, 0u, 0u}; P.v1 = P.v0; }
        f32x8 cs; float run = 0.f;
#pragma unroll
        for (int e = 0; e < 8; ++e) { run += P.lf[e]; cs[e] = run; }
        float offs = 0.f, tot = 0.f;
#pragma unroll
        for (int t = 0; t < 4; ++t) { const float Tt = __shfl(run, dkl + 16 * t); tot += Tt; offs += (t < tg) ? Tt : 0.f; }
        u32x8 kb;
#pragma unroll
        for (int e = 0; e < 8; ++e) { const float bb = offs + cs[e]; const float eb = __expf(bb), ei = __expf(-bb); const int i = 8 * tg + e;
            qe_l[i * GQ_P + dk] = (bf16_t)(cvt_pk_bf16(__uint_as_float(P.q[e] << 16) * 0.125f * eb, 0.f) & 0xffffu);
            kb[e] = cvt_pk_bf16(__uint_as_float(P.k[e] << 16) * ei, 0.f) & 0xffffu;
            ke_l[i * GQ_P + dk] = (bf16_t)kb[e]; }
        u32x4 w; w.x = kb[0] | (kb[1] << 16); w.y = kb[2] | (kb[3] << 16); w.z = kb[4] | (kb[5] << 16); w.w = kb[6] | (kb[7] << 16);
        *(LAS u32x4*)(kt_l + dk * GT_P + 8 * tg) = w;
        if (tg == 0) eb_l[dk] = __expf(tot);
        *(LAS u32x4*)(vl + (lane >> 1) * 64 + (lane & 1) * 32) = P.v0; *(LAS u32x4*)(vl + (lane >> 1) * 64 + (lane & 1) * 32 + 16) = P.v1;
    }
    if (j + 3 < nchunk) gla_h_loads<nvalid>(C, P, row0 + 32u * (j + 3), h, dk, tg, hw, lane);
    if (j + 1 < nchunk && fin_ok) { const bf16_t* rp = C.RB + ((row0 + 32u * (j + 1) + 8 * hw + ft) * 512u + h * 128 + 16 * dvg); G.g0 = *(const GAS u32x4*)rp; G.g1 = *(const GAS u32x4*)(rp + 8); }
    if (j <= nchunk) LDS_BARRIER();
}
template <int nvalid> __device__ __forceinline__ void gla_h_wave(const GlaCtx& C, LAS unsigned char* lds, int hw  , int lane, unsigned row0, int h, int nchunk) {
    const int tg = lane >> 4, dkl = lane & 15, dk = 16 * hw + dkl;
    const int ft = lane >> 3, dvg = lane & 7;
    f32x4 gn[4];
#pragma unroll
    for (int k4 = 0; k4 < 4; ++k4) gn[k4] = *(const f32x4*)(C.gnorm + h * 128 + 16 * dvg + 4 * k4);
    GlaPre P0, P1, P2; GlaGate G0 = {}, G1 = {}, G2 = {};
    gla_h_loads<nvalid>(C, P0, row0, h, dk, tg, hw, lane);
    if (1 < nchunk) gla_h_loads<nvalid>(C, P1, row0 + 32u, h, dk, tg, hw, lane);
    if (2 < nchunk) gla_h_loads<nvalid>(C, P2, row0 + 64u, h, dk, tg, hw, lane);
    if (8 * hw < nvalid) { const bf16_t* rp = C.RB + ((row0 + 8 * hw + ft) * 512u + h * 128 + 16 * dvg); G0.g0 = *(const GAS u32x4*)rp; G0.g1 = *(const GAS u32x4*)(rp + 8); }
    for (int j = 0; j <= nchunk + 1; j += 3) {
        gla_h_interval<nvalid>(C, lds, P0, G1, gn, j, nchunk, hw, lane, row0, h);
        if (j + 1 <= nchunk + 1) gla_h_interval<nvalid>(C, lds, P1, G2, gn, j + 1, nchunk, hw, lane, row0, h);
        if (j + 2 <= nchunk + 1) gla_h_interval<nvalid>(C, lds, P2, G0, gn, j + 2, nchunk, hw, lane, row0, h);
    }
}
template <int nvalid> __device__ __forceinline__ void gla_m_wave(LAS unsigned char* lds, int dvs, int lane, int nchunk, const float* s_in, float* s_out) {
    const int r32 = lane & 31, hi = lane >> 5;
    f32x16 S0 = {}, S1 = {};
    unsigned soff = (unsigned)(4 * hi * 128 + 32 * dvs + r32); asm volatile("" : "+v"(soff));
    if (s_in) {
#pragma unroll
        for (int r = 0; r < 16; ++r) { const unsigned o_ = soff + (unsigned)(((r & 3) + 8 * (r >> 2)) * 128); S0[r] = s_in[o_]; S1[r] = s_in[o_ + 4096u]; }
    }
    const int vrd = (4 * hi + ((lane & 15) >> 2)) * 64 + (((lane >> 4) & 1) * 16 + (lane & 3) * 4) * 2;
    LDS_BARRIER();
    for (int c = 0; c < nchunk; ++c) {
        const int buf = c & 1;
        LAS unsigned char* sh = lds + buf * G_BUF;
        LAS bf16_t* qe_l = (LAS bf16_t*)(sh + G_QE); LAS bf16_t* ke_l = (LAS bf16_t*)(sh + G_KE); LAS bf16_t* kt_l = (LAS bf16_t*)(sh + G_KT); LAS float* eb_l = (LAS float*)(sh + G_EB);
        const LAS unsigned char* vl = lds + GL_V + (buf * 4 + dvs) * 2048;
        f32x16 at = {};
#pragma unroll
        for (int s = 0; s < 4; ++s) { const bf16x8 a = *(const LAS bf16x8*)(ke_l + r32 * GQ_P + 16 * s + 8 * hi), bq = *(const LAS bf16x8*)(qe_l + r32 * GQ_P + 16 * s + 8 * hi);
            at = __builtin_amdgcn_mfma_f32_32x32x16_bf16(a, bq, at, 0, 0, 0); }
#pragma unroll
        for (int r = 0; r < 16; ++r) at[r] = (crow(r, hi) <= r32) ? at[r] : 0.f;
        u32x4 pa0, pa1;
        pa0.x = cvt_pk_bf16(at[0], at[1]); pa0.y = cvt_pk_bf16(at[2], at[3]); pa0.z = cvt_pk_bf16(at[4], at[5]); pa0.w = cvt_pk_bf16(at[6], at[7]);
        pa1.x = cvt_pk_bf16(at[8], at[9]); pa1.y = cvt_pk_bf16(at[10], at[11]); pa1.z = cvt_pk_bf16(at[12], at[13]); pa1.w = cvt_pk_bf16(at[14], at[15]);
        bf16x8 vf0, vf1;
        { const s16x4 lo = vtr(vl + vrd), h4 = vtr(vl + vrd + 8 * 64); vf0 = (bf16x8){lo[0], lo[1], lo[2], lo[3], h4[0], h4[1], h4[2], h4[3]}; }
        { const s16x4 lo = vtr(vl + vrd + 16 * 64), h4 = vtr(vl + vrd + 24 * 64); vf1 = (bf16x8){lo[0], lo[1], lo[2], lo[3], h4[0], h4[1], h4[2], h4[3]}; }
        f32x16 o = {};
        o = __builtin_amdgcn_mfma_f32_32x32x16_bf16(__builtin_bit_cast(bf16x8, pa0), vf0, o, 0, 0, 0);
        o = __builtin_amdgcn_mfma_f32_32x32x16_bf16(__builtin_bit_cast(bf16x8, pa1), vf1, o, 0, 0, 0);
#pragma unroll
        for (int s = 0; s < 4; ++s) {
            const u32x2 q0 = *(const LAS u32x2*)(qe_l + r32 * GQ_P + 16 * s + 4 * hi), q1 = *(const LAS u32x2*)(qe_l + r32 * GQ_P + 16 * s + 8 + 4 * hi);
            const u32x4 qa = (u32x4){q0.x, q0.y, q1.x, q1.y};
            u32x4 sb;
            if (s == 0) { sb.x = cvt_pk_bf16(S0[0], S0[1]); sb.y = cvt_pk_bf16(S0[2], S0[3]); sb.z = cvt_pk_bf16(S0[4], S0[5]); sb.w = cvt_pk_bf16(S0[6], S0[7]); }
            else if (s == 1) { sb.x = cvt_pk_bf16(S0[8], S0[9]); sb.y = cvt_pk_bf16(S0[10], S0[11]); sb.z = cvt_pk_bf16(S0[12], S0[13]); sb.w = cvt_pk_bf16(S0[14], S0[15]); }
            else if (s == 2) { sb.x = cvt_pk_bf16(S1[0], S1[1]); sb.y = cvt_pk_bf16(S1[2], S1[3]); sb.z = cvt_pk_bf16(S1[4], S1[5]); sb.w = cvt_pk_bf16(S1[6], S1[7]); }
            else { sb.x = cvt_pk_bf16(S1[8], S1[9]); sb.y = cvt_pk_bf16(S1[10], S1[11]); sb.z = cvt_pk_bf16(S1[12], S1[13]); sb.w = cvt_pk_bf16(S1[14], S1[15]); }
            o = __builtin_amdgcn_mfma_f32_32x32x16_bf16(__builtin_bit_cast(bf16x8, qa), __builtin_bit_cast(bf16x8, sb), o, 0, 0, 0);
        }
        { LAS float* ol = (LAS float*)(lds + GL_O + (buf * 4 + dvs) * 4608);
#pragma unroll
          for (int r = 0; r < 16; ++r) ol[crow(r, hi) * 36 + r32] = o[r]; }
        {
            const u32x2 a0 = *(const LAS u32x2*)(kt_l + r32 * GT_P + 4 * hi), a1 = *(const LAS u32x2*)(kt_l + r32 * GT_P + 8 + 4 * hi);
            const u32x2 c0 = *(const LAS u32x2*)(kt_l + (32 + r32) * GT_P + 4 * hi), c1 = *(const LAS u32x2*)(kt_l + (32 + r32) * GT_P + 8 + 4 * hi);
            S0 = __builtin_amdgcn_mfma_f32_32x32x16_bf16(__builtin_bit_cast(bf16x8, (u32x4){a0.x, a0.y, a1.x, a1.y}), vf0, S0, 0, 0, 0);
            S1 = __builtin_amdgcn_mfma_f32_32x32x16_bf16(__builtin_bit_cast(bf16x8, (u32x4){c0.x, c0.y, c1.x, c1.y}), vf0, S1, 0, 0, 0);
        }
        {
            const u32x2 a0 = *(const LAS u32x2*)(kt_l + r32 * GT_P + 16 + 4 * hi), a1 = *(const LAS u32x2*)(kt_l + r32 * GT_P + 24 + 4 * hi);
            const u32x2 c0 = *(const LAS u32x2*)(kt_l + (32 + r32) * GT_P + 16 + 4 * hi), c1 = *(const LAS u32x2*)(kt_l + (32 + r32) * GT_P + 24 + 4 * hi);
            S0 = __builtin_amdgcn_mfma_f32_32x32x16_bf16(__builtin_bit_cast(bf16x8, (u32x4){a0.x, a0.y, a1.x, a1.y}), vf1, S0, 0, 0, 0);
            S1 = __builtin_amdgcn_mfma_f32_32x32x16_bf16(__builtin_bit_cast(bf16x8, (u32x4){c0.x, c0.y, c1.x, c1.y}), vf1, S1, 0, 0, 0);
        }
#pragma unroll
        for (int r = 0; r < 16; ++r) { S0[r] *= eb_l[crow(r, hi)]; S1[r] *= eb_l[32 + crow(r, hi)]; }
        LDS_BARRIER();
    }
    if (s_out) {
        unsigned soff2 = (unsigned)(4 * hi * 128 + 32 * dvs + r32); asm volatile("" : "+v"(soff2));
#pragma unroll
        for (int r = 0; r < 16; ++r) { const unsigned o_ = soff2 + (unsigned)(((r & 3) + 8 * (r >> 2)) * 128); s_out[o_] = S0[r]; s_out[o_ + 4096u] = S1[r]; }
    }
}

#define XB_TMO      128
#define XB_XCNT(j)  (256  + 64 * (j))
#define XB_XSUB(j)  (1280 + 64 * (j))
#define XB_XGEN(j)  (2304 + 64 * (j))
#define XB_TOP      3328
#define XB_TOPGEN   3392
#define XCD_BAR_WORDS 3456
#define XB_SPIN_CAP (1u << 18)
__device__ __forceinline__ unsigned xb_ld(unsigned* p)              { return __hip_atomic_load(p, __ATOMIC_RELAXED, __HIP_MEMORY_SCOPE_AGENT); }
__device__ __forceinline__ unsigned xb_add(unsigned* p, unsigned v) { return __hip_atomic_fetch_add(p, v, __ATOMIC_RELAXED, __HIP_MEMORY_SCOPE_AGENT); }
__device__ __forceinline__ unsigned xb_xcc_id() { return (unsigned)__builtin_amdgcn_s_getreg((3 << 11) | 20) & 0xFu; }
#define XB_SPIN(cond, bar) do { unsigned _sp = 0; while (cond) { __builtin_amdgcn_s_sleep(1); \
    if ((++_sp & 255u) == 0u) { if (xb_ld(&(bar)[XB_TMO])) break; if (_sp > XB_SPIN_CAP) { atomicAdd(&(bar)[XB_TMO], 1u); break; } } } } while (0)
struct XcdBarrier { unsigned* bar; unsigned x; volatile LAS unsigned* st; };
__device__ __forceinline__ XcdBarrier xcd_barrier_post(unsigned* bar, volatile LAS unsigned* st) {
    XcdBarrier b; b.bar = bar; b.x = xb_xcc_id(); b.st = st;
    if (threadIdx.x == 0) (void)xb_add(&bar[XB_XCNT(b.x)], 1u);
    return b;
}
__device__ __forceinline__ void xcd_barrier_complete(unsigned* bar, unsigned x, unsigned& nloc, unsigned& nx) {
    const unsigned G = gridDim.x * gridDim.y * gridDim.z;
    unsigned sum, cnt, mine, sp = 0u;
    for (;;) {
        sum = 0u; cnt = 0u; mine = 0u;
#pragma unroll
        for (unsigned j = 0; j < 16; ++j) { const unsigned c = xb_ld(&bar[XB_XCNT(j)]); sum += c; cnt += (c > 0u) ? 1u : 0u; mine = (j == x) ? c : mine; }
        if (sum == G) break;
        __builtin_amdgcn_s_sleep(1);
        if ((++sp & 255u) == 0u) { if (xb_ld(&bar[XB_TMO])) break; if (sp > XB_SPIN_CAP) { atomicAdd(&bar[XB_TMO], 1u); break; } }
    }
    nloc = mine > 0u ? mine : 1u; nx = cnt > 0u ? cnt : 1u;
}
__device__ __forceinline__ void xcd_barrier(const XcdBarrier& b, int wave0) {
    asm volatile("s_waitcnt vmcnt(0)" ::: "memory");
    __syncthreads();
    if (wave0 == 0 && lane_id_v() == 0) {
        unsigned* bar = b.bar;
        __builtin_amdgcn_s_waitcnt(0);
        unsigned nloc = b.st[0], nx = b.st[1];
        if (nloc == 0u) { xcd_barrier_complete(bar, b.x, nloc, nx); b.st[0] = nloc; b.st[1] = nx; }
        const unsigned old = xb_add(&bar[XB_XSUB(b.x)], 1u);
        const unsigned gen = old / nloc;
        if (old + 1u == (gen + 1u) * nloc) {
            __builtin_amdgcn_fence(__ATOMIC_RELEASE, "agent");
            asm volatile("s_waitcnt vmcnt(0)" ::: "memory");
            const unsigned og = xb_add(&bar[XB_TOP], 1u);
            const unsigned tg = og / nx;
            if (og + 1u == (tg + 1u) * nx) xb_add(&bar[XB_TOPGEN], 1u);
            else XB_SPIN(xb_ld(&bar[XB_TOPGEN]) == tg, bar);
            __builtin_amdgcn_fence(__ATOMIC_ACQUIRE, "agent");
            xb_add(&bar[XB_XGEN(b.x)], 1u);
            asm volatile("s_waitcnt vmcnt(0)" ::: "memory");
        } else {
            XB_SPIN(xb_ld(&bar[XB_XGEN(b.x)]) == gen, bar);
            __builtin_amdgcn_fence(__ATOMIC_ACQUIRE, "agent");
            asm volatile("s_waitcnt vmcnt(0)" ::: "memory");
        }
    }
    __syncthreads();
}

constexpr int LDS_BYTES = 147456;

__global__ void __launch_bounds__(512, 2) hymba_fwd(Args args) {
    extern __shared__ __attribute__((aligned(16))) unsigned char lds_raw[];
    LAS unsigned char* lds = (LAS unsigned char*)lds_raw;
#define PHASE_IDS() const int lane = lane_id_v(); const int wave = wave0; (void)lane; (void)wave
    const int G = gridDim.x, bx = blockIdx.x;
    const int wave0 = __builtin_amdgcn_readfirstlane((int)(threadIdx.x >> 6));
    if (threadIdx.x < 4) ((LAS unsigned*)(lds + XBST_OFF))[threadIdx.x] = 0u;
    __syncthreads();
    const XcdBarrier xbar = xcd_barrier_post((unsigned*)(args.ws + WS_CTL) + 4096, (volatile LAS unsigned*)(lds + XBST_OFF));
    const int vcu = (G % 8 == 0) ? (bx % 8) * (G / 8) + bx / 8 : bx;
    const float* x_prompt = args.in[0]; const float* x_sample = args.in[1];
    const float* w_in = args.in[6]; const float* w_a2 = args.in[7]; const float* b_a = args.in[8];
    const float* w_o = args.in[10]; const float* g_pre_mix = args.in[11];
    const float* w_up = args.in[15]; const float* w_down = args.in[18];
#define PHASE_WS() unsigned char* ws = args.ws; asm volatile("" : "+s"(ws))

    {
        PHASE_IDS(); PHASE_WS();
        bf16_t* WinT = (bf16_t*)(ws + WS_WIN); bf16_t* WoT = (bf16_t*)(ws + WS_WO); bf16_t* WupT = (bf16_t*)(ws + WS_WUP); bf16_t* WdT = (bf16_t*)(ws + WS_WD); bf16_t* XN = (bf16_t*)(ws + WS_XN + 4096);
        LAS float* scr = (LAS float*)(lds + wave * 16384);
        const int gw = vcu * 8 + wave, NGW = G * 8;
        constexpr int I_IN = 16 * 96, I_G = 16 * 8, I_O = 16 * 32, I_UP = 16 * 176, I_D = 44 * 32;
        constexpr int NITEMS = I_IN + I_G + I_O + I_UP + I_D;
        for (int it = gw; it < NITEMS; it += NGW) {
            int r = it;
            if (r < I_IN) { const int kb = r / 96, nb = r % 96; p0_transpose_item(w_in, DIN, 32 * nb, 64 * kb, WinT, 1024, 32 * nb, scr, lane); continue; } r -= I_IN;
            if (r < I_G) { const int kb = r / 8, nb = r % 8; p0_gate_item(w_in, w_a2, 64 * kb, 32 * nb, WinT, scr, lane); continue; } r -= I_G;
            if (r < I_O) { const int kb = r / 32, nb = r % 32; p0_transpose_item(w_o, 1024, 32 * nb, 64 * kb, WoT, 1024, 32 * nb, scr, lane); continue; } r -= I_O;
            if (r < I_UP) { const int kb = r / 176, nb = r % 176; const int n0 = 32 * nb, t = n0 >> 8, w = n0 & 255;
                const int sc = (w < 128) ? (128 * t + w) : (DFF + 128 * t + (w - 128));
                p0_transpose_item(w_up, 2 * DFF, sc, 64 * kb, WupT, 1024, n0, scr, lane); continue; } r -= I_UP;
            { const int kb = r / 32, nb = r % 32; p0_transpose_item(w_down, 1024, 32 * nb, 64 * kb, WdT, DFF, 32 * nb, scr, lane); }
        }
        for (int m = gw; m < MT; m += NGW) {
            const float* xr = (m < MP) ? x_prompt + (size_t)m * DM : x_sample + (size_t)(m - MP) * DM;
            rms_row_to_bf16(xr, g_pre_mix, XN + (size_t)m * DM, lane);
        }
    }
    xcd_barrier(xbar, wave0);

    {
        PHASE_WS();
        pg8::Gemm g{(bf16_t*)(ws + WS_XN + 4096), (bf16_t*)(ws + WS_WIN), 1024, 256, 1024}; pg8::StaticOrder S; S.init(MT / 256, NIN / 256, G, bx);
        EpiInProj E{(bf16_t*)(ws + WS_QA), (bf16_t*)(ws + WS_KA), (bf16_t*)(ws + WS_VA), (bf16_t*)(ws + WS_QB), (bf16_t*)(ws + WS_KB), (bf16_t*)(ws + WS_VB), (bf16_t*)(ws + WS_RB),
                    (float*)(ws + WS_LF), args.out, b_a};
        pg8::gemm_phase<EpiInProj, pg8::StaticOrder>(lds, g, S, E, wave0);
    }
    xcd_barrier(xbar, wave0);

    {
        PHASE_IDS(); PHASE_WS();
        bf16_t* MIX = (bf16_t*)(ws + WS_MIX);
        GlaCtx GC{(const bf16_t*)(ws + WS_QB), (const bf16_t*)(ws + WS_KB), (const bf16_t*)(ws + WS_VB), (const bf16_t*)(ws + WS_RB), (const float*)(ws + WS_LF), MIX, args.in[9]};
        const float* state_gla = args.in[4];
#ifndef NO_GLA
        for (int it = bx; it < 64 + 128; it += G) {
            const bool pr = it < 64; const int seq = pr ? it : it - 64; const int b = seq >> 2, h = seq & 3;
            const size_t row0 = pr ? (size_t)b * SEQ : (size_t)MP + (size_t)b * 8;
            const float* s_in = pr ? nullptr : state_gla + (size_t)seq * 8192;
            float* s_out = args.out + (pr ? O_GP : O_GS) + (size_t)seq * 8192;
            const int nchunk = pr ? SEQ / 32 : 1;
            if (wave < 4) { if (pr) gla_m_wave<32>(lds, wave, lane, nchunk, s_in, s_out); else gla_m_wave<8>(lds, wave, lane, nchunk, s_in, s_out); }
            else { if (pr) gla_h_wave<32>(GC, lds, wave - 4, lane, (unsigned)row0, h, nchunk); else gla_h_wave<8>(GC, lds, wave - 4, lane, (unsigned)row0, h, nchunk); }
            __syncthreads();
        }
#endif
        AttnCtx AC{(const bf16_t*)(ws + WS_QA), (const bf16_t*)(ws + WS_KA), (const bf16_t*)(ws + WS_VA), MIX, args.in[2], args.in[3]};
        unsigned* counter = (unsigned*)(ws + WS_CTL);
        LAS unsigned char* wl = lds + wave * 8192;
        const int lane2 = lane_id_v();
        for (int sb = (bx + 64) % G; sb < NSB; sb += G) attn_item<true>(AC, sb, wave, 0, 0, wl, lane2);
        const unsigned xq0 = xb_xcc_id() & 7u;
        for (unsigned kq = 0; kq < 8u; ++kq) {
            const unsigned xq = (xq0 + kq) & 7u;
            unsigned* head = counter + 64 * xq;
            for (;;) {
                unsigned loc = 0; if (lane2 == 0) loc = atomicAdd(head, 1u);
                loc = (unsigned)__builtin_amdgcn_readfirstlane((int)loc);
                if (loc >= 1024u) break;
                { const unsigned p = loc; const unsigned grp = p >> 8, q = p & 255u; const int g = 15 - (int)(q >> 4); const unsigned bhl = (q >> 2) & 3u; const int r4 = (int)(q & 3u);
                    const int bh = (int)(xq + 8u * (4u * grp + bhl));
                    attn_item<false>(AC, bh >> 3, bh & 7, g, r4, wl, lane2); }
            }
        }
    }
    xcd_barrier(xbar, wave0);

    {
        PHASE_WS();
        bf16_t* MO = (bf16_t*)(ws + WS_MO); float* SSQ1 = (float*)(ws + WS_SSQ1);
        pg8::Gemm g{(bf16_t*)(ws + WS_MIX), (bf16_t*)(ws + WS_WO), 1024, 256, 1024}; pg8::StaticOrder S; S.init(MP / 256, 4, G, bx);
        EpiRowOut E{MO, SSQ1};
        pg8::gemm_phase<EpiRowOut, pg8::StaticOrder>(lds, g, S, E, wave0);
        pg8::Gemm g2{(bf16_t*)(ws + WS_MIX), (bf16_t*)(ws + WS_WO), 256, 256, 1024}; pg8::SplitOrder S2{16, G, bx, 128, 256};
        EpiSlice E2{(float*)(ws + WS_ACC1), 256};
        pg8::gemm_phase<EpiSlice, pg8::SplitOrder>(lds, g2, S2, E2, wave0);
    }
    xcd_barrier(xbar, wave0);
    {
        PHASE_IDS(); PHASE_WS();
        bf16_t* MO = (bf16_t*)(ws + WS_MO); float* SSQ1 = (float*)(ws + WS_SSQ1); bf16_t* XN = (bf16_t*)(ws + WS_XN + 4096);
        const float* g_post = args.in[12]; const float* g_pre = args.in[13];
        const int gw = vcu * 8 + wave, NGW = G * 8;
        {
            f32x4 gp4[4], gq4[4];
#pragma unroll
            for (int j = 0; j < 4; ++j) { gp4[j] = ((const GAS f32x4*)g_post)[64 * j + lane]; gq4[j] = ((const GAS f32x4*)g_pre)[64 * j + lane]; }
            for (int m0 = gw; m0 < MP; m0 += 2 * NGW) {
                const int m1 = (m0 + NGW < MP) ? m0 + NGW : m0;
                f32x4 sp[2], xv[2][4]; u32x2 mw[2][4];
#pragma unroll
                for (int r = 0; r < 2; ++r) { const int m = r ? m1 : m0; sp[r] = *((const GAS f32x4*)(SSQ1 + (size_t)m * 16) + (lane & 3));
#pragma unroll
                    for (int j = 0; j < 4; ++j) { xv[r][j] = __builtin_nontemporal_load((const GAS f32x4*)(x_prompt + (size_t)m * DM) + 64 * j + lane); mw[r][j] = ((const GAS u32x2*)(MO + (size_t)m * DM))[64 * j + lane]; } }
#pragma unroll
                for (int r = 0; r < 2; ++r) if (r == 0 || m1 != m0) { const int m = r ? m1 : m0;
                    float ss = (sp[r].x + sp[r].y) + (sp[r].z + sp[r].w); ss += __shfl_xor(ss, 1); ss += __shfl_xor(ss, 2);
                    const float rs = rsqrtf(ss * (1.f / DM) + EPS);
                    f32x4 x1[4]; float s2 = 0.f;
#pragma unroll
                    for (int j = 0; j < 4; ++j) { f32x4 mv; mv.x = __uint_as_float(mw[r][j].x << 16); mv.y = __uint_as_float(mw[r][j].x & 0xffff0000u); mv.z = __uint_as_float(mw[r][j].y << 16); mv.w = __uint_as_float(mw[r][j].y & 0xffff0000u);
                        x1[j] = xv[r][j] + mv * rs * gp4[j]; s2 += (x1[j].x * x1[j].x + x1[j].y * x1[j].y) + (x1[j].z * x1[j].z + x1[j].w * x1[j].w);
                        }
                    const float rs2 = rsqrtf(wave_sum(s2) * (1.f / DM) + EPS);
#pragma unroll
                    for (int j = 0; j < 4; ++j) { const f32x4 y = x1[j] * rs2 * gq4[j]; u32x2 w; w.x = pk2(y.x, y.y); w.y = pk2(y.z, y.w); ((GAS u32x2*)(XN + (size_t)m * DM))[64 * j + lane] = w; }
                }
            }
        }
        for (int m = MP + gw; m < MT; m += NGW) {
            const float* xr = (m < MP) ? x_prompt + (size_t)m * DM : x_sample + (size_t)(m - MP) * DM;
            float* orow = args.out + (size_t)m * DM;
            f32x4 mvv[4]; float ss;
            if (m < MP) {
                const f32x4 sp = *((const f32x4*)(SSQ1 + (size_t)m * 16) + (lane & 3));
                ss = (sp.x + sp.y) + (sp.z + sp.w); ss += __shfl_xor(ss, 1); ss += __shfl_xor(ss, 2);
#pragma unroll
                for (int j = 0; j < 4; ++j) { const u32x2 mw = ((const u32x2*)(MO + (size_t)m * DM))[64 * j + lane];
                    mvv[j].x = __uint_as_float(mw.x << 16); mvv[j].y = __uint_as_float(mw.x & 0xffff0000u); mvv[j].z = __uint_as_float(mw.y << 16); mvv[j].w = __uint_as_float(mw.y & 0xffff0000u); }
            } else {
                const f32x4* ar = (const f32x4*)(ws + WS_ACC1) + (size_t)(m - MP) * 256; float s = 0.f;
#pragma unroll
                for (int j = 0; j < 4; ++j) { f32x4 a = ar[64 * j + lane];
                    for (int sl = 1; sl < 4; ++sl) a += ar[(size_t)sl * 65536 + 64 * j + lane];
                    mvv[j] = a; s += (a.x * a.x + a.y * a.y) + (a.z * a.z + a.w * a.w); }
                ss = wave_sum(s);
            }
            const float rs = rsqrtf(ss * (1.f / DM) + EPS);
            f32x4 x1[4]; float s2 = 0.f;
#pragma unroll
            for (int j = 0; j < 4; ++j) { const int c4 = 64 * j + lane; const f32x4 xv = ((const f32x4*)xr)[c4]; const f32x4 gp = ((const f32x4*)g_post)[c4];
                const f32x4 mv = mvv[j];
                x1[j] = xv + mv * rs * gp; s2 += (x1[j].x * x1[j].x + x1[j].y * x1[j].y) + (x1[j].z * x1[j].z + x1[j].w * x1[j].w);
                ((f32x4*)orow)[c4] = x1[j]; }
            const float rs2 = rsqrtf(wave_sum(s2) * (1.f / DM) + EPS);
#pragma unroll
            for (int j = 0; j < 4; ++j) { const int c4 = 64 * j + lane; const f32x4 gq = ((const f32x4*)g_pre)[c4]; const f32x4 y = x1[j] * rs2 * gq; u32x2 w; w.x = pk2(y.x, y.y); w.y = pk2(y.z, y.w); ((u32x2*)(XN + (size_t)m * DM))[c4] = w; }
        }
    }
    xcd_barrier(xbar, wave0);
    {
        PHASE_WS();
        bf16_t* Hb = (bf16_t*)(ws + WS_H);
        pg8::Gemm g{(bf16_t*)(ws + WS_XN + 4096) - 2 * DM, (bf16_t*)(ws + WS_WUP), 1024, 254, 1024}; pg8::StaticOrder S; S.init(131, 22, G, bx);
        EpiUp E{Hb, args.out, args.in[16], args.in[17], args.in[5], lds};
        pg8::gemm_phase<EpiUp, pg8::StaticOrder>(lds, g, S, E, wave0);
    }
    xcd_barrier(xbar, wave0);
    {
        PHASE_WS();
        bf16_t* MO = (bf16_t*)(ws + WS_XN + 4096); float* SSQ2 = (float*)(ws + WS_SSQ2);
        pg8::Gemm g{(bf16_t*)(ws + WS_H), (bf16_t*)(ws + WS_WD), DFF, 256, DFF}; pg8::StaticOrder S; S.init(MP / 256, 4, G, bx);
        EpiRowOut E{MO, SSQ2};
        pg8::gemm_phase<EpiRowOut, pg8::StaticOrder>(lds, g, S, E, wave0);
        pg8::Gemm g2{(bf16_t*)(ws + WS_H), (bf16_t*)(ws + WS_WD), 256, 256, DFF}; pg8::SplitOrder S2{44, G, bx, 128, 256};
        EpiSlice E2{(float*)(ws + WS_ACC2), 256};
        pg8::gemm_phase<EpiSlice, pg8::SplitOrder>(lds, g2, S2, E2, wave0);
    }
    xcd_barrier(xbar, wave0);
    {
        PHASE_IDS(); PHASE_WS();
        bf16_t* MO = (bf16_t*)(ws + WS_MO); float* SSQ2 = (float*)(ws + WS_SSQ2);
        const float* g_post = args.in[14];
        const int gw = vcu * 8 + wave, NGW = G * 8;
        {
            const bf16_t* MO1 = (const bf16_t*)(ws + WS_MO); const bf16_t* FO = (const bf16_t*)(ws + WS_XN + 4096); const float* SSQ1 = (const float*)(ws + WS_SSQ1);
            const float* g_mix = args.in[12];
            f32x4 ga[4], gb[4];
#pragma unroll
            for (int j = 0; j < 4; ++j) { ga[j] = ((const GAS f32x4*)g_mix)[64 * j + lane]; gb[j] = ((const GAS f32x4*)g_post)[64 * j + lane]; }
            for (int m0 = gw; m0 < MP; m0 += 2 * NGW) {
                const int m1 = (m0 + NGW < MP) ? m0 + NGW : m0;
                f32x4 sa[2], sb[2], xv[2][4]; u32x2 mw[2][4], fw[2][4];
#pragma unroll
                for (int r = 0; r < 2; ++r) { const int m = r ? m1 : m0; sa[r] = *((const GAS f32x4*)(SSQ1 + (size_t)m * 16) + (lane & 3)); sb[r] = *((const GAS f32x4*)(SSQ2 + (size_t)m * 16) + (lane & 3));
#pragma unroll
                    for (int j = 0; j < 4; ++j) { xv[r][j] = __builtin_nontemporal_load((const GAS f32x4*)(x_prompt + (size_t)m * DM) + 64 * j + lane); mw[r][j] = ((const GAS u32x2*)(MO1 + (size_t)m * DM))[64 * j + lane]; fw[r][j] = ((const GAS u32x2*)(FO + (size_t)m * DM))[64 * j + lane]; } }
#pragma unroll
                for (int r = 0; r < 2; ++r) if (r == 0 || m1 != m0) { const int m = r ? m1 : m0;
                    float s1 = (sa[r].x + sa[r].y) + (sa[r].z + sa[r].w); s1 += __shfl_xor(s1, 1); s1 += __shfl_xor(s1, 2);
                    float s2 = (sb[r].x + sb[r].y) + (sb[r].z + sb[r].w); s2 += __shfl_xor(s2, 1); s2 += __shfl_xor(s2, 2);
                    const float rs1 = rsqrtf(s1 * (1.f / DM) + EPS), rs2 = rsqrtf(s2 * (1.f / DM) + EPS);
#pragma unroll
                    for (int j = 0; j < 4; ++j) { f32x4 mv, fv;
                        mv.x = __uint_as_float(mw[r][j].x << 16); mv.y = __uint_as_float(mw[r][j].x & 0xffff0000u); mv.z = __uint_as_float(mw[r][j].y << 16); mv.w = __uint_as_float(mw[r][j].y & 0xffff0000u);
                        fv.x = __uint_as_float(fw[r][j].x << 16); fv.y = __uint_as_float(fw[r][j].x & 0xffff0000u); fv.z = __uint_as_float(fw[r][j].y << 16); fv.w = __uint_as_float(fw[r][j].y & 0xffff0000u);
                        const f32x4 x1 = xv[r][j] + mv * rs1 * ga[j];
                        ((GAS f32x4*)(args.out + (size_t)m * DM))[64 * j + lane] = x1 + fv * rs2 * gb[j]; }
                }
            }
        }
        for (int m = MP + gw; m < MT; m += NGW) {
            float* orow = args.out + (size_t)m * DM;
            f32x4 mvv[4]; float ss;
            if (m < MP) {
                const f32x4 sp = *((const f32x4*)(SSQ2 + (size_t)m * 16) + (lane & 3));
                ss = (sp.x + sp.y) + (sp.z + sp.w); ss += __shfl_xor(ss, 1); ss += __shfl_xor(ss, 2);
#pragma unroll
                for (int j = 0; j < 4; ++j) { const u32x2 mw = ((const u32x2*)(MO + (size_t)m * DM))[64 * j + lane];
                    mvv[j].x = __uint_as_float(mw.x << 16); mvv[j].y = __uint_as_float(mw.x & 0xffff0000u); mvv[j].z = __uint_as_float(mw.y << 16); mvv[j].w = __uint_as_float(mw.y & 0xffff0000u); }
            } else {
                const f32x4* ar = (const f32x4*)(ws + WS_ACC2) + (size_t)(m - MP) * 256; float s = 0.f;
#pragma unroll
                for (int j = 0; j < 4; ++j) { f32x4 a = ar[64 * j + lane];
                    for (int sl = 1; sl < 11; ++sl) a += ar[(size_t)sl * 65536 + 64 * j + lane];
                    mvv[j] = a; s += (a.x * a.x + a.y * a.y) + (a.z * a.z + a.w * a.w); }
                ss = wave_sum(s);
            }
            const float rs = rsqrtf(ss * (1.f / DM) + EPS);
#pragma unroll
            for (int j = 0; j < 4; ++j) { const int c4 = 64 * j + lane; const f32x4 xv = ((const f32x4*)orow)[c4]; const f32x4 gp = ((const f32x4*)g_post)[c4];
                ((f32x4*)orow)[c4] = xv + mvv[j] * rs * gp; }
        }
    }
}

extern "C" void kernel_launch(void* const* d_in, const int* in_sizes, int n_in, void* d_out, int out_size, void* d_ws, size_t ws_size, hipStream_t stream) {
    static int grid = 0;
    if (grid == 0) {
        if (n_in != 19 || ws_size < WS_END || (size_t)out_size != O_END) { fprintf(stderr, "kernel_launch: unexpected shapes n_in %d out %d ws %zu\n", n_in, out_size, ws_size); grid = -1; return; }
        int dev = 0, cus = 0, per_cu = 0;
        hipGetDevice(&dev); hipDeviceGetAttribute(&cus, hipDeviceAttributeMultiprocessorCount, dev);
        hipFuncSetAttribute((const void*)hymba_fwd, hipFuncAttributeMaxDynamicSharedMemorySize, LDS_BYTES);
        hipOccupancyMaxActiveBlocksPerMultiprocessor(&per_cu, (const void*)hymba_fwd, 512, LDS_BYTES);
        if (per_cu < 1) { fprintf(stderr, "kernel_launch: occupancy query says %d blocks per CU\n", per_cu); grid = -1; return; }
        grid = cus;
    }
    if (grid < 0) return;
    hipMemsetAsync((char*)d_ws + WS_CTL, 0, CTL_BYTES, stream);
    Args a{};
    for (int i = 0; i < 19; ++i) a.in[i] = (const float*)d_in[i];
    a.out = (float*)d_out; a.ws = (unsigned char*)d_ws;
    void* kargs[] = {&a};
    hipError_t e = hipLaunchCooperativeKernel((const void*)hymba_fwd, dim3(grid), dim3(512), kargs, LDS_BYTES, stream);
    if (e != hipSuccess) fprintf(stderr, "cooperative launch failed: %s (grid %d)\n", hipGetErrorString(e), grid);
}
```
